# Optimizing an MI355X kernel written in HIP

```python
import math
import jax
import jax.numpy as jnp
from jax import lax
import numpy as np

D_MODEL = 1024
BATCH = 4
SEQ = 4096
DEPTH = 4
DEC_BATCH = 32
DEC_SEQ = 64
PAST_LEN = 1024

CHUNK = 64
EPS = 1e-6
N_EVEN = (DEPTH + 1) // 2
N_ODD = DEPTH // 2
GDN_HEADS = 4
GDN_DK = 128
GDN_DV = 128
GDN_CONV = 4
GDN_QKV = GDN_HEADS * (2 * GDN_DK + GDN_DV)
GDN_WIDTH = GDN_HEADS * GDN_DV
SC_WIDTH = D_MODEL - GDN_WIDTH
SC_CONV = 3
EVEN_IN = GDN_QKV + GDN_WIDTH + 2 * GDN_HEADS + 3 * SC_WIDTH
FOX_HEADS = 8
FOX_DH = 128
FOX_WIDTH = FOX_HEADS * FOX_DH
FOX_QBLK = 128
ODD_IN = 3 * FOX_WIDTH + FOX_HEADS
D_FF = 256 * ((8 * D_MODEL + 3 * 256 - 1) // (3 * 256))
INIT_FORGET_BIAS = 3.0
INIT_FORGET_W_SCALE = 0.1

kernel_name = 'hybrid_gdn_shortconv_fox_stream_step'


def rms_norm(x, g):
    xf = x.astype(jnp.float32)
    y = xf * lax.rsqrt(jnp.mean(xf * xf, axis=-1, keepdims=True) + EPS)
    return (y * g.astype(jnp.float32)).astype(x.dtype)


def l2_norm(x):
    xf = x.astype(jnp.float32)
    return xf * lax.rsqrt(jnp.sum(xf * xf, axis=-1, keepdims=True) + EPS)


def causal_dwconv(x, buf, w):
    width = w.shape[0]
    T = x.shape[1]
    xp = jnp.concatenate([buf.astype(x.dtype), x], axis=1)
    y = xp[:, 0:T] * w[0]
    for i in range(1, width):
        y = y + xp[:, i:i + T] * w[i]
    return y, xp[:, T:]


def gated_delta_rule(q, k, v, g, beta, S0, chunk):
    B, T, H, DK = q.shape
    DV = v.shape[-1]
    n = T // chunk

    def blocks(a):
        a = a.reshape((B, n, chunk, H) + a.shape[3:])
        return jnp.moveaxis(a, (1, 3), (0, 2))

    qc, kc, vc = blocks(q), blocks(k), blocks(v)
    gc, bc = blocks(g), blocks(beta)
    G = jnp.cumsum(gc, axis=-1)
    idx = jnp.arange(chunk)
    incl = idx[:, None] >= idx[None, :]
    strict = idx[:, None] > idx[None, :]
    decay = jnp.exp(jnp.where(incl, G[..., :, None] - G[..., None, :], -jnp.inf))
    kb = kc * bc[..., None]
    A = jnp.einsum('nbhid,nbhjd->nbhij', kb, kc) * jnp.where(strict, decay, 0.0)
    rhs = jnp.concatenate([vc * bc[..., None], kb * jnp.exp(G)[..., None]], axis=-1)
    sol = lax.linalg.triangular_solve(A + jnp.eye(chunk, dtype=A.dtype), rhs,
                                      left_side=True, lower=True, unit_diagonal=True)
    u_pre, w = sol[..., :DV], sol[..., DV:]
    P = jnp.einsum('nbhid,nbhjd->nbhij', qc, kc) * decay
    qg = qc * jnp.exp(G)[..., None]
    kd = kc * jnp.exp(G[..., -1:] - G)[..., None]
    gC = jnp.exp(G[..., -1])

    def step(S, xs):
        u_pre_i, w_i, P_i, qg_i, kd_i, gC_i = xs
        u = u_pre_i - jnp.einsum('bhck,bhkv->bhcv', w_i, S)
        o = jnp.einsum('bhck,bhkv->bhcv', qg_i, S) + jnp.einsum('bhij,bhjv->bhiv', P_i, u)
        S = S * gC_i[..., None, None] + jnp.einsum('bhck,bhcv->bhkv', kd_i, u)
        return S, o

    S_fin, o = lax.scan(step, S0, (u_pre, w, P, qg, kd, gC))
    o = jnp.moveaxis(o, (0, 2), (1, 3)).reshape(B, T, H, DV)
    return o, S_fin


def gdn_sconv_mixer(h, conv_buf, S0, sc_buf, w_in, conv_w, a_log, dt_bias, norm_g, sc_w, w_out):
    B, T, _ = h.shape
    p = h @ w_in
    o1 = GDN_QKV
    o2 = o1 + GDN_WIDTH
    o3 = o2 + GDN_HEADS
    o4 = o3 + GDN_HEADS
    o5 = o4 + SC_WIDTH
    o6 = o5 + SC_WIDTH
    qkv, z, a, b = p[..., :o1], p[..., o1:o2], p[..., o2:o3], p[..., o3:o4]
    gate_b, gate_c, h_in = p[..., o4:o5], p[..., o5:o6], p[..., o6:]
    if conv_buf is None:
        conv_buf = jnp.zeros((B, GDN_CONV - 1, GDN_QKV), p.dtype)
    if S0 is None:
        S0 = jnp.zeros((B, GDN_HEADS, GDN_DK, GDN_DV), jnp.float32)
    if sc_buf is None:
        sc_buf = jnp.zeros((B, SC_CONV - 1, SC_WIDTH), p.dtype)
    qkv, conv_buf_new = causal_dwconv(qkv, conv_buf, conv_w)
    qkv = jax.nn.silu(qkv)
    nk = GDN_HEADS * GDN_DK
    q = l2_norm(qkv[..., :nk].reshape(B, T, GDN_HEADS, GDN_DK)) * (GDN_DK ** -0.5)
    k = l2_norm(qkv[..., nk:2 * nk].reshape(B, T, GDN_HEADS, GDN_DK))
    v = qkv[..., 2 * nk:].reshape(B, T, GDN_HEADS, GDN_DV).astype(jnp.float32)
    g = -jnp.exp(a_log.astype(jnp.float32)) * jax.nn.softplus(a.astype(jnp.float32) + dt_bias.astype(jnp.float32))
    beta = jax.nn.sigmoid(b.astype(jnp.float32))
    o, S_new = gated_delta_rule(q, k, v, g, beta, S0.astype(jnp.float32), min(CHUNK, T))
    o = rms_norm(o, norm_g) * jax.nn.silu(z.reshape(B, T, GDN_HEADS, GDN_DV).astype(jnp.float32))
    o = o.reshape(B, T, GDN_WIDTH).astype(h.dtype)
    yc, sc_buf_new = causal_dwconv(gate_c * h_in, sc_buf, sc_w)
    ob = gate_b * yc
    out = jnp.concatenate([o, ob], axis=-1) @ w_out
    return out, conv_buf_new, S_new, sc_buf_new


def fox_project(h, w_in, b_f, qn_g, kn_g):
    B, T, _ = h.shape
    p = h @ w_in
    shp = (B, T, FOX_HEADS, FOX_DH)
    q = rms_norm(p[..., :FOX_WIDTH].reshape(shp), qn_g)
    k = rms_norm(p[..., FOX_WIDTH:2 * FOX_WIDTH].reshape(shp), kn_g)
    v = p[..., 2 * FOX_WIDTH:3 * FOX_WIDTH].reshape(shp)
    logf = jax.nn.log_sigmoid(p[..., 3 * FOX_WIDTH:].astype(jnp.float32) + b_f.astype(jnp.float32))
    return q, k, v, logf


def fox_attend_prompt(q, k, v, logf):
    B, S, H, Dh = q.shape
    nblk = S // FOX_QBLK
    c = jnp.cumsum(logf, axis=1).transpose(0, 2, 1)
    qb = q.reshape(B, nblk, FOX_QBLK, H, Dh).transpose(1, 0, 2, 3, 4)
    cq = c.reshape(B, H, nblk, FOX_QBLK).transpose(2, 0, 1, 3)
    kpos = jnp.arange(S)
    scale = Dh ** -0.5

    def block(args):
        q_i, c_i, start = args
        s = jnp.einsum('bqhd,bkhd->bhqk', q_i, k, preferred_element_type=jnp.float32) * scale
        s = s + c_i[..., :, None] - c[:, :, None, :]
        qpos = start + jnp.arange(FOX_QBLK)
        s = jnp.where(kpos[None, :] <= qpos[:, None], s, -jnp.inf)
        p = jax.nn.softmax(s, axis=-1)
        return jnp.einsum('bhqk,bkhd->bqhd', p.astype(v.dtype), v)

    o = lax.map(block, (qb, cq, jnp.arange(nblk) * FOX_QBLK))
    return o.transpose(1, 0, 2, 3, 4).reshape(B, S, H, Dh)


def fox_attend_sample(q, k, v, logf, k_cache, v_cache, logf_cache):
    B, T, H, Dh = q.shape
    P = k_cache.shape[1]
    k_all = jnp.concatenate([k_cache, k], axis=1)
    v_all = jnp.concatenate([v_cache, v], axis=1)
    lf = jnp.concatenate([logf_cache.astype(jnp.float32), logf], axis=1)
    c = jnp.cumsum(lf, axis=1).transpose(0, 2, 1)
    s = jnp.einsum('bqhd,bkhd->bhqk', q, k_all, preferred_element_type=jnp.float32) * (Dh ** -0.5)
    s = s + c[:, :, P:, None] - c[:, :, None, :]
    qpos = P + jnp.arange(T)
    kpos = jnp.arange(P + T)
    s = jnp.where(kpos[None, :] <= qpos[:, None], s, -jnp.inf)
    p = jax.nn.softmax(s, axis=-1)
    return jnp.einsum('bhqk,bkhd->bqhd', p.astype(v_all.dtype), v_all)


def swiglu(h, w_gate, w_up, w_down):
    return (jax.nn.silu(h @ w_gate) * (h @ w_up)) @ w_down


def trunk(x, gdn_conv, gdn_S, sconv, fox_k, fox_v, fox_logf, pw):
    B, T, _ = x.shape
    has_past = fox_k is not None
    new_k, new_v, new_lf, new_S, new_conv, new_sc = [], [], [], [], [], []
    for layer in range(DEPTH):
        i = layer // 2
        h = rms_norm(x, pw['norm_mix_g'][layer])
        if layer % 2 == 0:
            out, cb, S, sb = gdn_sconv_mixer(
                h,
                gdn_conv[i] if has_past else None,
                gdn_S[i] if has_past else None,
                sconv[i] if has_past else None,
                pw['w_in_even'][i], pw['gdn_conv_w'][i], pw['gdn_a_log'][i], pw['gdn_dt_bias'][i],
                pw['gdn_norm_g'][i], pw['sconv_w'][i], pw['w_out_even'][i])
            new_conv.append(cb)
            new_S.append(S)
            new_sc.append(sb)
        else:
            q, k, v, lf = fox_project(h, pw['w_in_odd'][i], pw['fox_b_f'][i],
                                      pw['fox_q_norm_g'][i], pw['fox_k_norm_g'][i])
            if has_past:
                o = fox_attend_sample(q, k, v, lf, fox_k[i], fox_v[i], fox_logf[i])
            else:
                o = fox_attend_prompt(q, k, v, lf)
            out = o.reshape(B, T, FOX_WIDTH) @ pw['w_out_odd'][i]
            new_k.append(k)
            new_v.append(v)
            new_lf.append(lf)
        x = x + out
        x = x + swiglu(rms_norm(x, pw['norm_ffn_g'][layer]), pw['ffn_w_gate'][layer],
                       pw['ffn_w_up'][layer], pw['ffn_w_down'][layer])
    return (x, jnp.stack(new_k), jnp.stack(new_v), jnp.stack(new_lf),
            jnp.stack(new_S), jnp.stack(new_conv), jnp.stack(new_sc))


def setup_inputs(seed: int = 0) -> dict:
    key = jax.random.key(seed)
    ks = jax.random.split(key, 25)
    f32 = jnp.float32

    def nrm(k, shape, s=1.0):
        return s * jax.random.normal(k, shape, f32)

    x_prompt = nrm(ks[0], (BATCH, SEQ, D_MODEL))
    x_sample = nrm(ks[1], (DEC_BATCH, DEC_SEQ, D_MODEL))
    cache_fox_k = nrm(ks[2], (N_ODD, DEC_BATCH, PAST_LEN, FOX_HEADS, FOX_DH))
    cache_fox_v = nrm(ks[3], (N_ODD, DEC_BATCH, PAST_LEN, FOX_HEADS, FOX_DH))
    cache_fox_logf = jax.nn.log_sigmoid(INIT_FORGET_BIAS + nrm(ks[4], (N_ODD, DEC_BATCH, PAST_LEN, FOX_HEADS), 0.3))
    state_gdn_S = nrm(ks[5], (N_EVEN, DEC_BATCH, GDN_HEADS, GDN_DK, GDN_DV), 0.1)
    state_gdn_conv = nrm(ks[6], (N_EVEN, DEC_BATCH, GDN_CONV - 1, GDN_QKV))
    state_sconv = nrm(ks[7], (N_EVEN, DEC_BATCH, SC_CONV - 1, SC_WIDTH))
    norm_mix_g = 1.0 + nrm(ks[8], (DEPTH, D_MODEL), 0.02)
    norm_ffn_g = 1.0 + nrm(ks[9], (DEPTH, D_MODEL), 0.02)
    w_in_even = nrm(ks[10], (N_EVEN, D_MODEL, EVEN_IN), D_MODEL ** -0.5)
    gdn_conv_w = nrm(ks[11], (N_EVEN, GDN_CONV, GDN_QKV), GDN_CONV ** -0.5)
    gdn_a_log = jnp.log(jax.random.uniform(ks[12], (N_EVEN, GDN_HEADS), f32, 1.0, 16.0))
    dt = jnp.exp(jax.random.uniform(ks[13], (N_EVEN, GDN_HEADS), f32, math.log(1e-3), math.log(1e-1)))
    gdn_dt_bias = dt + jnp.log(-jnp.expm1(-dt))
    gdn_norm_g = 1.0 + nrm(ks[14], (N_EVEN, GDN_DV), 0.02)
    sconv_w = nrm(ks[15], (N_EVEN, SC_CONV, SC_WIDTH), SC_CONV ** -0.5)
    w_out_even = nrm(ks[16], (N_EVEN, D_MODEL, D_MODEL), D_MODEL ** -0.5)
    w_in_odd = nrm(ks[17], (N_ODD, D_MODEL, ODD_IN), D_MODEL ** -0.5)
    w_in_odd = w_in_odd.at[..., 3 * FOX_WIDTH:].multiply(INIT_FORGET_W_SCALE)
    fox_b_f = INIT_FORGET_BIAS + nrm(ks[18], (N_ODD, FOX_HEADS), 0.1)
    fox_q_norm_g = 1.0 + nrm(ks[19], (N_ODD, FOX_DH), 0.02)
    fox_k_norm_g = 1.0 + nrm(ks[20], (N_ODD, FOX_DH), 0.02)
    w_out_odd = nrm(ks[21], (N_ODD, FOX_WIDTH, D_MODEL), FOX_WIDTH ** -0.5)
    ffn_w_gate = nrm(ks[22], (DEPTH, D_MODEL, D_FF), D_MODEL ** -0.5)
    ffn_w_up = nrm(ks[23], (DEPTH, D_MODEL, D_FF), D_MODEL ** -0.5)
    ffn_w_down = nrm(ks[24], (DEPTH, D_FF, D_MODEL), D_FF ** -0.5)
    return {
        'x_prompt': x_prompt, 'x_sample': x_sample,
        'cache_fox_k': cache_fox_k, 'cache_fox_v': cache_fox_v, 'cache_fox_logf': cache_fox_logf,
        'state_gdn_S': state_gdn_S, 'state_gdn_conv': state_gdn_conv, 'state_sconv': state_sconv,
        'norm_mix_g': norm_mix_g, 'norm_ffn_g': norm_ffn_g,
        'w_in_even': w_in_even, 'gdn_conv_w': gdn_conv_w, 'gdn_a_log': gdn_a_log,
        'gdn_dt_bias': gdn_dt_bias, 'gdn_norm_g': gdn_norm_g, 'sconv_w': sconv_w,
        'w_out_even': w_out_even,
        'w_in_odd': w_in_odd, 'fox_b_f': fox_b_f, 'fox_q_norm_g': fox_q_norm_g,
        'fox_k_norm_g': fox_k_norm_g, 'w_out_odd': w_out_odd,
        'ffn_w_gate': ffn_w_gate, 'ffn_w_up': ffn_w_up, 'ffn_w_down': ffn_w_down,
    }


def reference(x_prompt, x_sample, cache_fox_k, cache_fox_v, cache_fox_logf, state_gdn_S,
              state_gdn_conv, state_sconv, norm_mix_g, norm_ffn_g, w_in_even, gdn_conv_w,
              gdn_a_log, gdn_dt_bias, gdn_norm_g, sconv_w, w_out_even, w_in_odd, fox_b_f,
              fox_q_norm_g, fox_k_norm_g, w_out_odd, ffn_w_gate, ffn_w_up, ffn_w_down):
    pw = dict(norm_mix_g=norm_mix_g, norm_ffn_g=norm_ffn_g, w_in_even=w_in_even,
              gdn_conv_w=gdn_conv_w, gdn_a_log=gdn_a_log, gdn_dt_bias=gdn_dt_bias,
              gdn_norm_g=gdn_norm_g, sconv_w=sconv_w, w_out_even=w_out_even, w_in_odd=w_in_odd,
              fox_b_f=fox_b_f, fox_q_norm_g=fox_q_norm_g, fox_k_norm_g=fox_k_norm_g,
              w_out_odd=w_out_odd, ffn_w_gate=ffn_w_gate, ffn_w_up=ffn_w_up, ffn_w_down=ffn_w_down)
    (y_prompt, p_fox_k, p_fox_v, p_fox_logf,
     p_gdn_S, p_gdn_conv, p_sconv) = trunk(x_prompt, None, None, None, None, None, None, pw)
    (y_sample, s_fox_k, s_fox_v, s_fox_logf,
     s_gdn_S, s_gdn_conv, s_sconv) = trunk(x_sample, state_gdn_conv, state_gdn_S, state_sconv,
                                           cache_fox_k, cache_fox_v, cache_fox_logf, pw)
    return (y_prompt, y_sample, p_fox_k, p_fox_v, p_fox_logf, p_gdn_S, p_gdn_conv, p_sconv,
            s_fox_k, s_fox_v, s_fox_logf, s_gdn_S, s_gdn_conv, s_sconv)
```

```cpp
#include <hip/hip_runtime.h>
#include <hip/hip_cooperative_groups.h>
#include <cstdio>
#include <cstdint>
namespace cg = cooperative_groups;

typedef unsigned short bf16_t;
typedef short bf16x8 __attribute__((ext_vector_type(8)));
typedef short s16x4 __attribute__((ext_vector_type(4)));
typedef float f32x16 __attribute__((ext_vector_type(16)));
typedef float f32x4 __attribute__((ext_vector_type(4)));
typedef unsigned u32x4 __attribute__((ext_vector_type(4)));
typedef unsigned u32x2 __attribute__((ext_vector_type(2)));

constexpr int DM = 1024, MP = 16384, MS = 2048, MT = MP + MS;
constexpr int EVEN_IN = 3592, ODD_IN = 3080, NE = 3584, NO = 3072, DFF = 2816, NF1 = 2 * DFF;
constexpr float EPS = 1e-6f;
constexpr size_t OFF_Y = 0;
constexpr size_t OFF_PK = (size_t)MT * DM;
constexpr size_t OFF_PV = OFF_PK + (size_t)2 * MP * 1024;
constexpr size_t OFF_PLF = OFF_PV + (size_t)2 * MP * 1024;
constexpr size_t OFF_PS = OFF_PLF + (size_t)2 * MP * 8;
constexpr size_t OFF_PCONV = OFF_PS + (size_t)2 * 4 * 4 * 128 * 128;
constexpr size_t OFF_PSC = OFF_PCONV + (size_t)2 * 4 * 3 * 1536;
constexpr size_t OFF_SK = OFF_PSC + (size_t)2 * 4 * 2 * 512;
constexpr size_t OFF_SV = OFF_SK + (size_t)2 * MS * 1024;
constexpr size_t OFF_SLF = OFF_SV + (size_t)2 * MS * 1024;
constexpr size_t OFF_SS = OFF_SLF + (size_t)2 * MS * 8;
constexpr size_t OFF_SCONV = OFF_SS + (size_t)2 * 32 * 4 * 128 * 128;
constexpr size_t OFF_SSC = OFF_SCONV + (size_t)2 * 32 * 3 * 1536;
constexpr size_t OUT_TOTAL = OFF_SSC + (size_t)2 * 32 * 2 * 512;
static_assert(OUT_TOTAL == 99790848, "output size");
constexpr size_t WS_WINE = 0;
constexpr size_t WS_WOUTE = WS_WINE + (size_t)2 * NE * DM * 2;
constexpr size_t WS_WINO = WS_WOUTE + (size_t)2 * DM * DM * 2;
constexpr size_t WS_WOUTO = WS_WINO + (size_t)2 * NO * DM * 2;
constexpr size_t WS_WF1 = WS_WOUTO + (size_t)2 * DM * DM * 2;
constexpr size_t WS_WF2 = WS_WF1 + (size_t)4 * NF1 * DM * 2;
constexpr size_t WS_H = WS_WF2 + (size_t)4 * DM * DFF * 2;
constexpr size_t WS_BIG = WS_H + (size_t)MT * DM * 2;
constexpr size_t WS_CAT = WS_BIG + (size_t)MT * NE * 2;
constexpr size_t WS_AB = WS_CAT + (size_t)MT * DM * 2;
constexpr size_t WS_OG = WS_AB + (size_t)MT * 8 * 4;
constexpr size_t WS_GC = WS_OG + (size_t)MT * 512 * 2;
constexpr size_t WS_NEGW = WS_GC + 8192;
constexpr size_t WS_QG = WS_NEGW + (size_t)1152 * 16384;
constexpr size_t WS_KDT = WS_QG + (size_t)1152 * 16384;
constexpr size_t WS_PM = WS_KDT + (size_t)1152 * 16384;
constexpr size_t WS_UPRE = WS_PM + (size_t)1152 * 8192;
constexpr size_t WS_QP = WS_UPRE + (size_t)1152 * 16384;
constexpr size_t WS_KP = WS_QP + (size_t)32 * 4096 * 128 * 2;
constexpr size_t WS_VP = WS_KP + (size_t)32 * 4096 * 128 * 2;
constexpr size_t WS_QS = WS_VP + (size_t)32 * 4096 * 128 * 2;
constexpr size_t WS_KS = WS_QS + (size_t)256 * 64 * 128 * 2 + 65536;
constexpr size_t WS_VS = WS_KS + (size_t)256 * 1088 * 128 * 2;
constexpr size_t WS_NCP = WS_VS + (size_t)256 * 1088 * 128 * 2;
constexpr size_t WS_NCS = WS_NCP + (size_t)32 * 4096 * 4;
constexpr size_t WS_END = WS_NCS + (size_t)256 * 1088 * 4;
constexpr int LDS_BYTES = 131072;

struct Params { const float* in[25]; float* out; unsigned char* ws; int ph_lo, ph_hi; };
typedef const __attribute__((address_space(4))) Params CParams;

#define KSWZ(row, colB) ((row) * 256 + ((colB) ^ (((row) & 7) << 4)))
#define SBAR() __builtin_amdgcn_sched_barrier(0)
template <class A, class Bt> struct same_t { static constexpr bool v = false; };
template <class A> struct same_t<A, A> { static constexpr bool v = true; };
__device__ __forceinline__ int otid() { int t = threadIdx.x; asm volatile("" : "+v"(t)); return t; }
namespace pg8 {
#define PG8_LAS __attribute__((address_space(3)))
typedef unsigned short bf16_t;
typedef short bf16x8 __attribute__((ext_vector_type(8)));
typedef float f32x4 __attribute__((ext_vector_type(4)));
typedef unsigned u32x4 __attribute__((ext_vector_type(4)));
constexpr int BM = 256, BK = 64, HALF = 128, HTB = HALF * BK * 2  , STAGE_BYTES = 8 * HTB, NXCD = 8, WGM = 8;

__host__ __device__ __forceinline__ int lds_byte(int r, int c) { const int st = (r >> 4) * 2 + (c >> 5), rr = r & 15, cc = c & 31, ob = rr * 64 + cc * 2; return st * 1024 + (ob ^ (((ob >> 9) & 1) << 5)); }
__host__ __device__ __forceinline__ void stage_rc(int b, int& R, int& C) { const int st = b / 1024, sb = b % 1024, swz = sb ^ (((sb >> 9) & 1) << 5); R = (st >> 1) * 16 + swz / 64; C = (st & 1) * 32 + (swz % 64) / 2; }
__host__ __device__ __forceinline__ int perm32(int rho) { const int n = rho >> 4, i = rho & 15; return 8 * (i >> 2) + 4 * n + (i & 3); }

struct Unit { int pm, pn; };
struct Gemm { const bf16_t* A; const bf16_t* Bt; int M, N, K; };

struct StaticOrder {
    int nM, nN, nwg, G, c;
    __host__ __device__ void init(int M, int N, int G_, int c_) { nM = M / BM; nN = N / BM; nwg = nM * nN; G = G_; c = c_; }
    __host__ __device__ bool next(int i, Unit& u) const {
        const long L = (long)i * G + c; if (L >= nwg) return false;
        int wgid = (int)L; { const int q = nwg / NXCD, r = nwg % NXCD, xcd = wgid % NXCD, off = wgid / NXCD; wgid = (xcd < r ? xcd * (q + 1) : r * (q + 1) + (xcd - r) * q) + off; }
        const int nig = WGM * nN, gid = wgid / nig, fm = gid * WGM, gsz = (nM - fm) < WGM ? (nM - fm) : WGM;
        u.pm = fm + ((wgid % nig) % gsz); u.pn = (wgid % nig) / gsz; return true;
    }
    __device__ __forceinline__ void a_ready(const Unit&) const {}
    __device__ __forceinline__ void done(const Unit&) const {}
};
__device__ __forceinline__ unsigned cvt_pk_bf16(float lo, float hi) { unsigned r; asm volatile("v_cvt_pk_bf16_f32 %0, %1, %2" : "=v"(r) : "v"(lo), "v"(hi)); return r; }
template <class Epi, class Sched, bool STAMP = false>
__device__ __forceinline__ void gemm_phase(PG8_LAS unsigned char* lds, const Gemm g, const Sched& S, const Epi& E, unsigned long long* stamps) {
    const int tid = otid(), wid = __builtin_amdgcn_readfirstlane(tid >> 6), lane = tid & 63, wr = wid >> 2, wc = wid & 3, fr = lane & 15, fq = lane >> 4;
    const int K = g.K, nt = K / BK;
    int ts_lo = 0, ts_hi = 0, nts = 0; const unsigned long long rt_entry = STAMP ? (unsigned long long)wall_clock64() : 0ull;
#define PG8_STAMP() do { if (STAMP && wid == 0 && nts < 64) { const unsigned long long _c = (unsigned long long)clock64(); \
        ts_lo = (lane == nts) ? (int)(unsigned)_c : ts_lo; ts_hi = (lane == nts) ? (int)(unsigned)(_c >> 32) : ts_hi; ++nts; } } while (0)
    PG8_STAMP();
    unsigned voffA[2], voffB[2];
#pragma unroll
    for (int i = 0; i < 2; ++i) { int R, C; stage_rc(tid * 16 + i * 8192, R, C); const int Rb = Epi::PERM ? ((R & ~31) + perm32(R & 31)) : R;
        voffA[i] = (unsigned)(R * K + C) * 2u; voffB[i] = (unsigned)(Rb * K + C) * 2u; }
    const size_t kstep = (size_t)(BK * 2);
    const size_t hstep = (size_t)HALF * K * 2;
    const size_t tstep = 2 * hstep;
    const unsigned ldsw = (unsigned)wid * 1024u;
    const int aoff = lds_byte(wr * 64 + fr, fq * 8), boff = lds_byte(wc * 32 + fr, fq * 8);
#define PG8_SA(b, h) (((b) * 2 + (h)) * HTB)
#define PG8_SB(b, h) ((4 + (b) * 2 + (h)) * HTB)
#define PG8_STAGE(bufoff, gbase, voff) do { _Pragma("unroll") for (int _i = 0; _i < 2; ++_i) \
        __builtin_amdgcn_global_load_lds((const unsigned*)((const char*)(gbase) + (voff)[_i]), (PG8_LAS unsigned*)(lds + (bufoff) + ldsw + _i * 8192), 16, 0, 0); } while (0)
#define PG8_LDA(dst, b, h) do { _Pragma("unroll") for (int m = 0; m < 4; ++m) _Pragma("unroll") for (int k = 0; k < 2; ++k) dst[m][k] = *(const PG8_LAS bf16x8*)(lds + PG8_SA(b, h) + aoff + m * 2048 + k * 1024); } while (0)
#define PG8_LDB(dst, b, h) do { _Pragma("unroll") for (int n = 0; n < 2; ++n) _Pragma("unroll") for (int k = 0; k < 2; ++k) dst[n][k] = *(const PG8_LAS bf16x8*)(lds + PG8_SB(b, h) + boff + n * 2048 + k * 1024); } while (0)
#define PG8_MMA(ai, bj, At, Bt) do { __builtin_amdgcn_s_setprio(1); _Pragma("unroll") for (int m = 0; m < 4; ++m) _Pragma("unroll") for (int n = 0; n < 2; ++n) _Pragma("unroll") for (int k = 0; k < 2; ++k) \
        acc[ai][bj][m][n] = __builtin_amdgcn_mfma_f32_16x16x32_bf16(Bt[n][k], At[m][k], acc[ai][bj][m][n], 0, 0, 0); __builtin_amdgcn_s_setprio(0); } while (0)
#define PG8_WAIT_V(n) asm volatile("s_waitcnt vmcnt(" #n ")" ::: "memory")
#define PG8_WAIT_L(n) asm volatile("s_waitcnt lgkmcnt(" #n ")" ::: "memory")
#define PG8_BAR __builtin_amdgcn_s_barrier()
#define PG8_SCHED __builtin_amdgcn_sched_barrier(0)
    Unit cur, nxt; int ui = 0;
    if (!S.next(0, cur)) return;
    f32x4 acc[2][2][4][2];
#pragma unroll
    for (int a = 0; a < 2; ++a)
#pragma unroll
        for (int b = 0; b < 2; ++b)
#pragma unroll
            for (int m = 0; m < 4; ++m)
#pragma unroll
                for (int n = 0; n < 2; ++n) acc[a][b][m][n] = (f32x4){0.f, 0.f, 0.f, 0.f};
    bf16x8 At[4][2], B0[2][2], B1[2][2];
    const char* cA = (const char*)g.A + (size_t)cur.pm * tstep; const char* cB = (const char*)g.Bt + (size_t)cur.pn * tstep;
    S.a_ready(cur);
    PG8_STAGE(PG8_SB(0, 0), cB, voffB); PG8_STAGE(PG8_SA(0, 0), cA, voffA); PG8_STAGE(PG8_SB(0, 1), cB + hstep, voffB); PG8_STAGE(PG8_SA(0, 1), cA + hstep, voffA);
    if (wr == 1) PG8_BAR;
    PG8_WAIT_V(4); PG8_BAR;
    PG8_STAGE(PG8_SB(1, 0), cB + kstep, voffB); PG8_STAGE(PG8_SA(1, 0), cA + kstep, voffA); PG8_STAGE(PG8_SB(1, 1), cB + hstep + kstep, voffB);
    PG8_WAIT_V(6); PG8_BAR;
    PG8_STAMP();
    for (;;) {
        const bool has_next = S.next(ui + 1, nxt);
        const char* nA = has_next ? (const char*)g.A + (size_t)nxt.pm * tstep : cA; const char* nB = has_next ? (const char*)g.Bt + (size_t)nxt.pn * tstep : cB;
        for (int t = 0; t < nt; t += 2) {
            const bool last = (t == nt - 2);
            const char* a1 = cA + (size_t)(t + 1) * kstep;
            const char* a2 = last ? nA : cA + (size_t)(t + 2) * kstep; const char* b2 = last ? nB : cB + (size_t)(t + 2) * kstep;
            const char* a3 = a2 + kstep; const char* b3 = b2 + kstep;
            if (last && has_next) S.a_ready(nxt);
            PG8_LDB(B0, 0, 0); PG8_SCHED; PG8_LDA(At, 0, 0); PG8_STAGE(PG8_SA(1, 1), a1 + hstep, voffA);
            PG8_WAIT_L(8); PG8_BAR; PG8_WAIT_L(0); PG8_MMA(0, 0, At, B0); PG8_BAR; PG8_SCHED;
            PG8_LDB(B1, 0, 1); PG8_STAGE(PG8_SB(0, 0), b2, voffB);
            PG8_BAR; PG8_WAIT_L(0); PG8_MMA(0, 1, At, B1); PG8_BAR;
            PG8_LDA(At, 0, 1); PG8_STAGE(PG8_SA(0, 0), a2, voffA);
            PG8_BAR; PG8_WAIT_L(0); PG8_MMA(1, 0, At, B0); PG8_BAR; PG8_SCHED;
            PG8_STAGE(PG8_SB(0, 1), b2 + hstep, voffB);
            PG8_WAIT_V(6); PG8_BAR; PG8_MMA(1, 1, At, B1); PG8_BAR;
            PG8_LDB(B0, 1, 0); PG8_SCHED; PG8_LDA(At, 1, 0); PG8_STAGE(PG8_SA(0, 1), a2 + hstep, voffA);
            PG8_WAIT_L(8); PG8_BAR; PG8_WAIT_L(0); PG8_MMA(0, 0, At, B0); PG8_BAR; PG8_SCHED;
            PG8_LDB(B1, 1, 1); PG8_STAGE(PG8_SB(1, 0), b3, voffB);
            PG8_BAR; PG8_WAIT_L(0); PG8_MMA(0, 1, At, B1); PG8_BAR;
            PG8_LDA(At, 1, 1); PG8_STAGE(PG8_SA(1, 0), a3, voffA);
            PG8_BAR; PG8_WAIT_L(0); PG8_MMA(1, 0, At, B0); PG8_BAR; PG8_SCHED;
            PG8_STAGE(PG8_SB(1, 1), b3 + hstep, voffB);
            PG8_WAIT_V(6); PG8_BAR; PG8_MMA(1, 1, At, B1); PG8_BAR;
        }
        PG8_STAMP();
        if constexpr (!Epi::AFTER_DRAIN) { E(acc, cur, wr, wc, fr, fq); S.done(cur); }
        PG8_STAMP();
        if (!has_next) break;
#pragma unroll
        for (int a = 0; a < 2; ++a)
#pragma unroll
            for (int b = 0; b < 2; ++b)
#pragma unroll
                for (int m = 0; m < 4; ++m)
#pragma unroll
                    for (int n = 0; n < 2; ++n) acc[a][b][m][n] = (f32x4){0.f, 0.f, 0.f, 0.f};
        cur = nxt; cA = nA; cB = nB; ++ui;
    }
    PG8_WAIT_V(0);
    if (wr == 0) PG8_BAR;
    PG8_BAR;
    if constexpr (Epi::AFTER_DRAIN) { E.fused(acc, cur, wr, wc, fr, fq, lds, wid, lane); S.done(cur); }
    PG8_STAMP();
    if (STAMP && wid == 0) { stamps[lane] = lane < nts ? (((unsigned long long)(unsigned)ts_hi << 32) | (unsigned)ts_lo) : 0ull;
        if (lane == 62) stamps[62] = rt_entry; if (lane == 63) stamps[63] = (unsigned long long)wall_clock64(); }
#undef PG8_STAMP
#undef PG8_SA
#undef PG8_SB
#undef PG8_STAGE
#undef PG8_LDA
#undef PG8_LDB
#undef PG8_MMA
#undef PG8_WAIT_V
#undef PG8_WAIT_L
#undef PG8_BAR
#undef PG8_SCHED
}
}
namespace fa {
constexpr int D = 128, OSTR = 1024;
constexpr float SCALE = 0.08838834764831845f;
constexpr float THR = 8.f;
constexpr bool WSKIP = false;
constexpr int NW = 8, QBLK = 32, KVBLK = 64, QB = NW * QBLK;
constexpr int SHM_V = KVBLK * D * 2, SHM_K = KVBLK * D * 2;
__device__ __forceinline__ int v_st(int k, int c) { const int kk = (k & ~0xC) | ((k & 4) << 1) | ((k & 8) >> 1); return ((kk >> 3) * 4 + (c >> 5)) * 512 + ((kk & 7) * 32 + (c & 31)) * 2; }
__device__ __forceinline__ int v_rd_base(int lane) { return ((lane & 3) << 3) | (((lane >> 2) & 3) << 6) | (((lane >> 4) & 1) << 5) | (((lane >> 5) & 1) << 8); }
constexpr int v_rd_off(int d0, int ks, int half) { return d0 * 512 + ks * 4096 + half * 2048; }
__device__ __forceinline__ int crow(int r, int hi) { return (r & 3) + 8 * (r >> 2) + 4 * hi; }
__device__ __forceinline__ unsigned cvtpk(float lo, float hi) {
    unsigned r; asm volatile("v_cvt_pk_bf16_f32 %0, %1, %2" : "=v"(r) : "v"(lo), "v"(hi)); return r;
}
__device__ __forceinline__ bf16x8 pack8(f32x4 a, f32x4 b) {
    u32x4 w = {cvtpk(a[0], a[1]), cvtpk(a[2], a[3]), cvtpk(b[0], b[1]), cvtpk(b[2], b[3])};
    return *reinterpret_cast<bf16x8*>(&w);
}
template <class T> __device__ __forceinline__ bf16x8 load8(const T* p) {
    if constexpr (same_t<T, float>::v) { return pack8(*(const f32x4*)p, *(const f32x4*)(p + 4)); }
    else { return *reinterpret_cast<const bf16x8*>(p); }
}
__device__ __forceinline__ void mask_tile(f32x16& p0, f32x16& p1, int dq, unsigned W) {
    const float NEG = -__builtin_inff();
#pragma unroll
    for (int r = 0; r < 16; ++r) {
        const int c = (r & 3) + 8 * (r >> 2);
        if ((unsigned)(dq - c) >= W) p0[r] = NEG;
        if ((unsigned)(dq - c - 32) >= W) p1[r] = NEG;
    }
}
__device__ __forceinline__ void partialSM(f32x16& p0, f32x16& p1, float& m_reg, float& mn, float& alpha) {
    float pmax = p0[0]; for (int r = 1; r < 16; ++r) pmax = fmaxf(pmax, p0[r]); for (int r = 0; r < 16; ++r) pmax = fmaxf(pmax, p1[r]);
    { auto rr = __builtin_amdgcn_permlane32_swap(__float_as_uint(pmax), __float_as_uint(pmax), false, false);
      pmax = fmaxf(__uint_as_float(rr[0]), __uint_as_float(rr[1])); }
    constexpr float C2 = 1.4426950408889634f * SCALE;
    if (__builtin_expect(__all((pmax - m_reg) * SCALE <= THR), 1)) { mn = m_reg; alpha = 1.f; }
    else { mn = fmaxf(m_reg, pmax); alpha = __builtin_amdgcn_exp2f((m_reg - mn) * C2); m_reg = mn; }
    const float mnL = -mn * C2;
    for (int r = 0; r < 16; ++r) p0[r] = fmaf(p0[r], C2, mnL); for (int r = 0; r < 16; ++r) p1[r] = fmaf(p1[r], C2, mnL);
    for (int r = 0; r < 16; ++r) p0[r] = __builtin_amdgcn_exp2f(p0[r]);
}
__device__ __forceinline__ void finishSM(f32x16& p0, f32x16& p1, float alpha, float& l_reg, bf16x8& pa0, bf16x8& pa1, bf16x8& pa2, bf16x8& pa3) {
    for (int r = 0; r < 16; ++r) p1[r] = __builtin_amdgcn_exp2f(p1[r]);
    float ps = 0; for (int r = 0; r < 16; ++r) ps += p0[r]; for (int r = 0; r < 16; ++r) ps += p1[r];
    { auto rr = __builtin_amdgcn_permlane32_swap(__float_as_uint(ps), __float_as_uint(ps), false, false);
      ps = __uint_as_float(rr[0]) + __uint_as_float(rr[1]); }
    l_reg = l_reg * alpha + ps;
#define PK4(P, B_, OUT) do { unsigned a0 = cvtpk(P[B_+0], P[B_+1]), a1 = cvtpk(P[B_+2], P[B_+3]);                          \
        unsigned b0 = cvtpk(P[B_+4], P[B_+5]), b1 = cvtpk(P[B_+6], P[B_+7]);                                             \
        auto r0 = __builtin_amdgcn_permlane32_swap(a0, b0, false, false); auto r1 = __builtin_amdgcn_permlane32_swap(a1, b1, false, false); \
        u32x4 w = {r0[0], r1[0], r0[1], r1[1]}; OUT = *reinterpret_cast<bf16x8*>(&w); } while (0)
    PK4(p0, 0, pa0); PK4(p0, 8, pa1); PK4(p1, 0, pa2); PK4(p1, 8, pa3);
#undef PK4
}
template <int KB, bool SK>
__device__ __forceinline__ void qkt(f32x16& p0, f32x16& p1, const char* K_lds, const char* B_lds, int r32, int hi, const bf16x8* qr, bool act) {
    if (SK && !act) { const float NEG = -__builtin_inff();
#pragma unroll
        for (int r = 0; r < 16; ++r) { p0[r] = NEG; p1[r] = NEG; } return; }
    { const float* bl = (const float*)B_lds + 4 * hi;
#pragma unroll
      for (int g = 0; g < 4; ++g) { const f32x4 ba = *(const f32x4*)(bl + 8 * g); const f32x4 bb = *(const f32x4*)(bl + 32 + 8 * g);
#pragma unroll
        for (int e = 0; e < 4; ++e) { p0[4 * g + e] = ba[e]; p1[4 * g + e] = bb[e]; } } }
    const char* kb[4];
#pragma unroll
    for (int dd = 0; dd < 4; ++dd) kb[dd] = K_lds + KB * SHM_K + KSWZ(r32, (dd * 16 + hi * 8) * 2);
#pragma unroll
    for (int d0 = 0; d0 < 8; ++d0) { const char* a = kb[d0 & 3] + (d0 >> 2) * 128;
        bf16x8 b0 = *reinterpret_cast<const bf16x8*>(a);
        bf16x8 b1 = *reinterpret_cast<const bf16x8*>(a + 32 * 256);
        p0 = __builtin_amdgcn_mfma_f32_32x32x16_bf16(b0, qr[d0], p0, 0, 0, 0);
        p1 = __builtin_amdgcn_mfma_f32_32x32x16_bf16(b1, qr[d0], p1, 0, 0, 0); }
}
template <int VB, bool SK>
__device__ __forceinline__ void pv_tile(f32x16* o, int vb0, bf16x8 pa0, bf16x8 pa1, bf16x8 pa2, bf16x8 pa3, bool act) {
    if (SK && !act) return;
#define TRRD(dst, off) asm volatile("ds_read_b64_tr_b16 %0, %1 offset:%2" : "=&v"(dst) : "v"(vb0), "i"(off) : "memory")
#define PV_D0(d0) do { s16x4 l0, l1, l2, l3, h0, h1, h2, h3; constexpr int b_ = VB * SHM_V + v_rd_off(d0, 0, 0);     \
        TRRD(l0, b_); TRRD(h0, b_ + 2048); TRRD(l1, b_ + 4096); TRRD(h1, b_ + 6144); TRRD(l2, b_ + 8192); TRRD(h2, b_ + 10240); TRRD(l3, b_ + 12288); TRRD(h3, b_ + 14336); \
        asm volatile("s_waitcnt lgkmcnt(0)" ::: "memory"); SBAR();                 \
        o[d0] = __builtin_amdgcn_mfma_f32_32x32x16_bf16(pa0, (bf16x8){l0[0], l0[1], l0[2], l0[3], h0[0], h0[1], h0[2], h0[3]}, o[d0], 0, 0, 0);   \
        o[d0] = __builtin_amdgcn_mfma_f32_32x32x16_bf16(pa1, (bf16x8){l1[0], l1[1], l1[2], l1[3], h1[0], h1[1], h1[2], h1[3]}, o[d0], 0, 0, 0);   \
        o[d0] = __builtin_amdgcn_mfma_f32_32x32x16_bf16(pa2, (bf16x8){l2[0], l2[1], l2[2], l2[3], h2[0], h2[1], h2[2], h2[3]}, o[d0], 0, 0, 0);   \
        o[d0] = __builtin_amdgcn_mfma_f32_32x32x16_bf16(pa3, (bf16x8){l3[0], l3[1], l3[2], l3[3], h3[0], h3[1], h3[2], h3[3]}, o[d0], 0, 0, 0); } while (0)
    PV_D0(0); PV_D0(1); PV_D0(2); PV_D0(3);
#undef PV_D0
#undef TRRD
}

template <class TIn, class TOut> struct BlockRef { const TIn* Q; const TIn* K; const TIn* V; TOut* O; const float* NC; int P0; int nrows; };
template <class TIn> struct Seam {
    bf16x8 qr[8];
    bf16x8 st_v0, st_v1, st_k0, st_k1; f32x4 sf0, sf1, sf2, sf3;
    f32x4 tq[16];
};
__device__ __forceinline__ int swa_jlo(int P0, int W) { const int lowk = P0 - W + 1; return lowk > 0 ? lowk / KVBLK : 0; }
#define ROW(p, k0, rr) ((p) + (size_t)((k0) + (rr)) * D + sc)
#define VMW() asm volatile("s_waitcnt vmcnt(0)" ::: "memory")
#define VMWN(n) asm volatile("s_waitcnt vmcnt(%0)" :: "i"(n) : "memory")
#define SLOAD_H(Kp, Vp, NCp, k0) do { S.st_v0 = load8<TIn>(ROW(Vp, k0, sr)); S.st_v1 = load8<TIn>(ROW(Vp, k0, 32 + sr));              \
                         S.st_k0 = load8<TIn>(ROW(Kp, k0, sr)); S.st_k1 = load8<TIn>(ROW(Kp, k0, 32 + sr)); } while (0)
#define SWRITE_HK(bf) do { *(bf16x8*)(K_lds + (bf) * SHM_K + kws) = S.st_k0; *(bf16x8*)(K_lds + (bf) * SHM_K + kws + 32 * 256) = S.st_k1; } while (0)
#define SWRITE_HV(bf) do { *(bf16x8*)(V_lds + (bf) * SHM_V + vst0) = S.st_v0; *(bf16x8*)(V_lds + (bf) * SHM_V + vst1) = S.st_v1; } while (0)
#define SWRITE_H(bf) do { SWRITE_HV(bf); SWRITE_HK(bf); } while (0)
#define SLOAD_F(p, k0) do { S.sf0 = *(const f32x4*)ROW(p, k0, sr); S.sf1 = *(const f32x4*)(ROW(p, k0, sr) + 4);                \
                            S.sf2 = *(const f32x4*)ROW(p, k0, 32 + sr); S.sf3 = *(const f32x4*)(ROW(p, k0, 32 + sr) + 4); } while (0)
#define SWRITE_KF(bf) do { *(bf16x8*)(K_lds + (bf) * SHM_K + kws) = pack8(S.sf0, S.sf1); *(bf16x8*)(K_lds + (bf) * SHM_K + kws + 32 * 256) = pack8(S.sf2, S.sf3); } while (0)
#define SWRITE_VF(bf) do { *(bf16x8*)(V_lds + (bf) * SHM_V + vst0) = pack8(S.sf0, S.sf1); *(bf16x8*)(V_lds + (bf) * SHM_V + vst1) = pack8(S.sf2, S.sf3); } while (0)
template <class TIn, class TOut>
__device__ __forceinline__ void causal_swa_prime(const BlockRef<TIn, TOut>& cur, int W, char* lds, Seam<TIn>& S) {
    constexpr bool F32 = same_t<TIn, float>::v;
    const int tid = otid(), wid = __builtin_amdgcn_readfirstlane(tid >> 6), lane = tid & 63, r32 = lane & 31, hi = lane >> 5;
    const int sr = tid >> 4, sc = (tid & 15) * 8, kws = KSWZ(sr, sc * 2); char* K_lds = lds + 2 * SHM_V; char* B_lds = lds + 2 * SHM_V + 2 * SHM_K + NW * 64 * 4;
    const int kb0 = swa_jlo(cur.P0, W) * KVBLK;
    for (int d0 = 0; d0 < 8; ++d0) S.qr[d0] = load8<TIn>(cur.Q + (size_t)(wid * QBLK + r32) * D + d0 * 16 + hi * 8);
    if constexpr (F32) { SLOAD_F((const float*)cur.K, kb0); VMW(); SWRITE_KF(0); SBAR(); SLOAD_F((const float*)cur.V, kb0); }
    else { SLOAD_H(cur.K, cur.V, cur.NC, kb0); VMW(); SWRITE_HK(0); }
    __syncthreads();
}
template <class TIn, class TOut>
__device__ __forceinline__ void causal_swa_block(const BlockRef<TIn, TOut>& cur, const BlockRef<TIn, TOut>& nxt, int skv, int W, char* lds, Seam<TIn>& S) {
    constexpr bool F32 = same_t<TIn, float>::v;
    const int tid = otid(), wid = __builtin_amdgcn_readfirstlane(tid >> 6), lane = tid & 63, r32 = lane & 31, hi = lane >> 5;
    const int j_lo = swa_jlo(cur.P0, W);
    int j_hi = (cur.P0 + QB - 1) / KVBLK + 1; if (j_hi > skv / KVBLK) j_hi = skv / KVBLK;
    const int NT = j_hi - j_lo;
    const int kbn = swa_jlo(nxt.P0, W) * KVBLK;
    const int qlo = cur.P0 + wid * QBLK, qm = qlo + r32 - 4 * hi;
    char* V_lds = lds; char* K_lds = lds + 2 * SHM_V; char* B_lds = lds + 2 * SHM_V + 2 * SHM_K + NW * 64 * 4;
    float* ws = (float*)(lds + 2 * SHM_V + 2 * SHM_K) + wid * 64; float* li_l = ws, * al_l = ws + 32;
    float m_reg = -1e30f, l_reg = 0; f32x16 o[4] = {};
    const int sr = tid >> 4, sc = (tid & 15) * 8, vst0 = v_st(sr, sc), vst1 = v_st(32 + sr, sc), kws = KSWZ(sr, sc * 2);
    const int vb0 = (int)(uintptr_t)V_lds + v_rd_base(lane);
    const TIn* Kh = cur.K; const TIn* Vh = cur.V;
#define RESC(a) do { if (__any((a) < 1.f)) { if (hi == 0) al_l[r32] = (a); asm volatile("s_waitcnt lgkmcnt(0)" ::: "memory");              \
                     for (int d_ = 0; d_ < 4; ++d_) for (int r = 0; r < 16; ++r) o[d_][r] *= al_l[crow(r, hi)]; } } while (0)
#define KBASE(t) ((j_lo + (t)) * KVBLK)
#define ACT(t) (KBASE(t) <= qlo + QBLK - 1 && KBASE(t) + KVBLK - 1 >= qlo - W + 1)
#define MASKT(P0_, P1_, t) do { const int kb_ = KBASE(t); if ((!SK || ACT(t)) && (kb_ + KVBLK - 1 > qlo || kb_ <= qlo + QBLK - 1 - W)) mask_tile(P0_, P1_, qm - kb_, (unsigned)W); } while (0)
    constexpr int NQL = F32 ? 16 : 8;
    constexpr bool SK = WSKIP && !F32;
#define SEAM_K0() do { VMWN(NQL); if constexpr (F32) { SWRITE_KF(0); SBAR(); SLOAD_F((const float*)nxt.V, kbn); } else { SWRITE_HK(0); } SBAR(); } while (0)
    f32x16 pA0, pA1, pB0, pB1; float mnA, mnB, alA, alB; bf16x8 pa0, pa1, pa2, pa3;
    { const int nbk = j_hi * KVBLK;
      for (int q = tid * 4; q < nbk; q += 2048) *(f32x4*)(B_lds + q * 4) = *(const f32x4*)(cur.NC + q);
      __syncthreads(); }
    if constexpr (F32) { VMW(); SWRITE_VF(0); SBAR(); } else { SWRITE_HV(0); SBAR(); }
    if (NT > 1) { if constexpr (F32) SLOAD_F((const float*)Kh, KBASE(1)); else SLOAD_H(Kh, Vh, cur.NC, KBASE(1)); }
    SBAR(); qkt<0, SK>(pA0, pA1, K_lds, B_lds + KBASE(0) * 4, r32, hi, S.qr, ACT(0));
    if constexpr (F32) { if (NT > 1) { VMW(); SWRITE_KF(1); SBAR(); SLOAD_F((const float*)Vh, KBASE(1)); } }
    MASKT(pA0, pA1, 0); partialSM(pA0, pA1, m_reg, mnA, alA);
    if (NT > 1) { VMW(); if constexpr (F32) { SWRITE_VF(1); SBAR(); if (NT > 2) SLOAD_F((const float*)Kh, KBASE(2)); } else SWRITE_H(1); }
    __syncthreads();
#define HALF_STEP(PX0, PX1, mnX, alX, PY0, PY1, alY, t, KB, VB, SB) do {                                                      \
        SBAR(); qkt<KB, SK>(PX0, PX1, K_lds, B_lds + KBASE(t) * 4, r32, hi, S.qr, ACT(t));                                             \
        finishSM(PY0, PY1, alY, l_reg, pa0, pa1, pa2, pa3); SBAR();                                                           \
        if ((t) + 1 < NT) { if constexpr (F32) { VMW(); SWRITE_KF(SB); SBAR(); SLOAD_F((const float*)Vh, KBASE((t) + 1)); }  \
                            else { SLOAD_H(Kh, Vh, cur.NC, KBASE((t) + 1)); } SBAR(); }                                               \
        pv_tile<VB, SK>(o, vb0, pa0, pa1, pa2, pa3, ACT((t) - 1)); MASKT(PX0, PX1, (t)); partialSM(PX0, PX1, m_reg, mnX, alX);                                        \
        __syncthreads();                                                                                                      \
        if ((t) + 1 < NT) { VMW(); if constexpr (F32) { SWRITE_VF(SB); SBAR(); if ((t) + 2 < NT) SLOAD_F((const float*)Kh, KBASE((t) + 2)); } \
                            else { SWRITE_H(SB); } }                                                                          \
        RESC(alX); __syncthreads(); } while (0)
    for (int t = 1; t + 1 < NT; t += 2) {
        HALF_STEP(pB0, pB1, mnB, alB, pA0, pA1, alA, t, 1, 0, 0);
        HALF_STEP(pA0, pA1, mnA, alA, pB0, pB1, alB, t + 1, 0, 1, 1);
    }
    const bool even = (NT & 1) == 0;
    if (even) { SBAR(); qkt<1, SK>(pB0, pB1, K_lds, B_lds + KBASE(NT - 1) * 4, r32, hi, S.qr, ACT(NT - 1)); SBAR(); }
#define QROW(e) (nxt.Q + (size_t)(wid * QBLK + r32) * D + ((e) >> 1) * 16 + hi * 8 + ((e) & 1) * 4)
    if constexpr (F32) { SLOAD_F((const float*)nxt.K, kbn); SBAR();
#pragma unroll
        for (int e = 0; e < 8; ++e) S.tq[e] = *(const f32x4*)QROW(e); }
    else { SLOAD_H(nxt.K, nxt.V, nxt.NC, kbn); SBAR();
#pragma unroll
        for (int d0 = 0; d0 < 8; ++d0) S.qr[d0] = load8<TIn>(nxt.Q + (size_t)(wid * QBLK + r32) * D + d0 * 16 + hi * 8); }
    SBAR();
    finishSM(pA0, pA1, alA, l_reg, pa0, pa1, pa2, pa3); SBAR();
    if constexpr (F32) {
#pragma unroll
        for (int e = 8; e < 16; ++e) S.tq[e] = *(const f32x4*)QROW(e); SBAR(); }
#undef QROW
    pv_tile<0, SK>(o, vb0, pa0, pa1, pa2, pa3, ACT(even ? NT - 2 : NT - 1));
    if (even) { MASKT(pB0, pB1, NT - 1); partialSM(pB0, pB1, m_reg, mnB, alB); __syncthreads(); RESC(alB);
        finishSM(pB0, pB1, alB, l_reg, pa0, pa1, pa2, pa3); SBAR(); pv_tile<1, SK>(o, vb0, pa0, pa1, pa2, pa3, ACT(NT - 1)); }
    SBAR(); SEAM_K0();
    if (hi == 0) li_l[r32] = l_reg; asm volatile("s_waitcnt lgkmcnt(0)" ::: "memory");
    float rli[16];
#pragma unroll
    for (int r = 0; r < 16; ++r) rli[r] = __builtin_amdgcn_rcpf(li_l[crow(r, hi)]);
    TOut* Ow = cur.O + (size_t)(wid * QBLK) * OSTR;
    if (wid * QBLK < cur.nrows)
#pragma unroll
    for (int r = 0; r < 16; ++r) { const int orow = crow(r, hi);
#pragma unroll
        for (int d0 = 0; d0 < 4; ++d0) { const float v = o[d0][r] * rli[r];
            if constexpr (same_t<TOut, float>::v) { Ow[(size_t)orow * OSTR + d0 * 32 + r32] = v; }
            else { const float vn = __shfl_xor(v, 1);
                   if ((r32 & 1) == 0) *(unsigned*)(Ow + (size_t)orow * OSTR + d0 * 32 + r32) = cvtpk(v, vn); } } }
    if constexpr (F32) {
#pragma unroll
        for (int d0 = 0; d0 < 8; ++d0) S.qr[d0] = pack8(S.tq[2 * d0], S.tq[2 * d0 + 1]); }
    __syncthreads();
#undef RESC
#undef KBASE
#undef ACT
#undef MASKT
#undef SEAM_K0
#undef HALF_STEP
}
#undef ROW
#undef VMW
#undef VMWN
#undef SLOAD_H
#undef SWRITE_HK
#undef SWRITE_HV
#undef SWRITE_H
#undef SLOAD_F
#undef SWRITE_KF
#undef SWRITE_VF

}

__device__ __forceinline__ float bf2f(unsigned short b) { return __uint_as_float(((unsigned)b) << 16); }
__device__ __forceinline__ unsigned pk2(float lo, float hi) { unsigned r; asm volatile("v_cvt_pk_bf16_f32 %0, %1, %2" : "=v"(r) : "v"(lo), "v"(hi)); return r; }
__device__ __forceinline__ unsigned short f2bf(float x) { return (unsigned short)(pk2(x, 0.f) & 0xffffu); }
__device__ __forceinline__ float wave_sum(float v) {
#pragma unroll
    for (int o = 1; o < 64; o <<= 1) v += __shfl_xor(v, o);
    return v;
}
__device__ __forceinline__ float grp16_sum(float v) {
#pragma unroll
    for (int o = 1; o < 16; o <<= 1) v += __shfl_xor(v, o);
    return v;
}
__device__ __forceinline__ float wave_incl_scan(float v, int lane) {
#pragma unroll
    for (int o = 1; o < 64; o <<= 1) { const float t = __shfl_up(v, o); if (lane >= o) v += t; }
    return v;
}
__device__ __forceinline__ float silu_f(float x) { return x / (1.f + __expf(-x)); }
__device__ __forceinline__ void unpack8(u32x4 w, float (&o)[8]) {
#pragma unroll
    for (int q = 0; q < 4; ++q) { o[2 * q] = __uint_as_float(w[q] << 16); o[2 * q + 1] = __uint_as_float(w[q] & 0xffff0000u); }
}
__device__ __forceinline__ u32x4 pack8f(const float (&v)[8]) { u32x4 w = {pk2(v[0], v[1]), pk2(v[2], v[3]), pk2(v[4], v[5]), pk2(v[6], v[7])}; return w; }
__device__ __forceinline__ int pos16(int x) { return (x & ~12) | (((x >> 2) & 1) << 3) | (((x >> 3) & 1) << 2); }
__device__ __forceinline__ int crow32(int r, int hi) { return (r & 3) + 8 * (r >> 2) + 4 * hi; }

struct EpiBf16Plain {
    static constexpr bool PERM = true, AFTER_DRAIN = false;
    bf16_t* O; int ldc;
    __device__ __forceinline__ void operator()(const pg8::f32x4 (&acc)[2][2][4][2], const pg8::Unit& u, int wr, int wc, int fr, int fq) const {
        const int row0 = u.pm * 256 + wr * 64 + fr, col0 = u.pn * 256 + wc * 32 + 8 * fq;
#pragma unroll
        for (int ai = 0; ai < 2; ++ai)
#pragma unroll
            for (int m = 0; m < 4; ++m) { bf16_t* rowp = O + (size_t)(row0 + ai * 128 + m * 16) * ldc + col0;
#pragma unroll
                for (int bj = 0; bj < 2; ++bj) { const pg8::f32x4 v0 = acc[ai][bj][m][0], v1 = acc[ai][bj][m][1];
                    u32x4 w; w.x = pk2(v0[0], v0[1]); w.y = pk2(v0[2], v0[3]); w.z = pk2(v1[0], v1[1]); w.w = pk2(v1[2], v1[3]);
                    *(u32x4*)(rowp + bj * 128) = w; } }
    }
};
struct EpiSwiglu {
    static constexpr bool PERM = true, AFTER_DRAIN = false;
    bf16_t* O; int ldc;
    __device__ __forceinline__ void operator()(const pg8::f32x4 (&acc)[2][2][4][2], const pg8::Unit& u, int wr, int wc, int fr, int fq) const {
        const int row0 = u.pm * 256 + wr * 64 + fr, col0 = u.pn * 128 + wc * 32 + 8 * fq;
#pragma unroll
        for (int ai = 0; ai < 2; ++ai)
#pragma unroll
            for (int m = 0; m < 4; ++m) { bf16_t* rowp = O + (size_t)(row0 + ai * 128 + m * 16) * ldc + col0;
                float r[8];
#pragma unroll
                for (int n = 0; n < 2; ++n)
#pragma unroll
                    for (int e = 0; e < 4; ++e) { const float g = acc[ai][0][m][n][e], up = acc[ai][1][m][n][e]; r[4 * n + e] = silu_f(g) * up; }
                *(u32x4*)rowp = pack8f(r); }
    }
};
struct EpiResid {
    static constexpr bool PERM = false, AFTER_DRAIN = false;
    float* X; int ldc;
    __device__ __forceinline__ void operator()(const pg8::f32x4 (&acc)[2][2][4][2], const pg8::Unit& u, int wr, int wc, int fr, int fq) const {
        const int row0 = u.pm * 256 + wr * 64 + fr, col0 = u.pn * 256 + wc * 32 + 4 * fq;
#pragma unroll
        for (int ai = 0; ai < 2; ++ai)
#pragma unroll
            for (int m = 0; m < 4; ++m) { float* rowp = X + (size_t)(row0 + ai * 128 + m * 16) * ldc + col0;
#pragma unroll
                for (int bj = 0; bj < 2; ++bj)
#pragma unroll
                    for (int n = 0; n < 2; ++n) { pg8::f32x4* q = (pg8::f32x4*)(rowp + bj * 128 + n * 16); *q = *q + acc[ai][bj][m][n]; } }
    }
};
template <class Epi>
__device__ __forceinline__ void run_gemm(PG8_LAS unsigned char* lds, const bf16_t* A, const bf16_t* Bt, int N, int K, const Epi& E) {
    pg8::Gemm g; g.A = A; g.Bt = Bt; g.M = MT; g.N = N; g.K = K;
    pg8::StaticOrder S; S.init(MT, N, (int)gridDim.x, (int)blockIdx.x);
    pg8::gemm_phase<Epi, pg8::StaticOrder, false>(lds, g, S, E, nullptr);
}

__device__ __forceinline__ void transpose_weight(const float* __restrict__ W, int K, int N, bf16_t* WT, int mode, float* tile) {
    const int tid = otid();
    const int nct = (N + 63) >> 6, nkt = K >> 6, nt = nct * nkt;
    for (int t = blockIdx.x; t < nt; t += gridDim.x) {
        const int kt = t / nct, ct = t - kt * nct, k0 = kt * 64, n0 = ct * 64;
#pragma unroll
        for (int i = 0; i < 8; ++i) { const int r = (tid >> 6) + 8 * i, c = tid & 63, n = n0 + c;
            tile[r * 65 + c] = (n < N) ? W[(size_t)(k0 + r) * N + n] : 0.f; }
        __syncthreads();
        { const int nl = tid >> 3, kc = tid & 7, n = n0 + nl; int dest = -1;
          if (n < N) {
              if (mode == 0) dest = n;
              else if (mode == 1) dest = n < 2048 ? n : (n < 2056 ? -1 : n - 8);
              else if (mode == 2) dest = n < 3072 ? n : -1;
              else if (mode == 3) dest = 256 * (n >> 7) + (n & 127);
              else dest = 256 * (n >> 7) + 128 + (n & 127);
          }
          if (dest >= 0) { float v[8];
#pragma unroll
              for (int e = 0; e < 8; ++e) v[e] = tile[(8 * kc + e) * 65 + nl];
              *(u32x4*)(WT + (size_t)dest * K + k0 + 8 * kc) = pack8f(v); } }
        __syncthreads();
    }
}
__device__ __forceinline__ void phase_init(CParams& p, unsigned char* shm) {
    {
        f32x4* X = (f32x4*)p.out; const f32x4* xp = (const f32x4*)p.in[0]; const f32x4* xs = (const f32x4*)p.in[1];
        const size_t np = (size_t)MP * DM / 4, nall = (size_t)MT * DM / 4;
        for (size_t i = (size_t)blockIdx.x * 512 + threadIdx.x; i < nall; i += (size_t)gridDim.x * 512) X[i] = i < np ? xp[i] : xs[i - np];
    }
    float* tile = (float*)shm;
    for (int i = 0; i < 2; ++i) {
        transpose_weight(p.in[10] + (size_t)i * DM * EVEN_IN, DM, EVEN_IN, (bf16_t*)(p.ws + WS_WINE) + (size_t)i * NE * DM, 1, tile);
        transpose_weight(p.in[16] + (size_t)i * DM * DM, DM, DM, (bf16_t*)(p.ws + WS_WOUTE) + (size_t)i * DM * DM, 0, tile);
        transpose_weight(p.in[17] + (size_t)i * DM * ODD_IN, DM, ODD_IN, (bf16_t*)(p.ws + WS_WINO) + (size_t)i * NO * DM, 2, tile);
        transpose_weight(p.in[21] + (size_t)i * DM * DM, DM, DM, (bf16_t*)(p.ws + WS_WOUTO) + (size_t)i * DM * DM, 0, tile);
    }
    for (int l = 0; l < 4; ++l) {
        transpose_weight(p.in[22] + (size_t)l * DM * DFF, DM, DFF, (bf16_t*)(p.ws + WS_WF1) + (size_t)l * NF1 * DM, 3, tile);
        transpose_weight(p.in[23] + (size_t)l * DM * DFF, DM, DFF, (bf16_t*)(p.ws + WS_WF1) + (size_t)l * NF1 * DM, 4, tile);
        transpose_weight(p.in[24] + (size_t)l * DFF * DM, DFF, DM, (bf16_t*)(p.ws + WS_WF2) + (size_t)l * DM * DFF, 0, tile);
    }
}

template <int MODE>
__device__ __forceinline__ void phase_norm(CParams& p, int layer, unsigned char* shm) {
    const int tid = otid(), lane = tid & 63, wid = tid >> 6, i = layer >> 1;
    float* Wsm = (float*)shm;
    const float* X = p.out;
    bf16_t* H = (bf16_t*)(p.ws + WS_H);
    const float* gain = (MODE == 2 ? p.in[9] : p.in[8]) + layer * DM;
    if (MODE != 2) {
        const float* W = MODE == 0 ? p.in[10] + (size_t)i * DM * EVEN_IN + 2048 : p.in[17] + (size_t)i * DM * ODD_IN + 3072;
        const int ldw = MODE == 0 ? EVEN_IN : ODD_IN;
#pragma unroll
        for (int r = 0; r < 4; ++r) { const int q = tid + 512 * r, k = q >> 1, hf = q & 1;
            const f32x4 w = *(const f32x4*)(W + (size_t)k * ldw + 4 * hf);
            const int j = k >> 8, l = (k & 255) >> 2, e = k & 3;
            *(f32x4*)(Wsm + (((j * 4 + e) * 64 + l) * 8 + 4 * hf)) = w; }
        __syncthreads();
    }
    f32x4 g4[4];
#pragma unroll
    for (int j = 0; j < 4; ++j) g4[j] = *(const f32x4*)(gain + 256 * j + 4 * lane);
    for (int row = blockIdx.x * 8 + wid; row < MT; row += gridDim.x * 8) {
        const f32x4* xr = (const f32x4*)(X + (size_t)row * DM) + lane;
        f32x4 v[4]; float ss = 0.f;
#pragma unroll
        for (int j = 0; j < 4; ++j) { v[j] = xr[64 * j]; ss += (v[j].x * v[j].x + v[j].y * v[j].y) + (v[j].z * v[j].z + v[j].w * v[j].w); }
        ss = wave_sum(ss);
        const float rstd = 1.f / sqrtf(ss * (1.f / DM) + EPS);
        u32x2* ho = (u32x2*)(H + (size_t)row * DM) + lane;
#pragma unroll
        for (int j = 0; j < 4; ++j) { v[j] = v[j] * rstd * g4[j]; u32x2 w; w.x = pk2(v[j].x, v[j].y); w.y = pk2(v[j].z, v[j].w); ho[64 * j] = w; }
        if (MODE != 2) {
            float acc[8];
#pragma unroll
            for (int c = 0; c < 8; ++c) acc[c] = 0.f;
#pragma unroll
            for (int j = 0; j < 4; ++j)
#pragma unroll
                for (int e = 0; e < 4; ++e) { const float hv = v[j][e]; const float* wp = Wsm + ((j * 4 + e) * 64 + lane) * 8;
                    const f32x4 w0 = *(const f32x4*)wp, w1 = *(const f32x4*)(wp + 4);
#pragma unroll
                    for (int c = 0; c < 4; ++c) { acc[c] = fmaf(hv, w0[c], acc[c]); acc[4 + c] = fmaf(hv, w1[c], acc[4 + c]); } }
#pragma unroll
            for (int c = 0; c < 8; ++c) acc[c] = wave_sum(acc[c]);
            if (lane == 0) {
                if (MODE == 0) { float* d = (float*)(p.ws + WS_AB) + (size_t)row * 8;
                    *(f32x4*)d = (f32x4){acc[0], acc[1], acc[2], acc[3]}; *(f32x4*)(d + 4) = (f32x4){acc[4], acc[5], acc[6], acc[7]}; }
                else { const float* bfp = p.in[18] + i * 8; float lf[8];
#pragma unroll
                    for (int c = 0; c < 8; ++c) { const float x = acc[c] + bfp[c]; lf[c] = fminf(x, 0.f) - log1pf(expf(-fabsf(x))); }
                    float* d = row < MP ? p.out + OFF_PLF + ((size_t)i * MP + row) * 8 : p.out + OFF_SLF + ((size_t)i * MS + (row - MP)) * 8;
                    *(f32x4*)d = (f32x4){lf[0], lf[1], lf[2], lf[3]}; *(f32x4*)(d + 4) = (f32x4){lf[4], lf[5], lf[6], lf[7]}; }
            }
        }
    }
}

__device__ __forceinline__ void phase_gdn_prep(CParams& p, int i, unsigned char* shm) {
    const int tid = otid(), lane = tid & 63, wid = tid >> 6, r32 = lane & 31, hi = lane >> 5;
    const bf16_t* P = (const bf16_t*)(p.ws + WS_BIG);
    const float* AB = (const float*)(p.ws + WS_AB);
    const float* convw = p.in[11] + (size_t)i * 4 * 1536;
    bf16_t* qs = (bf16_t*)shm; bf16_t* ks = (bf16_t*)(shm + 17408); bf16_t* vs = (bf16_t*)(shm + 34816);
    float* As = (float*)(shm + 52224); float* Gs = (float*)(shm + 68608); float* Bs = Gs + 64;
    bf16_t* NEGW = (bf16_t*)(p.ws + WS_NEGW); bf16_t* QG = (bf16_t*)(p.ws + WS_QG); bf16_t* KDT = (bf16_t*)(p.ws + WS_KDT);
    bf16_t* PM = (bf16_t*)(p.ws + WS_PM); bf16_t* UPRE = (bf16_t*)(p.ws + WS_UPRE); float* GC = (float*)(p.ws + WS_GC);
    for (int it = blockIdx.x; it < 1152; it += gridDim.x) {
        int b, n, h, T0; bool sample;
        if (it < 1024) { b = it >> 8; n = (it >> 2) & 63; h = it & 3; T0 = b * 4096 + n * 64; sample = false; }
        else { const int j = it - 1024; b = j >> 2; h = j & 3; n = 0; T0 = MP + b * 64; sample = true; }
        const bool first = (n == 0), last = sample || (n == 63);
#pragma unroll 1
        for (int r = 0; r < 6; ++r) {
            const int idx = tid + 512 * r, t = idx / 48, cgi = idx - t * 48, part = cgi >> 4, c8 = (cgi & 15) * 8;
            const int col = part * 512 + h * 128 + c8;
            float y[8];
#pragma unroll
            for (int e = 0; e < 8; ++e) y[e] = 0.f;
#pragma unroll
            for (int tap = 0; tap < 4; ++tap) {
                const int tt = t - 3 + tap; float xv[8];
                if (tt >= 0 || !first) { unpack8(*(const u32x4*)(P + (size_t)(T0 + tt) * NE + col), xv); }
                else if (sample) { const float* sp = p.in[6] + (((size_t)i * 32 + b) * 3 + (tt + 3)) * 1536 + col;
                    const f32x4 a = *(const f32x4*)sp, c = *(const f32x4*)(sp + 4);
#pragma unroll
                    for (int e = 0; e < 4; ++e) { xv[e] = a[e]; xv[4 + e] = c[e]; } }
                else {
#pragma unroll
                    for (int e = 0; e < 8; ++e) xv[e] = 0.f; }
                const float* wp = convw + tap * 1536 + col; const f32x4 w0 = *(const f32x4*)wp, w1 = *(const f32x4*)(wp + 4);
#pragma unroll
                for (int e = 0; e < 4; ++e) { y[e] = fmaf(w0[e], xv[e], y[e]); y[4 + e] = fmaf(w1[e], xv[4 + e], y[4 + e]); }
                if (tap == 3 && last && t >= 61) {
                    float* d = (sample ? p.out + OFF_SCONV + (((size_t)i * 32 + b) * 3 + (t - 61)) * 1536 : p.out + OFF_PCONV + (((size_t)i * 4 + b) * 3 + (t - 61)) * 1536) + col;
                    *(f32x4*)d = (f32x4){xv[0], xv[1], xv[2], xv[3]}; *(f32x4*)(d + 4) = (f32x4){xv[4], xv[5], xv[6], xv[7]}; }
            }
            float ss = 0.f;
#pragma unroll
            for (int e = 0; e < 8; ++e) { y[e] = silu_f(y[e]); ss = fmaf(y[e], y[e], ss); }
            ss = grp16_sum(ss);
            const float sc = part == 2 ? 1.f : (1.f / sqrtf(ss + EPS)) * (part == 0 ? 0.08838834764831845f : 1.f);
#pragma unroll
            for (int e = 0; e < 8; ++e) y[e] *= sc;
            bf16_t* dst = (part == 0 ? qs : (part == 1 ? ks : vs)) + t * 136 + c8;
            *(u32x4*)dst = pack8f(y);
        }
        if (wid == 0) {
            const float a = AB[(size_t)(T0 + lane) * 8 + h], bb = AB[(size_t)(T0 + lane) * 8 + 4 + h];
            const float x = a + p.in[13][i * 4 + h];
            const float sp = fmaxf(x, 0.f) + log1pf(expf(-fabsf(x)));
            float g = -expf(p.in[12][i * 4 + h]) * sp;
            g = wave_incl_scan(g, lane);
            Gs[lane] = g; Bs[lane] = 1.f / (1.f + expf(-bb));
        }
        __syncthreads();
        {
            const int type = wid >> 2, bi = (wid >> 1) & 1, bj = wid & 1;
            const bf16_t* Xs = type ? qs : ks;
            f32x16 acc = {};
#pragma unroll
            for (int kk = 0; kk < 8; ++kk) {
                const bf16x8 a = *(const bf16x8*)(Xs + (32 * bi + r32) * 136 + kk * 16 + hi * 8);
                const bf16x8 bq = *(const bf16x8*)(ks + (32 * bj + r32) * 136 + kk * 16 + hi * 8);
                acc = __builtin_amdgcn_mfma_f32_32x32x16_bf16(a, bq, acc, 0, 0, 0);
            }
            const int j = 32 * bj + r32; const float Gj = Gs[j];
#pragma unroll
            for (int r = 0; r < 16; ++r) { const int ii = 32 * bi + crow32(r, hi); const float d = __expf(fminf(Gs[ii] - Gj, 0.f));
                if (type == 0) As[ii * 64 + j] = (ii > j) ? acc[r] * Bs[ii] * d : 0.f;
                else PM[(size_t)it * 4096 + ii * 64 + pos16(j)] = f2bf((ii >= j) ? acc[r] * d : 0.f); }
        }
        __syncthreads();
        if (wid < 4) {
            const int c = tid; float sol[64];
            if (c < 128) {
#pragma unroll
                for (int r = 0; r < 64; ++r) sol[r] = bf2f(vs[r * 136 + c]) * Bs[r];
            } else {
#pragma unroll
                for (int r = 0; r < 64; ++r) sol[r] = bf2f(ks[r * 136 + c - 128]) * Bs[r] * __expf(Gs[r]);
            }
#pragma unroll
            for (int r = 1; r < 64; ++r) { float a = sol[r];
#pragma unroll
                for (int j = 0; j < r; ++j) a = fmaf(-As[r * 64 + j], sol[j], a);
                sol[r] = a; }
            if (c < 128) { const int sl = c >> 5, cc = c & 31;
#pragma unroll
                for (int mb = 0; mb < 2; ++mb)
#pragma unroll
                    for (int rg = 0; rg < 2; ++rg)
#pragma unroll
                        for (int hh = 0; hh < 2; ++hh) { const int tb = 32 * mb + 16 * rg + 4 * hh;
                            u32x4 w = {pk2(sol[tb], sol[tb + 1]), pk2(sol[tb + 2], sol[tb + 3]), pk2(sol[tb + 8], sol[tb + 9]), pk2(sol[tb + 10], sol[tb + 11])};
                            *(u32x4*)(UPRE + ((((size_t)it * 4 + sl) * 2 + mb) * 2 + rg) * 512 + (cc + 32 * hh) * 8) = w; }
            } else { const int pp = pos16(c - 128); bf16_t* d = NEGW + (size_t)it * 8192 + pp;
#pragma unroll
                for (int r = 0; r < 64; ++r) d[r * 128] = f2bf(-sol[r]); }
        } else {
            const int t2 = tid - 256; const float GL = Gs[63];
#pragma unroll
            for (int r = 0; r < 4; ++r) { const int ch = t2 + 256 * r, row = ch >> 4, pc = ch & 15, dk0 = 16 * (pc >> 1) + 4 * (pc & 1);
                const float eg = __expf(Gs[row]); const bf16_t* s = qs + row * 136 + dk0; float v[8];
#pragma unroll
                for (int e = 0; e < 4; ++e) { v[e] = bf2f(s[e]) * eg; v[4 + e] = bf2f(s[8 + e]) * eg; }
                *(u32x4*)(QG + (size_t)it * 8192 + row * 128 + pc * 8) = pack8f(v); }
#pragma unroll
            for (int r = 0; r < 4; ++r) { const int ch = t2 + 256 * r, dk = ch & 127, pc = ch >> 7, t0 = 16 * (pc >> 1) + 4 * (pc & 1); float v[8];
#pragma unroll
                for (int e = 0; e < 8; ++e) { const int te = t0 + (e & 3) + 8 * (e >> 2); v[e] = bf2f(ks[te * 136 + dk]) * __expf(GL - Gs[te]); }
                *(u32x4*)(KDT + (size_t)it * 8192 + dk * 64 + pc * 8) = pack8f(v); }
            if (t2 == 0) GC[it] = __expf(GL);
        }
        __syncthreads();
    }
}

constexpr int SC_NW = 0, SC_QG = 17408, SC_KD = 34816, SC_PM = 53248, SC_BUF = 62464;
__device__ __forceinline__ void phase_gdn_scan(CParams& p, int i, unsigned char* shm) {
    const int tid = otid(), lane = tid & 63, wid = tid >> 6, r32 = lane & 31, hi = lane >> 5;
    const u32x4* NEGW = (const u32x4*)(p.ws + WS_NEGW); const u32x4* QG = (const u32x4*)(p.ws + WS_QG); const u32x4* KDT = (const u32x4*)(p.ws + WS_KDT);
    const u32x4* PM = (const u32x4*)(p.ws + WS_PM); const u32x4* UPRE = (const u32x4*)(p.ws + WS_UPRE); const float* GC = (const float*)(p.ws + WS_GC);
    bf16_t* OG = (bf16_t*)(p.ws + WS_OG);
    for (int it = blockIdx.x; it < 144; it += gridDim.x) {
        int b, h, nsteps, ch0, chs, T0; bool sample;
        if (it < 16) { b = it >> 2; h = it & 3; nsteps = 64; ch0 = b * 256 + h; chs = 4; T0 = b * 4096; sample = false; }
        else { const int j = it - 16; b = j >> 2; h = j & 3; nsteps = 1; ch0 = 1024 + j; chs = 0; T0 = MP + b * 64; sample = true; }
        if (wid >= 4) {
            const int t2 = tid - 256;
            for (int s = -1; s + 1 < nsteps; ++s) {
                const size_t ch = (size_t)(ch0 + (s + 1) * chs); u32x4 st[14];
#pragma unroll
                for (int r = 0; r < 4; ++r) st[r] = NEGW[ch * 1024 + t2 + 256 * r];
#pragma unroll
                for (int r = 0; r < 4; ++r) st[4 + r] = QG[ch * 1024 + t2 + 256 * r];
#pragma unroll
                for (int r = 0; r < 4; ++r) st[8 + r] = KDT[ch * 1024 + t2 + 256 * r];
#pragma unroll
                for (int r = 0; r < 2; ++r) st[12 + r] = PM[ch * 512 + t2 + 256 * r];
                unsigned char* base = shm + ((s + 1) & 1) * SC_BUF;
#pragma unroll
                for (int r = 0; r < 4; ++r) { const int q = t2 + 256 * r; *(u32x4*)(base + SC_NW + (q >> 4) * 272 + (q & 15) * 16) = st[r]; }
#pragma unroll
                for (int r = 0; r < 4; ++r) { const int q = t2 + 256 * r; *(u32x4*)(base + SC_QG + (q >> 4) * 272 + (q & 15) * 16) = st[4 + r]; }
#pragma unroll
                for (int r = 0; r < 4; ++r) { const int q = t2 + 256 * r; *(u32x4*)(base + SC_KD + (q >> 3) * 144 + (q & 7) * 16) = st[8 + r]; }
#pragma unroll
                for (int r = 0; r < 2; ++r) { const int q = t2 + 256 * r; *(u32x4*)(base + SC_PM + (q >> 3) * 144 + (q & 7) * 16) = st[12 + r]; }
                __syncthreads();
            }
            __syncthreads();
        } else {
            const int sl = wid;
            f32x16 S[4];
            if (sample) { const float* s0 = p.in[5] + ((((size_t)i * 32 + b) * 4 + h) << 14) + 32 * sl + r32;
#pragma unroll
                for (int mb = 0; mb < 4; ++mb)
#pragma unroll
                    for (int r = 0; r < 16; ++r) S[mb][r] = s0[(32 * mb + crow32(r, hi)) * 128];
            } else {
#pragma unroll
                for (int mb = 0; mb < 4; ++mb)
#pragma unroll
                    for (int r = 0; r < 16; ++r) S[mb][r] = 0.f;
            }
            u32x4 up[4]; float gcr;
#pragma unroll
            for (int q = 0; q < 4; ++q) up[q] = UPRE[(((size_t)ch0 * 4 + sl) * 4 + q) * 64 + lane];
            gcr = GC[ch0];
            __syncthreads();
            for (int s = 0; s < nsteps; ++s) {
                const unsigned char* B0 = shm + (s & 1) * SC_BUF;
                f32x16 u[2], o[2];
#pragma unroll
                for (int mb = 0; mb < 2; ++mb)
#pragma unroll
                    for (int rg = 0; rg < 2; ++rg) { const u32x4 w = up[mb * 2 + rg];
#pragma unroll
                        for (int q = 0; q < 4; ++q) { u[mb][8 * rg + 2 * q] = __uint_as_float(w[q] << 16); u[mb][8 * rg + 2 * q + 1] = __uint_as_float(w[q] & 0xffff0000u); } }
                const float gc = gcr;
                if (s + 1 < nsteps) { const size_t chn = (size_t)(ch0 + (s + 1) * chs);
#pragma unroll
                    for (int q = 0; q < 4; ++q) up[q] = UPRE[((chn * 4 + sl) * 4 + q) * 64 + lane];
                    gcr = GC[chn]; }
                bf16x8 Sb[8];
#pragma unroll
                for (int kk = 0; kk < 8; ++kk) { const int mb = kk >> 1, hf = kk & 1;
                    u32x4 w = {pk2(S[mb][8 * hf], S[mb][8 * hf + 1]), pk2(S[mb][8 * hf + 2], S[mb][8 * hf + 3]), pk2(S[mb][8 * hf + 4], S[mb][8 * hf + 5]), pk2(S[mb][8 * hf + 6], S[mb][8 * hf + 7])};
                    Sb[kk] = *reinterpret_cast<bf16x8*>(&w); }
#pragma unroll
                for (int mb = 0; mb < 2; ++mb) {
#pragma unroll
                    for (int r = 0; r < 16; ++r) o[mb][r] = 0.f;
#pragma unroll
                    for (int kk = 0; kk < 8; ++kk) {
                        const bf16x8 a = *(const bf16x8*)(B0 + SC_NW + (32 * mb + r32) * 272 + (kk * 16 + hi * 8) * 2);
                        u[mb] = __builtin_amdgcn_mfma_f32_32x32x16_bf16(a, Sb[kk], u[mb], 0, 0, 0);
                        const bf16x8 a2 = *(const bf16x8*)(B0 + SC_QG + (32 * mb + r32) * 272 + (kk * 16 + hi * 8) * 2);
                        o[mb] = __builtin_amdgcn_mfma_f32_32x32x16_bf16(a2, Sb[kk], o[mb], 0, 0, 0);
                    }
                }
                bf16x8 ub[4];
#pragma unroll
                for (int kk = 0; kk < 4; ++kk) { const int mb = kk >> 1, hf = kk & 1;
                    u32x4 w = {pk2(u[mb][8 * hf], u[mb][8 * hf + 1]), pk2(u[mb][8 * hf + 2], u[mb][8 * hf + 3]), pk2(u[mb][8 * hf + 4], u[mb][8 * hf + 5]), pk2(u[mb][8 * hf + 6], u[mb][8 * hf + 7])};
                    ub[kk] = *reinterpret_cast<bf16x8*>(&w); }
#pragma unroll
                for (int mb = 0; mb < 2; ++mb)
#pragma unroll
                    for (int kk = 0; kk < 4; ++kk) {
                        const bf16x8 a = *(const bf16x8*)(B0 + SC_PM + (32 * mb + r32) * 144 + (kk * 16 + hi * 8) * 2);
                        o[mb] = __builtin_amdgcn_mfma_f32_32x32x16_bf16(a, ub[kk], o[mb], 0, 0, 0); }
#pragma unroll
                for (int mb = 0; mb < 4; ++mb) {
#pragma unroll
                    for (int r = 0; r < 16; ++r) S[mb][r] *= gc;
#pragma unroll
                    for (int kk = 0; kk < 4; ++kk) {
                        const bf16x8 a = *(const bf16x8*)(B0 + SC_KD + (32 * mb + r32) * 144 + (kk * 16 + hi * 8) * 2);
                        S[mb] = __builtin_amdgcn_mfma_f32_32x32x16_bf16(a, ub[kk], S[mb], 0, 0, 0); }
                }
                bf16_t* od = OG + (size_t)(T0 + 64 * s) * 512 + h * 128 + 32 * sl + r32;
#pragma unroll
                for (int mb = 0; mb < 2; ++mb)
#pragma unroll
                    for (int r = 0; r < 16; ++r) od[(size_t)(32 * mb + crow32(r, hi)) * 512] = f2bf(o[mb][r]);
                __syncthreads();
            }
            float* so = (sample ? p.out + OFF_SS + ((((size_t)i * 32 + b) * 4 + h) << 14) : p.out + OFF_PS + ((((size_t)i * 4 + b) * 4 + h) << 14)) + 32 * sl + r32;
#pragma unroll
            for (int mb = 0; mb < 4; ++mb)
#pragma unroll
                for (int r = 0; r < 16; ++r) so[(32 * mb + crow32(r, hi)) * 128] = S[mb][r];
        }
        __syncthreads();
    }
}

__device__ __forceinline__ void phase_gdn_post(CParams& p, int i) {
    const int tid = otid(), lane = tid & 63, wid = tid >> 6;
    const bf16_t* P = (const bf16_t*)(p.ws + WS_BIG); const bf16_t* OG = (const bf16_t*)(p.ws + WS_OG); bf16_t* CAT = (bf16_t*)(p.ws + WS_CAT);
    float ng[8], w0[8], w1[8], w2[8];
    { const float* g = p.in[14] + i * 128 + ((8 * lane) & 127); const float* w = p.in[15] + (size_t)i * 3 * 512 + 8 * lane;
#pragma unroll
      for (int e = 0; e < 8; ++e) { ng[e] = g[e]; w0[e] = w[e]; w1[e] = w[512 + e]; w2[e] = w[1024 + e]; } }
    for (int row = blockIdx.x * 8 + wid; row < MT; row += gridDim.x * 8) {
        const bf16_t* pr = P + (size_t)row * NE + 8 * lane;
        { float ov[8], zv[8], r[8]; unpack8(*(const u32x4*)(OG + (size_t)row * 512 + 8 * lane), ov); unpack8(*(const u32x4*)(pr + 1536), zv);
          float ss = 0.f;
#pragma unroll
          for (int e = 0; e < 8; ++e) ss = fmaf(ov[e], ov[e], ss);
          ss = grp16_sum(ss);
          const float rms = 1.f / sqrtf(ss * (1.f / 128.f) + EPS);
#pragma unroll
          for (int e = 0; e < 8; ++e) r[e] = ov[e] * rms * ng[e] * silu_f(zv[e]);
          *(u32x4*)(CAT + (size_t)row * DM + 8 * lane) = pack8f(r); }
        int b, t, T; bool sample;
        if (row < MP) { b = row >> 12; t = row & 4095; T = 4096; sample = false; } else { const int r2 = row - MP; b = r2 >> 6; t = r2 & 63; T = 64; sample = true; }
        float gb[8], gc[8], hn[8], u0[8], u1[8], u2[8], r[8];
        unpack8(*(const u32x4*)(pr + 2048), gb); unpack8(*(const u32x4*)(pr + 2560), gc); unpack8(*(const u32x4*)(pr + 3072), hn);
#pragma unroll
        for (int e = 0; e < 8; ++e) u0[e] = gc[e] * hn[e];
        const float* st = p.in[7] + ((size_t)i * 32 + b) * 2 * 512 + 8 * lane;
        if (t >= 1) { unpack8(*(const u32x4*)(pr - NE + 2560), gc); unpack8(*(const u32x4*)(pr - NE + 3072), hn);
#pragma unroll
            for (int e = 0; e < 8; ++e) u1[e] = gc[e] * hn[e]; }
        else {
#pragma unroll
            for (int e = 0; e < 8; ++e) u1[e] = sample ? st[512 + e] : 0.f; }
        if (t >= 2) { unpack8(*(const u32x4*)(pr - 2 * NE + 2560), gc); unpack8(*(const u32x4*)(pr - 2 * NE + 3072), hn);
#pragma unroll
            for (int e = 0; e < 8; ++e) u2[e] = gc[e] * hn[e]; }
        else {
#pragma unroll
            for (int e = 0; e < 8; ++e) u2[e] = sample ? st[t * 512 + e] : 0.f; }
#pragma unroll
        for (int e = 0; e < 8; ++e) r[e] = gb[e] * (w0[e] * u2[e] + w1[e] * u1[e] + w2[e] * u0[e]);
        *(u32x4*)(CAT + (size_t)row * DM + 512 + 8 * lane) = pack8f(r);
        if (t >= T - 2) { float* d = (sample ? p.out + OFF_SSC + (((size_t)i * 32 + b) * 2 + (t - (T - 2))) * 512 : p.out + OFF_PSC + (((size_t)i * 4 + b) * 2 + (t - (T - 2))) * 512) + 8 * lane;
            *(f32x4*)d = (f32x4){u0[0], u0[1], u0[2], u0[3]}; *(f32x4*)(d + 4) = (f32x4){u0[4], u0[5], u0[6], u0[7]}; }
    }
}

__device__ __forceinline__ void phase_fox_prep(CParams& p, int i) {
    const int tid = otid(), lane = tid & 63, wid = tid >> 6;
    const bf16_t* R = (const bf16_t*)(p.ws + WS_BIG);
    bf16_t* QP = (bf16_t*)(p.ws + WS_QP); bf16_t* KP = (bf16_t*)(p.ws + WS_KP); bf16_t* VP = (bf16_t*)(p.ws + WS_VP);
    bf16_t* QS = (bf16_t*)(p.ws + WS_QS); bf16_t* KS = (bf16_t*)(p.ws + WS_KS); bf16_t* VS = (bf16_t*)(p.ws + WS_VS);
    for (int task = blockIdx.x + gridDim.x * wid; task < 288; task += gridDim.x * 8) {
        const float* src0; const float* src1; int len, n0; float* dst;
        if (task < 32) { const int bb = task >> 3, hh = task & 7; src0 = p.out + OFF_PLF + ((size_t)i * MP + (size_t)bb * 4096) * 8 + hh; src1 = src0; len = 4096; n0 = 4096; dst = (float*)(p.ws + WS_NCP) + task * 4096; }
        else { const int j = task - 32, bb = j >> 3, hh = j & 7; src0 = p.in[4] + ((size_t)i * 32 + bb) * 1024 * 8 + hh; src1 = p.out + OFF_SLF + ((size_t)i * MS + (size_t)bb * 64) * 8 + hh - (size_t)1024 * 8; len = 1088; n0 = 1024; dst = (float*)(p.ws + WS_NCS) + j * 1088; }
        float carry = 0.f;
        for (int s0 = 0; s0 < len; s0 += 512) {
            float v[8];
#pragma unroll
            for (int q = 0; q < 8; ++q) { const int s = s0 + 64 * q + lane; v[q] = s < len ? (s < n0 ? src0[(size_t)s * 8] : src1[(size_t)s * 8]) : 0.f; }
#pragma unroll
            for (int q = 0; q < 8; ++q) { const int s = s0 + 64 * q + lane; float x = wave_incl_scan(v[q], lane) + carry;
                if (s < len) dst[s] = -x * 11.313708498984761f;
                carry = __shfl(x, 63); }
        }
    }
    float qg[8], kg[8];
    { const float* a = p.in[19] + i * 128 + ((8 * lane) & 127); const float* c = p.in[20] + i * 128 + ((8 * lane) & 127);
#pragma unroll
      for (int e = 0; e < 8; ++e) { qg[e] = a[e]; kg[e] = c[e]; } }
    for (int row = blockIdx.x * 8 + wid; row < MT; row += gridDim.x * 8) {
        const bf16_t* rr = R + (size_t)row * NO;
        float* fK; float* fV; size_t qbase, kbase; int qstr, kstr; bf16_t* Qd; bf16_t* Kd; bf16_t* Vd;
        if (row < MP) { const int bb = row >> 12, s = row & 4095; fK = p.out + OFF_PK + ((size_t)i * MP + row) * 1024; fV = p.out + OFF_PV + ((size_t)i * MP + row) * 1024;
            Qd = QP; Kd = KP; Vd = VP; qstr = 4096; kstr = 4096; qbase = (size_t)bb * 8 * 4096 + s; kbase = qbase; }
        else { const int r2 = row - MP, bb = r2 >> 6, s = r2 & 63; fK = p.out + OFF_SK + ((size_t)i * MS + r2) * 1024; fV = p.out + OFF_SV + ((size_t)i * MS + r2) * 1024;
            Qd = QS; Kd = KS; Vd = VS; qstr = 64; kstr = 1088; qbase = (size_t)bb * 8 * 64 + s; kbase = (size_t)bb * 8 * 1088 + 1024 + s; }
#pragma unroll
        for (int hf = 0; hf < 2; ++hf) {
            const int col = hf * 512 + 8 * lane, hh = col >> 7, d = col & 127;
            float x[8], r[8]; float ss;
            unpack8(*(const u32x4*)(rr + col), x); ss = 0.f;
#pragma unroll
            for (int e = 0; e < 8; ++e) ss = fmaf(x[e], x[e], ss);
            ss = grp16_sum(ss); { const float rms = 1.f / sqrtf(ss * (1.f / 128.f) + EPS);
#pragma unroll
              for (int e = 0; e < 8; ++e) r[e] = x[e] * rms * qg[e]; }
            *(u32x4*)(Qd + (qbase + (size_t)hh * qstr) * 128 + d) = pack8f(r);
            unpack8(*(const u32x4*)(rr + 1024 + col), x); ss = 0.f;
#pragma unroll
            for (int e = 0; e < 8; ++e) ss = fmaf(x[e], x[e], ss);
            ss = grp16_sum(ss); { const float rms = 1.f / sqrtf(ss * (1.f / 128.f) + EPS);
#pragma unroll
              for (int e = 0; e < 8; ++e) r[e] = x[e] * rms * kg[e]; }
            *(f32x4*)(fK + col) = (f32x4){r[0], r[1], r[2], r[3]}; *(f32x4*)(fK + col + 4) = (f32x4){r[4], r[5], r[6], r[7]};
            *(u32x4*)(Kd + (kbase + (size_t)hh * kstr) * 128 + d) = pack8f(r);
            const u32x4 vw = *(const u32x4*)(rr + 2048 + col); unpack8(vw, x);
            *(f32x4*)(fV + col) = (f32x4){x[0], x[1], x[2], x[3]}; *(f32x4*)(fV + col + 4) = (f32x4){x[4], x[5], x[6], x[7]};
            *(u32x4*)(Vd + (kbase + (size_t)hh * kstr) * 128 + d) = vw;
        }
    }
    for (int cr = blockIdx.x * 8 + wid; cr < 65536; cr += gridDim.x * 8) {
        const int which = cr >> 15, r = cr & 32767, bb = r >> 10, pos = r & 1023;
        const f32x4* src = (const f32x4*)((which ? p.in[3] : p.in[2]) + ((size_t)i * 32768 + r) * 1024) + lane;
        bf16_t* dstb = which ? VS : KS;
#pragma unroll
        for (int j = 0; j < 4; ++j) { const f32x4 v = src[64 * j]; const int col = 256 * j + 4 * lane, hh = col >> 7, d = col & 127;
            u32x2 w; w.x = pk2(v.x, v.y); w.y = pk2(v.z, v.w);
            *(u32x2*)(dstb + (((size_t)bb * 8 + hh) * 1088 + pos) * 128 + d) = w; }
    }
}

typedef fa::BlockRef<bf16_t, bf16_t> FaRef;
__device__ __forceinline__ FaRef fox_ref(CParams& p, int g, int k) {
    FaRef r;
    if (k < 2) { const int xcd = g & 7, j = g >> 3, bh = 4 * xcd + (j >> 3), x = j & 7, bb = bh >> 3, hh = bh & 7, blk = k ? 15 - x : x;
        r.Q = (const bf16_t*)(p.ws + WS_QP) + ((size_t)bh * 4096 + 256 * blk) * 128; r.K = (const bf16_t*)(p.ws + WS_KP) + (size_t)bh * 4096 * 128; r.V = (const bf16_t*)(p.ws + WS_VP) + (size_t)bh * 4096 * 128;
        r.O = (bf16_t*)(p.ws + WS_CAT) + ((size_t)bb * 4096 + 256 * blk) * 1024 + hh * 128; r.NC = (const float*)(p.ws + WS_NCP) + (size_t)bh * 4096; r.P0 = 256 * blk; r.nrows = 256; }
    else { const int bh = g, bb = g >> 3, hh = g & 7;
        r.Q = (const bf16_t*)(p.ws + WS_QS) + (size_t)bh * 64 * 128; r.K = (const bf16_t*)(p.ws + WS_KS) + (size_t)bh * 1088 * 128; r.V = (const bf16_t*)(p.ws + WS_VS) + (size_t)bh * 1088 * 128;
        r.O = (bf16_t*)(p.ws + WS_CAT) + ((size_t)MP + bb * 64) * 1024 + hh * 128; r.NC = (const float*)(p.ws + WS_NCS) + (size_t)bh * 1088; r.P0 = 1024; r.nrows = 64; }
    return r;
}
__device__ __forceinline__ void phase_fox_attn(CParams& p, unsigned char* shm) {
    constexpr int W = 1 << 20;
    for (int g = blockIdx.x; g < 256; g += gridDim.x) {
        fa::Seam<bf16_t> S;
        FaRef cur = fox_ref(p, g, 0);
        fa::causal_swa_prime<bf16_t, bf16_t>(cur, W, (char*)shm, S);
#pragma unroll 1
        for (int k = 0; k < 3; ++k) {
            int kn = k < 2 ? k + 1 : 2; asm volatile("" : "+s"(kn));
            const FaRef nxt = fox_ref(p, g, kn);
            fa::causal_swa_block<bf16_t, bf16_t>(cur, nxt, k < 2 ? 4096 : 1088, W, (char*)shm, S);
            cur = nxt;
        }
    }
}

__device__ __forceinline__ CParams* kparams() {
    CParams* k = (CParams*)__builtin_amdgcn_kernarg_segment_ptr(); asm volatile("" : "+s"(k)); return k;
}
__global__ __launch_bounds__(512, 2) void mega_fwd(Params p_unused) {
    extern __shared__ __attribute__((aligned(16))) unsigned char shm[];
    cg::grid_group grid = cg::this_grid();
    PG8_LAS unsigned char* lds = (PG8_LAS unsigned char*)shm;
    int ph = 0;
#define PHASE(...) do { CParams& p = *kparams(); if (ph >= p.ph_lo && ph < p.ph_hi) { __VA_ARGS__; if (ph + 1 < p.ph_hi) grid.sync(); } ++ph; } while (0)
    PHASE(phase_init(p, shm));
#pragma unroll 1
    for (int layer = 0; layer < 4; ++layer) {
        const int i = layer >> 1; const bool even = (layer & 1) == 0;
        if (even) PHASE(phase_norm<0>(p, layer, shm)); else PHASE(phase_norm<1>(p, layer, shm));
        PHASE(const bf16_t* Bt = even ? (const bf16_t*)(p.ws + WS_WINE) + (size_t)i * NE * DM : (const bf16_t*)(p.ws + WS_WINO) + (size_t)i * NO * DM;
              EpiBf16Plain E; E.O = (bf16_t*)(p.ws + WS_BIG); E.ldc = even ? NE : NO;
              run_gemm(lds, (const bf16_t*)(p.ws + WS_H), Bt, even ? NE : NO, DM, E));
        if (even) { PHASE(phase_gdn_prep(p, i, shm)); PHASE(phase_gdn_scan(p, i, shm)); PHASE(phase_gdn_post(p, i)); }
        else { PHASE(phase_fox_prep(p, i)); PHASE(phase_fox_attn(p, shm)); }
        PHASE(const bf16_t* Bt = even ? (const bf16_t*)(p.ws + WS_WOUTE) + (size_t)i * DM * DM : (const bf16_t*)(p.ws + WS_WOUTO) + (size_t)i * DM * DM;
              EpiResid E; E.X = p.out; E.ldc = DM;
              run_gemm(lds, (const bf16_t*)(p.ws + WS_CAT), Bt, DM, DM, E));
        PHASE(phase_norm<2>(p, layer, shm));
        PHASE(EpiSwiglu E; E.O = (bf16_t*)(p.ws + WS_BIG); E.ldc = DFF;
              run_gemm(lds, (const bf16_t*)(p.ws + WS_H), (const bf16_t*)(p.ws + WS_WF1) + (size_t)layer * NF1 * DM, NF1, DM, E));
        PHASE(EpiResid E; E.X = p.out; E.ldc = DM;
              run_gemm(lds, (const bf16_t*)(p.ws + WS_BIG), (const bf16_t*)(p.ws + WS_WF2) + (size_t)layer * DM * DFF, DM, DFF, E));
    }
#undef PHASE
}
constexpr int N_PHASES = 1 + 2 * 9 + 2 * 8;

#ifndef MK_PER_PHASE
#define MK_PER_PHASE 0
#endif
extern "C" void kernel_launch(void* const* d_in, const int* in_sizes, int n_in, void* d_out, int out_size, void* d_ws, size_t ws_size, hipStream_t stream) {
    static int grid = 0;
    if (grid == 0) {
        if (n_in != 25 || (size_t)out_size != OUT_TOTAL || ws_size < WS_END) { fprintf(stderr, "kernel_launch: unexpected shapes (n_in %d, out %d, ws %zu < %zu)\n", n_in, out_size, ws_size, (size_t)WS_END); grid = -1; return; }
        int dev = 0, cus = 0, per_cu = 0;
        (void)hipGetDevice(&dev); (void)hipDeviceGetAttribute(&cus, hipDeviceAttributeMultiprocessorCount, dev);
        if (hipFuncSetAttribute((const void*)mega_fwd, hipFuncAttributeMaxDynamicSharedMemorySize, LDS_BYTES) != hipSuccess) { fprintf(stderr, "kernel_launch: hipFuncSetAttribute failed\n"); grid = -1; return; }
        if (hipOccupancyMaxActiveBlocksPerMultiprocessor(&per_cu, (const void*)mega_fwd, 512, LDS_BYTES) != hipSuccess || per_cu < 1) { fprintf(stderr, "kernel_launch: occupancy query says %d\n", per_cu); per_cu = 1; }
        (void)hipGetLastError();
        if (cus <= 0) cus = 256;
        grid = cus * 1;
    }
    if (grid < 0) return;
    Params p{};
    for (int k = 0; k < 25; ++k) p.in[k] = (const float*)d_in[k];
    p.out = (float*)d_out; p.ws = (unsigned char*)d_ws;
#if MK_PER_PHASE
    for (int ph = 0; ph < N_PHASES; ++ph) { p.ph_lo = ph; p.ph_hi = ph + 1; hipLaunchKernelGGL(mega_fwd, dim3(grid), dim3(512), LDS_BYTES, stream, p); }
#else
    p.ph_lo = 0; p.ph_hi = N_PHASES;
    void* args[] = {&p};
    hipError_t e = hipLaunchCooperativeKernel((const void*)mega_fwd, dim3(grid), dim3(512), args, LDS_BYTES, stream);
    if (e != hipSuccess) fprintf(stderr, "kernel_launch: cooperative launch failed: %s (grid %d)\n", hipGetErrorString(e), grid);
#endif
}
```

```cpp
#include <hip/hip_runtime.h>
#include <hip/hip_cooperative_groups.h>
#include <cstdio>
#include <cstdint>
namespace cg = cooperative_groups;

typedef unsigned short bf16_t;
typedef short bf16x8 __attribute__((ext_vector_type(8)));
typedef short s16x4 __attribute__((ext_vector_type(4)));
typedef float f32x16 __attribute__((ext_vector_type(16)));
typedef float f32x4 __attribute__((ext_vector_type(4)));
typedef unsigned u32x4 __attribute__((ext_vector_type(4)));
typedef unsigned u32x2 __attribute__((ext_vector_type(2)));

constexpr int DM = 1024, MP = 16384, MS = 2048, MT = MP + MS;
constexpr int EVEN_IN = 3592, ODD_IN = 3080, NE = 3584, NO = 3072, DFF = 2816, NF1 = 2 * DFF;
constexpr float EPS = 1e-6f;
constexpr size_t OFF_Y = 0;
constexpr size_t OFF_PK = (size_t)MT * DM;
constexpr size_t OFF_PV = OFF_PK + (size_t)2 * MP * 1024;
constexpr size_t OFF_PLF = OFF_PV + (size_t)2 * MP * 1024;
constexpr size_t OFF_PS = OFF_PLF + (size_t)2 * MP * 8;
constexpr size_t OFF_PCONV = OFF_PS + (size_t)2 * 4 * 4 * 128 * 128;
constexpr size_t OFF_PSC = OFF_PCONV + (size_t)2 * 4 * 3 * 1536;
constexpr size_t OFF_SK = OFF_PSC + (size_t)2 * 4 * 2 * 512;
constexpr size_t OFF_SV = OFF_SK + (size_t)2 * MS * 1024;
constexpr size_t OFF_SLF = OFF_SV + (size_t)2 * MS * 1024;
constexpr size_t OFF_SS = OFF_SLF + (size_t)2 * MS * 8;
constexpr size_t OFF_SCONV = OFF_SS + (size_t)2 * 32 * 4 * 128 * 128;
constexpr size_t OFF_SSC = OFF_SCONV + (size_t)2 * 32 * 3 * 1536;
constexpr size_t OUT_TOTAL = OFF_SSC + (size_t)2 * 32 * 2 * 512;
static_assert(OUT_TOTAL == 99790848, "output size");
constexpr size_t WS_WINE = 0;
constexpr size_t WS_WOUTE = WS_WINE + (size_t)2 * NE * DM * 2;
constexpr size_t WS_WINO = WS_WOUTE + (size_t)2 * DM * DM * 2;
constexpr size_t WS_WOUTO = WS_WINO + (size_t)2 * NO * DM * 2;
constexpr size_t WS_WF1 = WS_WOUTO + (size_t)2 * DM * DM * 2;
constexpr size_t WS_WF2 = WS_WF1 + (size_t)4 * NF1 * DM * 2;
constexpr size_t WS_H = WS_WF2 + (size_t)4 * DM * DFF * 2;
constexpr size_t WS_BIG = WS_H + (size_t)MT * DM * 2;
constexpr size_t WS_CAT = WS_BIG + (size_t)MT * NE * 2;
constexpr size_t WS_AB = WS_CAT + (size_t)MT * DM * 2;
constexpr size_t WS_OG = WS_AB + (size_t)MT * 8 * 4;
constexpr size_t WS_GC = WS_OG + (size_t)MT * 512 * 2;
constexpr size_t WS_NEGW = WS_GC + 8192;
constexpr size_t WS_QG = WS_NEGW + (size_t)1152 * 16384;
constexpr size_t WS_KDT = WS_QG + (size_t)1152 * 16384;
constexpr size_t WS_PM = WS_KDT + (size_t)1152 * 16384;
constexpr size_t WS_UPRE = WS_PM + (size_t)1152 * 8192;
constexpr size_t WS_QP = WS_UPRE + (size_t)1152 * 16384;
constexpr size_t WS_KP = WS_QP + (size_t)32 * 4096 * 128 * 2;
constexpr size_t WS_VP = WS_KP + (size_t)32 * 4096 * 128 * 2;
constexpr size_t WS_QS = WS_VP + (size_t)32 * 4096 * 128 * 2;
constexpr size_t WS_KS = WS_QS + (size_t)256 * 64 * 128 * 2 + 65536;
constexpr size_t WS_VS = WS_KS + (size_t)256 * 1088 * 128 * 2;
constexpr size_t WS_NCP = WS_VS + (size_t)256 * 1088 * 128 * 2;
constexpr size_t WS_NCS = WS_NCP + (size_t)32 * 4096 * 4;
constexpr size_t WS_BAR = WS_NCS + (size_t)256 * 1088 * 4;
constexpr size_t WS_SLAB = WS_BAR + 16384;
constexpr size_t WS_END = WS_SLAB + (size_t)8 * MS * DM * 4;
constexpr int LDS_BYTES = 163840;
constexpr int LDS_XB = LDS_BYTES - 16;

struct Params { const float* in[25]; float* out; unsigned char* ws; int ph_lo, ph_hi; };
typedef const __attribute__((address_space(4))) Params CParams;

#define KSWZ(row, colB) ((row) * 256 + ((colB) ^ (((row) & 7) << 4)))
#define SBAR() __builtin_amdgcn_sched_barrier(0)
template <class A, class Bt> struct same_t { static constexpr bool v = false; };
template <class A> struct same_t<A, A> { static constexpr bool v = true; };
__device__ __forceinline__ int otid() { int t = threadIdx.x; asm volatile("" : "+v"(t)); return t; }
#define LBAR() asm volatile("s_waitcnt lgkmcnt(0)\n\ts_barrier" ::: "memory")
namespace pg8 {
#define PG8_LAS __attribute__((address_space(3)))
typedef unsigned short bf16_t;
typedef short bf16x8 __attribute__((ext_vector_type(8)));
typedef float f32x4 __attribute__((ext_vector_type(4)));
typedef unsigned u32x4 __attribute__((ext_vector_type(4)));
constexpr int BM = 256, BK = 64, HALF = 128, HTB = HALF * BK * 2  , STAGE_BYTES = 8 * HTB, NXCD = 8, WGM = 8;

__host__ __device__ __forceinline__ int lds_byte(int r, int c) { const int st = (r >> 4) * 2 + (c >> 5), rr = r & 15, cc = c & 31, ob = rr * 64 + cc * 2; return st * 1024 + (ob ^ (((ob >> 9) & 1) << 5)); }
__host__ __device__ __forceinline__ void stage_rc(int b, int& R, int& C) { const int st = b / 1024, sb = b % 1024, swz = sb ^ (((sb >> 9) & 1) << 5); R = (st >> 1) * 16 + swz / 64; C = (st & 1) * 32 + (swz % 64) / 2; }
__host__ __device__ __forceinline__ int perm32(int rho) { const int n = rho >> 4, i = rho & 15; return 8 * (i >> 2) + 4 * n + (i & 3); }

struct Unit { int pm, pn, kt0, nkt, split; };
struct Gemm { const bf16_t* A; const bf16_t* Bt; int M, N, K; };

struct StaticOrder {
    int nM, nN, nwg, G, c, nktf;
    __host__ __device__ void init(int M, int N, int G_, int c_) { nM = M / BM; nN = N / BM; nwg = nM * nN; G = G_; c = c_; }
    __host__ __device__ bool next(int i, Unit& u) const {
        const long L = (long)i * G + c; if (L >= nwg) return false;
        int wgid = (int)L; { const int q = nwg / NXCD, r = nwg % NXCD, xcd = wgid % NXCD, off = wgid / NXCD; wgid = (xcd < r ? xcd * (q + 1) : r * (q + 1) + (xcd - r) * q) + off; }
        const int nig = WGM * nN, gid = wgid / nig, fm = gid * WGM, gsz = (nM - fm) < WGM ? (nM - fm) : WGM;
        u.pm = fm + ((wgid % nig) % gsz); u.pn = (wgid % nig) / gsz; u.kt0 = 0; u.nkt = nktf; u.split = 0; return true;
    }
    __device__ __forceinline__ void a_ready(const Unit&) const {}
    __device__ __forceinline__ void done(const Unit&) const {}
};
__device__ __forceinline__ unsigned cvt_pk_bf16(float lo, float hi) { unsigned r; asm volatile("v_cvt_pk_bf16_f32 %0, %1, %2" : "=v"(r) : "v"(lo), "v"(hi)); return r; }
template <class Epi, class Sched, bool STAMP = false>
__device__ __forceinline__ void gemm_phase(PG8_LAS unsigned char* lds, const Gemm g, const Sched& S, const Epi& E, unsigned long long* stamps) {
    const int tid = otid(), wid = __builtin_amdgcn_readfirstlane(tid >> 6), lane = tid & 63, wr = wid >> 2, wc = wid & 3, fr = lane & 15, fq = lane >> 4;
    const int K = g.K;
    int ts_lo = 0, ts_hi = 0, nts = 0; const unsigned long long rt_entry = STAMP ? (unsigned long long)wall_clock64() : 0ull;
#define PG8_STAMP() do { if (STAMP && wid == 0 && nts < 64) { const unsigned long long _c = (unsigned long long)clock64(); \
        ts_lo = (lane == nts) ? (int)(unsigned)_c : ts_lo; ts_hi = (lane == nts) ? (int)(unsigned)(_c >> 32) : ts_hi; ++nts; } } while (0)
    PG8_STAMP();
    unsigned voffA[2], voffB[2];
#pragma unroll
    for (int i = 0; i < 2; ++i) { int R, C; stage_rc(tid * 16 + i * 8192, R, C); const int Rb = Epi::PERM ? ((R & ~31) + perm32(R & 31)) : R;
        voffA[i] = (unsigned)(R * K + C) * 2u; voffB[i] = (unsigned)(Rb * K + C) * 2u; }
    const size_t kstep = (size_t)(BK * 2);
    const size_t hstep = (size_t)HALF * K * 2;
    const size_t tstep = 2 * hstep;
    const unsigned ldsw = (unsigned)wid * 1024u;
    const int aoff = lds_byte(wr * 64 + fr, fq * 8), boff = lds_byte(wc * 32 + fr, fq * 8);
#define PG8_SA(b, h) (((b) * 2 + (h)) * HTB)
#define PG8_SB(b, h) ((4 + (b) * 2 + (h)) * HTB)
#define PG8_STAGE(bufoff, gbase, voff) do { _Pragma("unroll") for (int _i = 0; _i < 2; ++_i) \
        __builtin_amdgcn_global_load_lds((const unsigned*)((const char*)(gbase) + (voff)[_i]), (PG8_LAS unsigned*)(lds + (bufoff) + ldsw + _i * 8192), 16, 0, 0); } while (0)
#define PG8_LDA(dst, b, h) do { _Pragma("unroll") for (int m = 0; m < 4; ++m) _Pragma("unroll") for (int k = 0; k < 2; ++k) dst[m][k] = *(const PG8_LAS bf16x8*)(lds + PG8_SA(b, h) + aoff + m * 2048 + k * 1024); } while (0)
#define PG8_LDB(dst, b, h) do { _Pragma("unroll") for (int n = 0; n < 2; ++n) _Pragma("unroll") for (int k = 0; k < 2; ++k) dst[n][k] = *(const PG8_LAS bf16x8*)(lds + PG8_SB(b, h) + boff + n * 2048 + k * 1024); } while (0)
#define PG8_MMA(ai, bj, At, Bt) do { __builtin_amdgcn_s_setprio(1); _Pragma("unroll") for (int m = 0; m < 4; ++m) _Pragma("unroll") for (int n = 0; n < 2; ++n) _Pragma("unroll") for (int k = 0; k < 2; ++k) \
        acc[ai][bj][m][n] = __builtin_amdgcn_mfma_f32_16x16x32_bf16(Bt[n][k], At[m][k], acc[ai][bj][m][n], 0, 0, 0); __builtin_amdgcn_s_setprio(0); } while (0)
#define PG8_WAIT_V(n) asm volatile("s_waitcnt vmcnt(" #n ")" ::: "memory")
#define PG8_WAIT_L(n) asm volatile("s_waitcnt lgkmcnt(" #n ")" ::: "memory")
#define PG8_BAR __builtin_amdgcn_s_barrier()
#define PG8_SCHED __builtin_amdgcn_sched_barrier(0)
    Unit cur, nxt; int ui = 0;
    if (!S.next(0, cur)) return;
    f32x4 acc[2][2][4][2];
#pragma unroll
    for (int a = 0; a < 2; ++a)
#pragma unroll
        for (int b = 0; b < 2; ++b)
#pragma unroll
            for (int m = 0; m < 4; ++m)
#pragma unroll
                for (int n = 0; n < 2; ++n) acc[a][b][m][n] = (f32x4){0.f, 0.f, 0.f, 0.f};
    bf16x8 At[4][2], B0[2][2], B1[2][2];
    const char* cA = (const char*)g.A + (size_t)cur.pm * tstep + (size_t)cur.kt0 * kstep; const char* cB = (const char*)g.Bt + (size_t)cur.pn * tstep + (size_t)cur.kt0 * kstep;
    S.a_ready(cur);
    PG8_STAGE(PG8_SB(0, 0), cB, voffB); PG8_STAGE(PG8_SA(0, 0), cA, voffA); PG8_STAGE(PG8_SB(0, 1), cB + hstep, voffB); PG8_STAGE(PG8_SA(0, 1), cA + hstep, voffA);
    if (wr == 1) PG8_BAR;
    PG8_WAIT_V(4); PG8_BAR;
    PG8_STAGE(PG8_SB(1, 0), cB + kstep, voffB); PG8_STAGE(PG8_SA(1, 0), cA + kstep, voffA); PG8_STAGE(PG8_SB(1, 1), cB + hstep + kstep, voffB);
    PG8_WAIT_V(6); PG8_BAR;
    PG8_STAMP();
    for (;;) {
        const bool has_next = S.next(ui + 1, nxt);
        const char* nA = has_next ? (const char*)g.A + (size_t)nxt.pm * tstep + (size_t)nxt.kt0 * kstep : cA; const char* nB = has_next ? (const char*)g.Bt + (size_t)nxt.pn * tstep + (size_t)nxt.kt0 * kstep : cB;
        const int nt = cur.nkt;
        for (int t = 0; t < nt; t += 2) {
            const bool last = (t == nt - 2);
            const char* a1 = cA + (size_t)(t + 1) * kstep;
            const char* a2 = last ? nA : cA + (size_t)(t + 2) * kstep; const char* b2 = last ? nB : cB + (size_t)(t + 2) * kstep;
            const char* a3 = a2 + kstep; const char* b3 = b2 + kstep;
            if (last && has_next) S.a_ready(nxt);
            PG8_LDB(B0, 0, 0); PG8_SCHED; PG8_LDA(At, 0, 0); PG8_STAGE(PG8_SA(1, 1), a1 + hstep, voffA);
            PG8_WAIT_L(8); PG8_BAR; PG8_WAIT_L(0); PG8_MMA(0, 0, At, B0); PG8_BAR; PG8_SCHED;
            PG8_LDB(B1, 0, 1); PG8_STAGE(PG8_SB(0, 0), b2, voffB);
            PG8_BAR; PG8_WAIT_L(0); PG8_MMA(0, 1, At, B1); PG8_BAR;
            PG8_LDA(At, 0, 1); PG8_STAGE(PG8_SA(0, 0), a2, voffA);
            PG8_BAR; PG8_WAIT_L(0); PG8_MMA(1, 0, At, B0); PG8_BAR; PG8_SCHED;
            PG8_STAGE(PG8_SB(0, 1), b2 + hstep, voffB);
            PG8_WAIT_V(6); PG8_BAR; PG8_MMA(1, 1, At, B1); PG8_BAR;
            PG8_LDB(B0, 1, 0); PG8_SCHED; PG8_LDA(At, 1, 0); PG8_STAGE(PG8_SA(0, 1), a2 + hstep, voffA);
            PG8_WAIT_L(8); PG8_BAR; PG8_WAIT_L(0); PG8_MMA(0, 0, At, B0); PG8_BAR; PG8_SCHED;
            PG8_LDB(B1, 1, 1); PG8_STAGE(PG8_SB(1, 0), b3, voffB);
            PG8_BAR; PG8_WAIT_L(0); PG8_MMA(0, 1, At, B1); PG8_BAR;
            PG8_LDA(At, 1, 1); PG8_STAGE(PG8_SA(1, 0), a3, voffA);
            PG8_BAR; PG8_WAIT_L(0); PG8_MMA(1, 0, At, B0); PG8_BAR; PG8_SCHED;
            PG8_STAGE(PG8_SB(1, 1), b3 + hstep, voffB);
            PG8_WAIT_V(6); PG8_BAR; PG8_MMA(1, 1, At, B1); PG8_BAR;
        }
        PG8_STAMP();
        if constexpr (!Epi::AFTER_DRAIN) { E(acc, cur, wr, wc, fr, fq); S.done(cur); }
        PG8_STAMP();
        if (!has_next) break;
#pragma unroll
        for (int a = 0; a < 2; ++a)
#pragma unroll
            for (int b = 0; b < 2; ++b)
#pragma unroll
                for (int m = 0; m < 4; ++m)
#pragma unroll
                    for (int n = 0; n < 2; ++n) acc[a][b][m][n] = (f32x4){0.f, 0.f, 0.f, 0.f};
        cur = nxt; cA = nA; cB = nB; ++ui;
    }
    PG8_WAIT_V(0);
    if (wr == 0) PG8_BAR;
    PG8_BAR;
    if constexpr (Epi::AFTER_DRAIN) { E.fused(acc, cur, wr, wc, fr, fq, lds, wid, lane); S.done(cur); }
    PG8_STAMP();
    if (STAMP && wid == 0) { stamps[lane] = lane < nts ? (((unsigned long long)(unsigned)ts_hi << 32) | (unsigned)ts_lo) : 0ull;
        if (lane == 62) stamps[62] = rt_entry; if (lane == 63) stamps[63] = (unsigned long long)wall_clock64(); }
#undef PG8_STAMP
#undef PG8_SA
#undef PG8_SB
#undef PG8_STAGE
#undef PG8_LDA
#undef PG8_LDB
#undef PG8_MMA
#undef PG8_WAIT_V
#undef PG8_WAIT_L
#undef PG8_BAR
#undef PG8_SCHED
}
}
namespace fa {
constexpr int D = 128, OSTR = 1024;
constexpr float SCALE = 0.08838834764831845f;
constexpr float THR = 8.f;
constexpr bool WSKIP = false;
constexpr int NW = 8, QBLK = 32, KVBLK = 64, QB = NW * QBLK;
constexpr int SHM_V = KVBLK * D * 2, SHM_K = KVBLK * D * 2;
__device__ __forceinline__ int v_st(int k, int c) { const int kk = (k & ~0xC) | ((k & 4) << 1) | ((k & 8) >> 1); return ((kk >> 3) * 4 + (c >> 5)) * 512 + ((kk & 7) * 32 + (c & 31)) * 2; }
__device__ __forceinline__ int v_rd_base(int lane) { return ((lane & 3) << 3) | (((lane >> 2) & 3) << 6) | (((lane >> 4) & 1) << 5) | (((lane >> 5) & 1) << 8); }
constexpr int v_rd_off(int d0, int ks, int half) { return d0 * 512 + ks * 4096 + half * 2048; }
__device__ __forceinline__ int crow(int r, int hi) { return (r & 3) + 8 * (r >> 2) + 4 * hi; }
__device__ __forceinline__ unsigned cvtpk(float lo, float hi) {
    unsigned r; asm volatile("v_cvt_pk_bf16_f32 %0, %1, %2" : "=v"(r) : "v"(lo), "v"(hi)); return r;
}
__device__ __forceinline__ bf16x8 pack8(f32x4 a, f32x4 b) {
    u32x4 w = {cvtpk(a[0], a[1]), cvtpk(a[2], a[3]), cvtpk(b[0], b[1]), cvtpk(b[2], b[3])};
    return *reinterpret_cast<bf16x8*>(&w);
}
template <class T> __device__ __forceinline__ bf16x8 load8(const T* p) {
    if constexpr (same_t<T, float>::v) { return pack8(*(const f32x4*)p, *(const f32x4*)(p + 4)); }
    else { return *reinterpret_cast<const bf16x8*>(p); }
}
__device__ __forceinline__ void mask_tile(f32x16& p0, f32x16& p1, int dq, unsigned W) {
    const float NEG = -__builtin_inff();
#pragma unroll
    for (int r = 0; r < 16; ++r) {
        const int c = (r & 3) + 8 * (r >> 2);
        if ((unsigned)(dq - c) >= W) p0[r] = NEG;
        if ((unsigned)(dq - c - 32) >= W) p1[r] = NEG;
    }
}
__device__ __forceinline__ void partialSM(f32x16& p0, f32x16& p1, float& m_reg, float& mn, float& alpha) {
    float pmax = p0[0]; for (int r = 1; r < 16; ++r) pmax = fmaxf(pmax, p0[r]); for (int r = 0; r < 16; ++r) pmax = fmaxf(pmax, p1[r]);
    { auto rr = __builtin_amdgcn_permlane32_swap(__float_as_uint(pmax), __float_as_uint(pmax), false, false);
      pmax = fmaxf(__uint_as_float(rr[0]), __uint_as_float(rr[1])); }
    constexpr float C2 = 1.4426950408889634f * SCALE;
    if (__builtin_expect(__all((pmax - m_reg) * SCALE <= THR), 1)) { mn = m_reg; alpha = 1.f; }
    else { mn = fmaxf(m_reg, pmax); alpha = __builtin_amdgcn_exp2f((m_reg - mn) * C2); m_reg = mn; }
    const float mnL = -mn * C2;
    for (int r = 0; r < 16; ++r) p0[r] = fmaf(p0[r], C2, mnL); for (int r = 0; r < 16; ++r) p1[r] = fmaf(p1[r], C2, mnL);
    for (int r = 0; r < 16; ++r) p0[r] = __builtin_amdgcn_exp2f(p0[r]);
}
__device__ __forceinline__ void finishSM(f32x16& p0, f32x16& p1, float alpha, float& l_reg, bf16x8& pa0, bf16x8& pa1, bf16x8& pa2, bf16x8& pa3) {
    for (int r = 0; r < 16; ++r) p1[r] = __builtin_amdgcn_exp2f(p1[r]);
    float ps = 0; for (int r = 0; r < 16; ++r) ps += p0[r]; for (int r = 0; r < 16; ++r) ps += p1[r];
    { auto rr = __builtin_amdgcn_permlane32_swap(__float_as_uint(ps), __float_as_uint(ps), false, false);
      ps = __uint_as_float(rr[0]) + __uint_as_float(rr[1]); }
    l_reg = l_reg * alpha + ps;
#define PK4(P, B_, OUT) do { unsigned a0 = cvtpk(P[B_+0], P[B_+1]), a1 = cvtpk(P[B_+2], P[B_+3]);                          \
        unsigned b0 = cvtpk(P[B_+4], P[B_+5]), b1 = cvtpk(P[B_+6], P[B_+7]);                                             \
        auto r0 = __builtin_amdgcn_permlane32_swap(a0, b0, false, false); auto r1 = __builtin_amdgcn_permlane32_swap(a1, b1, false, false); \
        u32x4 w = {r0[0], r1[0], r0[1], r1[1]}; OUT = *reinterpret_cast<bf16x8*>(&w); } while (0)
    PK4(p0, 0, pa0); PK4(p0, 8, pa1); PK4(p1, 0, pa2); PK4(p1, 8, pa3);
#undef PK4
}
template <int KB, bool SK>
__device__ __forceinline__ void qkt(f32x16& p0, f32x16& p1, const char* K_lds, const char* B_lds, int r32, int hi, const bf16x8* qr, bool act) {
    if (SK && !act) { const float NEG = -__builtin_inff();
#pragma unroll
        for (int r = 0; r < 16; ++r) { p0[r] = NEG; p1[r] = NEG; } return; }
    { const float* bl = (const float*)B_lds + 4 * hi;
#pragma unroll
      for (int g = 0; g < 4; ++g) { const f32x4 ba = *(const f32x4*)(bl + 8 * g); const f32x4 bb = *(const f32x4*)(bl + 32 + 8 * g);
#pragma unroll
        for (int e = 0; e < 4; ++e) { p0[4 * g + e] = ba[e]; p1[4 * g + e] = bb[e]; } } }
    const char* kb[4];
#pragma unroll
    for (int dd = 0; dd < 4; ++dd) kb[dd] = K_lds + KB * SHM_K + KSWZ(r32, (dd * 16 + hi * 8) * 2);
#pragma unroll
    for (int d0 = 0; d0 < 8; ++d0) { const char* a = kb[d0 & 3] + (d0 >> 2) * 128;
        bf16x8 b0 = *reinterpret_cast<const bf16x8*>(a);
        bf16x8 b1 = *reinterpret_cast<const bf16x8*>(a + 32 * 256);
        p0 = __builtin_amdgcn_mfma_f32_32x32x16_bf16(b0, qr[d0], p0, 0, 0, 0);
        p1 = __builtin_amdgcn_mfma_f32_32x32x16_bf16(b1, qr[d0], p1, 0, 0, 0); }
}
template <int VB, bool SK>
__device__ __forceinline__ void pv_tile(f32x16* o, int vb0, bf16x8 pa0, bf16x8 pa1, bf16x8 pa2, bf16x8 pa3, bool act) {
    if (SK && !act) return;
#define TRRD(dst, off) asm volatile("ds_read_b64_tr_b16 %0, %1 offset:%2" : "=&v"(dst) : "v"(vb0), "i"(off) : "memory")
#define PV_D0(d0) do { s16x4 l0, l1, l2, l3, h0, h1, h2, h3; constexpr int b_ = VB * SHM_V + v_rd_off(d0, 0, 0);     \
        TRRD(l0, b_); TRRD(h0, b_ + 2048); TRRD(l1, b_ + 4096); TRRD(h1, b_ + 6144); TRRD(l2, b_ + 8192); TRRD(h2, b_ + 10240); TRRD(l3, b_ + 12288); TRRD(h3, b_ + 14336); \
        asm volatile("s_waitcnt lgkmcnt(0)" ::: "memory"); SBAR();                 \
        o[d0] = __builtin_amdgcn_mfma_f32_32x32x16_bf16(pa0, (bf16x8){l0[0], l0[1], l0[2], l0[3], h0[0], h0[1], h0[2], h0[3]}, o[d0], 0, 0, 0);   \
        o[d0] = __builtin_amdgcn_mfma_f32_32x32x16_bf16(pa1, (bf16x8){l1[0], l1[1], l1[2], l1[3], h1[0], h1[1], h1[2], h1[3]}, o[d0], 0, 0, 0);   \
        o[d0] = __builtin_amdgcn_mfma_f32_32x32x16_bf16(pa2, (bf16x8){l2[0], l2[1], l2[2], l2[3], h2[0], h2[1], h2[2], h2[3]}, o[d0], 0, 0, 0);   \
        o[d0] = __builtin_amdgcn_mfma_f32_32x32x16_bf16(pa3, (bf16x8){l3[0], l3[1], l3[2], l3[3], h3[0], h3[1], h3[2], h3[3]}, o[d0], 0, 0, 0); } while (0)
    PV_D0(0); PV_D0(1); PV_D0(2); PV_D0(3);
#undef PV_D0
#undef TRRD
}

template <class TIn, class TOut> struct BlockRef { const TIn* Q; const TIn* K; const TIn* V; const TIn* K2; const TIn* V2; TOut* O; const float* NC; int P0; int nrows; };
template <class TIn> struct Seam {
    bf16x8 qr[8];
    bf16x8 st_v0, st_v1, st_k0, st_k1; f32x4 sf0, sf1, sf2, sf3;
    f32x4 tq[16];
};
__device__ __forceinline__ int swa_jlo(int P0, int W) { const int lowk = P0 - W + 1; return lowk > 0 ? lowk / KVBLK : 0; }
#define ROW(p, k0, rr) ((p) + (size_t)((k0) + (rr)) * D + sc)
#define VMW() asm volatile("s_waitcnt vmcnt(0)" ::: "memory")
#define VMWN(n) asm volatile("s_waitcnt vmcnt(%0)" :: "i"(n) : "memory")
#define SLOAD_H(Kp, Vp, NCp, k0) do { S.st_v0 = load8<TIn>(ROW(Vp, k0, sr)); S.st_v1 = load8<TIn>(ROW(Vp, k0, 32 + sr));              \
                         S.st_k0 = load8<TIn>(ROW(Kp, k0, sr)); S.st_k1 = load8<TIn>(ROW(Kp, k0, 32 + sr)); } while (0)
#define SWRITE_HK(bf) do { *(bf16x8*)(K_lds + (bf) * SHM_K + kws) = S.st_k0; *(bf16x8*)(K_lds + (bf) * SHM_K + kws + 32 * 256) = S.st_k1; } while (0)
#define SWRITE_HV(bf) do { *(bf16x8*)(V_lds + (bf) * SHM_V + vst0) = S.st_v0; *(bf16x8*)(V_lds + (bf) * SHM_V + vst1) = S.st_v1; } while (0)
#define SWRITE_H(bf) do { SWRITE_HV(bf); SWRITE_HK(bf); } while (0)
#define ROWF(p, k0, rr) ((p) + (size_t)((k0) + (rr)) * 1024 + sc)
#define FSEL(a, b, k0) ((const float*)((k0) < 1024 ? (a) : (b)))
#define SLOAD_F(p, k0) do { S.sf0 = *(const f32x4*)ROWF(p, k0, sr); S.sf1 = *(const f32x4*)(ROWF(p, k0, sr) + 4);                \
                            S.sf2 = *(const f32x4*)ROWF(p, k0, 32 + sr); S.sf3 = *(const f32x4*)(ROWF(p, k0, 32 + sr) + 4); } while (0)
#define SWRITE_KF(bf) do { *(bf16x8*)(K_lds + (bf) * SHM_K + kws) = pack8(S.sf0, S.sf1); *(bf16x8*)(K_lds + (bf) * SHM_K + kws + 32 * 256) = pack8(S.sf2, S.sf3); } while (0)
#define SWRITE_VF(bf) do { *(bf16x8*)(V_lds + (bf) * SHM_V + vst0) = pack8(S.sf0, S.sf1); *(bf16x8*)(V_lds + (bf) * SHM_V + vst1) = pack8(S.sf2, S.sf3); } while (0)
template <class TIn, class TOut>
__device__ __forceinline__ void causal_swa_prime(const BlockRef<TIn, TOut>& cur, int W, char* lds, Seam<TIn>& S) {
    constexpr bool F32 = same_t<TIn, float>::v;
    const int tid = otid(), wid = __builtin_amdgcn_readfirstlane(tid >> 6), lane = tid & 63, r32 = lane & 31, hi = lane >> 5;
    const int sr = tid >> 4, sc = (tid & 15) * 8, kws = KSWZ(sr, sc * 2); char* K_lds = lds + 2 * SHM_V; char* B_lds = lds + 2 * SHM_V + 2 * SHM_K + NW * 64 * 4;
    const int kb0 = swa_jlo(cur.P0, W) * KVBLK;
    for (int d0 = 0; d0 < 8; ++d0) S.qr[d0] = load8<TIn>(cur.Q + (size_t)(wid * QBLK + r32) * D + d0 * 16 + hi * 8);
    if constexpr (F32) { SLOAD_F(FSEL(cur.K, cur.K2, kb0), kb0); VMW(); SWRITE_KF(0); SBAR(); SLOAD_F(FSEL(cur.V, cur.V2, kb0), kb0); }
    else { SLOAD_H(cur.K, cur.V, cur.NC, kb0); VMW(); SWRITE_HK(0); }
    __syncthreads();
}
template <class TIn, class TOut>
__device__ __forceinline__ void causal_swa_block(const BlockRef<TIn, TOut>& cur, const BlockRef<TIn, TOut>& nxt, int skv, int W, char* lds, Seam<TIn>& S) {
    constexpr bool F32 = same_t<TIn, float>::v;
    const int tid = otid(), wid = __builtin_amdgcn_readfirstlane(tid >> 6), lane = tid & 63, r32 = lane & 31, hi = lane >> 5;
    const int j_lo = swa_jlo(cur.P0, W);
    int j_hi = (cur.P0 + QB - 1) / KVBLK + 1; if (j_hi > skv / KVBLK) j_hi = skv / KVBLK;
    const int NT = j_hi - j_lo;
    const int kbn = swa_jlo(nxt.P0, W) * KVBLK;
    const int qlo = cur.P0 + wid * QBLK, qm = qlo + r32 - 4 * hi;
    char* V_lds = lds; char* K_lds = lds + 2 * SHM_V; char* B_lds = lds + 2 * SHM_V + 2 * SHM_K + NW * 64 * 4;
    float* ws = (float*)(lds + 2 * SHM_V + 2 * SHM_K) + wid * 64; float* li_l = ws, * al_l = ws + 32;
    float m_reg = -1e30f, l_reg = 0; f32x16 o[4] = {};
    const int sr = tid >> 4, sc = (tid & 15) * 8, vst0 = v_st(sr, sc), vst1 = v_st(32 + sr, sc), kws = KSWZ(sr, sc * 2);
    const int vb0 = (int)(uintptr_t)V_lds + v_rd_base(lane);
    const TIn* Kh = cur.K; const TIn* Vh = cur.V;
#define RESC(a) do { if (__any((a) < 1.f)) { if (hi == 0) al_l[r32] = (a); asm volatile("s_waitcnt lgkmcnt(0)" ::: "memory");              \
                     for (int d_ = 0; d_ < 4; ++d_) for (int r = 0; r < 16; ++r) o[d_][r] *= al_l[crow(r, hi)]; } } while (0)
#define KBASE(t) ((j_lo + (t)) * KVBLK)
#define ACT(t) (KBASE(t) <= qlo + QBLK - 1 && KBASE(t) + KVBLK - 1 >= qlo - W + 1)
#define MASKT(P0_, P1_, t) do { const int kb_ = KBASE(t); if ((!SK || ACT(t)) && (kb_ + KVBLK - 1 > qlo || kb_ <= qlo + QBLK - 1 - W)) mask_tile(P0_, P1_, qm - kb_, (unsigned)W); } while (0)
    constexpr int NQL = F32 ? 16 : 8;
    constexpr bool SK = WSKIP && !F32;
#define SEAM_K0() do { VMWN(NQL); if constexpr (F32) { SWRITE_KF(0); SBAR(); SLOAD_F(FSEL(nxt.V, nxt.V2, kbn), kbn); } else { SWRITE_HK(0); } SBAR(); } while (0)
    f32x16 pA0, pA1, pB0, pB1; float mnA, mnB, alA, alB; bf16x8 pa0, pa1, pa2, pa3;
    { const int nbk = j_hi * KVBLK;
      for (int q = tid * 4; q < nbk; q += 2048) *(f32x4*)(B_lds + q * 4) = *(const f32x4*)(cur.NC + q);
      __syncthreads(); }
    if constexpr (F32) { VMW(); SWRITE_VF(0); SBAR(); } else { SWRITE_HV(0); SBAR(); }
    if (NT > 1) { if constexpr (F32) SLOAD_F(FSEL(cur.K, cur.K2, KBASE(1)), KBASE(1)); else SLOAD_H(Kh, Vh, cur.NC, KBASE(1)); }
    SBAR(); qkt<0, SK>(pA0, pA1, K_lds, B_lds + KBASE(0) * 4, r32, hi, S.qr, ACT(0));
    if constexpr (F32) { if (NT > 1) { VMW(); SWRITE_KF(1); SBAR(); SLOAD_F(FSEL(cur.V, cur.V2, KBASE(1)), KBASE(1)); } }
    MASKT(pA0, pA1, 0); partialSM(pA0, pA1, m_reg, mnA, alA);
    if (NT > 1) { VMW(); if constexpr (F32) { SWRITE_VF(1); SBAR(); if (NT > 2) SLOAD_F(FSEL(cur.K, cur.K2, KBASE(2)), KBASE(2)); } else SWRITE_H(1); }
    __syncthreads();
#define HALF_STEP(PX0, PX1, mnX, alX, PY0, PY1, alY, t, KB, VB, SB) do {                                                      \
        SBAR(); qkt<KB, SK>(PX0, PX1, K_lds, B_lds + KBASE(t) * 4, r32, hi, S.qr, ACT(t));                                             \
        finishSM(PY0, PY1, alY, l_reg, pa0, pa1, pa2, pa3); SBAR();                                                           \
        if ((t) + 1 < NT) { if constexpr (F32) { VMW(); SWRITE_KF(SB); SBAR(); SLOAD_F(FSEL(cur.V, cur.V2, KBASE((t) + 1)), KBASE((t) + 1)); }  \
                            else { SLOAD_H(Kh, Vh, cur.NC, KBASE((t) + 1)); } SBAR(); }                                               \
        pv_tile<VB, SK>(o, vb0, pa0, pa1, pa2, pa3, ACT((t) - 1)); MASKT(PX0, PX1, (t)); partialSM(PX0, PX1, m_reg, mnX, alX);                                        \
        __syncthreads();                                                                                                      \
        if ((t) + 1 < NT) { VMW(); if constexpr (F32) { SWRITE_VF(SB); SBAR(); if ((t) + 2 < NT) SLOAD_F(FSEL(cur.K, cur.K2, KBASE((t) + 2)), KBASE((t) + 2)); } \
                            else { SWRITE_H(SB); } }                                                                          \
        RESC(alX); __syncthreads(); } while (0)
    for (int t = 1; t + 1 < NT; t += 2) {
        HALF_STEP(pB0, pB1, mnB, alB, pA0, pA1, alA, t, 1, 0, 0);
        HALF_STEP(pA0, pA1, mnA, alA, pB0, pB1, alB, t + 1, 0, 1, 1);
    }
    const bool even = (NT & 1) == 0;
    if (even) { SBAR(); qkt<1, SK>(pB0, pB1, K_lds, B_lds + KBASE(NT - 1) * 4, r32, hi, S.qr, ACT(NT - 1)); SBAR(); }
#define QROW(e) (nxt.Q + (size_t)(wid * QBLK + r32) * D + ((e) >> 1) * 16 + hi * 8 + ((e) & 1) * 4)
    if constexpr (F32) { SLOAD_F(FSEL(nxt.K, nxt.K2, kbn), kbn); SBAR();
#pragma unroll
        for (int e = 0; e < 8; ++e) S.tq[e] = *(const f32x4*)QROW(e); }
    else { SLOAD_H(nxt.K, nxt.V, nxt.NC, kbn); SBAR();
#pragma unroll
        for (int d0 = 0; d0 < 8; ++d0) S.qr[d0] = load8<TIn>(nxt.Q + (size_t)(wid * QBLK + r32) * D + d0 * 16 + hi * 8); }
    SBAR();
    finishSM(pA0, pA1, alA, l_reg, pa0, pa1, pa2, pa3); SBAR();
    if constexpr (F32) {
#pragma unroll
        for (int e = 8; e < 16; ++e) S.tq[e] = *(const f32x4*)QROW(e); SBAR(); }
#undef QROW
    pv_tile<0, SK>(o, vb0, pa0, pa1, pa2, pa3, ACT(even ? NT - 2 : NT - 1));
    if (even) { MASKT(pB0, pB1, NT - 1); partialSM(pB0, pB1, m_reg, mnB, alB); __syncthreads(); RESC(alB);
        finishSM(pB0, pB1, alB, l_reg, pa0, pa1, pa2, pa3); SBAR(); pv_tile<1, SK>(o, vb0, pa0, pa1, pa2, pa3, ACT(NT - 1)); }
    SBAR(); SEAM_K0();
    if (hi == 0) li_l[r32] = l_reg; asm volatile("s_waitcnt lgkmcnt(0)" ::: "memory");
    float rli[16];
#pragma unroll
    for (int r = 0; r < 16; ++r) rli[r] = __builtin_amdgcn_rcpf(li_l[crow(r, hi)]);
    TOut* Ow = cur.O + (size_t)(wid * QBLK) * OSTR;
    if (wid * QBLK < cur.nrows)
#pragma unroll
    for (int r = 0; r < 16; ++r) { const int orow = crow(r, hi);
#pragma unroll
        for (int d0 = 0; d0 < 4; ++d0) { const float v = o[d0][r] * rli[r];
            if constexpr (same_t<TOut, float>::v) { Ow[(size_t)orow * OSTR + d0 * 32 + r32] = v; }
            else { const float vn = __shfl_xor(v, 1);
                   if ((r32 & 1) == 0) *(unsigned*)(Ow + (size_t)orow * OSTR + d0 * 32 + r32) = cvtpk(v, vn); } } }
    if constexpr (F32) {
#pragma unroll
        for (int d0 = 0; d0 < 8; ++d0) S.qr[d0] = pack8(S.tq[2 * d0], S.tq[2 * d0 + 1]); }
    __syncthreads();
#undef RESC
#undef KBASE
#undef ACT
#undef MASKT
#undef SEAM_K0
#undef HALF_STEP
}
#undef ROW
#undef VMW
#undef VMWN
#undef SLOAD_H
#undef SWRITE_HK
#undef SWRITE_HV
#undef SWRITE_H
#undef SLOAD_F
#undef SWRITE_KF
#undef SWRITE_VF

}
#define XB_TMO      128
#define XB_XCNT(j)  (256  + 64 * (j))
#define XB_XSUB(j)  (1280 + 64 * (j))
#define XB_XGEN(j)  (2304 + 64 * (j))
#define XB_TOP      3328
#define XB_TOPGEN   3392
#define XCD_BAR_WORDS 3456
#define XB_SPIN_CAP (1u << 18)
#define XB_LAS __attribute__((address_space(3)))

__device__ __forceinline__ unsigned xb_ld(unsigned* p)              { return __hip_atomic_load(p, __ATOMIC_RELAXED, __HIP_MEMORY_SCOPE_AGENT); }
__device__ __forceinline__ unsigned xb_add(unsigned* p, unsigned v) { return __hip_atomic_fetch_add(p, v, __ATOMIC_RELAXED, __HIP_MEMORY_SCOPE_AGENT); }
__device__ __forceinline__ unsigned xb_xcc_id() { return (unsigned)__builtin_amdgcn_s_getreg((3 << 11) | 20) & 0xFu; }
#define XB_SPIN(cond, bar) do { unsigned _sp = 0; while (cond) { __builtin_amdgcn_s_sleep(1); \
    if ((++_sp & 255u) == 0u) { if (xb_ld(&(bar)[XB_TMO])) break; if (_sp > XB_SPIN_CAP) { atomicAdd(&(bar)[XB_TMO], 1u); break; } } } } while (0)

struct XcdBarrier {
    unsigned* bar; unsigned x;
    volatile XB_LAS unsigned* st;
};

__device__ __forceinline__ XcdBarrier xcd_barrier_post(unsigned* bar, volatile XB_LAS unsigned* st) {
    XcdBarrier b; b.bar = bar; b.x = xb_xcc_id(); b.st = st;
    if (threadIdx.x == 0) (void)xb_add(&bar[XB_XCNT(b.x)], 1u);
    return b;
}
__device__ __forceinline__ void xcd_barrier_complete(unsigned* bar, unsigned x, unsigned& nloc, unsigned& nx) {
    const unsigned G = gridDim.x * gridDim.y * gridDim.z;
    unsigned sum, cnt, mine, sp = 0u;
    for (;;) {
        sum = 0u; cnt = 0u; mine = 0u;
#pragma unroll
        for (unsigned j = 0; j < 16; ++j) { const unsigned c = xb_ld(&bar[XB_XCNT(j)]); sum += c; cnt += (c > 0u) ? 1u : 0u; mine = (j == x) ? c : mine; }
        if (sum == G) break;
        __builtin_amdgcn_s_sleep(1);
        if ((++sp & 255u) == 0u) { if (xb_ld(&bar[XB_TMO])) break; if (sp > XB_SPIN_CAP) { atomicAdd(&bar[XB_TMO], 1u); break; } }
    }
    nloc = mine > 0u ? mine : 1u; nx = cnt > 0u ? cnt : 1u;
}

__device__ __forceinline__ void xcd_barrier(const XcdBarrier& b) {
    asm volatile("s_waitcnt vmcnt(0)" ::: "memory");
    __syncthreads();
    if (threadIdx.x == 0) {
        unsigned* bar = b.bar;
        __builtin_amdgcn_s_waitcnt(0);
        unsigned nloc = b.st[0], nx = b.st[1];
        if (nloc == 0u) { xcd_barrier_complete(bar, b.x, nloc, nx); b.st[0] = nloc; b.st[1] = nx; }
        const unsigned old = xb_add(&bar[XB_XSUB(b.x)], 1u);
        const unsigned gen = old / nloc;
        if (old + 1u == (gen + 1u) * nloc) {
            __builtin_amdgcn_fence(__ATOMIC_RELEASE, "agent");
            asm volatile("s_waitcnt vmcnt(0)" ::: "memory");
            const unsigned og = xb_add(&bar[XB_TOP], 1u);
            const unsigned tg = og / nx;
            if (og + 1u == (tg + 1u) * nx) xb_add(&bar[XB_TOPGEN], 1u);
            else XB_SPIN(xb_ld(&bar[XB_TOPGEN]) == tg, bar);
            __builtin_amdgcn_fence(__ATOMIC_ACQUIRE, "agent");
            xb_add(&bar[XB_XGEN(b.x)], 1u);
            asm volatile("s_waitcnt vmcnt(0)" ::: "memory");
        } else {
            XB_SPIN(xb_ld(&bar[XB_XGEN(b.x)]) == gen, bar);
            __builtin_amdgcn_fence(__ATOMIC_ACQUIRE, "agent");
            asm volatile("s_waitcnt vmcnt(0)" ::: "memory");
        }
    }
    __syncthreads();
}


__device__ __forceinline__ float bf2f(unsigned short b) { return __uint_as_float(((unsigned)b) << 16); }
__device__ __forceinline__ unsigned pk2(float lo, float hi) { unsigned r; asm volatile("v_cvt_pk_bf16_f32 %0, %1, %2" : "=v"(r) : "v"(lo), "v"(hi)); return r; }
__device__ __forceinline__ unsigned short f2bf(float x) { return (unsigned short)(pk2(x, 0.f) & 0xffffu); }
__device__ __forceinline__ float wave_sum(float v) {
#pragma unroll
    for (int o = 1; o < 64; o <<= 1) v += __shfl_xor(v, o);
    return v;
}
__device__ __forceinline__ float grp16_sum(float v) {
#pragma unroll
    for (int o = 1; o < 16; o <<= 1) v += __shfl_xor(v, o);
    return v;
}
__device__ __forceinline__ float wave_incl_scan(float v, int lane) {
#pragma unroll
    for (int o = 1; o < 64; o <<= 1) { const float t = __shfl_up(v, o); if (lane >= o) v += t; }
    return v;
}
__device__ __forceinline__ float silu_f(float x) { return x * __builtin_amdgcn_rcpf(1.f + __expf(-x)); }
__device__ __forceinline__ void unpack8(u32x4 w, float (&o)[8]) {
#pragma unroll
    for (int q = 0; q < 4; ++q) { o[2 * q] = __uint_as_float(w[q] << 16); o[2 * q + 1] = __uint_as_float(w[q] & 0xffff0000u); }
}
__device__ __forceinline__ u32x4 pack8f(const float (&v)[8]) { u32x4 w = {pk2(v[0], v[1]), pk2(v[2], v[3]), pk2(v[4], v[5]), pk2(v[6], v[7])}; return w; }
__device__ __forceinline__ int pos16(int x) { return (x & ~12) | (((x >> 2) & 1) << 3) | (((x >> 3) & 1) << 2); }
__device__ __forceinline__ int crow32(int r, int hi) { return (r & 3) + 8 * (r >> 2) + 4 * hi; }

struct EpiBf16Plain {
    static constexpr bool PERM = true, AFTER_DRAIN = false;
    bf16_t* O; int ldc;
    __device__ __forceinline__ void operator()(const pg8::f32x4 (&acc)[2][2][4][2], const pg8::Unit& u, int wr, int wc, int fr, int fq) const {
        const int row0 = u.pm * 256 + wr * 64 + fr, col0 = u.pn * 256 + wc * 32 + 8 * fq;
#pragma unroll
        for (int ai = 0; ai < 2; ++ai)
#pragma unroll
            for (int m = 0; m < 4; ++m) { bf16_t* rowp = O + (size_t)(row0 + ai * 128 + m * 16) * ldc + col0;
#pragma unroll
                for (int bj = 0; bj < 2; ++bj) { const pg8::f32x4 v0 = acc[ai][bj][m][0], v1 = acc[ai][bj][m][1];
                    u32x4 w; w.x = pk2(v0[0], v0[1]); w.y = pk2(v0[2], v0[3]); w.z = pk2(v1[0], v1[1]); w.w = pk2(v1[2], v1[3]);
                    *(u32x4*)(rowp + bj * 128) = w; } }
    }
};
struct EpiSwiglu {
    static constexpr bool PERM = true, AFTER_DRAIN = false;
    bf16_t* O; int ldc;
    __device__ __forceinline__ void operator()(const pg8::f32x4 (&acc)[2][2][4][2], const pg8::Unit& u, int wr, int wc, int fr, int fq) const {
        const int row0 = u.pm * 256 + wr * 64 + fr, col0 = u.pn * 128 + wc * 32 + 8 * fq;
#pragma unroll
        for (int ai = 0; ai < 2; ++ai)
#pragma unroll
            for (int m = 0; m < 4; ++m) { bf16_t* rowp = O + (size_t)(row0 + ai * 128 + m * 16) * ldc + col0;
                float r[8];
#pragma unroll
                for (int n = 0; n < 2; ++n)
#pragma unroll
                    for (int e = 0; e < 4; ++e) { const float g = acc[ai][0][m][n][e], up = acc[ai][1][m][n][e]; r[4 * n + e] = silu_f(g) * up; }
                *(u32x4*)rowp = pack8f(r); }
    }
};
struct EpiResid {
    static constexpr bool PERM = false, AFTER_DRAIN = false;
    float* X; int ldc; float* slab;
    __device__ __forceinline__ void operator()(const pg8::f32x4 (&acc)[2][2][4][2], const pg8::Unit& u, int wr, int wc, int fr, int fq) const {
        const int row0 = u.pm * 256 + wr * 64 + fr, col0 = u.pn * 256 + wc * 32 + 4 * fq;
        if (u.split) {
            float* Sl = slab + (size_t)(u.split - 1) * MS * DM;
#pragma unroll
            for (int ai = 0; ai < 2; ++ai)
#pragma unroll
                for (int m = 0; m < 4; ++m) { float* rowp = Sl + (size_t)(row0 - MP + ai * 128 + m * 16) * DM + col0;
#pragma unroll
                    for (int bj = 0; bj < 2; ++bj)
#pragma unroll
                        for (int n = 0; n < 2; ++n) *(pg8::f32x4*)(rowp + bj * 128 + n * 16) = acc[ai][bj][m][n]; }
        } else {
#pragma unroll
            for (int ai = 0; ai < 2; ++ai)
#pragma unroll
                for (int m = 0; m < 4; ++m) { float* rowp = X + (size_t)(row0 + ai * 128 + m * 16) * ldc + col0;
#pragma unroll
                    for (int bj = 0; bj < 2; ++bj)
#pragma unroll
                        for (int n = 0; n < 2; ++n) { pg8::f32x4* q = (pg8::f32x4*)(rowp + bj * 128 + n * 16); *q = *q + acc[ai][bj][m][n]; } }
        }
    }
};
template <class Epi>
__device__ __forceinline__ void run_gemm(PG8_LAS unsigned char* lds, const bf16_t* A, const bf16_t* Bt, int N, int K, const Epi& E) {
    pg8::Gemm g; g.A = A; g.Bt = Bt; g.M = MT; g.N = N; g.K = K;
    pg8::StaticOrder S; S.init(MT, N, (int)gridDim.x, (int)blockIdx.x); S.nktf = K / 64;
    pg8::gemm_phase<Epi, pg8::StaticOrder, false>(lds, g, S, E, nullptr);
}

__device__ __forceinline__ int tail_parts(int K, int G) { return G != 256 ? 0 : ((K / 128) >= 16 ? 8 : 4); }
struct TailSplitOrder {
    int c, G, nktf; pg8::StaticOrder so;
    __device__ void init(int K, int G_, int c_) { c = c_; G = G_; nktf = K / 64; so.init(MT, 1024, G_, c_); so.nktf = nktf; }
    __device__ bool next(int i, pg8::Unit& u) const {
        if (G != 256) return so.next(i, u);
        if (i == 0) { u.pm = (c & 7) + 8 * (c >> 5); u.pn = (c >> 3) & 3; u.kt0 = 0; u.nkt = nktf; u.split = 0; return true; }
        if (i > 1) return false;
        const int npairs = nktf >> 1, parts = npairs >= 16 ? 8 : 4, part = c >> 5, tix = c & 31;
        if (part >= parts) return false;
        const int q = npairs / parts, r = npairs - q * parts;
        const int p0 = part * q + (part < r ? part : r), np = q + (part < r ? 1 : 0);
        u.pm = 64 + (tix >> 2); u.pn = tix & 3; u.kt0 = 2 * p0; u.nkt = 2 * np; u.split = part + 1; return true;
    }
    __device__ __forceinline__ void a_ready(const pg8::Unit&) const {}
    __device__ __forceinline__ void done(const pg8::Unit&) const {}
};
__device__ __forceinline__ void run_gemm_n1024(PG8_LAS unsigned char* lds, const bf16_t* A, const bf16_t* Bt, int K, const EpiResid& E) {
    pg8::Gemm g; g.A = A; g.Bt = Bt; g.M = MT; g.N = 1024; g.K = K;
    TailSplitOrder S; S.init(K, (int)gridDim.x, (int)blockIdx.x);
    pg8::gemm_phase<EpiResid, TailSplitOrder, false>(lds, g, S, E, nullptr);
}

__device__ __forceinline__ void transpose_weight(const float* __restrict__ W, int K, int N, bf16_t* WT, int mode, float* tile, int bid, int nb) {
    const int tid = otid();
    const int nct = (N + 63) >> 6, nkt = K >> 6, nt = nct * nkt;
    constexpr int TB = 4;
    for (int t0 = bid; t0 < nt; t0 += TB * nb) {
        float v[TB][8];
#pragma unroll
        for (int q = 0; q < TB; ++q) { const int t = min(t0 + q * nb, nt - 1), kt = t / nct, ct = t - kt * nct, k0 = kt * 64, n0 = ct * 64;
#pragma unroll
            for (int i = 0; i < 8; ++i) { const int r = (tid >> 6) + 8 * i, c = tid & 63, n = n0 + c; v[q][i] = (n < N) ? W[(size_t)(k0 + r) * N + n] : 0.f; } }
#pragma unroll
        for (int q = 0; q < TB; ++q)
#pragma unroll
            for (int i = 0; i < 8; ++i) { const int r = (tid >> 6) + 8 * i, c = tid & 63; tile[q * 4160 + r * 65 + c] = v[q][i]; }
        __syncthreads();
#pragma unroll
        for (int q = 0; q < TB; ++q) { const int t = t0 + q * nb; if (t < nt) { const int kt = t / nct, ct = t - kt * nct, k0 = kt * 64, n0 = ct * 64;
            const int nl = tid >> 3, kc = tid & 7, n = n0 + nl; int dest = -1;
            if (n < N) {
                if (mode == 0) dest = n;
                else if (mode == 1) dest = n < 2048 ? n : (n < 2056 ? -1 : n - 8);
                else if (mode == 2) dest = n < 3072 ? n : -1;
                else if (mode == 3) dest = 256 * (n >> 7) + (n & 127);
                else dest = 256 * (n >> 7) + 128 + (n & 127);
            }
            if (dest >= 0) { float o[8];
#pragma unroll
                for (int e = 0; e < 8; ++e) o[e] = tile[q * 4160 + (8 * kc + e) * 65 + nl];
                *(u32x4*)(WT + (size_t)dest * K + k0 + 8 * kc) = pack8f(o); } } }
        __syncthreads();
    }
}
__device__ __forceinline__ void convert_weights(CParams& p, unsigned char* shm, int l0, int l1, int bid, int nb) {
    float* tile = (float*)shm;
    for (int l = l0; l < l1; ++l) {
        const int i = l >> 1;
        if ((l & 1) == 0) {
            transpose_weight(p.in[10] + (size_t)i * DM * EVEN_IN, DM, EVEN_IN, (bf16_t*)(p.ws + WS_WINE) + (size_t)i * NE * DM, 1, tile, bid, nb);
            transpose_weight(p.in[16] + (size_t)i * DM * DM, DM, DM, (bf16_t*)(p.ws + WS_WOUTE) + (size_t)i * DM * DM, 0, tile, bid, nb);
        } else {
            transpose_weight(p.in[17] + (size_t)i * DM * ODD_IN, DM, ODD_IN, (bf16_t*)(p.ws + WS_WINO) + (size_t)i * NO * DM, 2, tile, bid, nb);
            transpose_weight(p.in[21] + (size_t)i * DM * DM, DM, DM, (bf16_t*)(p.ws + WS_WOUTO) + (size_t)i * DM * DM, 0, tile, bid, nb);
        }
        transpose_weight(p.in[22] + (size_t)l * DM * DFF, DM, DFF, (bf16_t*)(p.ws + WS_WF1) + (size_t)l * NF1 * DM, 3, tile, bid, nb);
        transpose_weight(p.in[23] + (size_t)l * DM * DFF, DM, DFF, (bf16_t*)(p.ws + WS_WF1) + (size_t)l * NF1 * DM, 4, tile, bid, nb);
        transpose_weight(p.in[24] + (size_t)l * DFF * DM, DFF, DM, (bf16_t*)(p.ws + WS_WF2) + (size_t)l * DM * DFF, 0, tile, bid, nb);
    }
}
__device__ __forceinline__ void phase_init(CParams& p, unsigned char* shm) {
    convert_weights(p, shm, 0, 1, (int)blockIdx.x, (int)gridDim.x);
}

template <int MODE>
__device__ __forceinline__ void phase_norm(CParams& p, int layer, unsigned char* shm, int nparts) {
    const int tid = otid(), lane = tid & 63, wid = tid >> 6, i = layer >> 1;
    float* Wsm = (float*)shm;
    const float* X = p.out;
    const bool from_in = (MODE == 0) && layer == 0;
    const float* Xp = from_in ? p.in[0] : X; const float* Xs = from_in ? p.in[1] - (size_t)MP * DM : X;
    bf16_t* H = (bf16_t*)(p.ws + WS_H);
    const float* gain = (MODE == 2 ? p.in[9] : p.in[8]) + layer * DM;
    if (MODE != 2) {
        const float* W = MODE == 0 ? p.in[10] + (size_t)i * DM * EVEN_IN + 2048 : p.in[17] + (size_t)i * DM * ODD_IN + 3072;
        const int ldw = MODE == 0 ? EVEN_IN : ODD_IN;
#pragma unroll
        for (int r = 0; r < 4; ++r) { const int q = tid + 512 * r, k = q >> 1, hf = q & 1;
            const f32x4 w = *(const f32x4*)(W + (size_t)k * ldw + 4 * hf);
            const int j = k >> 8, l = (k & 255) >> 2, e = k & 3;
            *(f32x4*)(Wsm + (((j * 4 + e) * 64 + l) * 8 + 4 * hf)) = w; }
        __syncthreads();
    }
    f32x4 g4[4];
#pragma unroll
    for (int j = 0; j < 4; ++j) g4[j] = *(const f32x4*)(gain + 256 * j + 4 * lane);
    constexpr int R = 3;
    const int stride = gridDim.x * 8;
    f32x4 nv[R][4];
    int row = blockIdx.x * 8 + wid;
#pragma unroll
    for (int r = 0; r < R; ++r) { const int rr = min(row + r * stride, MT - 1); const f32x4* xr = (const f32x4*)((rr < MP ? Xp : Xs) + (size_t)rr * DM) + lane;
#pragma unroll
        for (int j = 0; j < 4; ++j) nv[r][j] = xr[64 * j]; }
    for (; row < MT; row += R * stride) {
        f32x4 cv[R][4];
#pragma unroll
        for (int r = 0; r < R; ++r)
#pragma unroll
            for (int j = 0; j < 4; ++j) cv[r][j] = nv[r][j];
        if (row + R * stride < MT) {
#pragma unroll
            for (int r = 0; r < R; ++r) { const int rr = min(row + (R + r) * stride, MT - 1); const f32x4* xr = (const f32x4*)((rr < MP ? Xp : Xs) + (size_t)rr * DM) + lane;
#pragma unroll
                for (int j = 0; j < 4; ++j) nv[r][j] = xr[64 * j]; }
        }
#pragma unroll
        for (int r = 0; r < R; ++r) {
            const int crow_ = row + r * stride;
            if (crow_ < MT) {
                f32x4 v[4]; float ss = 0.f;
#pragma unroll
                for (int j = 0; j < 4; ++j) v[j] = cv[r][j];
                if (from_in) { f32x4* xw = (f32x4*)(p.out + (size_t)crow_ * DM) + lane;
#pragma unroll
                    for (int j = 0; j < 4; ++j) xw[64 * j] = v[j]; }
                if (crow_ >= MP && nparts > 0) {
                    const f32x4* sl = (const f32x4*)((const float*)(p.ws + WS_SLAB) + (size_t)(crow_ - MP) * DM) + lane;
                    for (int q = 0; q < nparts; ++q) {
#pragma unroll
                        for (int j = 0; j < 4; ++j) v[j] += sl[(size_t)q * (MS * DM / 4) + 64 * j]; }
                    f32x4* xw = (f32x4*)(p.out + (size_t)crow_ * DM) + lane;
#pragma unroll
                    for (int j = 0; j < 4; ++j) xw[64 * j] = v[j];
                }
#pragma unroll
                for (int j = 0; j < 4; ++j) ss += (v[j].x * v[j].x + v[j].y * v[j].y) + (v[j].z * v[j].z + v[j].w * v[j].w);
                ss = wave_sum(ss);
                const float rstd = 1.f / sqrtf(ss * (1.f / DM) + EPS);
                u32x2* ho = (u32x2*)(H + (size_t)crow_ * DM) + lane;
#pragma unroll
                for (int j = 0; j < 4; ++j) { v[j] = v[j] * rstd * g4[j]; u32x2 w; w.x = pk2(v[j].x, v[j].y); w.y = pk2(v[j].z, v[j].w); ho[64 * j] = w; }
                if (MODE != 2) {
                    float acc[8];
#pragma unroll
                    for (int c = 0; c < 8; ++c) acc[c] = 0.f;
#pragma unroll
                    for (int j = 0; j < 4; ++j)
#pragma unroll
                        for (int e = 0; e < 4; ++e) { const float hv = v[j][e]; const float* wp = Wsm + ((j * 4 + e) * 64 + lane) * 8;
                            const f32x4 w0 = *(const f32x4*)wp, w1 = *(const f32x4*)(wp + 4);
#pragma unroll
                            for (int c = 0; c < 4; ++c) { acc[c] = fmaf(hv, w0[c], acc[c]); acc[4 + c] = fmaf(hv, w1[c], acc[4 + c]); } }
#pragma unroll
                    for (int c = 0; c < 8; ++c) acc[c] = wave_sum(acc[c]);
                    if (MODE == 0) { if (lane == 0) { float* d = (float*)(p.ws + WS_AB) + (size_t)crow_ * 8;
                            *(f32x4*)d = (f32x4){acc[0], acc[1], acc[2], acc[3]}; *(f32x4*)(d + 4) = (f32x4){acc[4], acc[5], acc[6], acc[7]}; } }
                    else {
                        const int c8 = lane & 7;
                        float xs = acc[0];
#pragma unroll
                        for (int c = 1; c < 8; ++c) xs = (c8 == c) ? acc[c] : xs;
                        const float x = xs + p.in[18][i * 8 + c8];
                        const float lf = fminf(x, 0.f) - log1pf(expf(-fabsf(x)));
                        float* d = crow_ < MP ? p.out + OFF_PLF + ((size_t)i * MP + crow_) * 8 : p.out + OFF_SLF + ((size_t)i * MS + (crow_ - MP)) * 8;
                        if (lane < 8) d[lane] = lf; }
                }
            }
        }
    }
}

__device__ __forceinline__ void phase_fixup(CParams& p, int nparts) {
    const int tid = otid(), lane = tid & 63, wid = tid >> 6;
    if (nparts <= 0) return;
    for (int row = MP + blockIdx.x * 8 + wid; row < MT; row += gridDim.x * 8) {
        f32x4* xw = (f32x4*)(p.out + (size_t)row * DM) + lane;
        const f32x4* sl = (const f32x4*)((const float*)(p.ws + WS_SLAB) + (size_t)(row - MP) * DM) + lane;
        f32x4 v[4];
#pragma unroll
        for (int j = 0; j < 4; ++j) v[j] = xw[64 * j];
        for (int q = 0; q < nparts; ++q) {
#pragma unroll
            for (int j = 0; j < 4; ++j) v[j] += sl[(size_t)q * (MS * DM / 4) + 64 * j]; }
#pragma unroll
        for (int j = 0; j < 4; ++j) xw[64 * j] = v[j];
    }
}

__device__ __forceinline__ void phase_gdn_prep(CParams& p, int i, unsigned char* shm) {
    const int tid = otid(), lane = tid & 63, wid = tid >> 6;
    const int half = wid >> 2, w4 = wid & 3;
    const bf16_t* P = (const bf16_t*)(p.ws + WS_BIG);
    const float* AB = (const float*)(p.ws + WS_AB);
    const float* convw = p.in[11] + (size_t)i * 4 * 1536;
    unsigned char* hb = shm + half * 78336;
    bf16_t* qs = (bf16_t*)hb; bf16_t* ks = (bf16_t*)(hb + 17408); bf16_t* vs = (bf16_t*)(hb + 34816);
    float* As = (float*)(hb + 52224); float* Gs = (float*)(hb + 68608); float* Bs = Gs + 64;
    bf16_t* Ps = (bf16_t*)(hb + 69120);
    bf16_t* Wb = vs;
    bf16_t* NEGW = (bf16_t*)(p.ws + WS_NEGW); bf16_t* QG = (bf16_t*)(p.ws + WS_QG); bf16_t* KDT = (bf16_t*)(p.ws + WS_KDT);
    bf16_t* PM = (bf16_t*)(p.ws + WS_PM); bf16_t* UPRE = (bf16_t*)(p.ws + WS_UPRE); float* GC = (float*)(p.ws + WS_GC);
    for (int pr = blockIdx.x; pr < 576; pr += gridDim.x) {
        const int it = 2 * pr + half;
        int b, n, h, T0; bool sample;
        if (it < 1024) { b = it >> 8; n = (it >> 2) & 63; h = it & 3; T0 = b * 4096 + n * 64; sample = false; }
        else { const int j = it - 1024; b = j >> 2; h = j & 3; n = 0; T0 = MP + b * 64; sample = true; }
        const bool first = (n == 0), last = sample || (n == 63);
#ifndef PROBE_PREP_A
#define PROBE_PREP_A 1
#endif
#ifndef PROBE_PREP_D
#define PROBE_PREP_D 1
#endif
#pragma unroll 1
        for (int rr = 0; rr < 2 * PROBE_PREP_A; ++rr) {
            const int task = (otid() & 255) + 256 * (rr & 1);
            if (task < 384) {
                const int tseg = task / 48, cgi = task - tseg * 48, part = cgi >> 4, c8 = (cgi & 15) * 8, t0 = tseg * 8;
                const int col = part * 512 + h * 128 + c8;
                const bool edge = first && t0 == 0;
                u32x4 L[11];
#pragma unroll
                for (int k = 0; k < 11; ++k) { const int tt = t0 - 3 + k; const int rowc = (k < 3 && edge) ? T0 : T0 + tt; L[k] = *(const u32x4*)(P + (size_t)rowc * NE + col); }
                float w[4][8];
#pragma unroll
                for (int tap = 0; tap < 4; ++tap) { const float* wp = convw + tap * 1536 + col; const f32x4 w0 = *(const f32x4*)wp, w1 = *(const f32x4*)(wp + 4);
#pragma unroll
                    for (int e = 0; e < 4; ++e) { w[tap][e] = w0[e]; w[tap][4 + e] = w1[e]; } }
                bf16_t* dst0 = (part == 0 ? qs : (part == 1 ? ks : vs)) + t0 * 136 + c8;
                float xw[4][8];
#pragma unroll
                for (int k = 0; k < 11; ++k) {
                    float (&xv)[8] = xw[k & 3];
                    if (k < 3 && edge) {
                        if (sample) { const float* sp = p.in[6] + (((size_t)i * 32 + b) * 3 + k) * 1536 + col; const f32x4 a = *(const f32x4*)sp, c = *(const f32x4*)(sp + 4);
#pragma unroll
                            for (int e = 0; e < 4; ++e) { xv[e] = a[e]; xv[4 + e] = c[e]; } }
                        else {
#pragma unroll
                            for (int e = 0; e < 8; ++e) xv[e] = 0.f; }
                    } else unpack8(L[k], xv);
                    if (last && t0 == 56 && k >= 8) {
                        float* d = (sample ? p.out + OFF_SCONV + (((size_t)i * 32 + b) * 3 + (k - 8)) * 1536 : p.out + OFF_PCONV + (((size_t)i * 4 + b) * 3 + (k - 8)) * 1536) + col;
                        *(f32x4*)d = (f32x4){xv[0], xv[1], xv[2], xv[3]}; *(f32x4*)(d + 4) = (f32x4){xv[4], xv[5], xv[6], xv[7]}; }
                    if (k >= 3) {
                        const int j = k - 3; float y[8];
#pragma unroll
                        for (int e = 0; e < 8; ++e) y[e] = w[0][e] * xw[j & 3][e];
#pragma unroll
                        for (int tap = 1; tap < 4; ++tap)
#pragma unroll
                            for (int e = 0; e < 8; ++e) y[e] = fmaf(w[tap][e], xw[(j + tap) & 3][e], y[e]);
                        float ss = 0.f;
#pragma unroll
                        for (int e = 0; e < 8; ++e) { y[e] = silu_f(y[e]); ss = fmaf(y[e], y[e], ss); }
                        ss = grp16_sum(ss);
                        const float sc = part == 2 ? 1.f : __builtin_amdgcn_rsqf(ss + EPS) * (part == 0 ? 0.08838834764831845f : 1.f);
#pragma unroll
                        for (int e = 0; e < 8; ++e) y[e] *= sc;
                        *(u32x4*)(dst0 + j * 136) = pack8f(y); }
                }
            }
        }
        if (w4 == 0) {
            const float a = AB[(size_t)(T0 + lane) * 8 + h], bb = AB[(size_t)(T0 + lane) * 8 + 4 + h];
            const float x = a + p.in[13][i * 4 + h];
            const float sp = fmaxf(x, 0.f) + log1pf(expf(-fabsf(x)));
            float g = -expf(p.in[12][i * 4 + h]) * sp;
            g = wave_incl_scan(g, lane);
            Gs[lane] = g; Bs[lane] = 1.f / (1.f + expf(-bb));
        }
        LBAR();
        {
            const int type = w4 >> 1, bi = w4 & 1; const int ln_ = otid() & 63, r32 = ln_ & 31, hi = ln_ >> 5;
            const bf16_t* Xs = type ? qs : ks;
#pragma unroll 1
            for (int bj = 0; bj < 2; ++bj) {
                f32x16 acc = {};
#pragma unroll
                for (int kk = 0; kk < 8; ++kk) {
                    const bf16x8 a = *(const bf16x8*)(Xs + (32 * bi + r32) * 136 + kk * 16 + hi * 8);
                    const bf16x8 bq = *(const bf16x8*)(ks + (32 * bj + r32) * 136 + kk * 16 + hi * 8);
                    acc = __builtin_amdgcn_mfma_f32_32x32x16_bf16(a, bq, acc, 0, 0, 0);
                }
                const int j = 32 * bj + r32; const float Gj = Gs[j];
#pragma unroll
                for (int r = 0; r < 16; ++r) { const int ii = 32 * bi + crow32(r, hi); const float d = __expf(fminf(Gs[ii] - Gj, 0.f));
                    if (type == 0) As[ii * 64 + j] = (ii > j) ? acc[r] * Bs[ii] * d : 0.f;
                    else Ps[ii * 72 + pos16(j)] = f2bf((ii >= j) ? acc[r] * d : 0.f); }
            }
        }
        LBAR();
        if (w4 < 2) {
            typedef float f32x2_t __attribute__((ext_vector_type(2)));
            const int c = otid() & 127; f32x2_t sol[64];
#pragma unroll 1
            for (int rep_ = 0; rep_ < PROBE_PREP_D; ++rep_) {
#pragma unroll
            for (int r = 0; r < 64; ++r) { const float br = Bs[r]; sol[r] = (f32x2_t){bf2f(vs[r * 136 + c]) * br, bf2f(ks[r * 136 + c]) * br * __expf(Gs[r])}; }
#pragma unroll
            for (int r = 1; r < 64; ++r) { f32x2_t a = sol[r];
#pragma unroll
                for (int j = 0; j < r; ++j) { const float m = -As[r * 64 + j]; a = __builtin_elementwise_fma((f32x2_t){m, m}, sol[j], a); }
                sol[r] = a; }
            }
            { const int sl = c >> 5, cc = c & 31;
#pragma unroll
              for (int mb = 0; mb < 2; ++mb)
#pragma unroll
                  for (int rg = 0; rg < 2; ++rg)
#pragma unroll
                      for (int hh = 0; hh < 2; ++hh) { const int tb = 32 * mb + 16 * rg + 4 * hh;
                          u32x4 w = {pk2(sol[tb].x, sol[tb + 1].x), pk2(sol[tb + 2].x, sol[tb + 3].x), pk2(sol[tb + 8].x, sol[tb + 9].x), pk2(sol[tb + 10].x, sol[tb + 11].x)};
                          *(u32x4*)(UPRE + ((((size_t)it * 4 + sl) * 2 + mb) * 2 + rg) * 512 + (cc + 32 * hh) * 8) = w; } }
            LBAR();
            { const int pp = pos16(c);
#pragma unroll
              for (int r = 0; r < 64; ++r) Wb[r * 136 + pp] = f2bf(-sol[r].y); }
        } else {
            const int t2 = otid() & 127; const float GL = Gs[63];
#pragma unroll 2
            for (int r = 0; r < 8; ++r) { const int ch = t2 + 128 * r, row = ch >> 4, pc = ch & 15, dk0 = 16 * (pc >> 1) + 4 * (pc & 1);
                const float eg = __expf(Gs[row]); const bf16_t* s_ = qs + row * 136 + dk0; float v[8];
#pragma unroll
                for (int e = 0; e < 4; ++e) { v[e] = bf2f(s_[e]) * eg; v[4 + e] = bf2f(s_[8 + e]) * eg; }
                *(u32x4*)(QG + (size_t)it * 8192 + row * 128 + pc * 8) = pack8f(v); }
#pragma unroll 2
            for (int r = 0; r < 8; ++r) { const int ch = t2 + 128 * r, dk = ch & 127, pc = ch >> 7, t0 = 16 * (pc >> 1) + 4 * (pc & 1); float v[8];
#pragma unroll
                for (int e = 0; e < 8; ++e) { const int te = t0 + (e & 3) + 8 * (e >> 2); v[e] = bf2f(ks[te * 136 + dk]) * __expf(GL - Gs[te]); }
                *(u32x4*)(KDT + (size_t)it * 8192 + dk * 64 + pc * 8) = pack8f(v); }
            if (t2 == 0) GC[it] = __expf(GL);
#pragma unroll
            for (int r = 0; r < 4; ++r) { const int ch = t2 + 128 * r, row = ch >> 3, cc = ch & 7;
                *(u32x4*)(PM + (size_t)it * 4096 + row * 64 + cc * 8) = *(const u32x4*)(Ps + row * 72 + cc * 8); }
            LBAR();
        }
        LBAR();
        { const int t4 = otid() & 255;
#pragma unroll
          for (int r = 0; r < 4; ++r) { const int ch = t4 + 256 * r, row = ch >> 4, cc = ch & 15;
              *(u32x4*)(NEGW + (size_t)it * 8192 + row * 128 + cc * 8) = *(const u32x4*)(Wb + row * 136 + cc * 8); } }
        LBAR();
    }
}

constexpr int SC_NW = 0, SC_QG = 17408, SC_KD = 34816, SC_PM = 53248, SC_UP = 62464, SC_GC = 66560, SC_BUF = 66816, SC_OB = 2 * SC_BUF, SC_OBSZ = 64 * 80;
static_assert(SC_OB + 2 * SC_OBSZ <= LDS_BYTES - 16, "scan LDS");
__device__ __forceinline__ void phase_gdn_scan(CParams& p, int i, unsigned char* shm) {
    const int tid = otid(), lane = tid & 63, wid = tid >> 6, r32 = lane & 31, hi = lane >> 5;
    const u32x4* NEGW = (const u32x4*)(p.ws + WS_NEGW); const u32x4* QG = (const u32x4*)(p.ws + WS_QG); const u32x4* KDT = (const u32x4*)(p.ws + WS_KDT);
    const u32x4* PM = (const u32x4*)(p.ws + WS_PM); const u32x4* UPRE = (const u32x4*)(p.ws + WS_UPRE); const float* GC = (const float*)(p.ws + WS_GC);
    bf16_t* OG = (bf16_t*)(p.ws + WS_OG);
    const int nb = gridDim.x, bid = blockIdx.x;
    for (int it = bid; it < 576; it = (nb > 64 ? (it < 64 ? 576 : it + (nb - 64)) : it + nb)) {
        int b, h, sl, nsteps, ch0, chs, T0; bool sample;
        if (it < 64) { b = it >> 4; h = (it >> 2) & 3; sl = it & 3; nsteps = 64; ch0 = b * 256 + h; chs = 4; T0 = b * 4096; sample = false; }
        else { const int j = it - 64; b = j >> 4; h = (j >> 2) & 3; sl = j & 3; nsteps = 1; ch0 = 1024 + (j >> 2); chs = 0; T0 = MP + b * 64; sample = true; }
        if (wid >= 4) {
            const int t2 = tid - 256; u32x4 st[15]; float stg = 0.f;
#define SC_LOAD(chv) do { const size_t ch_ = (size_t)(chv); \
                _Pragma("unroll") for (int r = 0; r < 4; ++r) st[r] = NEGW[ch_ * 1024 + t2 + 256 * r]; \
                _Pragma("unroll") for (int r = 0; r < 4; ++r) st[4 + r] = QG[ch_ * 1024 + t2 + 256 * r]; \
                _Pragma("unroll") for (int r = 0; r < 4; ++r) st[8 + r] = KDT[ch_ * 1024 + t2 + 256 * r]; \
                _Pragma("unroll") for (int r = 0; r < 2; ++r) st[12 + r] = PM[ch_ * 512 + t2 + 256 * r]; \
                st[14] = UPRE[(ch_ * 4 + sl) * 256 + t2]; if (t2 == 0) stg = GC[ch_]; } while (0)
#define SC_WRITE(bufi) do { unsigned char* base = shm + (bufi) * SC_BUF; \
                _Pragma("unroll") for (int r = 0; r < 4; ++r) { const int q = t2 + 256 * r; *(u32x4*)(base + SC_NW + (q >> 4) * 272 + (q & 15) * 16) = st[r]; } \
                _Pragma("unroll") for (int r = 0; r < 4; ++r) { const int q = t2 + 256 * r; *(u32x4*)(base + SC_QG + (q >> 4) * 272 + (q & 15) * 16) = st[4 + r]; } \
                _Pragma("unroll") for (int r = 0; r < 4; ++r) { const int q = t2 + 256 * r; *(u32x4*)(base + SC_KD + (q >> 3) * 144 + (q & 7) * 16) = st[8 + r]; } \
                _Pragma("unroll") for (int r = 0; r < 2; ++r) { const int q = t2 + 256 * r; *(u32x4*)(base + SC_PM + (q >> 3) * 144 + (q & 7) * 16) = st[12 + r]; } \
                *(u32x4*)(base + SC_UP + t2 * 16) = st[14]; if (t2 == 0) *(float*)(base + SC_GC) = stg; } while (0)
            SC_LOAD(ch0); SC_WRITE(0);
            if (nsteps > 1) SC_LOAD(ch0 + chs);
            LBAR();
            for (int s = 0; s < nsteps; ++s) {
                if (s + 1 < nsteps) { SC_WRITE((s + 1) & 1); if (s + 2 < nsteps) SC_LOAD(ch0 + (s + 2) * chs); }
                LBAR();
            }
#undef SC_LOAD
#undef SC_WRITE
        } else if (wid == 0) {
            f32x16 S[4];
            if (sample) { const float* s0 = p.in[5] + ((((size_t)i * 32 + b) * 4 + h) << 14) + 32 * sl + r32;
#pragma unroll
                for (int mb = 0; mb < 4; ++mb)
#pragma unroll
                    for (int r = 0; r < 16; ++r) S[mb][r] = s0[(32 * mb + crow32(r, hi)) * 128];
            } else {
#pragma unroll
                for (int mb = 0; mb < 4; ++mb)
#pragma unroll
                    for (int r = 0; r < 16; ++r) S[mb][r] = 0.f;
            }
            LBAR();
            for (int s = 0; s < nsteps; ++s) {
                const unsigned char* B0 = shm + (s & 1) * SC_BUF;
                f32x16 u[2], o[2];
#pragma unroll
                for (int mb = 0; mb < 2; ++mb)
#pragma unroll
                    for (int rg = 0; rg < 2; ++rg) { const u32x4 w = *(const u32x4*)(B0 + SC_UP + ((mb * 2 + rg) * 64 + lane) * 16);
#pragma unroll
                        for (int q = 0; q < 4; ++q) { u[mb][8 * rg + 2 * q] = __uint_as_float(w[q] << 16); u[mb][8 * rg + 2 * q + 1] = __uint_as_float(w[q] & 0xffff0000u); } }
                const float gc = *(const float*)(B0 + SC_GC);
                const unsigned char* lrow = B0 + r32 * 272 + hi * 16;
                const unsigned char* srow = B0 + r32 * 144 + hi * 16;
#define RD4(dst, base) do { _Pragma("unroll") for (int kk = 0; kk < 4; ++kk) dst[kk] = *(const bf16x8*)((base) + kk * 32); SBAR(); } while (0)
#define MM4(accv, fr, bop, o_) do { _Pragma("unroll") for (int kk = 0; kk < 4; ++kk) accv = __builtin_amdgcn_mfma_f32_32x32x16_bf16(fr[kk], bop[(o_) + kk], accv, 0, 0, 0); } while (0)
                bf16x8 fa[4], fb[4];
                RD4(fa, lrow + SC_NW); RD4(fb, lrow + SC_NW + 128);
                bf16x8 Sb[8];
#pragma unroll
                for (int kk = 0; kk < 8; ++kk) { const int mb = kk >> 1, hf = kk & 1;
                    u32x4 w = {pk2(S[mb][8 * hf], S[mb][8 * hf + 1]), pk2(S[mb][8 * hf + 2], S[mb][8 * hf + 3]), pk2(S[mb][8 * hf + 4], S[mb][8 * hf + 5]), pk2(S[mb][8 * hf + 6], S[mb][8 * hf + 7])};
                    Sb[kk] = *reinterpret_cast<bf16x8*>(&w); }
#pragma unroll
                for (int mb = 0; mb < 2; ++mb)
#pragma unroll
                    for (int r = 0; r < 16; ++r) o[mb][r] = 0.f;
                MM4(u[0], fa, Sb, 0); RD4(fa, lrow + SC_QG);
                MM4(u[0], fb, Sb, 4); RD4(fb, lrow + SC_QG + 128);
                MM4(o[0], fa, Sb, 0); RD4(fa, lrow + SC_NW + 32 * 272);
                MM4(o[0], fb, Sb, 4); RD4(fb, lrow + SC_NW + 32 * 272 + 128);
                MM4(u[1], fa, Sb, 0); RD4(fa, lrow + SC_QG + 32 * 272);
                MM4(u[1], fb, Sb, 4); RD4(fb, lrow + SC_QG + 32 * 272 + 128);
                MM4(o[1], fa, Sb, 0); RD4(fa, srow + SC_PM);
                MM4(o[1], fb, Sb, 4); RD4(fb, srow + SC_PM + 32 * 144);
                bf16x8 ub[4];
#pragma unroll
                for (int kk = 0; kk < 4; ++kk) { const int mb = kk >> 1, hf = kk & 1;
                    u32x4 w = {pk2(u[mb][8 * hf], u[mb][8 * hf + 1]), pk2(u[mb][8 * hf + 2], u[mb][8 * hf + 3]), pk2(u[mb][8 * hf + 4], u[mb][8 * hf + 5]), pk2(u[mb][8 * hf + 6], u[mb][8 * hf + 7])};
                    ub[kk] = *reinterpret_cast<bf16x8*>(&w); }
#pragma unroll
                for (int mb = 0; mb < 4; ++mb)
#pragma unroll
                    for (int r = 0; r < 16; ++r) S[mb][r] *= gc;
                MM4(o[0], fa, ub, 0); RD4(fa, srow + SC_KD);
                MM4(o[1], fb, ub, 0); RD4(fb, srow + SC_KD + 32 * 144);
                MM4(S[0], fa, ub, 0); RD4(fa, srow + SC_KD + 64 * 144);
                MM4(S[1], fb, ub, 0); RD4(fb, srow + SC_KD + 96 * 144);
                MM4(S[2], fa, ub, 0);
                MM4(S[3], fb, ub, 0);
#undef RD4
#undef MM4
                { unsigned char* ob = shm + SC_OB + (s & 1) * SC_OBSZ + r32 * 2;
#pragma unroll
                  for (int mb = 0; mb < 2; ++mb)
#pragma unroll
                      for (int r = 0; r < 16; ++r) *(bf16_t*)(ob + (32 * mb + crow32(r, hi)) * 80) = f2bf(o[mb][r]); }
                LBAR();
            }
            float* so = (sample ? p.out + OFF_SS + ((((size_t)i * 32 + b) * 4 + h) << 14) : p.out + OFF_PS + ((((size_t)i * 4 + b) * 4 + h) << 14)) + 32 * sl + r32;
#pragma unroll
            for (int mb = 0; mb < 4; ++mb)
#pragma unroll
                for (int r = 0; r < 16; ++r) so[(32 * mb + crow32(r, hi)) * 128] = S[mb][r];
        } else if (wid == 1) {
            LBAR();
            for (int s = 0; s <= nsteps; ++s) {
                if (s >= 1) { const unsigned char* ob = shm + SC_OB + ((s - 1) & 1) * SC_OBSZ;
#pragma unroll
                    for (int k = 0; k < 4; ++k) { const int q = lane + 64 * k, row = q >> 2, cc = q & 3;
                        *(u32x4*)(OG + (size_t)(T0 + 64 * (s - 1) + row) * 512 + h * 128 + 32 * sl + 8 * cc) = *(const u32x4*)(ob + row * 80 + cc * 16); } }
                if (s < nsteps) LBAR();
            }
        } else {
            LBAR();
            for (int s = 0; s < nsteps; ++s) LBAR();
        }
        LBAR();
    }
}

template <int PARTS>
__device__ __forceinline__ void phase_gdn_post(CParams& p, int i, int bid, int nb) {
    const int tid = otid(), lane = tid & 63, wid = tid >> 6;
    const bf16_t* P = (const bf16_t*)(p.ws + WS_BIG); const bf16_t* OG = (const bf16_t*)(p.ws + WS_OG); bf16_t* CAT = (bf16_t*)(p.ws + WS_CAT);
    float ng[8], w0[8], w1[8], w2[8];
    { const float* g = p.in[14] + i * 128 + ((8 * lane) & 127); const float* w = p.in[15] + (size_t)i * 3 * 512 + 8 * lane;
#pragma unroll
      for (int e = 0; e < 8; ++e) { ng[e] = g[e]; w0[e] = w[e]; w1[e] = w[512 + e]; w2[e] = w[1024 + e]; } }
    const int stride = nb * 8;
    for (int row0 = bid * 8 + wid; row0 < MT; row0 += 2 * stride) {
        u32x4 L[2][9]; int rows[2]; rows[0] = row0; rows[1] = row0 + stride < MT ? row0 + stride : row0;
#pragma unroll
        for (int q = 0; q < 2; ++q) { const int row = rows[q]; const bf16_t* pr = P + (size_t)row * NE + 8 * lane;
            const int t = row < MP ? (row & 4095) : ((row - MP) & 63);
            if (PARTS & 1) { L[q][0] = *(const u32x4*)(OG + (size_t)row * 512 + 8 * lane); L[q][1] = *(const u32x4*)(pr + 1536); }
            if (PARTS & 2) {
                L[q][2] = *(const u32x4*)(pr + 2048); L[q][3] = *(const u32x4*)(pr + 2560); L[q][4] = *(const u32x4*)(pr + 3072);
                const bf16_t* p1 = t >= 1 ? pr - NE : pr; const bf16_t* p2 = t >= 2 ? pr - 2 * NE : pr;
                L[q][5] = *(const u32x4*)(p1 + 2560); L[q][6] = *(const u32x4*)(p1 + 3072); L[q][7] = *(const u32x4*)(p2 + 2560); L[q][8] = *(const u32x4*)(p2 + 3072); } }
#pragma unroll
        for (int q = 0; q < 2; ++q) {
            const int row = rows[q];
            if (q == 1 && row0 + stride >= MT) break;
            if (PARTS & 1) { float ov[8], zv[8], r[8]; unpack8(L[q][0], ov); unpack8(L[q][1], zv);
              float ss = 0.f;
#pragma unroll
              for (int e = 0; e < 8; ++e) ss = fmaf(ov[e], ov[e], ss);
              ss = grp16_sum(ss);
              const float rms = 1.f / sqrtf(ss * (1.f / 128.f) + EPS);
#pragma unroll
              for (int e = 0; e < 8; ++e) r[e] = ov[e] * rms * ng[e] * silu_f(zv[e]);
              *(u32x4*)(CAT + (size_t)row * DM + 8 * lane) = pack8f(r); }
            if (PARTS & 2) {
            int b, t, T; bool sample;
            if (row < MP) { b = row >> 12; t = row & 4095; T = 4096; sample = false; } else { const int r2 = row - MP; b = r2 >> 6; t = r2 & 63; T = 64; sample = true; }
            float gb[8], gc[8], hn[8], u0[8], u1[8], u2[8], r[8];
            unpack8(L[q][2], gb); unpack8(L[q][3], gc); unpack8(L[q][4], hn);
#pragma unroll
            for (int e = 0; e < 8; ++e) u0[e] = gc[e] * hn[e];
            const float* st = p.in[7] + ((size_t)i * 32 + b) * 2 * 512 + 8 * lane;
            if (t >= 1) { unpack8(L[q][5], gc); unpack8(L[q][6], hn);
#pragma unroll
                for (int e = 0; e < 8; ++e) u1[e] = gc[e] * hn[e]; }
            else {
#pragma unroll
                for (int e = 0; e < 8; ++e) u1[e] = sample ? st[512 + e] : 0.f; }
            if (t >= 2) { unpack8(L[q][7], gc); unpack8(L[q][8], hn);
#pragma unroll
                for (int e = 0; e < 8; ++e) u2[e] = gc[e] * hn[e]; }
            else {
#pragma unroll
                for (int e = 0; e < 8; ++e) u2[e] = sample ? st[t * 512 + e] : 0.f; }
#pragma unroll
            for (int e = 0; e < 8; ++e) r[e] = gb[e] * (w0[e] * u2[e] + w1[e] * u1[e] + w2[e] * u0[e]);
            *(u32x4*)(CAT + (size_t)row * DM + 512 + 8 * lane) = pack8f(r);
            if (t >= T - 2) { float* d = (sample ? p.out + OFF_SSC + (((size_t)i * 32 + b) * 2 + (t - (T - 2))) * 512 : p.out + OFF_PSC + (((size_t)i * 4 + b) * 2 + (t - (T - 2))) * 512) + 8 * lane;
                *(f32x4*)d = (f32x4){u0[0], u0[1], u0[2], u0[3]}; *(f32x4*)(d + 4) = (f32x4){u0[4], u0[5], u0[6], u0[7]}; }
            }
        }
    }
}

__device__ __forceinline__ void phase_fox_prep(CParams& p, int i) {
    const int tid = otid(), lane = tid & 63, wid = tid >> 6;
    const bf16_t* R = (const bf16_t*)(p.ws + WS_BIG);
    bf16_t* QP = (bf16_t*)(p.ws + WS_QP); bf16_t* KP = (bf16_t*)(p.ws + WS_KP); bf16_t* VP = (bf16_t*)(p.ws + WS_VP);
    bf16_t* QS = (bf16_t*)(p.ws + WS_QS); bf16_t* KS = (bf16_t*)(p.ws + WS_KS); bf16_t* VS = (bf16_t*)(p.ws + WS_VS);
    for (int task = blockIdx.x + gridDim.x * wid; task < 288; task += gridDim.x * 8) {
        const float* src0; const float* src1; int len, n0; float* dst;
        if (task < 32) { const int bb = task >> 3, hh = task & 7; src0 = p.out + OFF_PLF + ((size_t)i * MP + (size_t)bb * 4096) * 8 + hh; src1 = src0; len = 4096; n0 = 4096; dst = (float*)(p.ws + WS_NCP) + task * 4096; }
        else { const int j = task - 32, bb = j >> 3, hh = j & 7; src0 = p.in[4] + ((size_t)i * 32 + bb) * 1024 * 8 + hh; src1 = p.out + OFF_SLF + ((size_t)i * MS + (size_t)bb * 64) * 8 + hh - (size_t)1024 * 8; len = 1088; n0 = 1024; dst = (float*)(p.ws + WS_NCS) + j * 1088; }
        float carry = 0.f;
        for (int s0 = 0; s0 < len; s0 += 512) {
            float v[8];
#pragma unroll
            for (int q = 0; q < 8; ++q) { const int s = s0 + 64 * q + lane; v[q] = s < len ? (s < n0 ? src0[(size_t)s * 8] : src1[(size_t)s * 8]) : 0.f; }
#pragma unroll
            for (int q = 0; q < 8; ++q) { const int s = s0 + 64 * q + lane; float x = wave_incl_scan(v[q], lane) + carry;
                if (s < len) dst[s] = -x * 11.313708498984761f;
                carry = __shfl(x, 63); }
        }
    }
    float qg[8], kg[8];
    { const float* a = p.in[19] + i * 128 + ((8 * lane) & 127); const float* c = p.in[20] + i * 128 + ((8 * lane) & 127);
#pragma unroll
      for (int e = 0; e < 8; ++e) { qg[e] = a[e]; kg[e] = c[e]; } }
    const int stride = gridDim.x * 8;
    for (int row0 = blockIdx.x * 8 + wid; row0 < MT; row0 += 2 * stride) {
        u32x4 L[2][6]; int rows[2]; rows[0] = row0; rows[1] = row0 + stride < MT ? row0 + stride : row0;
#pragma unroll
        for (int q = 0; q < 2; ++q) { const bf16_t* rr = R + (size_t)rows[q] * NO + 8 * lane;
#pragma unroll
            for (int hf = 0; hf < 2; ++hf) { L[q][hf * 3] = *(const u32x4*)(rr + hf * 512); L[q][hf * 3 + 1] = *(const u32x4*)(rr + 1024 + hf * 512); L[q][hf * 3 + 2] = *(const u32x4*)(rr + 2048 + hf * 512); } }
#pragma unroll
        for (int q = 0; q < 2; ++q) {
            const int row = rows[q];
            if (q == 1 && row0 + stride >= MT) break;
            float* fK; float* fV; size_t qbase, kbase; int qstr, kstr; bf16_t* Qd; bf16_t* Kd; bf16_t* Vd;
            if (row < MP) { const int bb = row >> 12, s_ = row & 4095; fK = p.out + OFF_PK + ((size_t)i * MP + row) * 1024; fV = p.out + OFF_PV + ((size_t)i * MP + row) * 1024;
                Qd = QP; Kd = KP; Vd = VP; qstr = 4096; kstr = 4096; qbase = (size_t)bb * 8 * 4096 + s_; kbase = qbase; }
            else { const int r2 = row - MP, bb = r2 >> 6, s_ = r2 & 63; fK = p.out + OFF_SK + ((size_t)i * MS + r2) * 1024; fV = p.out + OFF_SV + ((size_t)i * MS + r2) * 1024;
                Qd = nullptr; Kd = nullptr; Vd = nullptr; qstr = 64; kstr = 0; qbase = (size_t)bb * 8 * 64 + s_; kbase = 0; }
            const bool smp = row >= MP;
#pragma unroll
            for (int hf = 0; hf < 2; ++hf) {
                const int col = hf * 512 + 8 * lane, hh = col >> 7, d = col & 127;
                float x[8], r[8]; float ss;
                unpack8(L[q][hf * 3], x); ss = 0.f;
#pragma unroll
                for (int e = 0; e < 8; ++e) ss = fmaf(x[e], x[e], ss);
                ss = grp16_sum(ss); { const float rms = 1.f / sqrtf(ss * (1.f / 128.f) + EPS);
#pragma unroll
                  for (int e = 0; e < 8; ++e) r[e] = x[e] * rms * qg[e]; }
                if (smp) { float* qd = (float*)(p.ws + WS_KS) + (qbase + (size_t)hh * qstr) * 128 + d;
                    *(f32x4*)qd = (f32x4){r[0], r[1], r[2], r[3]}; *(f32x4*)(qd + 4) = (f32x4){r[4], r[5], r[6], r[7]}; }
                else *(u32x4*)(Qd + (qbase + (size_t)hh * qstr) * 128 + d) = pack8f(r);
                unpack8(L[q][hf * 3 + 1], x); ss = 0.f;
#pragma unroll
                for (int e = 0; e < 8; ++e) ss = fmaf(x[e], x[e], ss);
                ss = grp16_sum(ss); { const float rms = 1.f / sqrtf(ss * (1.f / 128.f) + EPS);
#pragma unroll
                  for (int e = 0; e < 8; ++e) r[e] = x[e] * rms * kg[e]; }
                *(f32x4*)(fK + col) = (f32x4){r[0], r[1], r[2], r[3]}; *(f32x4*)(fK + col + 4) = (f32x4){r[4], r[5], r[6], r[7]};
                if (!smp) *(u32x4*)(Kd + (kbase + (size_t)hh * kstr) * 128 + d) = pack8f(r);
                const u32x4 vw = L[q][hf * 3 + 2]; unpack8(vw, x);
                *(f32x4*)(fV + col) = (f32x4){x[0], x[1], x[2], x[3]}; *(f32x4*)(fV + col + 4) = (f32x4){x[4], x[5], x[6], x[7]};
                if (!smp) *(u32x4*)(Vd + (kbase + (size_t)hh * kstr) * 128 + d) = vw;
            }
        }
    }
}

typedef fa::BlockRef<bf16_t, bf16_t> FaRef;
typedef fa::BlockRef<float, bf16_t> FaRefS;
__device__ __forceinline__ FaRef fox_ref(CParams& p, int g, int k) {
    FaRef r;
    const int xcd = g & 7, j = g >> 3, bh = 4 * xcd + (j >> 3), x = j & 7, bb = bh >> 3, hh = bh & 7, blk = k ? 15 - x : x;
    r.Q = (const bf16_t*)(p.ws + WS_QP) + ((size_t)bh * 4096 + 256 * blk) * 128; r.K = (const bf16_t*)(p.ws + WS_KP) + (size_t)bh * 4096 * 128; r.V = (const bf16_t*)(p.ws + WS_VP) + (size_t)bh * 4096 * 128;
    r.K2 = r.K; r.V2 = r.V;
    r.O = (bf16_t*)(p.ws + WS_CAT) + ((size_t)bb * 4096 + 256 * blk) * 1024 + hh * 128; r.NC = (const float*)(p.ws + WS_NCP) + (size_t)bh * 4096; r.P0 = 256 * blk; r.nrows = 256;
    return r;
}
__device__ __forceinline__ FaRefS fox_ref_s(CParams& p, int i, int g) {
    FaRefS r; const int bh = g, bb = g >> 3, hh = g & 7;
    r.Q = (const float*)(p.ws + WS_KS) + (size_t)bh * 64 * 128;
    r.K = p.in[2] + ((size_t)i * 32 + bb) * 1024 * 1024 + hh * 128; r.V = p.in[3] + ((size_t)i * 32 + bb) * 1024 * 1024 + hh * 128;
    r.K2 = p.out + OFF_SK + ((size_t)i * MS + bb * 64) * 1024 + hh * 128 - (size_t)1024 * 1024; r.V2 = p.out + OFF_SV + ((size_t)i * MS + bb * 64) * 1024 + hh * 128 - (size_t)1024 * 1024;
    r.O = (bf16_t*)(p.ws + WS_CAT) + ((size_t)MP + bb * 64) * 1024 + hh * 128; r.NC = (const float*)(p.ws + WS_NCS) + (size_t)bh * 1088; r.P0 = 1024; r.nrows = 64;
    return r;
}
__device__ __forceinline__ void phase_fox_attn(CParams& p, int i, unsigned char* shm) {
    constexpr int W = 1 << 20;
    for (int g = blockIdx.x; g < 256; g += gridDim.x) {
#pragma unroll 1
        for (int k = 0; k < 2; ++k) {
            int kk = k; asm volatile("" : "+s"(kk));
            fa::Seam<bf16_t> S;
            const FaRef cur = fox_ref(p, g, kk);
            fa::causal_swa_prime<bf16_t, bf16_t>(cur, W, (char*)shm, S);
            fa::causal_swa_block<bf16_t, bf16_t>(cur, cur, 4096, W, (char*)shm, S);
        }
        { fa::Seam<float> S;
          const FaRefS cur = fox_ref_s(p, i, g);
          fa::causal_swa_prime<float, bf16_t>(cur, W, (char*)shm, S);
          fa::causal_swa_block<float, bf16_t>(cur, cur, 1088, W, (char*)shm, S); }
    }
}

__device__ __forceinline__ CParams* kparams() {
    CParams* k = (CParams*)__builtin_amdgcn_kernarg_segment_ptr(); asm volatile("" : "+s"(k)); return k;
}
__global__ __launch_bounds__(512, 2) void mega_fwd(Params p_unused) {
    extern __shared__ __attribute__((aligned(16))) unsigned char shm[];
    cg::grid_group grid = cg::this_grid();
    PG8_LAS unsigned char* lds = (PG8_LAS unsigned char*)shm;
    int ph = 0;
#ifndef PROBE_REP
#define PROBE_REP 0
#endif
#define GSYNC() do { XcdBarrier xb_; xb_.bar = (unsigned*)(kparams()->ws + WS_BAR); xb_.x = xb_xcc_id(); xb_.st = (volatile XB_LAS unsigned*)(lds + LDS_XB); xcd_barrier(xb_); } while (0)
#if PROBE_REP
#define PHASE(kind, ...) do { CParams& p = *kparams(); if (ph >= p.ph_lo && ph < p.ph_hi) { int nrep = 1 + ((PROBE_REP >> (kind)) & 1); asm volatile("" : "+s"(nrep)); \
        for (int rep = 0; rep < nrep; ++rep) { __VA_ARGS__; if (rep + 1 < nrep || ph + 1 < p.ph_hi) GSYNC(); } } ++ph; } while (0)
#else
#define PHASE(kind, ...) do { CParams& p = *kparams(); if (ph >= p.ph_lo && ph < p.ph_hi) { __VA_ARGS__; if (ph + 1 < p.ph_hi) GSYNC(); } ++ph; } while (0)
#endif
    if (otid() == 0) { *(volatile XB_LAS unsigned*)(lds + LDS_XB) = 0u; *(volatile XB_LAS unsigned*)(lds + LDS_XB + 4) = 0u; }
    __syncthreads();
    (void)xcd_barrier_post((unsigned*)(kparams()->ws + WS_BAR), (volatile XB_LAS unsigned*)(lds + LDS_XB));
    if (kparams()->ph_hi - kparams()->ph_lo > 1) grid.sync();
    PHASE(0, phase_init(p, shm));
#pragma unroll 1
    for (int layer = 0; layer < 4; ++layer) {
        const int i = layer >> 1; const bool even = (layer & 1) == 0;
        if (even) PHASE(1, phase_norm<0>(p, layer, shm, layer ? tail_parts(DFF, (int)gridDim.x) : 0)); else PHASE(1, phase_norm<1>(p, layer, shm, tail_parts(DFF, (int)gridDim.x)));
        PHASE(2, const bf16_t* Bt = even ? (const bf16_t*)(p.ws + WS_WINE) + (size_t)i * NE * DM : (const bf16_t*)(p.ws + WS_WINO) + (size_t)i * NO * DM;
              EpiBf16Plain E; E.O = (bf16_t*)(p.ws + WS_BIG); E.ldc = even ? NE : NO;
              run_gemm(lds, (const bf16_t*)(p.ws + WS_H), Bt, even ? NE : NO, DM, E));
        if (even) {
                    PHASE(3, phase_gdn_prep(p, i, shm);
                             if (gridDim.x > 64) { if (blockIdx.x >= 64) phase_gdn_post<2>(p, i, (int)blockIdx.x - 64, (int)gridDim.x - 64); }
                             else phase_gdn_post<2>(p, i, (int)blockIdx.x, (int)gridDim.x));
                    PHASE(4, phase_gdn_scan(p, i, shm);
                             if (layer == 0) { __syncthreads();
                                 if (gridDim.x > 64) { if (blockIdx.x >= 64) convert_weights(p, shm, 1, 4, (int)blockIdx.x - 64, (int)gridDim.x - 64); }
                                 else convert_weights(p, shm, 1, 4, (int)blockIdx.x, (int)gridDim.x); });
                    PHASE(5, phase_gdn_post<1>(p, i, (int)blockIdx.x, (int)gridDim.x)); }
        else { PHASE(6, phase_fox_prep(p, i)); PHASE(7, phase_fox_attn(p, i, shm)); }
        PHASE(31, const bf16_t* Bt = even ? (const bf16_t*)(p.ws + WS_WOUTE) + (size_t)i * DM * DM : (const bf16_t*)(p.ws + WS_WOUTO) + (size_t)i * DM * DM;
              EpiResid E; E.X = p.out; E.ldc = DM; E.slab = (float*)(p.ws + WS_SLAB);
              run_gemm_n1024(lds, (const bf16_t*)(p.ws + WS_CAT), Bt, DM, E));
        PHASE(1, phase_norm<2>(p, layer, shm, tail_parts(DM, (int)gridDim.x)));
        PHASE(9, EpiSwiglu E; E.O = (bf16_t*)(p.ws + WS_BIG); E.ldc = DFF;
              run_gemm(lds, (const bf16_t*)(p.ws + WS_H), (const bf16_t*)(p.ws + WS_WF1) + (size_t)layer * NF1 * DM, NF1, DM, E));
        PHASE(31, EpiResid E; E.X = p.out; E.ldc = DM; E.slab = (float*)(p.ws + WS_SLAB);
              run_gemm_n1024(lds, (const bf16_t*)(p.ws + WS_BIG), (const bf16_t*)(p.ws + WS_WF2) + (size_t)layer * DM * DFF, DFF, E));
    }
    PHASE(1, phase_fixup(p, tail_parts(DFF, (int)gridDim.x)));
#undef PHASE
}
constexpr int N_PHASES = 1 + 2 * 9 + 2 * 8 + 1;

#ifndef MK_PER_PHASE
#define MK_PER_PHASE 0
#endif
extern "C" void kernel_launch(void* const* d_in, const int* in_sizes, int n_in, void* d_out, int out_size, void* d_ws, size_t ws_size, hipStream_t stream) {
    static int grid = 0;
    if (grid == 0) {
        if (n_in != 25 || (size_t)out_size != OUT_TOTAL || ws_size < WS_END) { fprintf(stderr, "kernel_launch: unexpected shapes (n_in %d, out %d, ws %zu < %zu)\n", n_in, out_size, ws_size, (size_t)WS_END); grid = -1; return; }
        int dev = 0, cus = 0, per_cu = 0;
        (void)hipGetDevice(&dev); (void)hipDeviceGetAttribute(&cus, hipDeviceAttributeMultiprocessorCount, dev);
        if (hipFuncSetAttribute((const void*)mega_fwd, hipFuncAttributeMaxDynamicSharedMemorySize, LDS_BYTES) != hipSuccess) { fprintf(stderr, "kernel_launch: hipFuncSetAttribute failed\n"); grid = -1; return; }
        if (hipOccupancyMaxActiveBlocksPerMultiprocessor(&per_cu, (const void*)mega_fwd, 512, LDS_BYTES) != hipSuccess || per_cu < 1) { fprintf(stderr, "kernel_launch: occupancy query says %d\n", per_cu); per_cu = 1; }
        (void)hipGetLastError();
        if (cus <= 0) cus = 256;
        grid = cus * 1;
    }
    if (grid < 0) return;
    (void)hipMemsetAsync((unsigned char*)d_ws + WS_BAR, 0, 16384, stream);
    Params p{};
    for (int k = 0; k < 25; ++k) p.in[k] = (const float*)d_in[k];
    p.out = (float*)d_out; p.ws = (unsigned char*)d_ws;
#if MK_PER_PHASE
    for (int ph = 0; ph < N_PHASES; ++ph) { p.ph_lo = ph; p.ph_hi = ph + 1; hipLaunchKernelGGL(mega_fwd, dim3(grid), dim3(512), LDS_BYTES, stream, p); }
#else
    p.ph_lo = 0; p.ph_hi = N_PHASES;
    void* args[] = {&p};
    hipError_t e = hipLaunchCooperativeKernel((const void*)mega_fwd, dim3(grid), dim3(512), args, LDS_BYTES, stream);
    if (e != hipSuccess) fprintf(stderr, "kernel_launch: cooperative launch failed: %s (grid %d)\n", hipGetErrorString(e), grid);
#endif
}
```

```cpp
#include <hip/hip_runtime.h>
#include <hip/hip_cooperative_groups.h>
#include <cstdio>
#include <cstdint>
namespace cg = cooperative_groups;

typedef unsigned short bf16_t;
typedef short bf16x8 __attribute__((ext_vector_type(8)));
typedef short s16x4 __attribute__((ext_vector_type(4)));
typedef float f32x16 __attribute__((ext_vector_type(16)));
typedef float f32x4 __attribute__((ext_vector_type(4)));
typedef unsigned u32x4 __attribute__((ext_vector_type(4)));
typedef unsigned u32x2 __attribute__((ext_vector_type(2)));

constexpr int DM = 1024, MP = 16384, MS = 2048, MT = MP + MS;
constexpr int EVEN_IN = 3592, ODD_IN = 3080, NE = 3584, NO = 3072, DFF = 2816, NF1 = 2 * DFF;
constexpr float EPS = 1e-6f;
constexpr size_t OFF_Y = 0;
constexpr size_t OFF_PK = (size_t)MT * DM;
constexpr size_t OFF_PV = OFF_PK + (size_t)2 * MP * 1024;
constexpr size_t OFF_PLF = OFF_PV + (size_t)2 * MP * 1024;
constexpr size_t OFF_PS = OFF_PLF + (size_t)2 * MP * 8;
constexpr size_t OFF_PCONV = OFF_PS + (size_t)2 * 4 * 4 * 128 * 128;
constexpr size_t OFF_PSC = OFF_PCONV + (size_t)2 * 4 * 3 * 1536;
constexpr size_t OFF_SK = OFF_PSC + (size_t)2 * 4 * 2 * 512;
constexpr size_t OFF_SV = OFF_SK + (size_t)2 * MS * 1024;
constexpr size_t OFF_SLF = OFF_SV + (size_t)2 * MS * 1024;
constexpr size_t OFF_SS = OFF_SLF + (size_t)2 * MS * 8;
constexpr size_t OFF_SCONV = OFF_SS + (size_t)2 * 32 * 4 * 128 * 128;
constexpr size_t OFF_SSC = OFF_SCONV + (size_t)2 * 32 * 3 * 1536;
constexpr size_t OUT_TOTAL = OFF_SSC + (size_t)2 * 32 * 2 * 512;
static_assert(OUT_TOTAL == 99790848, "output size");
constexpr size_t WS_WINE = 0;
constexpr size_t WS_WOUTE = WS_WINE + (size_t)2 * NE * DM * 2;
constexpr size_t WS_WINO = WS_WOUTE + (size_t)2 * DM * DM * 2;
constexpr size_t WS_WOUTO = WS_WINO + (size_t)2 * NO * DM * 2;
constexpr size_t WS_WF1 = WS_WOUTO + (size_t)2 * DM * DM * 2;
constexpr size_t WS_WF2 = WS_WF1 + (size_t)4 * NF1 * DM * 2;
constexpr size_t WS_H = WS_WF2 + (size_t)4 * DM * DFF * 2;
constexpr size_t WS_BIG = WS_H + (size_t)MT * DM * 2;
constexpr size_t WS_CAT = WS_BIG + (size_t)MT * NE * 2;
constexpr size_t WS_AB = WS_CAT + (size_t)MT * DM * 2;
constexpr size_t WS_OG = WS_AB + (size_t)MT * 8 * 4;
constexpr size_t WS_GC = WS_OG + (size_t)MT * 512 * 2;
constexpr size_t WS_NEGW = WS_GC + 8192;
constexpr size_t WS_QG = WS_NEGW + (size_t)1152 * 16384;
constexpr size_t WS_KDT = WS_QG + (size_t)1152 * 16384;
constexpr size_t WS_PM = WS_KDT + (size_t)1152 * 16384;
constexpr size_t WS_UPRE = WS_PM + (size_t)1152 * 8192;
constexpr size_t WS_QP = WS_UPRE + (size_t)1152 * 16384;
constexpr size_t WS_KP = WS_QP + (size_t)32 * 4096 * 128 * 2;
constexpr size_t WS_VP = WS_KP + (size_t)32 * 4096 * 128 * 2;
constexpr size_t WS_QS = WS_VP + (size_t)32 * 4096 * 128 * 2;
constexpr size_t WS_KS = WS_QS + (size_t)256 * 64 * 128 * 2 + 65536;
constexpr size_t WS_VS = WS_KS + (size_t)256 * 1088 * 128 * 2;
constexpr size_t WS_NCP = WS_VS + (size_t)256 * 1088 * 128 * 2;
constexpr size_t WS_NCS = WS_NCP + (size_t)32 * 4096 * 4;
constexpr size_t WS_BAR = WS_NCS + (size_t)256 * 1088 * 4;
constexpr size_t WS_SLAB = WS_BAR + 16384;
constexpr size_t WS_END = WS_SLAB + (size_t)8 * MS * DM * 4;
constexpr int LDS_BYTES = 163840;
constexpr int LDS_XB = LDS_BYTES - 16;

struct Params { const float* in[25]; float* out; unsigned char* ws; int ph_lo, ph_hi; };
typedef const __attribute__((address_space(4))) Params CParams;

#define KSWZ(row, colB) ((row) * 256 + ((colB) ^ (((row) & 7) << 4)))
#define SBAR() __builtin_amdgcn_sched_barrier(0)
template <class A, class Bt> struct same_t { static constexpr bool v = false; };
template <class A> struct same_t<A, A> { static constexpr bool v = true; };
__device__ __forceinline__ int otid() { int t = threadIdx.x; asm volatile("" : "+v"(t)); return t; }
#define LBAR() asm volatile("s_waitcnt lgkmcnt(0)\n\ts_barrier" ::: "memory")
namespace pg8 {
#define PG8_LAS __attribute__((address_space(3)))
typedef unsigned short bf16_t;
typedef short bf16x8 __attribute__((ext_vector_type(8)));
typedef float f32x4 __attribute__((ext_vector_type(4)));
typedef unsigned u32x4 __attribute__((ext_vector_type(4)));
constexpr int BM = 256, BK = 64, HALF = 128, HTB = HALF * BK * 2  , STAGE_BYTES = 8 * HTB, NXCD = 8, WGM = 8;

__host__ __device__ __forceinline__ int lds_byte(int r, int c) { const int st = (r >> 4) * 2 + (c >> 5), rr = r & 15, cc = c & 31, ob = rr * 64 + cc * 2; return st * 1024 + (ob ^ (((ob >> 9) & 1) << 5)); }
__host__ __device__ __forceinline__ void stage_rc(int b, int& R, int& C) { const int st = b / 1024, sb = b % 1024, swz = sb ^ (((sb >> 9) & 1) << 5); R = (st >> 1) * 16 + swz / 64; C = (st & 1) * 32 + (swz % 64) / 2; }
__host__ __device__ __forceinline__ int perm32(int rho) { const int n = rho >> 4, i = rho & 15; return 8 * (i >> 2) + 4 * n + (i & 3); }

struct Unit { int pm, pn, kt0, nkt, split; };
struct Gemm { const bf16_t* A; const bf16_t* Bt; int M, N, K; };

struct StaticOrder {
    int nM, nN, nwg, G, c, nktf;
    __host__ __device__ void init(int M, int N, int G_, int c_) { nM = M / BM; nN = N / BM; nwg = nM * nN; G = G_; c = c_; }
    __host__ __device__ bool next(int i, Unit& u) const {
        const long L = (long)i * G + c; if (L >= nwg) return false;
        int wgid = (int)L; { const int q = nwg / NXCD, r = nwg % NXCD, xcd = wgid % NXCD, off = wgid / NXCD; wgid = (xcd < r ? xcd * (q + 1) : r * (q + 1) + (xcd - r) * q) + off; }
        const int nig = WGM * nN, gid = wgid / nig, fm = gid * WGM, gsz = (nM - fm) < WGM ? (nM - fm) : WGM;
        u.pm = fm + ((wgid % nig) % gsz); u.pn = (wgid % nig) / gsz; u.kt0 = 0; u.nkt = nktf; u.split = 0; return true;
    }
    __device__ __forceinline__ void a_ready(const Unit&) const {}
    __device__ __forceinline__ void done(const Unit&) const {}
};
__device__ __forceinline__ unsigned cvt_pk_bf16(float lo, float hi) { unsigned r; asm volatile("v_cvt_pk_bf16_f32 %0, %1, %2" : "=v"(r) : "v"(lo), "v"(hi)); return r; }
template <class Epi, class Sched, bool STAMP = false>
__device__ __forceinline__ void gemm_phase(PG8_LAS unsigned char* lds, const Gemm g, const Sched& S, const Epi& E, unsigned long long* stamps) {
    const int tid = otid(), wid = __builtin_amdgcn_readfirstlane(tid >> 6), lane = tid & 63, wr = wid >> 2, wc = wid & 3, fr = lane & 15, fq = lane >> 4;
    const int K = g.K;
    int ts_lo = 0, ts_hi = 0, nts = 0; const unsigned long long rt_entry = STAMP ? (unsigned long long)wall_clock64() : 0ull;
#define PG8_STAMP() do { if (STAMP && wid == 0 && nts < 64) { const unsigned long long _c = (unsigned long long)clock64(); \
        ts_lo = (lane == nts) ? (int)(unsigned)_c : ts_lo; ts_hi = (lane == nts) ? (int)(unsigned)(_c >> 32) : ts_hi; ++nts; } } while (0)
    PG8_STAMP();
    unsigned voffA[2], voffB[2];
#pragma unroll
    for (int i = 0; i < 2; ++i) { int R, C; stage_rc(tid * 16 + i * 8192, R, C); const int Rb = Epi::PERM ? ((R & ~31) + perm32(R & 31)) : R;
        voffA[i] = (unsigned)(R * K + C) * 2u; voffB[i] = (unsigned)(Rb * K + C) * 2u; }
    const size_t kstep = (size_t)(BK * 2);
    const size_t hstep = (size_t)HALF * K * 2;
    const size_t tstep = 2 * hstep;
    const unsigned ldsw = (unsigned)wid * 1024u;
    const int aoff = lds_byte(wr * 64 + fr, fq * 8), boff = lds_byte(wc * 32 + fr, fq * 8);
#define PG8_SA(b, h) (((b) * 2 + (h)) * HTB)
#define PG8_SB(b, h) ((4 + (b) * 2 + (h)) * HTB)
#define PG8_STAGE(bufoff, gbase, voff) do { _Pragma("unroll") for (int _i = 0; _i < 2; ++_i) \
        __builtin_amdgcn_global_load_lds((const unsigned*)((const char*)(gbase) + (voff)[_i]), (PG8_LAS unsigned*)(lds + (bufoff) + ldsw + _i * 8192), 16, 0, 0); } while (0)
#define PG8_LDA(dst, b, h) do { _Pragma("unroll") for (int m = 0; m < 4; ++m) _Pragma("unroll") for (int k = 0; k < 2; ++k) dst[m][k] = *(const PG8_LAS bf16x8*)(lds + PG8_SA(b, h) + aoff + m * 2048 + k * 1024); } while (0)
#define PG8_LDB(dst, b, h) do { _Pragma("unroll") for (int n = 0; n < 2; ++n) _Pragma("unroll") for (int k = 0; k < 2; ++k) dst[n][k] = *(const PG8_LAS bf16x8*)(lds + PG8_SB(b, h) + boff + n * 2048 + k * 1024); } while (0)
#define PG8_MMA(ai, bj, At, Bt) do { __builtin_amdgcn_s_setprio(1); _Pragma("unroll") for (int m = 0; m < 4; ++m) _Pragma("unroll") for (int n = 0; n < 2; ++n) _Pragma("unroll") for (int k = 0; k < 2; ++k) \
        acc[ai][bj][m][n] = __builtin_amdgcn_mfma_f32_16x16x32_bf16(Bt[n][k], At[m][k], acc[ai][bj][m][n], 0, 0, 0); __builtin_amdgcn_s_setprio(0); } while (0)
#define PG8_WAIT_V(n) asm volatile("s_waitcnt vmcnt(" #n ")" ::: "memory")
#define PG8_WAIT_L(n) asm volatile("s_waitcnt lgkmcnt(" #n ")" ::: "memory")
#define PG8_BAR __builtin_amdgcn_s_barrier()
#define PG8_SCHED __builtin_amdgcn_sched_barrier(0)
    Unit cur, nxt; int ui = 0;
    if (!S.next(0, cur)) return;
    f32x4 acc[2][2][4][2];
#pragma unroll
    for (int a = 0; a < 2; ++a)
#pragma unroll
        for (int b = 0; b < 2; ++b)
#pragma unroll
            for (int m = 0; m < 4; ++m)
#pragma unroll
                for (int n = 0; n < 2; ++n) acc[a][b][m][n] = (f32x4){0.f, 0.f, 0.f, 0.f};
    bf16x8 At[4][2], B0[2][2], B1[2][2];
    const char* cA = (const char*)g.A + (size_t)cur.pm * tstep + (size_t)cur.kt0 * kstep; const char* cB = (const char*)g.Bt + (size_t)cur.pn * tstep + (size_t)cur.kt0 * kstep;
    S.a_ready(cur);
    PG8_STAGE(PG8_SB(0, 0), cB, voffB); PG8_STAGE(PG8_SA(0, 0), cA, voffA); PG8_STAGE(PG8_SB(0, 1), cB + hstep, voffB); PG8_STAGE(PG8_SA(0, 1), cA + hstep, voffA);
    if (wr == 1) PG8_BAR;
    PG8_WAIT_V(4); PG8_BAR;
    PG8_STAGE(PG8_SB(1, 0), cB + kstep, voffB); PG8_STAGE(PG8_SA(1, 0), cA + kstep, voffA); PG8_STAGE(PG8_SB(1, 1), cB + hstep + kstep, voffB);
    PG8_WAIT_V(6); PG8_BAR;
    PG8_STAMP();
    for (;;) {
        const bool has_next = S.next(ui + 1, nxt);
        const char* nA = has_next ? (const char*)g.A + (size_t)nxt.pm * tstep + (size_t)nxt.kt0 * kstep : cA; const char* nB = has_next ? (const char*)g.Bt + (size_t)nxt.pn * tstep + (size_t)nxt.kt0 * kstep : cB;
        const int nt = cur.nkt;
        for (int t = 0; t < nt; t += 2) {
            const bool last = (t == nt - 2);
            const char* a1 = cA + (size_t)(t + 1) * kstep;
            const char* a2 = last ? nA : cA + (size_t)(t + 2) * kstep; const char* b2 = last ? nB : cB + (size_t)(t + 2) * kstep;
            const char* a3 = a2 + kstep; const char* b3 = b2 + kstep;
            if (last && has_next) S.a_ready(nxt);
            PG8_LDB(B0, 0, 0); PG8_SCHED; PG8_LDA(At, 0, 0); PG8_STAGE(PG8_SA(1, 1), a1 + hstep, voffA);
            PG8_WAIT_L(8); PG8_BAR; PG8_WAIT_L(0); PG8_MMA(0, 0, At, B0); PG8_BAR; PG8_SCHED;
            PG8_LDB(B1, 0, 1); PG8_STAGE(PG8_SB(0, 0), b2, voffB);
            PG8_BAR; PG8_WAIT_L(0); PG8_MMA(0, 1, At, B1); PG8_BAR;
            PG8_LDA(At, 0, 1); PG8_STAGE(PG8_SA(0, 0), a2, voffA);
            PG8_BAR; PG8_WAIT_L(0); PG8_MMA(1, 0, At, B0); PG8_BAR; PG8_SCHED;
            PG8_STAGE(PG8_SB(0, 1), b2 + hstep, voffB);
            PG8_WAIT_V(6); PG8_BAR; PG8_MMA(1, 1, At, B1); PG8_BAR;
            PG8_LDB(B0, 1, 0); PG8_SCHED; PG8_LDA(At, 1, 0); PG8_STAGE(PG8_SA(0, 1), a2 + hstep, voffA);
            PG8_WAIT_L(8); PG8_BAR; PG8_WAIT_L(0); PG8_MMA(0, 0, At, B0); PG8_BAR; PG8_SCHED;
            PG8_LDB(B1, 1, 1); PG8_STAGE(PG8_SB(1, 0), b3, voffB);
            PG8_BAR; PG8_WAIT_L(0); PG8_MMA(0, 1, At, B1); PG8_BAR;
            PG8_LDA(At, 1, 1); PG8_STAGE(PG8_SA(1, 0), a3, voffA);
            PG8_BAR; PG8_WAIT_L(0); PG8_MMA(1, 0, At, B0); PG8_BAR; PG8_SCHED;
            PG8_STAGE(PG8_SB(1, 1), b3 + hstep, voffB);
            PG8_WAIT_V(6); PG8_BAR; PG8_MMA(1, 1, At, B1); PG8_BAR;
        }
        PG8_STAMP();
        if constexpr (!Epi::AFTER_DRAIN) { E(acc, cur, wr, wc, fr, fq); S.done(cur); }
        PG8_STAMP();
        if (!has_next) break;
#pragma unroll
        for (int a = 0; a < 2; ++a)
#pragma unroll
            for (int b = 0; b < 2; ++b)
#pragma unroll
                for (int m = 0; m < 4; ++m)
#pragma unroll
                    for (int n = 0; n < 2; ++n) acc[a][b][m][n] = (f32x4){0.f, 0.f, 0.f, 0.f};
        cur = nxt; cA = nA; cB = nB; ++ui;
    }
    PG8_WAIT_V(0);
    if (wr == 0) PG8_BAR;
    PG8_BAR;
    if constexpr (Epi::AFTER_DRAIN) { E.fused(acc, cur, wr, wc, fr, fq, lds, wid, lane); S.done(cur); }
    PG8_STAMP();
    if (STAMP && wid == 0) { stamps[lane] = lane < nts ? (((unsigned long long)(unsigned)ts_hi << 32) | (unsigned)ts_lo) : 0ull;
        if (lane == 62) stamps[62] = rt_entry; if (lane == 63) stamps[63] = (unsigned long long)wall_clock64(); }
#undef PG8_STAMP
#undef PG8_SA
#undef PG8_SB
#undef PG8_STAGE
#undef PG8_LDA
#undef PG8_LDB
#undef PG8_MMA
#undef PG8_WAIT_V
#undef PG8_WAIT_L
#undef PG8_BAR
#undef PG8_SCHED
}
}
namespace fa {
constexpr int D = 128, OSTR = 1024;
constexpr float SCALE = 0.08838834764831845f;
constexpr float THR = 8.f;
constexpr bool WSKIP = false;
constexpr int NW = 8, QBLK = 32, KVBLK = 64, QB = NW * QBLK;
constexpr int SHM_V = KVBLK * D * 2, SHM_K = KVBLK * D * 2;
__device__ __forceinline__ int v_st(int k, int c) { const int kk = (k & ~0xC) | ((k & 4) << 1) | ((k & 8) >> 1); return ((kk >> 3) * 4 + (c >> 5)) * 512 + ((kk & 7) * 32 + (c & 31)) * 2; }
__device__ __forceinline__ int v_rd_base(int lane) { return ((lane & 3) << 3) | (((lane >> 2) & 3) << 6) | (((lane >> 4) & 1) << 5) | (((lane >> 5) & 1) << 8); }
constexpr int v_rd_off(int d0, int ks, int half) { return d0 * 512 + ks * 4096 + half * 2048; }
__device__ __forceinline__ int crow(int r, int hi) { return (r & 3) + 8 * (r >> 2) + 4 * hi; }
__device__ __forceinline__ unsigned cvtpk(float lo, float hi) {
    unsigned r; asm volatile("v_cvt_pk_bf16_f32 %0, %1, %2" : "=v"(r) : "v"(lo), "v"(hi)); return r;
}
__device__ __forceinline__ bf16x8 pack8(f32x4 a, f32x4 b) {
    u32x4 w = {cvtpk(a[0], a[1]), cvtpk(a[2], a[3]), cvtpk(b[0], b[1]), cvtpk(b[2], b[3])};
    return *reinterpret_cast<bf16x8*>(&w);
}
template <class T> __device__ __forceinline__ bf16x8 load8(const T* p) {
    if constexpr (same_t<T, float>::v) { return pack8(*(const f32x4*)p, *(const f32x4*)(p + 4)); }
    else { return *reinterpret_cast<const bf16x8*>(p); }
}
__device__ __forceinline__ void mask_tile(f32x16& p0, f32x16& p1, int dq, unsigned W) {
    const float NEG = -__builtin_inff();
#pragma unroll
    for (int r = 0; r < 16; ++r) {
        const int c = (r & 3) + 8 * (r >> 2);
        if ((unsigned)(dq - c) >= W) p0[r] = NEG;
        if ((unsigned)(dq - c - 32) >= W) p1[r] = NEG;
    }
}
__device__ __forceinline__ void partialSM(f32x16& p0, f32x16& p1, float& m_reg, float& mn, float& alpha) {
    float pmax = p0[0]; for (int r = 1; r < 16; ++r) pmax = fmaxf(pmax, p0[r]); for (int r = 0; r < 16; ++r) pmax = fmaxf(pmax, p1[r]);
    { auto rr = __builtin_amdgcn_permlane32_swap(__float_as_uint(pmax), __float_as_uint(pmax), false, false);
      pmax = fmaxf(__uint_as_float(rr[0]), __uint_as_float(rr[1])); }
    constexpr float C2 = 1.4426950408889634f * SCALE;
    if (__builtin_expect(__all((pmax - m_reg) * SCALE <= THR), 1)) { mn = m_reg; alpha = 1.f; }
    else { mn = fmaxf(m_reg, pmax); alpha = __builtin_amdgcn_exp2f((m_reg - mn) * C2); m_reg = mn; }
    const float mnL = -mn * C2;
    for (int r = 0; r < 16; ++r) p0[r] = fmaf(p0[r], C2, mnL); for (int r = 0; r < 16; ++r) p1[r] = fmaf(p1[r], C2, mnL);
    for (int r = 0; r < 16; ++r) p0[r] = __builtin_amdgcn_exp2f(p0[r]);
}
__device__ __forceinline__ void finishSM(f32x16& p0, f32x16& p1, float alpha, float& l_reg, bf16x8& pa0, bf16x8& pa1, bf16x8& pa2, bf16x8& pa3) {
    for (int r = 0; r < 16; ++r) p1[r] = __builtin_amdgcn_exp2f(p1[r]);
    float ps = 0; for (int r = 0; r < 16; ++r) ps += p0[r]; for (int r = 0; r < 16; ++r) ps += p1[r];
    { auto rr = __builtin_amdgcn_permlane32_swap(__float_as_uint(ps), __float_as_uint(ps), false, false);
      ps = __uint_as_float(rr[0]) + __uint_as_float(rr[1]); }
    l_reg = l_reg * alpha + ps;
#define PK4(P, B_, OUT) do { unsigned a0 = cvtpk(P[B_+0], P[B_+1]), a1 = cvtpk(P[B_+2], P[B_+3]);                          \
        unsigned b0 = cvtpk(P[B_+4], P[B_+5]), b1 = cvtpk(P[B_+6], P[B_+7]);                                             \
        auto r0 = __builtin_amdgcn_permlane32_swap(a0, b0, false, false); auto r1 = __builtin_amdgcn_permlane32_swap(a1, b1, false, false); \
        u32x4 w = {r0[0], r1[0], r0[1], r1[1]}; OUT = *reinterpret_cast<bf16x8*>(&w); } while (0)
    PK4(p0, 0, pa0); PK4(p0, 8, pa1); PK4(p1, 0, pa2); PK4(p1, 8, pa3);
#undef PK4
}
template <int KB, bool SK>
__device__ __forceinline__ void qkt(f32x16& p0, f32x16& p1, const char* K_lds, const char* B_lds, int r32, int hi, const bf16x8* qr, bool act) {
    if (SK && !act) { const float NEG = -__builtin_inff();
#pragma unroll
        for (int r = 0; r < 16; ++r) { p0[r] = NEG; p1[r] = NEG; } return; }
    { const float* bl = (const float*)B_lds + 4 * hi;
#pragma unroll
      for (int g = 0; g < 4; ++g) { const f32x4 ba = *(const f32x4*)(bl + 8 * g); const f32x4 bb = *(const f32x4*)(bl + 32 + 8 * g);
#pragma unroll
        for (int e = 0; e < 4; ++e) { p0[4 * g + e] = ba[e]; p1[4 * g + e] = bb[e]; } } }
    const char* kb[4];
#pragma unroll
    for (int dd = 0; dd < 4; ++dd) kb[dd] = K_lds + KB * SHM_K + KSWZ(r32, (dd * 16 + hi * 8) * 2);
#pragma unroll
    for (int d0 = 0; d0 < 8; ++d0) { const char* a = kb[d0 & 3] + (d0 >> 2) * 128;
        bf16x8 b0 = *reinterpret_cast<const bf16x8*>(a);
        bf16x8 b1 = *reinterpret_cast<const bf16x8*>(a + 32 * 256);
        p0 = __builtin_amdgcn_mfma_f32_32x32x16_bf16(b0, qr[d0], p0, 0, 0, 0);
        p1 = __builtin_amdgcn_mfma_f32_32x32x16_bf16(b1, qr[d0], p1, 0, 0, 0); }
}
template <int VB, bool SK>
__device__ __forceinline__ void pv_tile(f32x16* o, int vb0, bf16x8 pa0, bf16x8 pa1, bf16x8 pa2, bf16x8 pa3, bool act) {
    if (SK && !act) return;
#define TRRD(dst, off) asm volatile("ds_read_b64_tr_b16 %0, %1 offset:%2" : "=&v"(dst) : "v"(vb0), "i"(off) : "memory")
#define PV_D0(d0) do { s16x4 l0, l1, l2, l3, h0, h1, h2, h3; constexpr int b_ = VB * SHM_V + v_rd_off(d0, 0, 0);     \
        TRRD(l0, b_); TRRD(h0, b_ + 2048); TRRD(l1, b_ + 4096); TRRD(h1, b_ + 6144); TRRD(l2, b_ + 8192); TRRD(h2, b_ + 10240); TRRD(l3, b_ + 12288); TRRD(h3, b_ + 14336); \
        asm volatile("s_waitcnt lgkmcnt(0)" ::: "memory"); SBAR();                 \
        o[d0] = __builtin_amdgcn_mfma_f32_32x32x16_bf16(pa0, (bf16x8){l0[0], l0[1], l0[2], l0[3], h0[0], h0[1], h0[2], h0[3]}, o[d0], 0, 0, 0);   \
        o[d0] = __builtin_amdgcn_mfma_f32_32x32x16_bf16(pa1, (bf16x8){l1[0], l1[1], l1[2], l1[3], h1[0], h1[1], h1[2], h1[3]}, o[d0], 0, 0, 0);   \
        o[d0] = __builtin_amdgcn_mfma_f32_32x32x16_bf16(pa2, (bf16x8){l2[0], l2[1], l2[2], l2[3], h2[0], h2[1], h2[2], h2[3]}, o[d0], 0, 0, 0);   \
        o[d0] = __builtin_amdgcn_mfma_f32_32x32x16_bf16(pa3, (bf16x8){l3[0], l3[1], l3[2], l3[3], h3[0], h3[1], h3[2], h3[3]}, o[d0], 0, 0, 0); } while (0)
    PV_D0(0); PV_D0(1); PV_D0(2); PV_D0(3);
#undef PV_D0
#undef TRRD
}

template <class TIn, class TOut> struct BlockRef { const TIn* Q; const TIn* K; const TIn* V; const TIn* K2; const TIn* V2; TOut* O; const float* NC; int P0; int nrows; };
template <class TIn> struct Seam {
    bf16x8 qr[8];
    bf16x8 st_v0, st_v1, st_k0, st_k1; f32x4 sf0, sf1, sf2, sf3;
    f32x4 tq[16];
};
__device__ __forceinline__ int swa_jlo(int P0, int W) { const int lowk = P0 - W + 1; return lowk > 0 ? lowk / KVBLK : 0; }
#define ROW(p, k0, rr) ((p) + (size_t)((k0) + (rr)) * D + sc)
#define VMW() asm volatile("s_waitcnt vmcnt(0)" ::: "memory")
#define VMWN(n) asm volatile("s_waitcnt vmcnt(%0)" :: "i"(n) : "memory")
#define SLOAD_H(Kp, Vp, NCp, k0) do { S.st_v0 = load8<TIn>(ROW(Vp, k0, sr)); S.st_v1 = load8<TIn>(ROW(Vp, k0, 32 + sr));              \
                         S.st_k0 = load8<TIn>(ROW(Kp, k0, sr)); S.st_k1 = load8<TIn>(ROW(Kp, k0, 32 + sr)); } while (0)
#define SWRITE_HK(bf) do { *(bf16x8*)(K_lds + (bf) * SHM_K + kws) = S.st_k0; *(bf16x8*)(K_lds + (bf) * SHM_K + kws + 32 * 256) = S.st_k1; } while (0)
#define SWRITE_HV(bf) do { *(bf16x8*)(V_lds + (bf) * SHM_V + vst0) = S.st_v0; *(bf16x8*)(V_lds + (bf) * SHM_V + vst1) = S.st_v1; } while (0)
#define SWRITE_H(bf) do { SWRITE_HV(bf); SWRITE_HK(bf); } while (0)
#define ROWF(p, k0, rr) ((p) + (size_t)((k0) + (rr)) * 1024 + sc)
#define FSEL(a, b, k0) ((const float*)((k0) < 1024 ? (a) : (b)))
#define SLOAD_F(p, k0) do { S.sf0 = *(const f32x4*)ROWF(p, k0, sr); S.sf1 = *(const f32x4*)(ROWF(p, k0, sr) + 4);                \
                            S.sf2 = *(const f32x4*)ROWF(p, k0, 32 + sr); S.sf3 = *(const f32x4*)(ROWF(p, k0, 32 + sr) + 4); } while (0)
#define SWRITE_KF(bf) do { *(bf16x8*)(K_lds + (bf) * SHM_K + kws) = pack8(S.sf0, S.sf1); *(bf16x8*)(K_lds + (bf) * SHM_K + kws + 32 * 256) = pack8(S.sf2, S.sf3); } while (0)
#define SWRITE_VF(bf) do { *(bf16x8*)(V_lds + (bf) * SHM_V + vst0) = pack8(S.sf0, S.sf1); *(bf16x8*)(V_lds + (bf) * SHM_V + vst1) = pack8(S.sf2, S.sf3); } while (0)
template <class TIn, class TOut>
__device__ __forceinline__ void causal_swa_prime(const BlockRef<TIn, TOut>& cur, int W, char* lds, Seam<TIn>& S) {
    constexpr bool F32 = same_t<TIn, float>::v;
    const int tid = otid(), wid = __builtin_amdgcn_readfirstlane(tid >> 6), lane = tid & 63, r32 = lane & 31, hi = lane >> 5;
    const int sr = tid >> 4, sc = (tid & 15) * 8, kws = KSWZ(sr, sc * 2); char* K_lds = lds + 2 * SHM_V; char* B_lds = lds + 2 * SHM_V + 2 * SHM_K + NW * 64 * 4;
    const int kb0 = swa_jlo(cur.P0, W) * KVBLK;
    for (int d0 = 0; d0 < 8; ++d0) S.qr[d0] = load8<TIn>(cur.Q + (size_t)(wid * QBLK + r32) * D + d0 * 16 + hi * 8);
    if constexpr (F32) { SLOAD_F(FSEL(cur.K, cur.K2, kb0), kb0); VMW(); SWRITE_KF(0); SBAR(); SLOAD_F(FSEL(cur.V, cur.V2, kb0), kb0); }
    else { SLOAD_H(cur.K, cur.V, cur.NC, kb0); VMW(); SWRITE_HK(0); }
    __syncthreads();
}
template <class TIn, class TOut>
__device__ __forceinline__ void causal_swa_block(const BlockRef<TIn, TOut>& cur, const BlockRef<TIn, TOut>& nxt, int skv, int W, char* lds, Seam<TIn>& S) {
    constexpr bool F32 = same_t<TIn, float>::v;
    const int tid = otid(), wid = __builtin_amdgcn_readfirstlane(tid >> 6), lane = tid & 63, r32 = lane & 31, hi = lane >> 5;
    const int j_lo = swa_jlo(cur.P0, W);
    int j_hi = (cur.P0 + QB - 1) / KVBLK + 1; if (j_hi > skv / KVBLK) j_hi = skv / KVBLK;
    const int NT = j_hi - j_lo;
    const int kbn = swa_jlo(nxt.P0, W) * KVBLK;
    const int qlo = cur.P0 + wid * QBLK, qm = qlo + r32 - 4 * hi;
    char* V_lds = lds; char* K_lds = lds + 2 * SHM_V; char* B_lds = lds + 2 * SHM_V + 2 * SHM_K + NW * 64 * 4;
    float* ws = (float*)(lds + 2 * SHM_V + 2 * SHM_K) + wid * 64; float* li_l = ws, * al_l = ws + 32;
    float m_reg = -1e30f, l_reg = 0; f32x16 o[4] = {};
    const int sr = tid >> 4, sc = (tid & 15) * 8, vst0 = v_st(sr, sc), vst1 = v_st(32 + sr, sc), kws = KSWZ(sr, sc * 2);
    const int vb0 = (int)(uintptr_t)V_lds + v_rd_base(lane);
    const TIn* Kh = cur.K; const TIn* Vh = cur.V;
#define RESC(a) do { if (__any((a) < 1.f)) { if (hi == 0) al_l[r32] = (a); asm volatile("s_waitcnt lgkmcnt(0)" ::: "memory");              \
                     for (int d_ = 0; d_ < 4; ++d_) for (int r = 0; r < 16; ++r) o[d_][r] *= al_l[crow(r, hi)]; } } while (0)
#define KBASE(t) ((j_lo + (t)) * KVBLK)
#define ACT(t) (KBASE(t) <= qlo + QBLK - 1 && KBASE(t) + KVBLK - 1 >= qlo - W + 1)
#define MASKT(P0_, P1_, t) do { const int kb_ = KBASE(t); if ((!SK || ACT(t)) && (kb_ + KVBLK - 1 > qlo || kb_ <= qlo + QBLK - 1 - W)) mask_tile(P0_, P1_, qm - kb_, (unsigned)W); } while (0)
    constexpr int NQL = F32 ? 16 : 8;
    constexpr bool SK = WSKIP && !F32;
#define SEAM_K0() do { VMWN(NQL); if constexpr (F32) { SWRITE_KF(0); SBAR(); SLOAD_F(FSEL(nxt.V, nxt.V2, kbn), kbn); } else { SWRITE_HK(0); } SBAR(); } while (0)
    f32x16 pA0, pA1, pB0, pB1; float mnA, mnB, alA, alB; bf16x8 pa0, pa1, pa2, pa3;
    { const int nbk = j_hi * KVBLK;
      for (int q = tid * 4; q < nbk; q += 2048) *(f32x4*)(B_lds + q * 4) = *(const f32x4*)(cur.NC + q);
      __syncthreads(); }
    if constexpr (F32) { VMW(); SWRITE_VF(0); SBAR(); } else { SWRITE_HV(0); SBAR(); }
    if (NT > 1) { if constexpr (F32) SLOAD_F(FSEL(cur.K, cur.K2, KBASE(1)), KBASE(1)); else SLOAD_H(Kh, Vh, cur.NC, KBASE(1)); }
    SBAR(); qkt<0, SK>(pA0, pA1, K_lds, B_lds + KBASE(0) * 4, r32, hi, S.qr, ACT(0));
    if constexpr (F32) { if (NT > 1) { VMW(); SWRITE_KF(1); SBAR(); SLOAD_F(FSEL(cur.V, cur.V2, KBASE(1)), KBASE(1)); } }
    MASKT(pA0, pA1, 0); partialSM(pA0, pA1, m_reg, mnA, alA);
    if (NT > 1) { VMW(); if constexpr (F32) { SWRITE_VF(1); SBAR(); if (NT > 2) SLOAD_F(FSEL(cur.K, cur.K2, KBASE(2)), KBASE(2)); } else SWRITE_H(1); }
    __syncthreads();
#define HALF_STEP(PX0, PX1, mnX, alX, PY0, PY1, alY, t, KB, VB, SB) do {                                                      \
        SBAR(); qkt<KB, SK>(PX0, PX1, K_lds, B_lds + KBASE(t) * 4, r32, hi, S.qr, ACT(t));                                             \
        finishSM(PY0, PY1, alY, l_reg, pa0, pa1, pa2, pa3); SBAR();                                                           \
        if ((t) + 1 < NT) { if constexpr (F32) { VMW(); SWRITE_KF(SB); SBAR(); SLOAD_F(FSEL(cur.V, cur.V2, KBASE((t) + 1)), KBASE((t) + 1)); }  \
                            else { SLOAD_H(Kh, Vh, cur.NC, KBASE((t) + 1)); } SBAR(); }                                               \
        pv_tile<VB, SK>(o, vb0, pa0, pa1, pa2, pa3, ACT((t) - 1)); MASKT(PX0, PX1, (t)); partialSM(PX0, PX1, m_reg, mnX, alX);                                        \
        __syncthreads();                                                                                                      \
        if ((t) + 1 < NT) { VMW(); if constexpr (F32) { SWRITE_VF(SB); SBAR(); if ((t) + 2 < NT) SLOAD_F(FSEL(cur.K, cur.K2, KBASE((t) + 2)), KBASE((t) + 2)); } \
                            else { SWRITE_H(SB); } }                                                                          \
        RESC(alX); __syncthreads(); } while (0)
    for (int t = 1; t + 1 < NT; t += 2) {
        HALF_STEP(pB0, pB1, mnB, alB, pA0, pA1, alA, t, 1, 0, 0);
        HALF_STEP(pA0, pA1, mnA, alA, pB0, pB1, alB, t + 1, 0, 1, 1);
    }
    const bool even = (NT & 1) == 0;
    if (even) { SBAR(); qkt<1, SK>(pB0, pB1, K_lds, B_lds + KBASE(NT - 1) * 4, r32, hi, S.qr, ACT(NT - 1)); SBAR(); }
#define QROW(e) (nxt.Q + (size_t)(wid * QBLK + r32) * D + ((e) >> 1) * 16 + hi * 8 + ((e) & 1) * 4)
    if constexpr (F32) { SLOAD_F(FSEL(nxt.K, nxt.K2, kbn), kbn); SBAR();
#pragma unroll
        for (int e = 0; e < 8; ++e) S.tq[e] = *(const f32x4*)QROW(e); }
    else { SLOAD_H(nxt.K, nxt.V, nxt.NC, kbn); SBAR();
#pragma unroll
        for (int d0 = 0; d0 < 8; ++d0) S.qr[d0] = load8<TIn>(nxt.Q + (size_t)(wid * QBLK + r32) * D + d0 * 16 + hi * 8); }
    SBAR();
    finishSM(pA0, pA1, alA, l_reg, pa0, pa1, pa2, pa3); SBAR();
    if constexpr (F32) {
#pragma unroll
        for (int e = 8; e < 16; ++e) S.tq[e] = *(const f32x4*)QROW(e); SBAR(); }
#undef QROW
    pv_tile<0, SK>(o, vb0, pa0, pa1, pa2, pa3, ACT(even ? NT - 2 : NT - 1));
    if (even) { MASKT(pB0, pB1, NT - 1); partialSM(pB0, pB1, m_reg, mnB, alB); __syncthreads(); RESC(alB);
        finishSM(pB0, pB1, alB, l_reg, pa0, pa1, pa2, pa3); SBAR(); pv_tile<1, SK>(o, vb0, pa0, pa1, pa2, pa3, ACT(NT - 1)); }
    SBAR(); SEAM_K0();
    if (hi == 0) li_l[r32] = l_reg; asm volatile("s_waitcnt lgkmcnt(0)" ::: "memory");
    float rli[16];
#pragma unroll
    for (int r = 0; r < 16; ++r) rli[r] = __builtin_amdgcn_rcpf(li_l[crow(r, hi)]);
    TOut* Ow = cur.O + (size_t)(wid * QBLK) * OSTR;
    if (wid * QBLK < cur.nrows)
#pragma unroll
    for (int r = 0; r < 16; ++r) { const int orow = crow(r, hi);
#pragma unroll
        for (int d0 = 0; d0 < 4; ++d0) { const float v = o[d0][r] * rli[r];
            if constexpr (same_t<TOut, float>::v) { Ow[(size_t)orow * OSTR + d0 * 32 + r32] = v; }
            else { const float vn = __shfl_xor(v, 1);
                   if ((r32 & 1) == 0) *(unsigned*)(Ow + (size_t)orow * OSTR + d0 * 32 + r32) = cvtpk(v, vn); } } }
    if constexpr (F32) {
#pragma unroll
        for (int d0 = 0; d0 < 8; ++d0) S.qr[d0] = pack8(S.tq[2 * d0], S.tq[2 * d0 + 1]); }
    __syncthreads();
#undef RESC
#undef KBASE
#undef ACT
#undef MASKT
#undef SEAM_K0
#undef HALF_STEP
}
#undef ROW
#undef VMW
#undef VMWN
#undef SLOAD_H
#undef SWRITE_HK
#undef SWRITE_HV
#undef SWRITE_H
#undef SLOAD_F
#undef SWRITE_KF
#undef SWRITE_VF

}
#define XB_TMO      128
#define XB_XCNT(j)  (256  + 64 * (j))
#define XB_XSUB(j)  (1280 + 64 * (j))
#define XB_XGEN(j)  (2304 + 64 * (j))
#define XB_TOP      3328
#define XB_TOPGEN   3392
#define XCD_BAR_WORDS 3456
#define XB_SPIN_CAP (1u << 18)
#define XB_LAS __attribute__((address_space(3)))

__device__ __forceinline__ unsigned xb_ld(unsigned* p)              { return __hip_atomic_load(p, __ATOMIC_RELAXED, __HIP_MEMORY_SCOPE_AGENT); }
__device__ __forceinline__ unsigned xb_add(unsigned* p, unsigned v) { return __hip_atomic_fetch_add(p, v, __ATOMIC_RELAXED, __HIP_MEMORY_SCOPE_AGENT); }
__device__ __forceinline__ unsigned xb_xcc_id() { return (unsigned)__builtin_amdgcn_s_getreg((3 << 11) | 20) & 0xFu; }
#define XB_SPIN(cond, bar) do { unsigned _sp = 0; while (cond) { __builtin_amdgcn_s_sleep(1); \
    if ((++_sp & 255u) == 0u) { if (xb_ld(&(bar)[XB_TMO])) break; if (_sp > XB_SPIN_CAP) { atomicAdd(&(bar)[XB_TMO], 1u); break; } } } } while (0)

struct XcdBarrier {
    unsigned* bar; unsigned x;
    volatile XB_LAS unsigned* st;
};

__device__ __forceinline__ XcdBarrier xcd_barrier_post(unsigned* bar, volatile XB_LAS unsigned* st) {
    XcdBarrier b; b.bar = bar; b.x = xb_xcc_id(); b.st = st;
    if (threadIdx.x == 0) (void)xb_add(&bar[XB_XCNT(b.x)], 1u);
    return b;
}
__device__ __forceinline__ void xcd_barrier_complete(unsigned* bar, unsigned x, unsigned& nloc, unsigned& nx) {
    const unsigned G = gridDim.x * gridDim.y * gridDim.z;
    unsigned sum, cnt, mine, sp = 0u;
    for (;;) {
        sum = 0u; cnt = 0u; mine = 0u;
#pragma unroll
        for (unsigned j = 0; j < 16; ++j) { const unsigned c = xb_ld(&bar[XB_XCNT(j)]); sum += c; cnt += (c > 0u) ? 1u : 0u; mine = (j == x) ? c : mine; }
        if (sum == G) break;
        __builtin_amdgcn_s_sleep(1);
        if ((++sp & 255u) == 0u) { if (xb_ld(&bar[XB_TMO])) break; if (sp > XB_SPIN_CAP) { atomicAdd(&bar[XB_TMO], 1u); break; } }
    }
    nloc = mine > 0u ? mine : 1u; nx = cnt > 0u ? cnt : 1u;
}

__device__ __forceinline__ void xcd_barrier(const XcdBarrier& b) {
    asm volatile("s_waitcnt vmcnt(0)" ::: "memory");
    __syncthreads();
    if (threadIdx.x == 0) {
        unsigned* bar = b.bar;
        __builtin_amdgcn_s_waitcnt(0);
        unsigned nloc = b.st[0], nx = b.st[1];
        if (nloc == 0u) { xcd_barrier_complete(bar, b.x, nloc, nx); b.st[0] = nloc; b.st[1] = nx; }
        const unsigned old = xb_add(&bar[XB_XSUB(b.x)], 1u);
        const unsigned gen = old / nloc;
        if (old + 1u == (gen + 1u) * nloc) {
            __builtin_amdgcn_fence(__ATOMIC_RELEASE, "agent");
            asm volatile("s_waitcnt vmcnt(0)" ::: "memory");
            const unsigned og = xb_add(&bar[XB_TOP], 1u);
            const unsigned tg = og / nx;
            if (og + 1u == (tg + 1u) * nx) xb_add(&bar[XB_TOPGEN], 1u);
            else XB_SPIN(xb_ld(&bar[XB_TOPGEN]) == tg, bar);
            __builtin_amdgcn_fence(__ATOMIC_ACQUIRE, "agent");
            xb_add(&bar[XB_XGEN(b.x)], 1u);
            asm volatile("s_waitcnt vmcnt(0)" ::: "memory");
        } else {
            XB_SPIN(xb_ld(&bar[XB_XGEN(b.x)]) == gen, bar);
            __builtin_amdgcn_fence(__ATOMIC_ACQUIRE, "agent");
            asm volatile("s_waitcnt vmcnt(0)" ::: "memory");
        }
    }
    __syncthreads();
}


__device__ __forceinline__ float bf2f(unsigned short b) { return __uint_as_float(((unsigned)b) << 16); }
__device__ __forceinline__ unsigned pk2(float lo, float hi) { unsigned r; asm volatile("v_cvt_pk_bf16_f32 %0, %1, %2" : "=v"(r) : "v"(lo), "v"(hi)); return r; }
__device__ __forceinline__ unsigned short f2bf(float x) { return (unsigned short)(pk2(x, 0.f) & 0xffffu); }
__device__ __forceinline__ float wave_sum(float v) {
#pragma unroll
    for (int o = 1; o < 64; o <<= 1) v += __shfl_xor(v, o);
    return v;
}
__device__ __forceinline__ float grp16_sum(float v) {
#pragma unroll
    for (int o = 1; o < 16; o <<= 1) v += __shfl_xor(v, o);
    return v;
}
__device__ __forceinline__ float wave_incl_scan(float v, int lane) {
#pragma unroll
    for (int o = 1; o < 64; o <<= 1) { const float t = __shfl_up(v, o); if (lane >= o) v += t; }
    return v;
}
__device__ __forceinline__ float silu_f(float x) { return x * __builtin_amdgcn_rcpf(1.f + __expf(-x)); }
__device__ __forceinline__ void unpack8(u32x4 w, float (&o)[8]) {
#pragma unroll
    for (int q = 0; q < 4; ++q) { o[2 * q] = __uint_as_float(w[q] << 16); o[2 * q + 1] = __uint_as_float(w[q] & 0xffff0000u); }
}
__device__ __forceinline__ u32x4 pack8f(const float (&v)[8]) { u32x4 w = {pk2(v[0], v[1]), pk2(v[2], v[3]), pk2(v[4], v[5]), pk2(v[6], v[7])}; return w; }
__device__ __forceinline__ int pos16(int x) { return (x & ~12) | (((x >> 2) & 1) << 3) | (((x >> 3) & 1) << 2); }
__device__ __forceinline__ int crow32(int r, int hi) { return (r & 3) + 8 * (r >> 2) + 4 * hi; }

struct EpiBf16Plain {
    static constexpr bool PERM = true, AFTER_DRAIN = false;
    bf16_t* O; int ldc;
    __device__ __forceinline__ void operator()(const pg8::f32x4 (&acc)[2][2][4][2], const pg8::Unit& u, int wr, int wc, int fr, int fq) const {
        const int row0 = u.pm * 256 + wr * 64 + fr, col0 = u.pn * 256 + wc * 32 + 8 * fq;
#pragma unroll
        for (int ai = 0; ai < 2; ++ai)
#pragma unroll
            for (int m = 0; m < 4; ++m) { bf16_t* rowp = O + (size_t)(row0 + ai * 128 + m * 16) * ldc + col0;
#pragma unroll
                for (int bj = 0; bj < 2; ++bj) { const pg8::f32x4 v0 = acc[ai][bj][m][0], v1 = acc[ai][bj][m][1];
                    u32x4 w; w.x = pk2(v0[0], v0[1]); w.y = pk2(v0[2], v0[3]); w.z = pk2(v1[0], v1[1]); w.w = pk2(v1[2], v1[3]);
                    *(u32x4*)(rowp + bj * 128) = w; } }
    }
};
struct EpiSwiglu {
    static constexpr bool PERM = true, AFTER_DRAIN = false;
    bf16_t* O; int ldc;
    __device__ __forceinline__ void operator()(const pg8::f32x4 (&acc)[2][2][4][2], const pg8::Unit& u, int wr, int wc, int fr, int fq) const {
        const int row0 = u.pm * 256 + wr * 64 + fr, col0 = u.pn * 128 + wc * 32 + 8 * fq;
#pragma unroll
        for (int ai = 0; ai < 2; ++ai)
#pragma unroll
            for (int m = 0; m < 4; ++m) { bf16_t* rowp = O + (size_t)(row0 + ai * 128 + m * 16) * ldc + col0;
                float r[8];
#pragma unroll
                for (int n = 0; n < 2; ++n)
#pragma unroll
                    for (int e = 0; e < 4; ++e) { const float g = acc[ai][0][m][n][e], up = acc[ai][1][m][n][e]; r[4 * n + e] = silu_f(g) * up; }
                *(u32x4*)rowp = pack8f(r); }
    }
};
struct EpiResid {
    static constexpr bool PERM = false, AFTER_DRAIN = false;
    float* X; int ldc; float* slab;
    __device__ __forceinline__ void operator()(const pg8::f32x4 (&acc)[2][2][4][2], const pg8::Unit& u, int wr, int wc, int fr, int fq) const {
        const int row0 = u.pm * 256 + wr * 64 + fr, col0 = u.pn * 256 + wc * 32 + 4 * fq;
        if (u.split) {
            float* Sl = slab + (size_t)(u.split - 1) * MS * DM;
#pragma unroll
            for (int ai = 0; ai < 2; ++ai)
#pragma unroll
                for (int m = 0; m < 4; ++m) { float* rowp = Sl + (size_t)(row0 - MP + ai * 128 + m * 16) * DM + col0;
#pragma unroll
                    for (int bj = 0; bj < 2; ++bj)
#pragma unroll
                        for (int n = 0; n < 2; ++n) *(pg8::f32x4*)(rowp + bj * 128 + n * 16) = acc[ai][bj][m][n]; }
        } else {
#pragma unroll
            for (int ai = 0; ai < 2; ++ai)
#pragma unroll
                for (int m = 0; m < 4; ++m) { float* rowp = X + (size_t)(row0 + ai * 128 + m * 16) * ldc + col0;
#pragma unroll
                    for (int bj = 0; bj < 2; ++bj)
#pragma unroll
                        for (int n = 0; n < 2; ++n) { pg8::f32x4* q = (pg8::f32x4*)(rowp + bj * 128 + n * 16); *q = *q + acc[ai][bj][m][n]; } }
        }
    }
};
template <class Epi>
__device__ __forceinline__ void run_gemm(PG8_LAS unsigned char* lds, const bf16_t* A, const bf16_t* Bt, int N, int K, const Epi& E) {
    pg8::Gemm g; g.A = A; g.Bt = Bt; g.M = MT; g.N = N; g.K = K;
    pg8::StaticOrder S; S.init(MT, N, (int)gridDim.x, (int)blockIdx.x); S.nktf = K / 64;
    pg8::gemm_phase<Epi, pg8::StaticOrder, false>(lds, g, S, E, nullptr);
}

__device__ __forceinline__ int tail_parts(int K, int G) { return G != 256 ? 0 : ((K / 128) >= 16 ? 8 : 4); }
struct TailSplitOrder {
    int c, G, nktf; pg8::StaticOrder so;
    __device__ void init(int K, int G_, int c_) { c = c_; G = G_; nktf = K / 64; so.init(MT, 1024, G_, c_); so.nktf = nktf; }
    __device__ bool next(int i, pg8::Unit& u) const {
        if (G != 256) return so.next(i, u);
        if (i == 0) { u.pm = (c & 7) + 8 * (c >> 5); u.pn = (c >> 3) & 3; u.kt0 = 0; u.nkt = nktf; u.split = 0; return true; }
        if (i > 1) return false;
        const int npairs = nktf >> 1, parts = npairs >= 16 ? 8 : 4, part = c >> 5, tix = c & 31;
        if (part >= parts) return false;
        const int q = npairs / parts, r = npairs - q * parts;
        const int p0 = part * q + (part < r ? part : r), np = q + (part < r ? 1 : 0);
        u.pm = 64 + (tix >> 2); u.pn = tix & 3; u.kt0 = 2 * p0; u.nkt = 2 * np; u.split = part + 1; return true;
    }
    __device__ __forceinline__ void a_ready(const pg8::Unit&) const {}
    __device__ __forceinline__ void done(const pg8::Unit&) const {}
};
__device__ __forceinline__ void run_gemm_n1024(PG8_LAS unsigned char* lds, const bf16_t* A, const bf16_t* Bt, int K, const EpiResid& E) {
    pg8::Gemm g; g.A = A; g.Bt = Bt; g.M = MT; g.N = 1024; g.K = K;
    TailSplitOrder S; S.init(K, (int)gridDim.x, (int)blockIdx.x);
    pg8::gemm_phase<EpiResid, TailSplitOrder, false>(lds, g, S, E, nullptr);
}

__device__ __forceinline__ void transpose_weight(const float* __restrict__ W, int K, int N, bf16_t* WT, int mode, float* tile, int bid, int nb) {
    const int tid = otid();
    const int nct = (N + 63) >> 6, nkt = K >> 6, nt = nct * nkt;
    constexpr int TB = 4;
    for (int t0 = bid; t0 < nt; t0 += TB * nb) {
        float v[TB][8];
#pragma unroll
        for (int q = 0; q < TB; ++q) { const int t = min(t0 + q * nb, nt - 1), kt = t / nct, ct = t - kt * nct, k0 = kt * 64, n0 = ct * 64;
#pragma unroll
            for (int i = 0; i < 8; ++i) { const int r = (tid >> 6) + 8 * i, c = tid & 63, n = n0 + c; v[q][i] = (n < N) ? W[(size_t)(k0 + r) * N + n] : 0.f; } }
#pragma unroll
        for (int q = 0; q < TB; ++q)
#pragma unroll
            for (int i = 0; i < 8; ++i) { const int r = (tid >> 6) + 8 * i, c = tid & 63; tile[q * 4160 + r * 65 + c] = v[q][i]; }
        __syncthreads();
#pragma unroll
        for (int q = 0; q < TB; ++q) { const int t = t0 + q * nb; if (t < nt) { const int kt = t / nct, ct = t - kt * nct, k0 = kt * 64, n0 = ct * 64;
            const int nl = tid >> 3, kc = tid & 7, n = n0 + nl; int dest = -1;
            if (n < N) {
                if (mode == 0) dest = n;
                else if (mode == 1) dest = n < 2048 ? n : (n < 2056 ? -1 : n - 8);
                else if (mode == 2) dest = n < 3072 ? n : -1;
                else if (mode == 3) dest = 256 * (n >> 7) + (n & 127);
                else dest = 256 * (n >> 7) + 128 + (n & 127);
            }
            if (dest >= 0) { float o[8];
#pragma unroll
                for (int e = 0; e < 8; ++e) o[e] = tile[q * 4160 + (8 * kc + e) * 65 + nl];
                *(u32x4*)(WT + (size_t)dest * K + k0 + 8 * kc) = pack8f(o); } } }
        __syncthreads();
    }
}
__device__ __forceinline__ void convert_weights(CParams& p, unsigned char* shm, int l0, int l1, int bid, int nb) {
    float* tile = (float*)shm;
    for (int l = l0; l < l1; ++l) {
        const int i = l >> 1;
        if ((l & 1) == 0) {
            transpose_weight(p.in[10] + (size_t)i * DM * EVEN_IN, DM, EVEN_IN, (bf16_t*)(p.ws + WS_WINE) + (size_t)i * NE * DM, 1, tile, bid, nb);
            transpose_weight(p.in[16] + (size_t)i * DM * DM, DM, DM, (bf16_t*)(p.ws + WS_WOUTE) + (size_t)i * DM * DM, 0, tile, bid, nb);
        } else {
            transpose_weight(p.in[17] + (size_t)i * DM * ODD_IN, DM, ODD_IN, (bf16_t*)(p.ws + WS_WINO) + (size_t)i * NO * DM, 2, tile, bid, nb);
            transpose_weight(p.in[21] + (size_t)i * DM * DM, DM, DM, (bf16_t*)(p.ws + WS_WOUTO) + (size_t)i * DM * DM, 0, tile, bid, nb);
        }
        transpose_weight(p.in[22] + (size_t)l * DM * DFF, DM, DFF, (bf16_t*)(p.ws + WS_WF1) + (size_t)l * NF1 * DM, 3, tile, bid, nb);
        transpose_weight(p.in[23] + (size_t)l * DM * DFF, DM, DFF, (bf16_t*)(p.ws + WS_WF1) + (size_t)l * NF1 * DM, 4, tile, bid, nb);
        transpose_weight(p.in[24] + (size_t)l * DFF * DM, DFF, DM, (bf16_t*)(p.ws + WS_WF2) + (size_t)l * DM * DFF, 0, tile, bid, nb);
    }
}
__device__ __forceinline__ void phase_init(CParams& p, unsigned char* shm) {
    convert_weights(p, shm, 0, 1, (int)blockIdx.x, (int)gridDim.x);
}

template <int MODE>
__device__ __forceinline__ void phase_norm(CParams& p, int layer, unsigned char* shm, int nparts) {
    const int tid = otid(), lane = tid & 63, wid = tid >> 6, i = layer >> 1;
    float* Wsm = (float*)shm;
    const float* X = p.out;
    const bool from_in = (MODE == 0) && layer == 0;
    const float* Xp = from_in ? p.in[0] : X; const float* Xs = from_in ? p.in[1] - (size_t)MP * DM : X;
    bf16_t* H = (bf16_t*)(p.ws + WS_H);
    const float* gain = (MODE == 2 ? p.in[9] : p.in[8]) + layer * DM;
    if (MODE != 2) {
        const float* W = MODE == 0 ? p.in[10] + (size_t)i * DM * EVEN_IN + 2048 : p.in[17] + (size_t)i * DM * ODD_IN + 3072;
        const int ldw = MODE == 0 ? EVEN_IN : ODD_IN;
#pragma unroll
        for (int r = 0; r < 4; ++r) { const int q = tid + 512 * r, k = q >> 1, hf = q & 1;
            const f32x4 w = *(const f32x4*)(W + (size_t)k * ldw + 4 * hf);
            const int j = k >> 8, l = (k & 255) >> 2, e = k & 3;
            *(f32x4*)(Wsm + (((j * 4 + e) * 64 + l) * 8 + 4 * hf)) = w; }
        __syncthreads();
    }
    f32x4 g4[4];
#pragma unroll
    for (int j = 0; j < 4; ++j) g4[j] = *(const f32x4*)(gain + 256 * j + 4 * lane);
    constexpr int R = 3;
    const int stride = gridDim.x * 8;
    f32x4 nv[R][4];
    int row = blockIdx.x * 8 + wid;
#pragma unroll
    for (int r = 0; r < R; ++r) { const int rr = min(row + r * stride, MT - 1); const f32x4* xr = (const f32x4*)((rr < MP ? Xp : Xs) + (size_t)rr * DM) + lane;
#pragma unroll
        for (int j = 0; j < 4; ++j) nv[r][j] = xr[64 * j]; }
    for (; row < MT; row += R * stride) {
        f32x4 cv[R][4];
#pragma unroll
        for (int r = 0; r < R; ++r)
#pragma unroll
            for (int j = 0; j < 4; ++j) cv[r][j] = nv[r][j];
        if (row + R * stride < MT) {
#pragma unroll
            for (int r = 0; r < R; ++r) { const int rr = min(row + (R + r) * stride, MT - 1); const f32x4* xr = (const f32x4*)((rr < MP ? Xp : Xs) + (size_t)rr * DM) + lane;
#pragma unroll
                for (int j = 0; j < 4; ++j) nv[r][j] = xr[64 * j]; }
        }
#pragma unroll
        for (int r = 0; r < R; ++r) {
            const int crow_ = row + r * stride;
            if (crow_ < MT) {
                f32x4 v[4]; float ss = 0.f;
#pragma unroll
                for (int j = 0; j < 4; ++j) v[j] = cv[r][j];
                if (from_in) { f32x4* xw = (f32x4*)(p.out + (size_t)crow_ * DM) + lane;
#pragma unroll
                    for (int j = 0; j < 4; ++j) xw[64 * j] = v[j]; }
                if (crow_ >= MP && nparts > 0) {
                    const f32x4* sl = (const f32x4*)((const float*)(p.ws + WS_SLAB) + (size_t)(crow_ - MP) * DM) + lane;
                    for (int q0 = 0; q0 < nparts; q0 += 4) {
                        f32x4 tsl[4][4];
#pragma unroll
                        for (int q = 0; q < 4; ++q)
#pragma unroll
                            for (int j = 0; j < 4; ++j) tsl[q][j] = sl[(size_t)(q0 + q) * (MS * DM / 4) + 64 * j];
#pragma unroll
                        for (int q = 0; q < 4; ++q)
#pragma unroll
                            for (int j = 0; j < 4; ++j) v[j] += tsl[q][j]; }
                    f32x4* xw = (f32x4*)(p.out + (size_t)crow_ * DM) + lane;
#pragma unroll
                    for (int j = 0; j < 4; ++j) xw[64 * j] = v[j];
                }
#pragma unroll
                for (int j = 0; j < 4; ++j) ss += (v[j].x * v[j].x + v[j].y * v[j].y) + (v[j].z * v[j].z + v[j].w * v[j].w);
                ss = wave_sum(ss);
                const float rstd = 1.f / sqrtf(ss * (1.f / DM) + EPS);
                u32x2* ho = (u32x2*)(H + (size_t)crow_ * DM) + lane;
#pragma unroll
                for (int j = 0; j < 4; ++j) { v[j] = v[j] * rstd * g4[j]; u32x2 w; w.x = pk2(v[j].x, v[j].y); w.y = pk2(v[j].z, v[j].w); ho[64 * j] = w; }
                if (MODE != 2) {
                    float acc[8];
#pragma unroll
                    for (int c = 0; c < 8; ++c) acc[c] = 0.f;
#pragma unroll
                    for (int j = 0; j < 4; ++j)
#pragma unroll
                        for (int e = 0; e < 4; ++e) { const float hv = v[j][e]; const float* wp = Wsm + ((j * 4 + e) * 64 + lane) * 8;
                            const f32x4 w0 = *(const f32x4*)wp, w1 = *(const f32x4*)(wp + 4);
#pragma unroll
                            for (int c = 0; c < 4; ++c) { acc[c] = fmaf(hv, w0[c], acc[c]); acc[4 + c] = fmaf(hv, w1[c], acc[4 + c]); } }
#pragma unroll
                    for (int c = 0; c < 8; ++c) acc[c] = wave_sum(acc[c]);
                    if (MODE == 0) { if (lane == 0) { float* d = (float*)(p.ws + WS_AB) + (size_t)crow_ * 8;
                            *(f32x4*)d = (f32x4){acc[0], acc[1], acc[2], acc[3]}; *(f32x4*)(d + 4) = (f32x4){acc[4], acc[5], acc[6], acc[7]}; } }
                    else {
                        const int c8 = lane & 7;
                        float xs = acc[0];
#pragma unroll
                        for (int c = 1; c < 8; ++c) xs = (c8 == c) ? acc[c] : xs;
                        const float x = xs + p.in[18][i * 8 + c8];
                        const float lf = fminf(x, 0.f) - log1pf(expf(-fabsf(x)));
                        float* d = crow_ < MP ? p.out + OFF_PLF + ((size_t)i * MP + crow_) * 8 : p.out + OFF_SLF + ((size_t)i * MS + (crow_ - MP)) * 8;
                        if (lane < 8) d[lane] = lf; }
                }
            }
        }
    }
}

__device__ __forceinline__ void phase_fixup(CParams& p, int nparts) {
    const int tid = otid(), lane = tid & 63, wid = tid >> 6;
    if (nparts <= 0) return;
    for (int row = MP + blockIdx.x * 8 + wid; row < MT; row += gridDim.x * 8) {
        f32x4* xw = (f32x4*)(p.out + (size_t)row * DM) + lane;
        const f32x4* sl = (const f32x4*)((const float*)(p.ws + WS_SLAB) + (size_t)(row - MP) * DM) + lane;
        f32x4 v[4];
#pragma unroll
        for (int j = 0; j < 4; ++j) v[j] = xw[64 * j];
        for (int q0 = 0; q0 < nparts; q0 += 4) {
            f32x4 tsl[4][4];
#pragma unroll
            for (int q = 0; q < 4; ++q)
#pragma unroll
                for (int j = 0; j < 4; ++j) tsl[q][j] = sl[(size_t)(q0 + q) * (MS * DM / 4) + 64 * j];
#pragma unroll
            for (int q = 0; q < 4; ++q)
#pragma unroll
                for (int j = 0; j < 4; ++j) v[j] += tsl[q][j]; }
#pragma unroll
        for (int j = 0; j < 4; ++j) xw[64 * j] = v[j];
    }
}

__device__ __forceinline__ void phase_gdn_prep(CParams& p, int i, unsigned char* shm) {
    const int tid = otid(), lane = tid & 63, wid = tid >> 6;
    const int half = wid >> 2, w4 = wid & 3;
    const bf16_t* P = (const bf16_t*)(p.ws + WS_BIG);
    const float* AB = (const float*)(p.ws + WS_AB);
    const float* convw = p.in[11] + (size_t)i * 4 * 1536;
    unsigned char* hb = shm + half * 78336;
    bf16_t* qs = (bf16_t*)hb; bf16_t* ks = (bf16_t*)(hb + 17408); bf16_t* vs = (bf16_t*)(hb + 34816);
    float* As = (float*)(hb + 52224); float* Gs = (float*)(hb + 68608); float* Bs = Gs + 64;
    bf16_t* Ps = (bf16_t*)(hb + 69120);
    bf16_t* Wb = vs;
    bf16_t* NEGW = (bf16_t*)(p.ws + WS_NEGW); bf16_t* QG = (bf16_t*)(p.ws + WS_QG); bf16_t* KDT = (bf16_t*)(p.ws + WS_KDT);
    bf16_t* PM = (bf16_t*)(p.ws + WS_PM); bf16_t* UPRE = (bf16_t*)(p.ws + WS_UPRE); float* GC = (float*)(p.ws + WS_GC);
    for (int pr = blockIdx.x; pr < 576; pr += gridDim.x) {
        const int it = 2 * pr + half;
        int b, n, h, T0; bool sample;
        if (it < 1024) { b = it >> 8; n = (it >> 2) & 63; h = it & 3; T0 = b * 4096 + n * 64; sample = false; }
        else { const int j = it - 1024; b = j >> 2; h = j & 3; n = 0; T0 = MP + b * 64; sample = true; }
        const bool first = (n == 0), last = sample || (n == 63);
#ifndef PROBE_PREP_A
#define PROBE_PREP_A 1
#endif
#ifndef PROBE_PREP_D
#define PROBE_PREP_D 1
#endif
#pragma unroll 1
        for (int rr = 0; rr < 2 * PROBE_PREP_A; ++rr) {
            const int task = (otid() & 255) + 256 * (rr & 1);
            if (task < 384) {
                const int tseg = task / 48, cgi = task - tseg * 48, part = cgi >> 4, c8 = (cgi & 15) * 8, t0 = tseg * 8;
                const int col = part * 512 + h * 128 + c8;
                const bool edge = first && t0 == 0;
                u32x4 L[11];
#pragma unroll
                for (int k = 0; k < 11; ++k) { const int tt = t0 - 3 + k; const int rowc = (k < 3 && edge) ? T0 : T0 + tt; L[k] = *(const u32x4*)(P + (size_t)rowc * NE + col); }
                float w[4][8];
#pragma unroll
                for (int tap = 0; tap < 4; ++tap) { const float* wp = convw + tap * 1536 + col; const f32x4 w0 = *(const f32x4*)wp, w1 = *(const f32x4*)(wp + 4);
#pragma unroll
                    for (int e = 0; e < 4; ++e) { w[tap][e] = w0[e]; w[tap][4 + e] = w1[e]; } }
                bf16_t* dst0 = (part == 0 ? qs : (part == 1 ? ks : vs)) + t0 * 136 + c8;
                float xw[4][8];
#pragma unroll
                for (int k = 0; k < 11; ++k) {
                    float (&xv)[8] = xw[k & 3];
                    if (k < 3 && edge) {
                        if (sample) { const float* sp = p.in[6] + (((size_t)i * 32 + b) * 3 + k) * 1536 + col; const f32x4 a = *(const f32x4*)sp, c = *(const f32x4*)(sp + 4);
#pragma unroll
                            for (int e = 0; e < 4; ++e) { xv[e] = a[e]; xv[4 + e] = c[e]; } }
                        else {
#pragma unroll
                            for (int e = 0; e < 8; ++e) xv[e] = 0.f; }
                    } else unpack8(L[k], xv);
                    if (last && t0 == 56 && k >= 8) {
                        float* d = (sample ? p.out + OFF_SCONV + (((size_t)i * 32 + b) * 3 + (k - 8)) * 1536 : p.out + OFF_PCONV + (((size_t)i * 4 + b) * 3 + (k - 8)) * 1536) + col;
                        *(f32x4*)d = (f32x4){xv[0], xv[1], xv[2], xv[3]}; *(f32x4*)(d + 4) = (f32x4){xv[4], xv[5], xv[6], xv[7]}; }
                    if (k >= 3) {
                        const int j = k - 3; float y[8];
#pragma unroll
                        for (int e = 0; e < 8; ++e) y[e] = w[0][e] * xw[j & 3][e];
#pragma unroll
                        for (int tap = 1; tap < 4; ++tap)
#pragma unroll
                            for (int e = 0; e < 8; ++e) y[e] = fmaf(w[tap][e], xw[(j + tap) & 3][e], y[e]);
                        float ss = 0.f;
#pragma unroll
                        for (int e = 0; e < 8; ++e) { y[e] = silu_f(y[e]); ss = fmaf(y[e], y[e], ss); }
                        ss = grp16_sum(ss);
                        const float sc = part == 2 ? 1.f : __builtin_amdgcn_rsqf(ss + EPS) * (part == 0 ? 0.08838834764831845f : 1.f);
#pragma unroll
                        for (int e = 0; e < 8; ++e) y[e] *= sc;
                        *(u32x4*)(dst0 + j * 136) = pack8f(y); }
                }
            }
        }
        if (w4 == 0) {
            const float a = AB[(size_t)(T0 + lane) * 8 + h], bb = AB[(size_t)(T0 + lane) * 8 + 4 + h];
            const float x = a + p.in[13][i * 4 + h];
            const float sp = fmaxf(x, 0.f) + log1pf(expf(-fabsf(x)));
            float g = -expf(p.in[12][i * 4 + h]) * sp;
            g = wave_incl_scan(g, lane);
            Gs[lane] = g; Bs[lane] = 1.f / (1.f + expf(-bb));
        }
        LBAR();
        {
            const int type = w4 >> 1, bi = w4 & 1; const int ln_ = otid() & 63, r32 = ln_ & 31, hi = ln_ >> 5;
            const bf16_t* Xs = type ? qs : ks;
#pragma unroll 1
            for (int bj = 0; bj < 2; ++bj) {
                f32x16 acc = {};
#pragma unroll
                for (int kk = 0; kk < 8; ++kk) {
                    const bf16x8 a = *(const bf16x8*)(Xs + (32 * bi + r32) * 136 + kk * 16 + hi * 8);
                    const bf16x8 bq = *(const bf16x8*)(ks + (32 * bj + r32) * 136 + kk * 16 + hi * 8);
                    acc = __builtin_amdgcn_mfma_f32_32x32x16_bf16(a, bq, acc, 0, 0, 0);
                }
                const int j = 32 * bj + r32; const float Gj = Gs[j];
#pragma unroll
                for (int r = 0; r < 16; ++r) { const int ii = 32 * bi + crow32(r, hi); const float d = __expf(fminf(Gs[ii] - Gj, 0.f));
                    if (type == 0) As[ii * 64 + j] = (ii > j) ? acc[r] * Bs[ii] * d : 0.f;
                    else Ps[ii * 72 + pos16(j)] = f2bf((ii >= j) ? acc[r] * d : 0.f); }
            }
        }
        LBAR();
        if (w4 < 2) {
            typedef float f32x2_t __attribute__((ext_vector_type(2)));
            const int c = otid() & 127; f32x2_t sol[64];
#pragma unroll 1
            for (int rep_ = 0; rep_ < PROBE_PREP_D; ++rep_) {
#pragma unroll
            for (int r = 0; r < 64; ++r) { const float br = Bs[r]; sol[r] = (f32x2_t){bf2f(vs[r * 136 + c]) * br, bf2f(ks[r * 136 + c]) * br * __expf(Gs[r])}; }
#pragma unroll
            for (int r = 1; r < 64; ++r) { f32x2_t a = sol[r];
#pragma unroll
                for (int j = 0; j < r; ++j) { const float m = -As[r * 64 + j]; a = __builtin_elementwise_fma((f32x2_t){m, m}, sol[j], a); }
                sol[r] = a; }
            }
            { const int sl = c >> 5, cc = c & 31;
#pragma unroll
              for (int mb = 0; mb < 2; ++mb)
#pragma unroll
                  for (int rg = 0; rg < 2; ++rg)
#pragma unroll
                      for (int hh = 0; hh < 2; ++hh) { const int tb = 32 * mb + 16 * rg + 4 * hh;
                          u32x4 w = {pk2(sol[tb].x, sol[tb + 1].x), pk2(sol[tb + 2].x, sol[tb + 3].x), pk2(sol[tb + 8].x, sol[tb + 9].x), pk2(sol[tb + 10].x, sol[tb + 11].x)};
                          *(u32x4*)(UPRE + ((((size_t)it * 4 + sl) * 2 + mb) * 2 + rg) * 512 + (cc + 32 * hh) * 8) = w; } }
            LBAR();
            { const int pp = pos16(c);
#pragma unroll
              for (int r = 0; r < 64; ++r) Wb[r * 136 + pp] = f2bf(-sol[r].y); }
        } else {
            const int t2 = otid() & 127; const float GL = Gs[63];
#pragma unroll 2
            for (int r = 0; r < 8; ++r) { const int ch = t2 + 128 * r, row = ch >> 4, pc = ch & 15, dk0 = 16 * (pc >> 1) + 4 * (pc & 1);
                const float eg = __expf(Gs[row]); const bf16_t* s_ = qs + row * 136 + dk0; float v[8];
#pragma unroll
                for (int e = 0; e < 4; ++e) { v[e] = bf2f(s_[e]) * eg; v[4 + e] = bf2f(s_[8 + e]) * eg; }
                *(u32x4*)(QG + (size_t)it * 8192 + row * 128 + pc * 8) = pack8f(v); }
#pragma unroll 2
            for (int r = 0; r < 8; ++r) { const int ch = t2 + 128 * r, dk = ch & 127, pc = ch >> 7, t0 = 16 * (pc >> 1) + 4 * (pc & 1); float v[8];
#pragma unroll
                for (int e = 0; e < 8; ++e) { const int te = t0 + (e & 3) + 8 * (e >> 2); v[e] = bf2f(ks[te * 136 + dk]) * __expf(GL - Gs[te]); }
                *(u32x4*)(KDT + (size_t)it * 8192 + dk * 64 + pc * 8) = pack8f(v); }
            if (t2 == 0) GC[it] = __expf(GL);
#pragma unroll
            for (int r = 0; r < 4; ++r) { const int ch = t2 + 128 * r, row = ch >> 3, cc = ch & 7;
                *(u32x4*)(PM + (size_t)it * 4096 + row * 64 + cc * 8) = *(const u32x4*)(Ps + row * 72 + cc * 8); }
            LBAR();
        }
        LBAR();
        { const int t4 = otid() & 255;
#pragma unroll
          for (int r = 0; r < 4; ++r) { const int ch = t4 + 256 * r, row = ch >> 4, cc = ch & 15;
              *(u32x4*)(NEGW + (size_t)it * 8192 + row * 128 + cc * 8) = *(const u32x4*)(Wb + row * 136 + cc * 8); } }
        LBAR();
    }
}

constexpr int SC_NW = 0, SC_QG = 17408, SC_KD = 34816, SC_PM = 53248, SC_UP = 62464, SC_GC = 66560, SC_BUF = 66816, SC_OB = 2 * SC_BUF, SC_OBSZ = 64 * 80;
static_assert(SC_OB + 2 * SC_OBSZ <= LDS_BYTES - 16, "scan LDS");
__device__ __forceinline__ void phase_gdn_scan(CParams& p, int i, unsigned char* shm) {
    const int tid = otid(), lane = tid & 63, wid = tid >> 6, r32 = lane & 31, hi = lane >> 5;
    const u32x4* NEGW = (const u32x4*)(p.ws + WS_NEGW); const u32x4* QG = (const u32x4*)(p.ws + WS_QG); const u32x4* KDT = (const u32x4*)(p.ws + WS_KDT);
    const u32x4* PM = (const u32x4*)(p.ws + WS_PM); const u32x4* UPRE = (const u32x4*)(p.ws + WS_UPRE); const float* GC = (const float*)(p.ws + WS_GC);
    bf16_t* OG = (bf16_t*)(p.ws + WS_OG);
    const int nb = gridDim.x, bid = blockIdx.x;
    for (int it = bid; it < 576; it = (nb > 64 ? (it < 64 ? 576 : it + (nb - 64)) : it + nb)) {
        int b, h, sl, nsteps, ch0, chs, T0; bool sample;
        if (it < 64) { b = it >> 4; h = (it >> 2) & 3; sl = it & 3; nsteps = 64; ch0 = b * 256 + h; chs = 4; T0 = b * 4096; sample = false; }
        else { const int j = it - 64; b = j >> 4; h = (j >> 2) & 3; sl = j & 3; nsteps = 1; ch0 = 1024 + (j >> 2); chs = 0; T0 = MP + b * 64; sample = true; }
        if (wid >= 4) {
            const int t2 = tid - 256; u32x4 st[15]; float stg = 0.f;
#define SC_LOAD(chv) do { const size_t ch_ = (size_t)(chv); \
                _Pragma("unroll") for (int r = 0; r < 4; ++r) st[r] = NEGW[ch_ * 1024 + t2 + 256 * r]; \
                _Pragma("unroll") for (int r = 0; r < 4; ++r) st[4 + r] = QG[ch_ * 1024 + t2 + 256 * r]; \
                _Pragma("unroll") for (int r = 0; r < 4; ++r) st[8 + r] = KDT[ch_ * 1024 + t2 + 256 * r]; \
                _Pragma("unroll") for (int r = 0; r < 2; ++r) st[12 + r] = PM[ch_ * 512 + t2 + 256 * r]; \
                st[14] = UPRE[(ch_ * 4 + sl) * 256 + t2]; if (t2 == 0) stg = GC[ch_]; } while (0)
#define SC_WRITE(bufi) do { unsigned char* base = shm + (bufi) * SC_BUF; \
                _Pragma("unroll") for (int r = 0; r < 4; ++r) { const int q = t2 + 256 * r; *(u32x4*)(base + SC_NW + (q >> 4) * 272 + (q & 15) * 16) = st[r]; } \
                _Pragma("unroll") for (int r = 0; r < 4; ++r) { const int q = t2 + 256 * r; *(u32x4*)(base + SC_QG + (q >> 4) * 272 + (q & 15) * 16) = st[4 + r]; } \
                _Pragma("unroll") for (int r = 0; r < 4; ++r) { const int q = t2 + 256 * r; *(u32x4*)(base + SC_KD + (q >> 3) * 144 + (q & 7) * 16) = st[8 + r]; } \
                _Pragma("unroll") for (int r = 0; r < 2; ++r) { const int q = t2 + 256 * r; *(u32x4*)(base + SC_PM + (q >> 3) * 144 + (q & 7) * 16) = st[12 + r]; } \
                *(u32x4*)(base + SC_UP + t2 * 16) = st[14]; if (t2 == 0) *(float*)(base + SC_GC) = stg; } while (0)
            SC_LOAD(ch0); SC_WRITE(0);
            if (nsteps > 1) SC_LOAD(ch0 + chs);
            LBAR();
            for (int s = 0; s < nsteps; ++s) {
                if (s + 1 < nsteps) { SC_WRITE((s + 1) & 1); if (s + 2 < nsteps) SC_LOAD(ch0 + (s + 2) * chs); }
                LBAR();
            }
#undef SC_LOAD
#undef SC_WRITE
        } else if (wid == 0) {
            f32x16 S[4];
            if (sample) { const float* s0 = p.in[5] + ((((size_t)i * 32 + b) * 4 + h) << 14) + 32 * sl + r32;
#pragma unroll
                for (int mb = 0; mb < 4; ++mb)
#pragma unroll
                    for (int r = 0; r < 16; ++r) S[mb][r] = s0[(32 * mb + crow32(r, hi)) * 128];
            } else {
#pragma unroll
                for (int mb = 0; mb < 4; ++mb)
#pragma unroll
                    for (int r = 0; r < 16; ++r) S[mb][r] = 0.f;
            }
            LBAR();
            for (int s = 0; s < nsteps; ++s) {
                const unsigned char* B0 = shm + (s & 1) * SC_BUF;
                f32x16 u[2], o[2];
#pragma unroll
                for (int mb = 0; mb < 2; ++mb)
#pragma unroll
                    for (int rg = 0; rg < 2; ++rg) { const u32x4 w = *(const u32x4*)(B0 + SC_UP + ((mb * 2 + rg) * 64 + lane) * 16);
#pragma unroll
                        for (int q = 0; q < 4; ++q) { u[mb][8 * rg + 2 * q] = __uint_as_float(w[q] << 16); u[mb][8 * rg + 2 * q + 1] = __uint_as_float(w[q] & 0xffff0000u); } }
                const float gc = *(const float*)(B0 + SC_GC);
                const unsigned char* lrow = B0 + r32 * 272 + hi * 16;
                const unsigned char* srow = B0 + r32 * 144 + hi * 16;
#define RD4(dst, base) do { _Pragma("unroll") for (int kk = 0; kk < 4; ++kk) dst[kk] = *(const bf16x8*)((base) + kk * 32); SBAR(); } while (0)
#define MM4(accv, fr, bop, o_) do { _Pragma("unroll") for (int kk = 0; kk < 4; ++kk) accv = __builtin_amdgcn_mfma_f32_32x32x16_bf16(fr[kk], bop[(o_) + kk], accv, 0, 0, 0); } while (0)
                bf16x8 fa[4], fb[4];
                RD4(fa, lrow + SC_NW); RD4(fb, lrow + SC_NW + 128);
                bf16x8 Sb[8];
#pragma unroll
                for (int kk = 0; kk < 8; ++kk) { const int mb = kk >> 1, hf = kk & 1;
                    u32x4 w = {pk2(S[mb][8 * hf], S[mb][8 * hf + 1]), pk2(S[mb][8 * hf + 2], S[mb][8 * hf + 3]), pk2(S[mb][8 * hf + 4], S[mb][8 * hf + 5]), pk2(S[mb][8 * hf + 6], S[mb][8 * hf + 7])};
                    Sb[kk] = *reinterpret_cast<bf16x8*>(&w); }
#pragma unroll
                for (int mb = 0; mb < 2; ++mb)
#pragma unroll
                    for (int r = 0; r < 16; ++r) o[mb][r] = 0.f;
                MM4(u[0], fa, Sb, 0); RD4(fa, lrow + SC_QG);
                MM4(u[0], fb, Sb, 4); RD4(fb, lrow + SC_QG + 128);
                MM4(o[0], fa, Sb, 0); RD4(fa, lrow + SC_NW + 32 * 272);
                MM4(o[0], fb, Sb, 4); RD4(fb, lrow + SC_NW + 32 * 272 + 128);
                MM4(u[1], fa, Sb, 0); RD4(fa, lrow + SC_QG + 32 * 272);
                MM4(u[1], fb, Sb, 4); RD4(fb, lrow + SC_QG + 32 * 272 + 128);
                MM4(o[1], fa, Sb, 0); RD4(fa, srow + SC_PM);
                MM4(o[1], fb, Sb, 4); RD4(fb, srow + SC_PM + 32 * 144);
                bf16x8 ub[4];
#pragma unroll
                for (int kk = 0; kk < 4; ++kk) { const int mb = kk >> 1, hf = kk & 1;
                    u32x4 w = {pk2(u[mb][8 * hf], u[mb][8 * hf + 1]), pk2(u[mb][8 * hf + 2], u[mb][8 * hf + 3]), pk2(u[mb][8 * hf + 4], u[mb][8 * hf + 5]), pk2(u[mb][8 * hf + 6], u[mb][8 * hf + 7])};
                    ub[kk] = *reinterpret_cast<bf16x8*>(&w); }
#pragma unroll
                for (int mb = 0; mb < 4; ++mb)
#pragma unroll
                    for (int r = 0; r < 16; ++r) S[mb][r] *= gc;
                MM4(o[0], fa, ub, 0); RD4(fa, srow + SC_KD);
                MM4(o[1], fb, ub, 0); RD4(fb, srow + SC_KD + 32 * 144);
                MM4(S[0], fa, ub, 0); RD4(fa, srow + SC_KD + 64 * 144);
                MM4(S[1], fb, ub, 0); RD4(fb, srow + SC_KD + 96 * 144);
                MM4(S[2], fa, ub, 0);
                MM4(S[3], fb, ub, 0);
#undef RD4
#undef MM4
                { unsigned char* ob = shm + SC_OB + (s & 1) * SC_OBSZ + r32 * 2;
#pragma unroll
                  for (int mb = 0; mb < 2; ++mb)
#pragma unroll
                      for (int r = 0; r < 16; ++r) *(bf16_t*)(ob + (32 * mb + crow32(r, hi)) * 80) = f2bf(o[mb][r]); }
                LBAR();
            }
            float* so = (sample ? p.out + OFF_SS + ((((size_t)i * 32 + b) * 4 + h) << 14) : p.out + OFF_PS + ((((size_t)i * 4 + b) * 4 + h) << 14)) + 32 * sl + r32;
#pragma unroll
            for (int mb = 0; mb < 4; ++mb)
#pragma unroll
                for (int r = 0; r < 16; ++r) so[(32 * mb + crow32(r, hi)) * 128] = S[mb][r];
        } else if (wid == 1) {
            LBAR();
            for (int s = 0; s <= nsteps; ++s) {
                if (s >= 1) { const unsigned char* ob = shm + SC_OB + ((s - 1) & 1) * SC_OBSZ;
#pragma unroll
                    for (int k = 0; k < 4; ++k) { const int q = lane + 64 * k, row = q >> 2, cc = q & 3;
                        *(u32x4*)(OG + (size_t)(T0 + 64 * (s - 1) + row) * 512 + h * 128 + 32 * sl + 8 * cc) = *(const u32x4*)(ob + row * 80 + cc * 16); } }
                if (s < nsteps) LBAR();
            }
        } else {
            LBAR();
            for (int s = 0; s < nsteps; ++s) LBAR();
        }
        LBAR();
    }
}

template <int PARTS>
__device__ __forceinline__ void phase_gdn_post(CParams& p, int i, int bid, int nb) {
    const int tid = otid(), lane = tid & 63, wid = tid >> 6;
    const bf16_t* P = (const bf16_t*)(p.ws + WS_BIG); const bf16_t* OG = (const bf16_t*)(p.ws + WS_OG); bf16_t* CAT = (bf16_t*)(p.ws + WS_CAT);
    float ng[8], w0[8], w1[8], w2[8];
    { const float* g = p.in[14] + i * 128 + ((8 * lane) & 127); const float* w = p.in[15] + (size_t)i * 3 * 512 + 8 * lane;
#pragma unroll
      for (int e = 0; e < 8; ++e) { ng[e] = g[e]; w0[e] = w[e]; w1[e] = w[512 + e]; w2[e] = w[1024 + e]; } }
    const int stride = nb * 8;
    for (int row0 = bid * 8 + wid; row0 < MT; row0 += 2 * stride) {
        u32x4 L[2][9]; int rows[2]; rows[0] = row0; rows[1] = row0 + stride < MT ? row0 + stride : row0;
#pragma unroll
        for (int q = 0; q < 2; ++q) { const int row = rows[q]; const bf16_t* pr = P + (size_t)row * NE + 8 * lane;
            const int t = row < MP ? (row & 4095) : ((row - MP) & 63);
            if (PARTS & 1) { L[q][0] = *(const u32x4*)(OG + (size_t)row * 512 + 8 * lane); L[q][1] = *(const u32x4*)(pr + 1536); }
            if (PARTS & 2) {
                L[q][2] = *(const u32x4*)(pr + 2048); L[q][3] = *(const u32x4*)(pr + 2560); L[q][4] = *(const u32x4*)(pr + 3072);
                const bf16_t* p1 = t >= 1 ? pr - NE : pr; const bf16_t* p2 = t >= 2 ? pr - 2 * NE : pr;
                L[q][5] = *(const u32x4*)(p1 + 2560); L[q][6] = *(const u32x4*)(p1 + 3072); L[q][7] = *(const u32x4*)(p2 + 2560); L[q][8] = *(const u32x4*)(p2 + 3072); } }
#pragma unroll
        for (int q = 0; q < 2; ++q) {
            const int row = rows[q];
            if (q == 1 && row0 + stride >= MT) break;
            if (PARTS & 1) { float ov[8], zv[8], r[8]; unpack8(L[q][0], ov); unpack8(L[q][1], zv);
              float ss = 0.f;
#pragma unroll
              for (int e = 0; e < 8; ++e) ss = fmaf(ov[e], ov[e], ss);
              ss = grp16_sum(ss);
              const float rms = 1.f / sqrtf(ss * (1.f / 128.f) + EPS);
#pragma unroll
              for (int e = 0; e < 8; ++e) r[e] = ov[e] * rms * ng[e] * silu_f(zv[e]);
              *(u32x4*)(CAT + (size_t)row * DM + 8 * lane) = pack8f(r); }
            if (PARTS & 2) {
            int b, t, T; bool sample;
            if (row < MP) { b = row >> 12; t = row & 4095; T = 4096; sample = false; } else { const int r2 = row - MP; b = r2 >> 6; t = r2 & 63; T = 64; sample = true; }
            float gb[8], gc[8], hn[8], u0[8], u1[8], u2[8], r[8];
            unpack8(L[q][2], gb); unpack8(L[q][3], gc); unpack8(L[q][4], hn);
#pragma unroll
            for (int e = 0; e < 8; ++e) u0[e] = gc[e] * hn[e];
            const float* st = p.in[7] + ((size_t)i * 32 + b) * 2 * 512 + 8 * lane;
            if (t >= 1) { unpack8(L[q][5], gc); unpack8(L[q][6], hn);
#pragma unroll
                for (int e = 0; e < 8; ++e) u1[e] = gc[e] * hn[e]; }
            else {
#pragma unroll
                for (int e = 0; e < 8; ++e) u1[e] = sample ? st[512 + e] : 0.f; }
            if (t >= 2) { unpack8(L[q][7], gc); unpack8(L[q][8], hn);
#pragma unroll
                for (int e = 0; e < 8; ++e) u2[e] = gc[e] * hn[e]; }
            else {
#pragma unroll
                for (int e = 0; e < 8; ++e) u2[e] = sample ? st[t * 512 + e] : 0.f; }
#pragma unroll
            for (int e = 0; e < 8; ++e) r[e] = gb[e] * (w0[e] * u2[e] + w1[e] * u1[e] + w2[e] * u0[e]);
            *(u32x4*)(CAT + (size_t)row * DM + 512 + 8 * lane) = pack8f(r);
            if (t >= T - 2) { float* d = (sample ? p.out + OFF_SSC + (((size_t)i * 32 + b) * 2 + (t - (T - 2))) * 512 : p.out + OFF_PSC + (((size_t)i * 4 + b) * 2 + (t - (T - 2))) * 512) + 8 * lane;
                *(f32x4*)d = (f32x4){u0[0], u0[1], u0[2], u0[3]}; *(f32x4*)(d + 4) = (f32x4){u0[4], u0[5], u0[6], u0[7]}; }
            }
        }
    }
}

__device__ __forceinline__ void phase_fox_prep(CParams& p, int i) {
    const int tid = otid(), lane = tid & 63, wid = tid >> 6;
    const bf16_t* R = (const bf16_t*)(p.ws + WS_BIG);
    bf16_t* QP = (bf16_t*)(p.ws + WS_QP); bf16_t* KP = (bf16_t*)(p.ws + WS_KP); bf16_t* VP = (bf16_t*)(p.ws + WS_VP);
    bf16_t* QS = (bf16_t*)(p.ws + WS_QS); bf16_t* KS = (bf16_t*)(p.ws + WS_KS); bf16_t* VS = (bf16_t*)(p.ws + WS_VS);
    for (int task = blockIdx.x + gridDim.x * wid; task < 288; task += gridDim.x * 8) {
        const float* src0; const float* src1; int len, n0; float* dst;
        if (task < 32) { const int bb = task >> 3, hh = task & 7; src0 = p.out + OFF_PLF + ((size_t)i * MP + (size_t)bb * 4096) * 8 + hh; src1 = src0; len = 4096; n0 = 4096; dst = (float*)(p.ws + WS_NCP) + task * 4096; }
        else { const int j = task - 32, bb = j >> 3, hh = j & 7; src0 = p.in[4] + ((size_t)i * 32 + bb) * 1024 * 8 + hh; src1 = p.out + OFF_SLF + ((size_t)i * MS + (size_t)bb * 64) * 8 + hh - (size_t)1024 * 8; len = 1088; n0 = 1024; dst = (float*)(p.ws + WS_NCS) + j * 1088; }
        float carry = 0.f;
        for (int s0 = 0; s0 < len; s0 += 512) {
            float v[8];
#pragma unroll
            for (int q = 0; q < 8; ++q) { const int s = s0 + 64 * q + lane; v[q] = s < len ? (s < n0 ? src0[(size_t)s * 8] : src1[(size_t)s * 8]) : 0.f; }
#pragma unroll
            for (int q = 0; q < 8; ++q) { const int s = s0 + 64 * q + lane; float x = wave_incl_scan(v[q], lane) + carry;
                if (s < len) dst[s] = -x * 11.313708498984761f;
                carry = __shfl(x, 63); }
        }
    }
    float qg[8], kg[8];
    { const float* a = p.in[19] + i * 128 + ((8 * lane) & 127); const float* c = p.in[20] + i * 128 + ((8 * lane) & 127);
#pragma unroll
      for (int e = 0; e < 8; ++e) { qg[e] = a[e]; kg[e] = c[e]; } }
    const int stride = gridDim.x * 8;
    for (int row0 = blockIdx.x * 8 + wid; row0 < MT; row0 += 2 * stride) {
        u32x4 L[2][6]; int rows[2]; rows[0] = row0; rows[1] = row0 + stride < MT ? row0 + stride : row0;
#pragma unroll
        for (int q = 0; q < 2; ++q) { const bf16_t* rr = R + (size_t)rows[q] * NO + 8 * lane;
#pragma unroll
            for (int hf = 0; hf < 2; ++hf) { L[q][hf * 3] = *(const u32x4*)(rr + hf * 512); L[q][hf * 3 + 1] = *(const u32x4*)(rr + 1024 + hf * 512); L[q][hf * 3 + 2] = *(const u32x4*)(rr + 2048 + hf * 512); } }
#pragma unroll
        for (int q = 0; q < 2; ++q) {
            const int row = rows[q];
            if (q == 1 && row0 + stride >= MT) break;
            float* fK; float* fV; size_t qbase, kbase; int qstr, kstr; bf16_t* Qd; bf16_t* Kd; bf16_t* Vd;
            if (row < MP) { const int bb = row >> 12, s_ = row & 4095; fK = p.out + OFF_PK + ((size_t)i * MP + row) * 1024; fV = p.out + OFF_PV + ((size_t)i * MP + row) * 1024;
                Qd = QP; Kd = KP; Vd = VP; qstr = 4096; kstr = 4096; qbase = (size_t)bb * 8 * 4096 + s_; kbase = qbase; }
            else { const int r2 = row - MP, bb = r2 >> 6, s_ = r2 & 63; fK = p.out + OFF_SK + ((size_t)i * MS + r2) * 1024; fV = p.out + OFF_SV + ((size_t)i * MS + r2) * 1024;
                Qd = nullptr; Kd = nullptr; Vd = nullptr; qstr = 64; kstr = 0; qbase = (size_t)bb * 8 * 64 + s_; kbase = 0; }
            const bool smp = row >= MP;
#pragma unroll
            for (int hf = 0; hf < 2; ++hf) {
                const int col = hf * 512 + 8 * lane, hh = col >> 7, d = col & 127;
                float x[8], r[8]; float ss;
                unpack8(L[q][hf * 3], x); ss = 0.f;
#pragma unroll
                for (int e = 0; e < 8; ++e) ss = fmaf(x[e], x[e], ss);
                ss = grp16_sum(ss); { const float rms = 1.f / sqrtf(ss * (1.f / 128.f) + EPS);
#pragma unroll
                  for (int e = 0; e < 8; ++e) r[e] = x[e] * rms * qg[e]; }
                if (smp) { float* qd = (float*)(p.ws + WS_KS) + (qbase + (size_t)hh * qstr) * 128 + d;
                    *(f32x4*)qd = (f32x4){r[0], r[1], r[2], r[3]}; *(f32x4*)(qd + 4) = (f32x4){r[4], r[5], r[6], r[7]}; }
                else *(u32x4*)(Qd + (qbase + (size_t)hh * qstr) * 128 + d) = pack8f(r);
                unpack8(L[q][hf * 3 + 1], x); ss = 0.f;
#pragma unroll
                for (int e = 0; e < 8; ++e) ss = fmaf(x[e], x[e], ss);
                ss = grp16_sum(ss); { const float rms = 1.f / sqrtf(ss * (1.f / 128.f) + EPS);
#pragma unroll
                  for (int e = 0; e < 8; ++e) r[e] = x[e] * rms * kg[e]; }
                *(f32x4*)(fK + col) = (f32x4){r[0], r[1], r[2], r[3]}; *(f32x4*)(fK + col + 4) = (f32x4){r[4], r[5], r[6], r[7]};
                if (!smp) *(u32x4*)(Kd + (kbase + (size_t)hh * kstr) * 128 + d) = pack8f(r);
                const u32x4 vw = L[q][hf * 3 + 2]; unpack8(vw, x);
                *(f32x4*)(fV + col) = (f32x4){x[0], x[1], x[2], x[3]}; *(f32x4*)(fV + col + 4) = (f32x4){x[4], x[5], x[6], x[7]};
                if (!smp) *(u32x4*)(Vd + (kbase + (size_t)hh * kstr) * 128 + d) = vw;
            }
        }
    }
}

typedef fa::BlockRef<bf16_t, bf16_t> FaRef;
typedef fa::BlockRef<float, bf16_t> FaRefS;
__device__ __forceinline__ FaRef fox_ref(CParams& p, int g, int k) {
    FaRef r;
    const int xcd = g & 7, j = g >> 3, bh = 4 * xcd + (j >> 3), x = j & 7, bb = bh >> 3, hh = bh & 7, blk = k ? 15 - x : x;
    r.Q = (const bf16_t*)(p.ws + WS_QP) + ((size_t)bh * 4096 + 256 * blk) * 128; r.K = (const bf16_t*)(p.ws + WS_KP) + (size_t)bh * 4096 * 128; r.V = (const bf16_t*)(p.ws + WS_VP) + (size_t)bh * 4096 * 128;
    r.K2 = r.K; r.V2 = r.V;
    r.O = (bf16_t*)(p.ws + WS_CAT) + ((size_t)bb * 4096 + 256 * blk) * 1024 + hh * 128; r.NC = (const float*)(p.ws + WS_NCP) + (size_t)bh * 4096; r.P0 = 256 * blk; r.nrows = 256;
    return r;
}
__device__ __forceinline__ FaRefS fox_ref_s(CParams& p, int i, int g) {
    FaRefS r; const int bh = g, bb = g >> 3, hh = g & 7;
    r.Q = (const float*)(p.ws + WS_KS) + (size_t)bh * 64 * 128;
    r.K = p.in[2] + ((size_t)i * 32 + bb) * 1024 * 1024 + hh * 128; r.V = p.in[3] + ((size_t)i * 32 + bb) * 1024 * 1024 + hh * 128;
    r.K2 = p.out + OFF_SK + ((size_t)i * MS + bb * 64) * 1024 + hh * 128 - (size_t)1024 * 1024; r.V2 = p.out + OFF_SV + ((size_t)i * MS + bb * 64) * 1024 + hh * 128 - (size_t)1024 * 1024;
    r.O = (bf16_t*)(p.ws + WS_CAT) + ((size_t)MP + bb * 64) * 1024 + hh * 128; r.NC = (const float*)(p.ws + WS_NCS) + (size_t)bh * 1088; r.P0 = 1024; r.nrows = 64;
    return r;
}
__device__ __forceinline__ void phase_fox_attn(CParams& p, int i, unsigned char* shm) {
    constexpr int W = 1 << 20;
    for (int g = blockIdx.x; g < 256; g += gridDim.x) {
#pragma unroll 1
        for (int k = 0; k < 2; ++k) {
            int kk = k; asm volatile("" : "+s"(kk));
            fa::Seam<bf16_t> S;
            const FaRef cur = fox_ref(p, g, kk);
            fa::causal_swa_prime<bf16_t, bf16_t>(cur, W, (char*)shm, S);
            fa::causal_swa_block<bf16_t, bf16_t>(cur, cur, 4096, W, (char*)shm, S);
        }
        { fa::Seam<float> S;
          const FaRefS cur = fox_ref_s(p, i, g);
          fa::causal_swa_prime<float, bf16_t>(cur, W, (char*)shm, S);
          fa::causal_swa_block<float, bf16_t>(cur, cur, 1088, W, (char*)shm, S); }
    }
}

__device__ __forceinline__ CParams* kparams() {
    CParams* k = (CParams*)__builtin_amdgcn_kernarg_segment_ptr(); asm volatile("" : "+s"(k)); return k;
}
__global__ __launch_bounds__(512, 2) void mega_fwd(Params p_unused) {
    extern __shared__ __attribute__((aligned(16))) unsigned char shm[];
    cg::grid_group grid = cg::this_grid();
    PG8_LAS unsigned char* lds = (PG8_LAS unsigned char*)shm;
    int ph = 0;
#ifndef PROBE_REP
#define PROBE_REP 0
#endif
#define GSYNC() do { XcdBarrier xb_; xb_.bar = (unsigned*)(kparams()->ws + WS_BAR); xb_.x = xb_xcc_id(); xb_.st = (volatile XB_LAS unsigned*)(lds + LDS_XB); xcd_barrier(xb_); } while (0)
#if PROBE_REP
#define PHASE(kind, ...) do { CParams& p = *kparams(); if (ph >= p.ph_lo && ph < p.ph_hi) { int nrep = 1 + ((PROBE_REP >> (kind)) & 1); asm volatile("" : "+s"(nrep)); \
        for (int rep = 0; rep < nrep; ++rep) { __VA_ARGS__; if (rep + 1 < nrep || ph + 1 < p.ph_hi) GSYNC(); } } ++ph; } while (0)
#else
#define PHASE(kind, ...) do { CParams& p = *kparams(); if (ph >= p.ph_lo && ph < p.ph_hi) { __VA_ARGS__; if (ph + 1 < p.ph_hi) GSYNC(); } ++ph; } while (0)
#endif
    if (otid() == 0) { *(volatile XB_LAS unsigned*)(lds + LDS_XB) = 0u; *(volatile XB_LAS unsigned*)(lds + LDS_XB + 4) = 0u; }
    __syncthreads();
    (void)xcd_barrier_post((unsigned*)(kparams()->ws + WS_BAR), (volatile XB_LAS unsigned*)(lds + LDS_XB));
    if (kparams()->ph_hi - kparams()->ph_lo > 1) grid.sync();
    PHASE(0, phase_init(p, shm));
#pragma unroll 1
    for (int layer = 0; layer < 4; ++layer) {
        const int i = layer >> 1; const bool even = (layer & 1) == 0;
        if (even) PHASE(1, phase_norm<0>(p, layer, shm, layer ? tail_parts(DFF, (int)gridDim.x) : 0)); else PHASE(1, phase_norm<1>(p, layer, shm, tail_parts(DFF, (int)gridDim.x)));
        PHASE(2, const bf16_t* Bt = even ? (const bf16_t*)(p.ws + WS_WINE) + (size_t)i * NE * DM : (const bf16_t*)(p.ws + WS_WINO) + (size_t)i * NO * DM;
              EpiBf16Plain E; E.O = (bf16_t*)(p.ws + WS_BIG); E.ldc = even ? NE : NO;
              run_gemm(lds, (const bf16_t*)(p.ws + WS_H), Bt, even ? NE : NO, DM, E));
        if (even) { PHASE(3, phase_gdn_prep(p, i, shm));
                    PHASE(4, phase_gdn_scan(p, i, shm); __syncthreads();
                             if (gridDim.x > 64) { if (blockIdx.x >= 64) { if (layer == 0) convert_weights(p, shm, 1, 4, (int)blockIdx.x - 64, (int)gridDim.x - 64);
                                                                           phase_gdn_post<2>(p, i, (int)blockIdx.x - 64, (int)gridDim.x - 64); } }
                             else { if (layer == 0) convert_weights(p, shm, 1, 4, (int)blockIdx.x, (int)gridDim.x); phase_gdn_post<2>(p, i, (int)blockIdx.x, (int)gridDim.x); });
                    PHASE(5, phase_gdn_post<1>(p, i, (int)blockIdx.x, (int)gridDim.x)); }
        else { PHASE(6, phase_fox_prep(p, i)); PHASE(7, phase_fox_attn(p, i, shm)); }
        PHASE(31, const bf16_t* Bt = even ? (const bf16_t*)(p.ws + WS_WOUTE) + (size_t)i * DM * DM : (const bf16_t*)(p.ws + WS_WOUTO) + (size_t)i * DM * DM;
              EpiResid E; E.X = p.out; E.ldc = DM; E.slab = (float*)(p.ws + WS_SLAB);
              run_gemm_n1024(lds, (const bf16_t*)(p.ws + WS_CAT), Bt, DM, E));
        PHASE(1, phase_norm<2>(p, layer, shm, tail_parts(DM, (int)gridDim.x)));
        PHASE(9, EpiSwiglu E; E.O = (bf16_t*)(p.ws + WS_BIG); E.ldc = DFF;
              run_gemm(lds, (const bf16_t*)(p.ws + WS_H), (const bf16_t*)(p.ws + WS_WF1) + (size_t)layer * NF1 * DM, NF1, DM, E));
        PHASE(31, EpiResid E; E.X = p.out; E.ldc = DM; E.slab = (float*)(p.ws + WS_SLAB);
              run_gemm_n1024(lds, (const bf16_t*)(p.ws + WS_BIG), (const bf16_t*)(p.ws + WS_WF2) + (size_t)layer * DM * DFF, DFF, E));
    }
    PHASE(1, phase_fixup(p, tail_parts(DFF, (int)gridDim.x)));
#undef PHASE
}
constexpr int N_PHASES = 1 + 2 * 9 + 2 * 8 + 1;

#ifndef MK_PER_PHASE
#define MK_PER_PHASE 0
#endif
extern "C" void kernel_launch(void* const* d_in, const int* in_sizes, int n_in, void* d_out, int out_size, void* d_ws, size_t ws_size, hipStream_t stream) {
    static int grid = 0;
    if (grid == 0) {
        if (n_in != 25 || (size_t)out_size != OUT_TOTAL || ws_size < WS_END) { fprintf(stderr, "kernel_launch: unexpected shapes (n_in %d, out %d, ws %zu < %zu)\n", n_in, out_size, ws_size, (size_t)WS_END); grid = -1; return; }
        int dev = 0, cus = 0, per_cu = 0;
        (void)hipGetDevice(&dev); (void)hipDeviceGetAttribute(&cus, hipDeviceAttributeMultiprocessorCount, dev);
        if (hipFuncSetAttribute((const void*)mega_fwd, hipFuncAttributeMaxDynamicSharedMemorySize, LDS_BYTES) != hipSuccess) { fprintf(stderr, "kernel_launch: hipFuncSetAttribute failed\n"); grid = -1; return; }
        if (hipOccupancyMaxActiveBlocksPerMultiprocessor(&per_cu, (const void*)mega_fwd, 512, LDS_BYTES) != hipSuccess || per_cu < 1) { fprintf(stderr, "kernel_launch: occupancy query says %d\n", per_cu); per_cu = 1; }
        (void)hipGetLastError();
        if (cus <= 0) cus = 256;
        grid = cus * 1;
    }
    if (grid < 0) return;
    (void)hipMemsetAsync((unsigned char*)d_ws + WS_BAR, 0, 16384, stream);
    Params p{};
    for (int k = 0; k < 25; ++k) p.in[k] = (const float*)d_in[k];
    p.out = (float*)d_out; p.ws = (unsigned char*)d_ws;
#if MK_PER_PHASE
    for (int ph = 0; ph < N_PHASES; ++ph) { p.ph_lo = ph; p.ph_hi = ph + 1; hipLaunchKernelGGL(mega_fwd, dim3(grid), dim3(512), LDS_BYTES, stream, p); }
#else
    p.ph_lo = 0; p.ph_hi = N_PHASES;
    void* args[] = {&p};
    hipError_t e = hipLaunchCooperativeKernel((const void*)mega_fwd, dim3(grid), dim3(512), args, LDS_BYTES, stream);
    if (e != hipSuccess) fprintf(stderr, "kernel_launch: cooperative launch failed: %s (grid %d)\n", hipGetErrorString(e), grid);
#endif
}
```

```cpp
#include <hip/hip_runtime.h>
#include <hip/hip_cooperative_groups.h>
#include <cstdio>
#include <cstdint>
namespace cg = cooperative_groups;

typedef unsigned short bf16_t;
typedef short bf16x8 __attribute__((ext_vector_type(8)));
typedef short s16x4 __attribute__((ext_vector_type(4)));
typedef float f32x16 __attribute__((ext_vector_type(16)));
typedef float f32x4 __attribute__((ext_vector_type(4)));
typedef unsigned u32x4 __attribute__((ext_vector_type(4)));
typedef unsigned u32x2 __attribute__((ext_vector_type(2)));

constexpr int DM = 1024, MP = 16384, MS = 2048, MT = MP + MS;
constexpr int EVEN_IN = 3592, ODD_IN = 3080, NE = 3584, NO = 3072, DFF = 2816, NF1 = 2 * DFF;
constexpr float EPS = 1e-6f;
constexpr size_t OFF_Y = 0;
constexpr size_t OFF_PK = (size_t)MT * DM;
constexpr size_t OFF_PV = OFF_PK + (size_t)2 * MP * 1024;
constexpr size_t OFF_PLF = OFF_PV + (size_t)2 * MP * 1024;
constexpr size_t OFF_PS = OFF_PLF + (size_t)2 * MP * 8;
constexpr size_t OFF_PCONV = OFF_PS + (size_t)2 * 4 * 4 * 128 * 128;
constexpr size_t OFF_PSC = OFF_PCONV + (size_t)2 * 4 * 3 * 1536;
constexpr size_t OFF_SK = OFF_PSC + (size_t)2 * 4 * 2 * 512;
constexpr size_t OFF_SV = OFF_SK + (size_t)2 * MS * 1024;
constexpr size_t OFF_SLF = OFF_SV + (size_t)2 * MS * 1024;
constexpr size_t OFF_SS = OFF_SLF + (size_t)2 * MS * 8;
constexpr size_t OFF_SCONV = OFF_SS + (size_t)2 * 32 * 4 * 128 * 128;
constexpr size_t OFF_SSC = OFF_SCONV + (size_t)2 * 32 * 3 * 1536;
constexpr size_t OUT_TOTAL = OFF_SSC + (size_t)2 * 32 * 2 * 512;
static_assert(OUT_TOTAL == 99790848, "output size");
constexpr size_t WS_WINE = 0;
constexpr size_t WS_WOUTE = WS_WINE + (size_t)2 * NE * DM * 2;
constexpr size_t WS_WINO = WS_WOUTE + (size_t)2 * DM * DM * 2;
constexpr size_t WS_WOUTO = WS_WINO + (size_t)2 * NO * DM * 2;
constexpr size_t WS_WF1 = WS_WOUTO + (size_t)2 * DM * DM * 2;
constexpr size_t WS_WF2 = WS_WF1 + (size_t)4 * NF1 * DM * 2;
constexpr size_t WS_H = WS_WF2 + (size_t)4 * DM * DFF * 2;
constexpr size_t WS_BIG = WS_H + (size_t)MT * DM * 2;
constexpr size_t WS_CAT = WS_BIG + (size_t)MT * NE * 2;
constexpr size_t WS_AB = WS_CAT + (size_t)MT * DM * 2;
constexpr size_t WS_OG = WS_AB + (size_t)MT * 8 * 4;
constexpr size_t WS_GC = WS_OG + (size_t)MT * 512 * 2;
constexpr size_t WS_NEGW = WS_GC + 8192;
constexpr size_t WS_QG = WS_NEGW + (size_t)1152 * 16384;
constexpr size_t WS_KDT = WS_QG + (size_t)1152 * 16384;
constexpr size_t WS_PM = WS_KDT + (size_t)1152 * 16384;
constexpr size_t WS_UPRE = WS_PM + (size_t)1152 * 8192;
constexpr size_t WS_QP = WS_UPRE + (size_t)1152 * 16384;
constexpr size_t WS_KP = WS_QP + (size_t)32 * 4096 * 128 * 2;
constexpr size_t WS_VP = WS_KP + (size_t)32 * 4096 * 128 * 2;
constexpr size_t WS_QS = WS_VP + (size_t)32 * 4096 * 128 * 2;
constexpr size_t WS_KS = WS_QS + (size_t)256 * 64 * 128 * 2 + 65536;
constexpr size_t WS_VS = WS_KS + (size_t)256 * 1088 * 128 * 2;
constexpr size_t WS_NCP = WS_VS + (size_t)256 * 1088 * 128 * 2;
constexpr size_t WS_NCS = WS_NCP + (size_t)32 * 4096 * 4;
constexpr size_t WS_BAR = WS_NCS + (size_t)256 * 1088 * 4;
constexpr size_t WS_SLAB = WS_BAR + 16384;
constexpr size_t WS_END = WS_SLAB + (size_t)8 * MS * DM * 4;
constexpr int LDS_BYTES = 163840;
constexpr int LDS_XB = LDS_BYTES - 16;

struct Params { const float* in[25]; float* out; unsigned char* ws; int ph_lo, ph_hi; };
typedef const __attribute__((address_space(4))) Params CParams;

#define KSWZ(row, colB) ((row) * 256 + ((colB) ^ (((row) & 7) << 4)))
#define SBAR() __builtin_amdgcn_sched_barrier(0)
template <class A, class Bt> struct same_t { static constexpr bool v = false; };
template <class A> struct same_t<A, A> { static constexpr bool v = true; };
__device__ __forceinline__ int otid() { int t = threadIdx.x; asm volatile("" : "+v"(t)); return t; }
#define LBAR() asm volatile("s_waitcnt lgkmcnt(0)\n\ts_barrier" ::: "memory")
namespace pg8 {
#define PG8_LAS __attribute__((address_space(3)))
typedef unsigned short bf16_t;
typedef short bf16x8 __attribute__((ext_vector_type(8)));
typedef float f32x4 __attribute__((ext_vector_type(4)));
typedef unsigned u32x4 __attribute__((ext_vector_type(4)));
constexpr int BM = 256, BK = 64, HALF = 128, HTB = HALF * BK * 2  , STAGE_BYTES = 8 * HTB, NXCD = 8, WGM = 8;

__host__ __device__ __forceinline__ int lds_byte(int r, int c) { const int st = (r >> 4) * 2 + (c >> 5), rr = r & 15, cc = c & 31, ob = rr * 64 + cc * 2; return st * 1024 + (ob ^ (((ob >> 9) & 1) << 5)); }
__host__ __device__ __forceinline__ void stage_rc(int b, int& R, int& C) { const int st = b / 1024, sb = b % 1024, swz = sb ^ (((sb >> 9) & 1) << 5); R = (st >> 1) * 16 + swz / 64; C = (st & 1) * 32 + (swz % 64) / 2; }
__host__ __device__ __forceinline__ int perm32(int rho) { const int n = rho >> 4, i = rho & 15; return 8 * (i >> 2) + 4 * n + (i & 3); }

struct Unit { int pm, pn, kt0, nkt, split; };
struct Gemm { const bf16_t* A; const bf16_t* Bt; int M, N, K; };

struct StaticOrder {
    int nM, nN, nwg, G, c, nktf;
    __host__ __device__ void init(int M, int N, int G_, int c_) { nM = M / BM; nN = N / BM; nwg = nM * nN; G = G_; c = c_; }
    __host__ __device__ bool next(int i, Unit& u) const {
        const long L = (long)i * G + c; if (L >= nwg) return false;
        int wgid = (int)L; { const int q = nwg / NXCD, r = nwg % NXCD, xcd = wgid % NXCD, off = wgid / NXCD; wgid = (xcd < r ? xcd * (q + 1) : r * (q + 1) + (xcd - r) * q) + off; }
        const int nig = WGM * nN, gid = wgid / nig, fm = gid * WGM, gsz = (nM - fm) < WGM ? (nM - fm) : WGM;
        u.pm = fm + ((wgid % nig) % gsz); u.pn = (wgid % nig) / gsz; u.kt0 = 0; u.nkt = nktf; u.split = 0; return true;
    }
    __device__ __forceinline__ void a_ready(const Unit&) const {}
    __device__ __forceinline__ void done(const Unit&) const {}
};
__device__ __forceinline__ unsigned cvt_pk_bf16(float lo, float hi) { unsigned r; asm volatile("v_cvt_pk_bf16_f32 %0, %1, %2" : "=v"(r) : "v"(lo), "v"(hi)); return r; }
template <class Epi, class Sched, bool STAMP = false>
__device__ __forceinline__ void gemm_phase(PG8_LAS unsigned char* lds, const Gemm g, const Sched& S, const Epi& E, unsigned long long* stamps) {
    const int tid = otid(), wid = __builtin_amdgcn_readfirstlane(tid >> 6), lane = tid & 63, wr = wid >> 2, wc = wid & 3, fr = lane & 15, fq = lane >> 4;
    const int K = g.K;
    int ts_lo = 0, ts_hi = 0, nts = 0; const unsigned long long rt_entry = STAMP ? (unsigned long long)wall_clock64() : 0ull;
#define PG8_STAMP() do { if (STAMP && wid == 0 && nts < 64) { const unsigned long long _c = (unsigned long long)clock64(); \
        ts_lo = (lane == nts) ? (int)(unsigned)_c : ts_lo; ts_hi = (lane == nts) ? (int)(unsigned)(_c >> 32) : ts_hi; ++nts; } } while (0)
    PG8_STAMP();
    unsigned voffA[2], voffB[2];
#pragma unroll
    for (int i = 0; i < 2; ++i) { int R, C; stage_rc(tid * 16 + i * 8192, R, C); const int Rb = Epi::PERM ? ((R & ~31) + perm32(R & 31)) : R;
        voffA[i] = (unsigned)(R * K + C) * 2u; voffB[i] = (unsigned)(Rb * K + C) * 2u; }
    const size_t kstep = (size_t)(BK * 2);
    const size_t hstep = (size_t)HALF * K * 2;
    const size_t tstep = 2 * hstep;
    const unsigned ldsw = (unsigned)wid * 1024u;
    const int aoff = lds_byte(wr * 64 + fr, fq * 8), boff = lds_byte(wc * 32 + fr, fq * 8);
#define PG8_SA(b, h) (((b) * 2 + (h)) * HTB)
#define PG8_SB(b, h) ((4 + (b) * 2 + (h)) * HTB)
#define PG8_STAGE(bufoff, gbase, voff) do { _Pragma("unroll") for (int _i = 0; _i < 2; ++_i) \
        __builtin_amdgcn_global_load_lds((const unsigned*)((const char*)(gbase) + (voff)[_i]), (PG8_LAS unsigned*)(lds + (bufoff) + ldsw + _i * 8192), 16, 0, 0); } while (0)
#define PG8_LDA(dst, b, h) do { _Pragma("unroll") for (int m = 0; m < 4; ++m) _Pragma("unroll") for (int k = 0; k < 2; ++k) dst[m][k] = *(const PG8_LAS bf16x8*)(lds + PG8_SA(b, h) + aoff + m * 2048 + k * 1024); } while (0)
#define PG8_LDB(dst, b, h) do { _Pragma("unroll") for (int n = 0; n < 2; ++n) _Pragma("unroll") for (int k = 0; k < 2; ++k) dst[n][k] = *(const PG8_LAS bf16x8*)(lds + PG8_SB(b, h) + boff + n * 2048 + k * 1024); } while (0)
#define PG8_MMA(ai, bj, At, Bt) do { __builtin_amdgcn_s_setprio(1); _Pragma("unroll") for (int m = 0; m < 4; ++m) _Pragma("unroll") for (int n = 0; n < 2; ++n) _Pragma("unroll") for (int k = 0; k < 2; ++k) \
        acc[ai][bj][m][n] = __builtin_amdgcn_mfma_f32_16x16x32_bf16(Bt[n][k], At[m][k], acc[ai][bj][m][n], 0, 0, 0); __builtin_amdgcn_s_setprio(0); } while (0)
#define PG8_WAIT_V(n) asm volatile("s_waitcnt vmcnt(" #n ")" ::: "memory")
#define PG8_WAIT_L(n) asm volatile("s_waitcnt lgkmcnt(" #n ")" ::: "memory")
#define PG8_BAR __builtin_amdgcn_s_barrier()
#define PG8_SCHED __builtin_amdgcn_sched_barrier(0)
    Unit cur, nxt; int ui = 0;
    if (!S.next(0, cur)) return;
    f32x4 acc[2][2][4][2];
#pragma unroll
    for (int a = 0; a < 2; ++a)
#pragma unroll
        for (int b = 0; b < 2; ++b)
#pragma unroll
            for (int m = 0; m < 4; ++m)
#pragma unroll
                for (int n = 0; n < 2; ++n) acc[a][b][m][n] = (f32x4){0.f, 0.f, 0.f, 0.f};
    bf16x8 At[4][2], B0[2][2], B1[2][2];
    const char* cA = (const char*)g.A + (size_t)cur.pm * tstep + (size_t)cur.kt0 * kstep; const char* cB = (const char*)g.Bt + (size_t)cur.pn * tstep + (size_t)cur.kt0 * kstep;
    S.a_ready(cur);
    PG8_STAGE(PG8_SB(0, 0), cB, voffB); PG8_STAGE(PG8_SA(0, 0), cA, voffA); PG8_STAGE(PG8_SB(0, 1), cB + hstep, voffB); PG8_STAGE(PG8_SA(0, 1), cA + hstep, voffA);
    if (wr == 1) PG8_BAR;
    PG8_WAIT_V(4); PG8_BAR;
    PG8_STAGE(PG8_SB(1, 0), cB + kstep, voffB); PG8_STAGE(PG8_SA(1, 0), cA + kstep, voffA); PG8_STAGE(PG8_SB(1, 1), cB + hstep + kstep, voffB);
    PG8_WAIT_V(6); PG8_BAR;
    PG8_STAMP();
    for (;;) {
        const bool has_next = S.next(ui + 1, nxt);
        const char* nA = has_next ? (const char*)g.A + (size_t)nxt.pm * tstep + (size_t)nxt.kt0 * kstep : cA; const char* nB = has_next ? (const char*)g.Bt + (size_t)nxt.pn * tstep + (size_t)nxt.kt0 * kstep : cB;
        const int nt = cur.nkt;
        for (int t = 0; t < nt; t += 2) {
            const bool last = (t == nt - 2);
            const char* a1 = cA + (size_t)(t + 1) * kstep;
            const char* a2 = last ? nA : cA + (size_t)(t + 2) * kstep; const char* b2 = last ? nB : cB + (size_t)(t + 2) * kstep;
            const char* a3 = a2 + kstep; const char* b3 = b2 + kstep;
            if (last && has_next) S.a_ready(nxt);
            PG8_LDB(B0, 0, 0); PG8_SCHED; PG8_LDA(At, 0, 0); PG8_STAGE(PG8_SA(1, 1), a1 + hstep, voffA);
            PG8_WAIT_L(8); PG8_BAR; PG8_WAIT_L(0); PG8_MMA(0, 0, At, B0); PG8_BAR; PG8_SCHED;
            PG8_LDB(B1, 0, 1); PG8_STAGE(PG8_SB(0, 0), b2, voffB);
            PG8_BAR; PG8_WAIT_L(0); PG8_MMA(0, 1, At, B1); PG8_BAR;
            PG8_LDA(At, 0, 1); PG8_STAGE(PG8_SA(0, 0), a2, voffA);
            PG8_BAR; PG8_WAIT_L(0); PG8_MMA(1, 0, At, B0); PG8_BAR; PG8_SCHED;
            PG8_STAGE(PG8_SB(0, 1), b2 + hstep, voffB);
            PG8_WAIT_V(6); PG8_BAR; PG8_MMA(1, 1, At, B1); PG8_BAR;
            PG8_LDB(B0, 1, 0); PG8_SCHED; PG8_LDA(At, 1, 0); PG8_STAGE(PG8_SA(0, 1), a2 + hstep, voffA);
            PG8_WAIT_L(8); PG8_BAR; PG8_WAIT_L(0); PG8_MMA(0, 0, At, B0); PG8_BAR; PG8_SCHED;
            PG8_LDB(B1, 1, 1); PG8_STAGE(PG8_SB(1, 0), b3, voffB);
            PG8_BAR; PG8_WAIT_L(0); PG8_MMA(0, 1, At, B1); PG8_BAR;
            PG8_LDA(At, 1, 1); PG8_STAGE(PG8_SA(1, 0), a3, voffA);
            PG8_BAR; PG8_WAIT_L(0); PG8_MMA(1, 0, At, B0); PG8_BAR; PG8_SCHED;
            PG8_STAGE(PG8_SB(1, 1), b3 + hstep, voffB);
            PG8_WAIT_V(6); PG8_BAR; PG8_MMA(1, 1, At, B1); PG8_BAR;
        }
        PG8_STAMP();
        if constexpr (!Epi::AFTER_DRAIN) { E(acc, cur, wr, wc, fr, fq); S.done(cur); }
        PG8_STAMP();
        if (!has_next) break;
#pragma unroll
        for (int a = 0; a < 2; ++a)
#pragma unroll
            for (int b = 0; b < 2; ++b)
#pragma unroll
                for (int m = 0; m < 4; ++m)
#pragma unroll
                    for (int n = 0; n < 2; ++n) acc[a][b][m][n] = (f32x4){0.f, 0.f, 0.f, 0.f};
        cur = nxt; cA = nA; cB = nB; ++ui;
    }
    PG8_WAIT_V(0);
    if (wr == 0) PG8_BAR;
    PG8_BAR;
    if constexpr (Epi::AFTER_DRAIN) { E.fused(acc, cur, wr, wc, fr, fq, lds, wid, lane); S.done(cur); }
    PG8_STAMP();
    if (STAMP && wid == 0) { stamps[lane] = lane < nts ? (((unsigned long long)(unsigned)ts_hi << 32) | (unsigned)ts_lo) : 0ull;
        if (lane == 62) stamps[62] = rt_entry; if (lane == 63) stamps[63] = (unsigned long long)wall_clock64(); }
#undef PG8_STAMP
#undef PG8_SA
#undef PG8_SB
#undef PG8_STAGE
#undef PG8_LDA
#undef PG8_LDB
#undef PG8_MMA
#undef PG8_WAIT_V
#undef PG8_WAIT_L
#undef PG8_BAR
#undef PG8_SCHED
}
}
namespace fa {
constexpr int D = 128, OSTR = 1024;
constexpr float SCALE = 0.08838834764831845f;
constexpr float THR = 8.f;
constexpr bool WSKIP = false;
constexpr int NW = 8, QBLK = 32, KVBLK = 64, QB = NW * QBLK;
constexpr int SHM_V = KVBLK * D * 2, SHM_K = KVBLK * D * 2;
__device__ __forceinline__ int v_st(int k, int c) { const int kk = (k & ~0xC) | ((k & 4) << 1) | ((k & 8) >> 1); return ((kk >> 3) * 4 + (c >> 5)) * 512 + ((kk & 7) * 32 + (c & 31)) * 2; }
__device__ __forceinline__ int v_rd_base(int lane) { return ((lane & 3) << 3) | (((lane >> 2) & 3) << 6) | (((lane >> 4) & 1) << 5) | (((lane >> 5) & 1) << 8); }
constexpr int v_rd_off(int d0, int ks, int half) { return d0 * 512 + ks * 4096 + half * 2048; }
__device__ __forceinline__ int crow(int r, int hi) { return (r & 3) + 8 * (r >> 2) + 4 * hi; }
__device__ __forceinline__ unsigned cvtpk(float lo, float hi) {
    unsigned r; asm volatile("v_cvt_pk_bf16_f32 %0, %1, %2" : "=v"(r) : "v"(lo), "v"(hi)); return r;
}
__device__ __forceinline__ bf16x8 pack8(f32x4 a, f32x4 b) {
    u32x4 w = {cvtpk(a[0], a[1]), cvtpk(a[2], a[3]), cvtpk(b[0], b[1]), cvtpk(b[2], b[3])};
    return *reinterpret_cast<bf16x8*>(&w);
}
template <class T> __device__ __forceinline__ bf16x8 load8(const T* p) {
    if constexpr (same_t<T, float>::v) { return pack8(*(const f32x4*)p, *(const f32x4*)(p + 4)); }
    else { return *reinterpret_cast<const bf16x8*>(p); }
}
__device__ __forceinline__ void mask_tile(f32x16& p0, f32x16& p1, int dq, unsigned W) {
    const float NEG = -__builtin_inff();
#pragma unroll
    for (int r = 0; r < 16; ++r) {
        const int c = (r & 3) + 8 * (r >> 2);
        if ((unsigned)(dq - c) >= W) p0[r] = NEG;
        if ((unsigned)(dq - c - 32) >= W) p1[r] = NEG;
    }
}
__device__ __forceinline__ void partialSM(f32x16& p0, f32x16& p1, float& m_reg, float& mn, float& alpha) {
    float pmax = p0[0]; for (int r = 1; r < 16; ++r) pmax = fmaxf(pmax, p0[r]); for (int r = 0; r < 16; ++r) pmax = fmaxf(pmax, p1[r]);
    { auto rr = __builtin_amdgcn_permlane32_swap(__float_as_uint(pmax), __float_as_uint(pmax), false, false);
      pmax = fmaxf(__uint_as_float(rr[0]), __uint_as_float(rr[1])); }
    constexpr float C2 = 1.4426950408889634f * SCALE;
    if (__builtin_expect(__all((pmax - m_reg) * SCALE <= THR), 1)) { mn = m_reg; alpha = 1.f; }
    else { mn = fmaxf(m_reg, pmax); alpha = __builtin_amdgcn_exp2f((m_reg - mn) * C2); m_reg = mn; }
    const float mnL = -mn * C2;
    for (int r = 0; r < 16; ++r) p0[r] = fmaf(p0[r], C2, mnL); for (int r = 0; r < 16; ++r) p1[r] = fmaf(p1[r], C2, mnL);
    for (int r = 0; r < 16; ++r) p0[r] = __builtin_amdgcn_exp2f(p0[r]);
}
__device__ __forceinline__ void finishSM(f32x16& p0, f32x16& p1, float alpha, float& l_reg, bf16x8& pa0, bf16x8& pa1, bf16x8& pa2, bf16x8& pa3) {
    for (int r = 0; r < 16; ++r) p1[r] = __builtin_amdgcn_exp2f(p1[r]);
    float ps = 0; for (int r = 0; r < 16; ++r) ps += p0[r]; for (int r = 0; r < 16; ++r) ps += p1[r];
    { auto rr = __builtin_amdgcn_permlane32_swap(__float_as_uint(ps), __float_as_uint(ps), false, false);
      ps = __uint_as_float(rr[0]) + __uint_as_float(rr[1]); }
    l_reg = l_reg * alpha + ps;
#define PK4(P, B_, OUT) do { unsigned a0 = cvtpk(P[B_+0], P[B_+1]), a1 = cvtpk(P[B_+2], P[B_+3]);                          \
        unsigned b0 = cvtpk(P[B_+4], P[B_+5]), b1 = cvtpk(P[B_+6], P[B_+7]);                                             \
        auto r0 = __builtin_amdgcn_permlane32_swap(a0, b0, false, false); auto r1 = __builtin_amdgcn_permlane32_swap(a1, b1, false, false); \
        u32x4 w = {r0[0], r1[0], r0[1], r1[1]}; OUT = *reinterpret_cast<bf16x8*>(&w); } while (0)
    PK4(p0, 0, pa0); PK4(p0, 8, pa1); PK4(p1, 0, pa2); PK4(p1, 8, pa3);
#undef PK4
}
template <int KB, bool SK>
__device__ __forceinline__ void qkt(f32x16& p0, f32x16& p1, const char* K_lds, const char* B_lds, int r32, int hi, const bf16x8* qr, bool act) {
    if (SK && !act) { const float NEG = -__builtin_inff();
#pragma unroll
        for (int r = 0; r < 16; ++r) { p0[r] = NEG; p1[r] = NEG; } return; }
    { const float* bl = (const float*)B_lds + 4 * hi;
#pragma unroll
      for (int g = 0; g < 4; ++g) { const f32x4 ba = *(const f32x4*)(bl + 8 * g); const f32x4 bb = *(const f32x4*)(bl + 32 + 8 * g);
#pragma unroll
        for (int e = 0; e < 4; ++e) { p0[4 * g + e] = ba[e]; p1[4 * g + e] = bb[e]; } } }
    const char* kb[4];
#pragma unroll
    for (int dd = 0; dd < 4; ++dd) kb[dd] = K_lds + KB * SHM_K + KSWZ(r32, (dd * 16 + hi * 8) * 2);
#pragma unroll
    for (int d0 = 0; d0 < 8; ++d0) { const char* a = kb[d0 & 3] + (d0 >> 2) * 128;
        bf16x8 b0 = *reinterpret_cast<const bf16x8*>(a);
        bf16x8 b1 = *reinterpret_cast<const bf16x8*>(a + 32 * 256);
        p0 = __builtin_amdgcn_mfma_f32_32x32x16_bf16(b0, qr[d0], p0, 0, 0, 0);
        p1 = __builtin_amdgcn_mfma_f32_32x32x16_bf16(b1, qr[d0], p1, 0, 0, 0); }
}
template <int VB, bool SK>
__device__ __forceinline__ void pv_tile(f32x16* o, int vb0, bf16x8 pa0, bf16x8 pa1, bf16x8 pa2, bf16x8 pa3, bool act) {
    if (SK && !act) return;
#define TRRD(dst, off) asm volatile("ds_read_b64_tr_b16 %0, %1 offset:%2" : "=&v"(dst) : "v"(vb0), "i"(off) : "memory")
#define PV_D0(d0) do { s16x4 l0, l1, l2, l3, h0, h1, h2, h3; constexpr int b_ = VB * SHM_V + v_rd_off(d0, 0, 0);     \
        TRRD(l0, b_); TRRD(h0, b_ + 2048); TRRD(l1, b_ + 4096); TRRD(h1, b_ + 6144); TRRD(l2, b_ + 8192); TRRD(h2, b_ + 10240); TRRD(l3, b_ + 12288); TRRD(h3, b_ + 14336); \
        asm volatile("s_waitcnt lgkmcnt(0)" ::: "memory"); SBAR();                 \
        o[d0] = __builtin_amdgcn_mfma_f32_32x32x16_bf16(pa0, (bf16x8){l0[0], l0[1], l0[2], l0[3], h0[0], h0[1], h0[2], h0[3]}, o[d0], 0, 0, 0);   \
        o[d0] = __builtin_amdgcn_mfma_f32_32x32x16_bf16(pa1, (bf16x8){l1[0], l1[1], l1[2], l1[3], h1[0], h1[1], h1[2], h1[3]}, o[d0], 0, 0, 0);   \
        o[d0] = __builtin_amdgcn_mfma_f32_32x32x16_bf16(pa2, (bf16x8){l2[0], l2[1], l2[2], l2[3], h2[0], h2[1], h2[2], h2[3]}, o[d0], 0, 0, 0);   \
        o[d0] = __builtin_amdgcn_mfma_f32_32x32x16_bf16(pa3, (bf16x8){l3[0], l3[1], l3[2], l3[3], h3[0], h3[1], h3[2], h3[3]}, o[d0], 0, 0, 0); } while (0)
    PV_D0(0); PV_D0(1); PV_D0(2); PV_D0(3);
#undef PV_D0
#undef TRRD
}

template <class TIn, class TOut> struct BlockRef { const TIn* Q; const TIn* K; const TIn* V; const TIn* K2; const TIn* V2; TOut* O; const float* NC; int P0; int nrows; };
template <class TIn> struct Seam {
    bf16x8 qr[8];
    bf16x8 st_v0, st_v1, st_k0, st_k1; f32x4 sf0, sf1, sf2, sf3;
    f32x4 tq[16];
};
__device__ __forceinline__ int swa_jlo(int P0, int W) { const int lowk = P0 - W + 1; return lowk > 0 ? lowk / KVBLK : 0; }
#define ROW(p, k0, rr) ((p) + (size_t)((k0) + (rr)) * D + sc)
#define VMW() asm volatile("s_waitcnt vmcnt(0)" ::: "memory")
#define VMWN(n) asm volatile("s_waitcnt vmcnt(%0)" :: "i"(n) : "memory")
#define SLOAD_H(Kp, Vp, NCp, k0) do { S.st_v0 = load8<TIn>(ROW(Vp, k0, sr)); S.st_v1 = load8<TIn>(ROW(Vp, k0, 32 + sr));              \
                         S.st_k0 = load8<TIn>(ROW(Kp, k0, sr)); S.st_k1 = load8<TIn>(ROW(Kp, k0, 32 + sr)); } while (0)
#define SWRITE_HK(bf) do { *(bf16x8*)(K_lds + (bf) * SHM_K + kws) = S.st_k0; *(bf16x8*)(K_lds + (bf) * SHM_K + kws + 32 * 256) = S.st_k1; } while (0)
#define SWRITE_HV(bf) do { *(bf16x8*)(V_lds + (bf) * SHM_V + vst0) = S.st_v0; *(bf16x8*)(V_lds + (bf) * SHM_V + vst1) = S.st_v1; } while (0)
#define SWRITE_H(bf) do { SWRITE_HV(bf); SWRITE_HK(bf); } while (0)
#define ROWF(p, k0, rr) ((p) + (size_t)((k0) + (rr)) * 1024 + sc)
#define FSEL(a, b, k0) ((const float*)((k0) < 1024 ? (a) : (b)))
#define SLOAD_F(p, k0) do { S.sf0 = *(const f32x4*)ROWF(p, k0, sr); S.sf1 = *(const f32x4*)(ROWF(p, k0, sr) + 4);                \
                            S.sf2 = *(const f32x4*)ROWF(p, k0, 32 + sr); S.sf3 = *(const f32x4*)(ROWF(p, k0, 32 + sr) + 4); } while (0)
#define SWRITE_KF(bf) do { *(bf16x8*)(K_lds + (bf) * SHM_K + kws) = pack8(S.sf0, S.sf1); *(bf16x8*)(K_lds + (bf) * SHM_K + kws + 32 * 256) = pack8(S.sf2, S.sf3); } while (0)
#define SWRITE_VF(bf) do { *(bf16x8*)(V_lds + (bf) * SHM_V + vst0) = pack8(S.sf0, S.sf1); *(bf16x8*)(V_lds + (bf) * SHM_V + vst1) = pack8(S.sf2, S.sf3); } while (0)
template <class TIn, class TOut>
__device__ __forceinline__ void causal_swa_prime(const BlockRef<TIn, TOut>& cur, int W, char* lds, Seam<TIn>& S) {
    constexpr bool F32 = same_t<TIn, float>::v;
    const int tid = otid(), wid = __builtin_amdgcn_readfirstlane(tid >> 6), lane = tid & 63, r32 = lane & 31, hi = lane >> 5;
    const int sr = tid >> 4, sc = (tid & 15) * 8, kws = KSWZ(sr, sc * 2); char* K_lds = lds + 2 * SHM_V; char* B_lds = lds + 2 * SHM_V + 2 * SHM_K + NW * 64 * 4;
    const int kb0 = swa_jlo(cur.P0, W) * KVBLK;
    for (int d0 = 0; d0 < 8; ++d0) S.qr[d0] = load8<TIn>(cur.Q + (size_t)(wid * QBLK + r32) * D + d0 * 16 + hi * 8);
    if constexpr (F32) { SLOAD_F(FSEL(cur.K, cur.K2, kb0), kb0); VMW(); SWRITE_KF(0); SBAR(); SLOAD_F(FSEL(cur.V, cur.V2, kb0), kb0); }
    else { SLOAD_H(cur.K, cur.V, cur.NC, kb0); VMW(); SWRITE_HK(0); }
    __syncthreads();
}
template <class TIn, class TOut>
__device__ __forceinline__ void causal_swa_block(const BlockRef<TIn, TOut>& cur, const BlockRef<TIn, TOut>& nxt, int skv, int W, char* lds, Seam<TIn>& S) {
    constexpr bool F32 = same_t<TIn, float>::v;
    const int tid = otid(), wid = __builtin_amdgcn_readfirstlane(tid >> 6), lane = tid & 63, r32 = lane & 31, hi = lane >> 5;
    const int j_lo = swa_jlo(cur.P0, W);
    int j_hi = (cur.P0 + QB - 1) / KVBLK + 1; if (j_hi > skv / KVBLK) j_hi = skv / KVBLK;
    const int NT = j_hi - j_lo;
    const int kbn = swa_jlo(nxt.P0, W) * KVBLK;
    const int qlo = cur.P0 + wid * QBLK, qm = qlo + r32 - 4 * hi;
    char* V_lds = lds; char* K_lds = lds + 2 * SHM_V; char* B_lds = lds + 2 * SHM_V + 2 * SHM_K + NW * 64 * 4;
    float* ws = (float*)(lds + 2 * SHM_V + 2 * SHM_K) + wid * 64; float* li_l = ws, * al_l = ws + 32;
    float m_reg = -1e30f, l_reg = 0; f32x16 o[4] = {};
    const int sr = tid >> 4, sc = (tid & 15) * 8, vst0 = v_st(sr, sc), vst1 = v_st(32 + sr, sc), kws = KSWZ(sr, sc * 2);
    const int vb0 = (int)(uintptr_t)V_lds + v_rd_base(lane);
    const TIn* Kh = cur.K; const TIn* Vh = cur.V;
#define RESC(a) do { if (__any((a) < 1.f)) { if (hi == 0) al_l[r32] = (a); asm volatile("s_waitcnt lgkmcnt(0)" ::: "memory");              \
                     for (int d_ = 0; d_ < 4; ++d_) for (int r = 0; r < 16; ++r) o[d_][r] *= al_l[crow(r, hi)]; } } while (0)
#define KBASE(t) ((j_lo + (t)) * KVBLK)
#define ACT(t) (KBASE(t) <= qlo + QBLK - 1 && KBASE(t) + KVBLK - 1 >= qlo - W + 1)
#define MASKT(P0_, P1_, t) do { const int kb_ = KBASE(t); if ((!SK || ACT(t)) && (kb_ + KVBLK - 1 > qlo || kb_ <= qlo + QBLK - 1 - W)) mask_tile(P0_, P1_, qm - kb_, (unsigned)W); } while (0)
    constexpr int NQL = F32 ? 16 : 8;
    constexpr bool SK = WSKIP && !F32;
#define SEAM_K0() do { VMWN(NQL); if constexpr (F32) { SWRITE_KF(0); SBAR(); SLOAD_F(FSEL(nxt.V, nxt.V2, kbn), kbn); } else { SWRITE_HK(0); } SBAR(); } while (0)
    f32x16 pA0, pA1, pB0, pB1; float mnA, mnB, alA, alB; bf16x8 pa0, pa1, pa2, pa3;
    { const int nbk = j_hi * KVBLK;
      for (int q = tid * 4; q < nbk; q += 2048) *(f32x4*)(B_lds + q * 4) = *(const f32x4*)(cur.NC + q);
      __syncthreads(); }
    if constexpr (F32) { VMW(); SWRITE_VF(0); SBAR(); } else { SWRITE_HV(0); SBAR(); }
    if (NT > 1) { if constexpr (F32) SLOAD_F(FSEL(cur.K, cur.K2, KBASE(1)), KBASE(1)); else SLOAD_H(Kh, Vh, cur.NC, KBASE(1)); }
    SBAR(); qkt<0, SK>(pA0, pA1, K_lds, B_lds + KBASE(0) * 4, r32, hi, S.qr, ACT(0));
    if constexpr (F32) { if (NT > 1) { VMW(); SWRITE_KF(1); SBAR(); SLOAD_F(FSEL(cur.V, cur.V2, KBASE(1)), KBASE(1)); } }
    MASKT(pA0, pA1, 0); partialSM(pA0, pA1, m_reg, mnA, alA);
    if (NT > 1) { VMW(); if constexpr (F32) { SWRITE_VF(1); SBAR(); if (NT > 2) SLOAD_F(FSEL(cur.K, cur.K2, KBASE(2)), KBASE(2)); } else SWRITE_H(1); }
    __syncthreads();
#define HALF_STEP(PX0, PX1, mnX, alX, PY0, PY1, alY, t, KB, VB, SB) do {                                                      \
        SBAR(); qkt<KB, SK>(PX0, PX1, K_lds, B_lds + KBASE(t) * 4, r32, hi, S.qr, ACT(t));                                             \
        finishSM(PY0, PY1, alY, l_reg, pa0, pa1, pa2, pa3); SBAR();                                                           \
        if ((t) + 1 < NT) { if constexpr (F32) { VMW(); SWRITE_KF(SB); SBAR(); SLOAD_F(FSEL(cur.V, cur.V2, KBASE((t) + 1)), KBASE((t) + 1)); }  \
                            else { SLOAD_H(Kh, Vh, cur.NC, KBASE((t) + 1)); } SBAR(); }                                               \
        pv_tile<VB, SK>(o, vb0, pa0, pa1, pa2, pa3, ACT((t) - 1)); MASKT(PX0, PX1, (t)); partialSM(PX0, PX1, m_reg, mnX, alX);                                        \
        __syncthreads();                                                                                                      \
        if ((t) + 1 < NT) { VMW(); if constexpr (F32) { SWRITE_VF(SB); SBAR(); if ((t) + 2 < NT) SLOAD_F(FSEL(cur.K, cur.K2, KBASE((t) + 2)), KBASE((t) + 2)); } \
                            else { SWRITE_H(SB); } }                                                                          \
        RESC(alX); __syncthreads(); } while (0)
    for (int t = 1; t + 1 < NT; t += 2) {
        HALF_STEP(pB0, pB1, mnB, alB, pA0, pA1, alA, t, 1, 0, 0);
        HALF_STEP(pA0, pA1, mnA, alA, pB0, pB1, alB, t + 1, 0, 1, 1);
    }
    const bool even = (NT & 1) == 0;
    if (even) { SBAR(); qkt<1, SK>(pB0, pB1, K_lds, B_lds + KBASE(NT - 1) * 4, r32, hi, S.qr, ACT(NT - 1)); SBAR(); }
#define QROW(e) (nxt.Q + (size_t)(wid * QBLK + r32) * D + ((e) >> 1) * 16 + hi * 8 + ((e) & 1) * 4)
    if constexpr (F32) { SLOAD_F(FSEL(nxt.K, nxt.K2, kbn), kbn); SBAR();
#pragma unroll
        for (int e = 0; e < 8; ++e) S.tq[e] = *(const f32x4*)QROW(e); }
    else { SLOAD_H(nxt.K, nxt.V, nxt.NC, kbn); SBAR();
#pragma unroll
        for (int d0 = 0; d0 < 8; ++d0) S.qr[d0] = load8<TIn>(nxt.Q + (size_t)(wid * QBLK + r32) * D + d0 * 16 + hi * 8); }
    SBAR();
    finishSM(pA0, pA1, alA, l_reg, pa0, pa1, pa2, pa3); SBAR();
    if constexpr (F32) {
#pragma unroll
        for (int e = 8; e < 16; ++e) S.tq[e] = *(const f32x4*)QROW(e); SBAR(); }
#undef QROW
    pv_tile<0, SK>(o, vb0, pa0, pa1, pa2, pa3, ACT(even ? NT - 2 : NT - 1));
    if (even) { MASKT(pB0, pB1, NT - 1); partialSM(pB0, pB1, m_reg, mnB, alB); __syncthreads(); RESC(alB);
        finishSM(pB0, pB1, alB, l_reg, pa0, pa1, pa2, pa3); SBAR(); pv_tile<1, SK>(o, vb0, pa0, pa1, pa2, pa3, ACT(NT - 1)); }
    SBAR(); SEAM_K0();
    if (hi == 0) li_l[r32] = l_reg; asm volatile("s_waitcnt lgkmcnt(0)" ::: "memory");
    float rli[16];
#pragma unroll
    for (int r = 0; r < 16; ++r) rli[r] = __builtin_amdgcn_rcpf(li_l[crow(r, hi)]);
    TOut* Ow = cur.O + (size_t)(wid * QBLK) * OSTR;
    if (wid * QBLK < cur.nrows)
#pragma unroll
    for (int r = 0; r < 16; ++r) { const int orow = crow(r, hi);
#pragma unroll
        for (int d0 = 0; d0 < 4; ++d0) { const float v = o[d0][r] * rli[r];
            if constexpr (same_t<TOut, float>::v) { Ow[(size_t)orow * OSTR + d0 * 32 + r32] = v; }
            else { const float vn = __shfl_xor(v, 1);
                   if ((r32 & 1) == 0) *(unsigned*)(Ow + (size_t)orow * OSTR + d0 * 32 + r32) = cvtpk(v, vn); } } }
    if constexpr (F32) {
#pragma unroll
        for (int d0 = 0; d0 < 8; ++d0) S.qr[d0] = pack8(S.tq[2 * d0], S.tq[2 * d0 + 1]); }
    __syncthreads();
#undef RESC
#undef KBASE
#undef ACT
#undef MASKT
#undef SEAM_K0
#undef HALF_STEP
}
#undef ROW
#undef VMW
#undef VMWN
#undef SLOAD_H
#undef SWRITE_HK
#undef SWRITE_HV
#undef SWRITE_H
#undef SLOAD_F
#undef SWRITE_KF
#undef SWRITE_VF

}
#define XB_TMO      128
#define XB_XCNT(j)  (256  + 64 * (j))
#define XB_XSUB(j)  (1280 + 64 * (j))
#define XB_XGEN(j)  (2304 + 64 * (j))
#define XB_TOP      3328
#define XB_TOPGEN   3392
#define XCD_BAR_WORDS 3456
#define XB_SPIN_CAP (1u << 18)
#define XB_LAS __attribute__((address_space(3)))

__device__ __forceinline__ unsigned xb_ld(unsigned* p)              { return __hip_atomic_load(p, __ATOMIC_RELAXED, __HIP_MEMORY_SCOPE_AGENT); }
__device__ __forceinline__ unsigned xb_add(unsigned* p, unsigned v) { return __hip_atomic_fetch_add(p, v, __ATOMIC_RELAXED, __HIP_MEMORY_SCOPE_AGENT); }
__device__ __forceinline__ unsigned xb_xcc_id() { return (unsigned)__builtin_amdgcn_s_getreg((3 << 11) | 20) & 0xFu; }
#define XB_SPIN(cond, bar) do { unsigned _sp = 0; while (cond) { __builtin_amdgcn_s_sleep(1); \
    if ((++_sp & 255u) == 0u) { if (xb_ld(&(bar)[XB_TMO])) break; if (_sp > XB_SPIN_CAP) { atomicAdd(&(bar)[XB_TMO], 1u); break; } } } } while (0)

struct XcdBarrier {
    unsigned* bar; unsigned x;
    volatile XB_LAS unsigned* st;
};

__device__ __forceinline__ XcdBarrier xcd_barrier_post(unsigned* bar, volatile XB_LAS unsigned* st) {
    XcdBarrier b; b.bar = bar; b.x = xb_xcc_id(); b.st = st;
    if (threadIdx.x == 0) (void)xb_add(&bar[XB_XCNT(b.x)], 1u);
    return b;
}
__device__ __forceinline__ void xcd_barrier_complete(unsigned* bar, unsigned x, unsigned& nloc, unsigned& nx) {
    const unsigned G = gridDim.x * gridDim.y * gridDim.z;
    unsigned sum, cnt, mine, sp = 0u;
    for (;;) {
        sum = 0u; cnt = 0u; mine = 0u;
#pragma unroll
        for (unsigned j = 0; j < 16; ++j) { const unsigned c = xb_ld(&bar[XB_XCNT(j)]); sum += c; cnt += (c > 0u) ? 1u : 0u; mine = (j == x) ? c : mine; }
        if (sum == G) break;
        __builtin_amdgcn_s_sleep(1);
        if ((++sp & 255u) == 0u) { if (xb_ld(&bar[XB_TMO])) break; if (sp > XB_SPIN_CAP) { atomicAdd(&bar[XB_TMO], 1u); break; } }
    }
    nloc = mine > 0u ? mine : 1u; nx = cnt > 0u ? cnt : 1u;
}

__device__ __forceinline__ void xcd_barrier(const XcdBarrier& b) {
    asm volatile("s_waitcnt vmcnt(0)" ::: "memory");
    __syncthreads();
    if (threadIdx.x == 0) {
        unsigned* bar = b.bar;
        __builtin_amdgcn_s_waitcnt(0);
        unsigned nloc = b.st[0], nx = b.st[1];
        if (nloc == 0u) { xcd_barrier_complete(bar, b.x, nloc, nx); b.st[0] = nloc; b.st[1] = nx; }
        const unsigned old = xb_add(&bar[XB_XSUB(b.x)], 1u);
        const unsigned gen = old / nloc;
        if (old + 1u == (gen + 1u) * nloc) {
            __builtin_amdgcn_fence(__ATOMIC_RELEASE, "agent");
            asm volatile("s_waitcnt vmcnt(0)" ::: "memory");
            const unsigned og = xb_add(&bar[XB_TOP], 1u);
            const unsigned tg = og / nx;
            if (og + 1u == (tg + 1u) * nx) xb_add(&bar[XB_TOPGEN], 1u);
            else XB_SPIN(xb_ld(&bar[XB_TOPGEN]) == tg, bar);
            __builtin_amdgcn_fence(__ATOMIC_ACQUIRE, "agent");
            xb_add(&bar[XB_XGEN(b.x)], 1u);
            asm volatile("s_waitcnt vmcnt(0)" ::: "memory");
        } else {
            XB_SPIN(xb_ld(&bar[XB_XGEN(b.x)]) == gen, bar);
            __builtin_amdgcn_fence(__ATOMIC_ACQUIRE, "agent");
            asm volatile("s_waitcnt vmcnt(0)" ::: "memory");
        }
    }
    __syncthreads();
}


__device__ __forceinline__ float bf2f(unsigned short b) { return __uint_as_float(((unsigned)b) << 16); }
__device__ __forceinline__ unsigned pk2(float lo, float hi) { unsigned r; asm volatile("v_cvt_pk_bf16_f32 %0, %1, %2" : "=v"(r) : "v"(lo), "v"(hi)); return r; }
__device__ __forceinline__ unsigned short f2bf(float x) { return (unsigned short)(pk2(x, 0.f) & 0xffffu); }
__device__ __forceinline__ float wave_sum(float v) {
#pragma unroll
    for (int o = 1; o < 64; o <<= 1) v += __shfl_xor(v, o);
    return v;
}
__device__ __forceinline__ float grp16_sum(float v) {
#pragma unroll
    for (int o = 1; o < 16; o <<= 1) v += __shfl_xor(v, o);
    return v;
}
__device__ __forceinline__ float wave_incl_scan(float v, int lane) {
#pragma unroll
    for (int o = 1; o < 64; o <<= 1) { const float t = __shfl_up(v, o); if (lane >= o) v += t; }
    return v;
}
__device__ __forceinline__ float silu_f(float x) { return x * __builtin_amdgcn_rcpf(1.f + __expf(-x)); }
__device__ __forceinline__ void unpack8(u32x4 w, float (&o)[8]) {
#pragma unroll
    for (int q = 0; q < 4; ++q) { o[2 * q] = __uint_as_float(w[q] << 16); o[2 * q + 1] = __uint_as_float(w[q] & 0xffff0000u); }
}
__device__ __forceinline__ u32x4 pack8f(const float (&v)[8]) { u32x4 w = {pk2(v[0], v[1]), pk2(v[2], v[3]), pk2(v[4], v[5]), pk2(v[6], v[7])}; return w; }
__device__ __forceinline__ int pos16(int x) { return (x & ~12) | (((x >> 2) & 1) << 3) | (((x >> 3) & 1) << 2); }
__device__ __forceinline__ int crow32(int r, int hi) { return (r & 3) + 8 * (r >> 2) + 4 * hi; }

struct EpiBf16Plain {
    static constexpr bool PERM = true, AFTER_DRAIN = false;
    bf16_t* O; int ldc;
    __device__ __forceinline__ void operator()(const pg8::f32x4 (&acc)[2][2][4][2], const pg8::Unit& u, int wr, int wc, int fr, int fq) const {
        const int row0 = u.pm * 256 + wr * 64 + fr, col0 = u.pn * 256 + wc * 32 + 8 * fq;
#pragma unroll
        for (int ai = 0; ai < 2; ++ai)
#pragma unroll
            for (int m = 0; m < 4; ++m) { bf16_t* rowp = O + (size_t)(row0 + ai * 128 + m * 16) * ldc + col0;
#pragma unroll
                for (int bj = 0; bj < 2; ++bj) { const pg8::f32x4 v0 = acc[ai][bj][m][0], v1 = acc[ai][bj][m][1];
                    u32x4 w; w.x = pk2(v0[0], v0[1]); w.y = pk2(v0[2], v0[3]); w.z = pk2(v1[0], v1[1]); w.w = pk2(v1[2], v1[3]);
                    *(u32x4*)(rowp + bj * 128) = w; } }
    }
};
struct EpiSwiglu {
    static constexpr bool PERM = true, AFTER_DRAIN = false;
    bf16_t* O; int ldc;
    __device__ __forceinline__ void operator()(const pg8::f32x4 (&acc)[2][2][4][2], const pg8::Unit& u, int wr, int wc, int fr, int fq) const {
        const int row0 = u.pm * 256 + wr * 64 + fr, col0 = u.pn * 128 + wc * 32 + 8 * fq;
#pragma unroll
        for (int ai = 0; ai < 2; ++ai)
#pragma unroll
            for (int m = 0; m < 4; ++m) { bf16_t* rowp = O + (size_t)(row0 + ai * 128 + m * 16) * ldc + col0;
                float r[8];
#pragma unroll
                for (int n = 0; n < 2; ++n)
#pragma unroll
                    for (int e = 0; e < 4; ++e) { const float g = acc[ai][0][m][n][e], up = acc[ai][1][m][n][e]; r[4 * n + e] = silu_f(g) * up; }
                *(u32x4*)rowp = pack8f(r); }
    }
};
struct EpiResid {
    static constexpr bool PERM = false, AFTER_DRAIN = false;
    float* X; int ldc; float* slab;
    __device__ __forceinline__ void operator()(const pg8::f32x4 (&acc)[2][2][4][2], const pg8::Unit& u, int wr, int wc, int fr, int fq) const {
        const int row0 = u.pm * 256 + wr * 64 + fr, col0 = u.pn * 256 + wc * 32 + 4 * fq;
        if (u.split) {
            float* Sl = slab + (size_t)(u.split - 1) * MS * DM;
#pragma unroll
            for (int ai = 0; ai < 2; ++ai)
#pragma unroll
                for (int m = 0; m < 4; ++m) { float* rowp = Sl + (size_t)(row0 - MP + ai * 128 + m * 16) * DM + col0;
#pragma unroll
                    for (int bj = 0; bj < 2; ++bj)
#pragma unroll
                        for (int n = 0; n < 2; ++n) *(pg8::f32x4*)(rowp + bj * 128 + n * 16) = acc[ai][bj][m][n]; }
        } else {
#pragma unroll
            for (int ai = 0; ai < 2; ++ai)
#pragma unroll
                for (int m0 = 0; m0 < 4; m0 += 2) {
                    pg8::f32x4 xv[2][2][2];
#pragma unroll
                    for (int mm = 0; mm < 2; ++mm) { const float* rowp = X + (size_t)(row0 + ai * 128 + (m0 + mm) * 16) * ldc + col0;
#pragma unroll
                        for (int bj = 0; bj < 2; ++bj)
#pragma unroll
                            for (int n = 0; n < 2; ++n) xv[mm][bj][n] = *(const pg8::f32x4*)(rowp + bj * 128 + n * 16); }
#pragma unroll
                    for (int mm = 0; mm < 2; ++mm) { float* rowp = X + (size_t)(row0 + ai * 128 + (m0 + mm) * 16) * ldc + col0;
#pragma unroll
                        for (int bj = 0; bj < 2; ++bj)
#pragma unroll
                            for (int n = 0; n < 2; ++n) *(pg8::f32x4*)(rowp + bj * 128 + n * 16) = xv[mm][bj][n] + acc[ai][bj][m0 + mm][n]; }
                }
        }
    }
};
template <class Epi>
__device__ __forceinline__ void run_gemm(PG8_LAS unsigned char* lds, const bf16_t* A, const bf16_t* Bt, int N, int K, const Epi& E) {
    pg8::Gemm g; g.A = A; g.Bt = Bt; g.M = MT; g.N = N; g.K = K;
    pg8::StaticOrder S; S.init(MT, N, (int)gridDim.x, (int)blockIdx.x); S.nktf = K / 64;
    pg8::gemm_phase<Epi, pg8::StaticOrder, false>(lds, g, S, E, nullptr);
}

__device__ __forceinline__ int tail_parts(int K, int G) { return G != 256 ? 0 : ((K / 128) >= 16 ? 8 : 4); }
struct TailSplitOrder {
    int c, G, nktf; pg8::StaticOrder so;
    __device__ void init(int K, int G_, int c_) { c = c_; G = G_; nktf = K / 64; so.init(MT, 1024, G_, c_); so.nktf = nktf; }
    __device__ bool next(int i, pg8::Unit& u) const {
        if (G != 256) return so.next(i, u);
        if (i == 0) { u.pm = (c & 7) + 8 * (c >> 5); u.pn = (c >> 3) & 3; u.kt0 = 0; u.nkt = nktf; u.split = 0; return true; }
        if (i > 1) return false;
        const int npairs = nktf >> 1, parts = npairs >= 16 ? 8 : 4, part = c >> 5, tix = c & 31;
        if (part >= parts) return false;
        const int q = npairs / parts, r = npairs - q * parts;
        const int p0 = part * q + (part < r ? part : r), np = q + (part < r ? 1 : 0);
        u.pm = 64 + (tix >> 2); u.pn = tix & 3; u.kt0 = 2 * p0; u.nkt = 2 * np; u.split = part + 1; return true;
    }
    __device__ __forceinline__ void a_ready(const pg8::Unit&) const {}
    __device__ __forceinline__ void done(const pg8::Unit&) const {}
};
__device__ __forceinline__ void run_gemm_n1024(PG8_LAS unsigned char* lds, const bf16_t* A, const bf16_t* Bt, int K, const EpiResid& E) {
    pg8::Gemm g; g.A = A; g.Bt = Bt; g.M = MT; g.N = 1024; g.K = K;
    TailSplitOrder S; S.init(K, (int)gridDim.x, (int)blockIdx.x);
    pg8::gemm_phase<EpiResid, TailSplitOrder, false>(lds, g, S, E, nullptr);
}

__device__ __forceinline__ void transpose_weight(const float* __restrict__ W, int K, int N, bf16_t* WT, int mode, float* tile, int bid, int nb) {
    const int tid = otid();
    const int nct = (N + 63) >> 6, nkt = K >> 6, nt = nct * nkt;
    constexpr int TB = 4;
    for (int t0 = bid; t0 < nt; t0 += TB * nb) {
        float v[TB][8];
#pragma unroll
        for (int q = 0; q < TB; ++q) { const int t = min(t0 + q * nb, nt - 1), kt = t / nct, ct = t - kt * nct, k0 = kt * 64, n0 = ct * 64;
#pragma unroll
            for (int i = 0; i < 8; ++i) { const int r = (tid >> 6) + 8 * i, c = tid & 63, n = n0 + c; v[q][i] = (n < N) ? W[(size_t)(k0 + r) * N + n] : 0.f; } }
#pragma unroll
        for (int q = 0; q < TB; ++q)
#pragma unroll
            for (int i = 0; i < 8; ++i) { const int r = (tid >> 6) + 8 * i, c = tid & 63; tile[q * 4160 + r * 65 + c] = v[q][i]; }
        __syncthreads();
#pragma unroll
        for (int q = 0; q < TB; ++q) { const int t = t0 + q * nb; if (t < nt) { const int kt = t / nct, ct = t - kt * nct, k0 = kt * 64, n0 = ct * 64;
            const int nl = tid >> 3, kc = tid & 7, n = n0 + nl; int dest = -1;
            if (n < N) {
                if (mode == 0) dest = n;
                else if (mode == 1) dest = n < 2048 ? n : (n < 2056 ? -1 : n - 8);
                else if (mode == 2) dest = n < 3072 ? n : -1;
                else if (mode == 3) dest = 256 * (n >> 7) + (n & 127);
                else dest = 256 * (n >> 7) + 128 + (n & 127);
            }
            if (dest >= 0) { float o[8];
#pragma unroll
                for (int e = 0; e < 8; ++e) o[e] = tile[q * 4160 + (8 * kc + e) * 65 + nl];
                *(u32x4*)(WT + (size_t)dest * K + k0 + 8 * kc) = pack8f(o); } } }
        __syncthreads();
    }
}
__device__ __forceinline__ void convert_weights(CParams& p, unsigned char* shm, int l0, int l1, int bid, int nb) {
    float* tile = (float*)shm;
    for (int l = l0; l < l1; ++l) {
        const int i = l >> 1;
        if ((l & 1) == 0) {
            transpose_weight(p.in[10] + (size_t)i * DM * EVEN_IN, DM, EVEN_IN, (bf16_t*)(p.ws + WS_WINE) + (size_t)i * NE * DM, 1, tile, bid, nb);
            transpose_weight(p.in[16] + (size_t)i * DM * DM, DM, DM, (bf16_t*)(p.ws + WS_WOUTE) + (size_t)i * DM * DM, 0, tile, bid, nb);
        } else {
            transpose_weight(p.in[17] + (size_t)i * DM * ODD_IN, DM, ODD_IN, (bf16_t*)(p.ws + WS_WINO) + (size_t)i * NO * DM, 2, tile, bid, nb);
            transpose_weight(p.in[21] + (size_t)i * DM * DM, DM, DM, (bf16_t*)(p.ws + WS_WOUTO) + (size_t)i * DM * DM, 0, tile, bid, nb);
        }
        transpose_weight(p.in[22] + (size_t)l * DM * DFF, DM, DFF, (bf16_t*)(p.ws + WS_WF1) + (size_t)l * NF1 * DM, 3, tile, bid, nb);
        transpose_weight(p.in[23] + (size_t)l * DM * DFF, DM, DFF, (bf16_t*)(p.ws + WS_WF1) + (size_t)l * NF1 * DM, 4, tile, bid, nb);
        transpose_weight(p.in[24] + (size_t)l * DFF * DM, DFF, DM, (bf16_t*)(p.ws + WS_WF2) + (size_t)l * DM * DFF, 0, tile, bid, nb);
    }
}
__device__ __forceinline__ void phase_init(CParams& p, unsigned char* shm) {
    convert_weights(p, shm, 0, 1, (int)blockIdx.x, (int)gridDim.x);
}

template <int MODE>
__device__ __forceinline__ void phase_norm(CParams& p, int layer, unsigned char* shm, int nparts) {
    const int tid = otid(), lane = tid & 63, wid = tid >> 6, i = layer >> 1;
    float* Wsm = (float*)shm;
    const float* X = p.out;
    const bool from_in = (MODE == 0) && layer == 0;
    const float* Xp = from_in ? p.in[0] : X; const float* Xs = from_in ? p.in[1] - (size_t)MP * DM : X;
    bf16_t* H = (bf16_t*)(p.ws + WS_H);
    const float* gain = (MODE == 2 ? p.in[9] : p.in[8]) + layer * DM;
    if (MODE != 2) {
        const float* W = MODE == 0 ? p.in[10] + (size_t)i * DM * EVEN_IN + 2048 : p.in[17] + (size_t)i * DM * ODD_IN + 3072;
        const int ldw = MODE == 0 ? EVEN_IN : ODD_IN;
#pragma unroll
        for (int r = 0; r < 4; ++r) { const int q = tid + 512 * r, k = q >> 1, hf = q & 1;
            const f32x4 w = *(const f32x4*)(W + (size_t)k * ldw + 4 * hf);
            const int j = k >> 8, l = (k & 255) >> 2, e = k & 3;
            *(f32x4*)(Wsm + (((j * 4 + e) * 64 + l) * 8 + 4 * hf)) = w; }
        __syncthreads();
    }
    f32x4 g4[4];
#pragma unroll
    for (int j = 0; j < 4; ++j) g4[j] = *(const f32x4*)(gain + 256 * j + 4 * lane);
    constexpr int R = 3;
    const int stride = gridDim.x * 8;
    f32x4 nv[R][4];
    int row = blockIdx.x * 8 + wid;
#pragma unroll
    for (int r = 0; r < R; ++r) { const int rr = min(row + r * stride, MT - 1); const f32x4* xr = (const f32x4*)((rr < MP ? Xp : Xs) + (size_t)rr * DM) + lane;
#pragma unroll
        for (int j = 0; j < 4; ++j) nv[r][j] = xr[64 * j]; }
    for (; row < MT; row += R * stride) {
        f32x4 cv[R][4];
#pragma unroll
        for (int r = 0; r < R; ++r)
#pragma unroll
            for (int j = 0; j < 4; ++j) cv[r][j] = nv[r][j];
        if (row + R * stride < MT) {
#pragma unroll
            for (int r = 0; r < R; ++r) { const int rr = min(row + (R + r) * stride, MT - 1); const f32x4* xr = (const f32x4*)((rr < MP ? Xp : Xs) + (size_t)rr * DM) + lane;
#pragma unroll
                for (int j = 0; j < 4; ++j) nv[r][j] = xr[64 * j]; }
        }
#pragma unroll
        for (int r = 0; r < R; ++r) {
            const int crow_ = row + r * stride;
            if (crow_ < MT) {
                f32x4 v[4]; float ss = 0.f;
#pragma unroll
                for (int j = 0; j < 4; ++j) v[j] = cv[r][j];
                if (from_in) { f32x4* xw = (f32x4*)(p.out + (size_t)crow_ * DM) + lane;
#pragma unroll
                    for (int j = 0; j < 4; ++j) xw[64 * j] = v[j]; }
                if (crow_ >= MP && nparts > 0) {
                    const f32x4* sl = (const f32x4*)((const float*)(p.ws + WS_SLAB) + (size_t)(crow_ - MP) * DM) + lane;
                    for (int q0 = 0; q0 < nparts; q0 += 4) {
                        f32x4 tsl[4][4];
#pragma unroll
                        for (int q = 0; q < 4; ++q)
#pragma unroll
                            for (int j = 0; j < 4; ++j) tsl[q][j] = sl[(size_t)(q0 + q) * (MS * DM / 4) + 64 * j];
#pragma unroll
                        for (int q = 0; q < 4; ++q)
#pragma unroll
                            for (int j = 0; j < 4; ++j) v[j] += tsl[q][j]; }
                    f32x4* xw = (f32x4*)(p.out + (size_t)crow_ * DM) + lane;
#pragma unroll
                    for (int j = 0; j < 4; ++j) xw[64 * j] = v[j];
                }
#pragma unroll
                for (int j = 0; j < 4; ++j) ss += (v[j].x * v[j].x + v[j].y * v[j].y) + (v[j].z * v[j].z + v[j].w * v[j].w);
                ss = wave_sum(ss);
                const float rstd = 1.f / sqrtf(ss * (1.f / DM) + EPS);
                u32x2* ho = (u32x2*)(H + (size_t)crow_ * DM) + lane;
#pragma unroll
                for (int j = 0; j < 4; ++j) { v[j] = v[j] * rstd * g4[j]; u32x2 w; w.x = pk2(v[j].x, v[j].y); w.y = pk2(v[j].z, v[j].w); ho[64 * j] = w; }
                if (MODE != 2) {
                    float acc[8];
#pragma unroll
                    for (int c = 0; c < 8; ++c) acc[c] = 0.f;
#pragma unroll
                    for (int j = 0; j < 4; ++j)
#pragma unroll
                        for (int e = 0; e < 4; ++e) { const float hv = v[j][e]; const float* wp = Wsm + ((j * 4 + e) * 64 + lane) * 8;
                            const f32x4 w0 = *(const f32x4*)wp, w1 = *(const f32x4*)(wp + 4);
#pragma unroll
                            for (int c = 0; c < 4; ++c) { acc[c] = fmaf(hv, w0[c], acc[c]); acc[4 + c] = fmaf(hv, w1[c], acc[4 + c]); } }
#pragma unroll
                    for (int c = 0; c < 8; ++c) acc[c] = wave_sum(acc[c]);
                    if (MODE == 0) { if (lane == 0) { float* d = (float*)(p.ws + WS_AB) + (size_t)crow_ * 8;
                            *(f32x4*)d = (f32x4){acc[0], acc[1], acc[2], acc[3]}; *(f32x4*)(d + 4) = (f32x4){acc[4], acc[5], acc[6], acc[7]}; } }
                    else {
                        const int c8 = lane & 7;
                        float xs = acc[0];
#pragma unroll
                        for (int c = 1; c < 8; ++c) xs = (c8 == c) ? acc[c] : xs;
                        const float x = xs + p.in[18][i * 8 + c8];
                        const float lf = fminf(x, 0.f) - log1pf(expf(-fabsf(x)));
                        float* d = crow_ < MP ? p.out + OFF_PLF + ((size_t)i * MP + crow_) * 8 : p.out + OFF_SLF + ((size_t)i * MS + (crow_ - MP)) * 8;
                        if (lane < 8) d[lane] = lf; }
                }
            }
        }
    }
}

__device__ __forceinline__ void phase_fixup(CParams& p, int nparts) {
    const int tid = otid(), lane = tid & 63, wid = tid >> 6;
    if (nparts <= 0) return;
    for (int row = MP + blockIdx.x * 8 + wid; row < MT; row += gridDim.x * 8) {
        f32x4* xw = (f32x4*)(p.out + (size_t)row * DM) + lane;
        const f32x4* sl = (const f32x4*)((const float*)(p.ws + WS_SLAB) + (size_t)(row - MP) * DM) + lane;
        f32x4 v[4];
#pragma unroll
        for (int j = 0; j < 4; ++j) v[j] = xw[64 * j];
        for (int q0 = 0; q0 < nparts; q0 += 4) {
            f32x4 tsl[4][4];
#pragma unroll
            for (int q = 0; q < 4; ++q)
#pragma unroll
                for (int j = 0; j < 4; ++j) tsl[q][j] = sl[(size_t)(q0 + q) * (MS * DM / 4) + 64 * j];
#pragma unroll
            for (int q = 0; q < 4; ++q)
#pragma unroll
                for (int j = 0; j < 4; ++j) v[j] += tsl[q][j]; }
#pragma unroll
        for (int j = 0; j < 4; ++j) xw[64 * j] = v[j];
    }
}

__device__ __forceinline__ void phase_gdn_prep(CParams& p, int i, unsigned char* shm) {
    const int tid = otid(), lane = tid & 63, wid = tid >> 6;
    const int half = wid >> 2, w4 = wid & 3;
    const bf16_t* P = (const bf16_t*)(p.ws + WS_BIG);
    const float* AB = (const float*)(p.ws + WS_AB);
    const float* convw = p.in[11] + (size_t)i * 4 * 1536;
    unsigned char* hb = shm + half * 78336;
    bf16_t* qs = (bf16_t*)hb; bf16_t* ks = (bf16_t*)(hb + 17408); bf16_t* vs = (bf16_t*)(hb + 34816);
    float* As = (float*)(hb + 52224); float* Gs = (float*)(hb + 68608); float* Bs = Gs + 64;
    bf16_t* Ps = (bf16_t*)(hb + 69120);
    bf16_t* Wb = vs;
    bf16_t* NEGW = (bf16_t*)(p.ws + WS_NEGW); bf16_t* QG = (bf16_t*)(p.ws + WS_QG); bf16_t* KDT = (bf16_t*)(p.ws + WS_KDT);
    bf16_t* PM = (bf16_t*)(p.ws + WS_PM); bf16_t* UPRE = (bf16_t*)(p.ws + WS_UPRE); float* GC = (float*)(p.ws + WS_GC);
    for (int pr = blockIdx.x; pr < 576; pr += gridDim.x) {
        const int it = 2 * pr + half;
        int b, n, h, T0; bool sample;
        if (it < 1024) { b = it >> 8; n = (it >> 2) & 63; h = it & 3; T0 = b * 4096 + n * 64; sample = false; }
        else { const int j = it - 1024; b = j >> 2; h = j & 3; n = 0; T0 = MP + b * 64; sample = true; }
        const bool first = (n == 0), last = sample || (n == 63);
#ifndef PROBE_PREP_A
#define PROBE_PREP_A 1
#endif
#ifndef PROBE_PREP_D
#define PROBE_PREP_D 1
#endif
#pragma unroll 1
        for (int rr = 0; rr < 2 * PROBE_PREP_A; ++rr) {
            const int task = (otid() & 255) + 256 * (rr & 1);
            if (task < 384) {
                const int tseg = task / 48, cgi = task - tseg * 48, part = cgi >> 4, c8 = (cgi & 15) * 8, t0 = tseg * 8;
                const int col = part * 512 + h * 128 + c8;
                const bool edge = first && t0 == 0;
                u32x4 L[11];
#pragma unroll
                for (int k = 0; k < 11; ++k) { const int tt = t0 - 3 + k; const int rowc = (k < 3 && edge) ? T0 : T0 + tt; L[k] = *(const u32x4*)(P + (size_t)rowc * NE + col); }
                float w[4][8];
#pragma unroll
                for (int tap = 0; tap < 4; ++tap) { const float* wp = convw + tap * 1536 + col; const f32x4 w0 = *(const f32x4*)wp, w1 = *(const f32x4*)(wp + 4);
#pragma unroll
                    for (int e = 0; e < 4; ++e) { w[tap][e] = w0[e]; w[tap][4 + e] = w1[e]; } }
                bf16_t* dst0 = (part == 0 ? qs : (part == 1 ? ks : vs)) + t0 * 136 + c8;
                float xw[4][8];
#pragma unroll
                for (int k = 0; k < 11; ++k) {
                    float (&xv)[8] = xw[k & 3];
                    if (k < 3 && edge) {
                        if (sample) { const float* sp = p.in[6] + (((size_t)i * 32 + b) * 3 + k) * 1536 + col; const f32x4 a = *(const f32x4*)sp, c = *(const f32x4*)(sp + 4);
#pragma unroll
                            for (int e = 0; e < 4; ++e) { xv[e] = a[e]; xv[4 + e] = c[e]; } }
                        else {
#pragma unroll
                            for (int e = 0; e < 8; ++e) xv[e] = 0.f; }
                    } else unpack8(L[k], xv);
                    if (last && t0 == 56 && k >= 8) {
                        float* d = (sample ? p.out + OFF_SCONV + (((size_t)i * 32 + b) * 3 + (k - 8)) * 1536 : p.out + OFF_PCONV + (((size_t)i * 4 + b) * 3 + (k - 8)) * 1536) + col;
                        *(f32x4*)d = (f32x4){xv[0], xv[1], xv[2], xv[3]}; *(f32x4*)(d + 4) = (f32x4){xv[4], xv[5], xv[6], xv[7]}; }
                    if (k >= 3) {
                        const int j = k - 3; float y[8];
#pragma unroll
                        for (int e = 0; e < 8; ++e) y[e] = w[0][e] * xw[j & 3][e];
#pragma unroll
                        for (int tap = 1; tap < 4; ++tap)
#pragma unroll
                            for (int e = 0; e < 8; ++e) y[e] = fmaf(w[tap][e], xw[(j + tap) & 3][e], y[e]);
                        float ss = 0.f;
#pragma unroll
                        for (int e = 0; e < 8; ++e) { y[e] = silu_f(y[e]); ss = fmaf(y[e], y[e], ss); }
                        ss = grp16_sum(ss);
                        const float sc = part == 2 ? 1.f : __builtin_amdgcn_rsqf(ss + EPS) * (part == 0 ? 0.08838834764831845f : 1.f);
#pragma unroll
                        for (int e = 0; e < 8; ++e) y[e] *= sc;
                        *(u32x4*)(dst0 + j * 136) = pack8f(y); }
                }
            }
        }
        if (w4 == 0) {
            const float a = AB[(size_t)(T0 + lane) * 8 + h], bb = AB[(size_t)(T0 + lane) * 8 + 4 + h];
            const float x = a + p.in[13][i * 4 + h];
            const float sp = fmaxf(x, 0.f) + log1pf(expf(-fabsf(x)));
            float g = -expf(p.in[12][i * 4 + h]) * sp;
            g = wave_incl_scan(g, lane);
            Gs[lane] = g; Bs[lane] = 1.f / (1.f + expf(-bb));
        }
        LBAR();
        {
            const int type = w4 >> 1, bi = w4 & 1; const int ln_ = otid() & 63, r32 = ln_ & 31, hi = ln_ >> 5;
            const bf16_t* Xs = type ? qs : ks;
#pragma unroll 1
            for (int bj = 0; bj < 2; ++bj) {
                f32x16 acc = {};
#pragma unroll
                for (int kk = 0; kk < 8; ++kk) {
                    const bf16x8 a = *(const bf16x8*)(Xs + (32 * bi + r32) * 136 + kk * 16 + hi * 8);
                    const bf16x8 bq = *(const bf16x8*)(ks + (32 * bj + r32) * 136 + kk * 16 + hi * 8);
                    acc = __builtin_amdgcn_mfma_f32_32x32x16_bf16(a, bq, acc, 0, 0, 0);
                }
                const int j = 32 * bj + r32; const float Gj = Gs[j];
#pragma unroll
                for (int r = 0; r < 16; ++r) { const int ii = 32 * bi + crow32(r, hi); const float d = __expf(fminf(Gs[ii] - Gj, 0.f));
                    if (type == 0) As[ii * 64 + j] = (ii > j) ? acc[r] * Bs[ii] * d : 0.f;
                    else Ps[ii * 72 + pos16(j)] = f2bf((ii >= j) ? acc[r] * d : 0.f); }
            }
        }
        LBAR();
        if (w4 < 2) {
            typedef float f32x2_t __attribute__((ext_vector_type(2)));
            const int c = otid() & 127; f32x2_t sol[64];
#pragma unroll 1
            for (int rep_ = 0; rep_ < PROBE_PREP_D; ++rep_) {
#pragma unroll
            for (int r = 0; r < 64; ++r) { const float br = Bs[r]; sol[r] = (f32x2_t){bf2f(vs[r * 136 + c]) * br, bf2f(ks[r * 136 + c]) * br * __expf(Gs[r])}; }
#pragma unroll
            for (int r = 1; r < 64; ++r) { f32x2_t a = sol[r];
#pragma unroll
                for (int j = 0; j < r; ++j) { const float m = -As[r * 64 + j]; a = __builtin_elementwise_fma((f32x2_t){m, m}, sol[j], a); }
                sol[r] = a; }
            }
            { const int sl = c >> 5, cc = c & 31;
#pragma unroll
              for (int mb = 0; mb < 2; ++mb)
#pragma unroll
                  for (int rg = 0; rg < 2; ++rg)
#pragma unroll
                      for (int hh = 0; hh < 2; ++hh) { const int tb = 32 * mb + 16 * rg + 4 * hh;
                          u32x4 w = {pk2(sol[tb].x, sol[tb + 1].x), pk2(sol[tb + 2].x, sol[tb + 3].x), pk2(sol[tb + 8].x, sol[tb + 9].x), pk2(sol[tb + 10].x, sol[tb + 11].x)};
                          *(u32x4*)(UPRE + ((((size_t)it * 4 + sl) * 2 + mb) * 2 + rg) * 512 + (cc + 32 * hh) * 8) = w; } }
            LBAR();
            { const int pp = pos16(c);
#pragma unroll
              for (int r = 0; r < 64; ++r) Wb[r * 136 + pp] = f2bf(-sol[r].y); }
        } else {
            const int t2 = otid() & 127; const float GL = Gs[63];
#pragma unroll 2
            for (int r = 0; r < 8; ++r) { const int ch = t2 + 128 * r, row = ch >> 4, pc = ch & 15, dk0 = 16 * (pc >> 1) + 4 * (pc & 1);
                const float eg = __expf(Gs[row]); const bf16_t* s_ = qs + row * 136 + dk0; float v[8];
#pragma unroll
                for (int e = 0; e < 4; ++e) { v[e] = bf2f(s_[e]) * eg; v[4 + e] = bf2f(s_[8 + e]) * eg; }
                *(u32x4*)(QG + (size_t)it * 8192 + row * 128 + pc * 8) = pack8f(v); }
#pragma unroll 2
            for (int r = 0; r < 8; ++r) { const int ch = t2 + 128 * r, dk = ch & 127, pc = ch >> 7, t0 = 16 * (pc >> 1) + 4 * (pc & 1); float v[8];
#pragma unroll
                for (int e = 0; e < 8; ++e) { const int te = t0 + (e & 3) + 8 * (e >> 2); v[e] = bf2f(ks[te * 136 + dk]) * __expf(GL - Gs[te]); }
                *(u32x4*)(KDT + (size_t)it * 8192 + dk * 64 + pc * 8) = pack8f(v); }
            if (t2 == 0) GC[it] = __expf(GL);
#pragma unroll
            for (int r = 0; r < 4; ++r) { const int ch = t2 + 128 * r, row = ch >> 3, cc = ch & 7;
                *(u32x4*)(PM + (size_t)it * 4096 + row * 64 + cc * 8) = *(const u32x4*)(Ps + row * 72 + cc * 8); }
            LBAR();
        }
        LBAR();
        { const int t4 = otid() & 255;
#pragma unroll
          for (int r = 0; r < 4; ++r) { const int ch = t4 + 256 * r, row = ch >> 4, cc = ch & 15;
              *(u32x4*)(NEGW + (size_t)it * 8192 + row * 128 + cc * 8) = *(const u32x4*)(Wb + row * 136 + cc * 8); } }
        LBAR();
    }
}

constexpr int SC_NW = 0, SC_QG = 17408, SC_KD = 34816, SC_PM = 53248, SC_UP = 62464, SC_GC = 66560, SC_BUF = 66816, SC_OB = 2 * SC_BUF, SC_OBSZ = 64 * 80;
static_assert(SC_OB + 2 * SC_OBSZ <= LDS_BYTES - 16, "scan LDS");
__device__ __forceinline__ void phase_gdn_scan(CParams& p, int i, unsigned char* shm) {
    const int tid = otid(), lane = tid & 63, wid = tid >> 6, r32 = lane & 31, hi = lane >> 5;
    const u32x4* NEGW = (const u32x4*)(p.ws + WS_NEGW); const u32x4* QG = (const u32x4*)(p.ws + WS_QG); const u32x4* KDT = (const u32x4*)(p.ws + WS_KDT);
    const u32x4* PM = (const u32x4*)(p.ws + WS_PM); const u32x4* UPRE = (const u32x4*)(p.ws + WS_UPRE); const float* GC = (const float*)(p.ws + WS_GC);
    bf16_t* OG = (bf16_t*)(p.ws + WS_OG);
    const int nb = gridDim.x, bid = blockIdx.x;
    for (int it = bid; it < 576; it = (nb > 64 ? (it < 64 ? 576 : it + (nb - 64)) : it + nb)) {
        int b, h, sl, nsteps, ch0, chs, T0; bool sample;
        if (it < 64) { b = it >> 4; h = (it >> 2) & 3; sl = it & 3; nsteps = 64; ch0 = b * 256 + h; chs = 4; T0 = b * 4096; sample = false; }
        else { const int j = it - 64; b = j >> 4; h = (j >> 2) & 3; sl = j & 3; nsteps = 1; ch0 = 1024 + (j >> 2); chs = 0; T0 = MP + b * 64; sample = true; }
        if (wid >= 4) {
            const int t2 = tid - 256; u32x4 st[15]; float stg = 0.f;
#define SC_LOAD(chv) do { const size_t ch_ = (size_t)(chv); \
                _Pragma("unroll") for (int r = 0; r < 4; ++r) st[r] = NEGW[ch_ * 1024 + t2 + 256 * r]; \
                _Pragma("unroll") for (int r = 0; r < 4; ++r) st[4 + r] = QG[ch_ * 1024 + t2 + 256 * r]; \
                _Pragma("unroll") for (int r = 0; r < 4; ++r) st[8 + r] = KDT[ch_ * 1024 + t2 + 256 * r]; \
                _Pragma("unroll") for (int r = 0; r < 2; ++r) st[12 + r] = PM[ch_ * 512 + t2 + 256 * r]; \
                st[14] = UPRE[(ch_ * 4 + sl) * 256 + t2]; if (t2 == 0) stg = GC[ch_]; } while (0)
#define SC_WRITE(bufi) do { unsigned char* base = shm + (bufi) * SC_BUF; \
                _Pragma("unroll") for (int r = 0; r < 4; ++r) { const int q = t2 + 256 * r; *(u32x4*)(base + SC_NW + (q >> 4) * 272 + (q & 15) * 16) = st[r]; } \
                _Pragma("unroll") for (int r = 0; r < 4; ++r) { const int q = t2 + 256 * r; *(u32x4*)(base + SC_QG + (q >> 4) * 272 + (q & 15) * 16) = st[4 + r]; } \
                _Pragma("unroll") for (int r = 0; r < 4; ++r) { const int q = t2 + 256 * r; *(u32x4*)(base + SC_KD + (q >> 3) * 144 + (q & 7) * 16) = st[8 + r]; } \
                _Pragma("unroll") for (int r = 0; r < 2; ++r) { const int q = t2 + 256 * r; *(u32x4*)(base + SC_PM + (q >> 3) * 144 + (q & 7) * 16) = st[12 + r]; } \
                *(u32x4*)(base + SC_UP + t2 * 16) = st[14]; if (t2 == 0) *(float*)(base + SC_GC) = stg; } while (0)
            SC_LOAD(ch0); SC_WRITE(0);
            if (nsteps > 1) SC_LOAD(ch0 + chs);
            LBAR();
            for (int s = 0; s < nsteps; ++s) {
                if (s + 1 < nsteps) { SC_WRITE((s + 1) & 1); if (s + 2 < nsteps) SC_LOAD(ch0 + (s + 2) * chs); }
                LBAR();
            }
#undef SC_LOAD
#undef SC_WRITE
        } else if (wid == 0) {
            f32x16 S[4];
            if (sample) { const float* s0 = p.in[5] + ((((size_t)i * 32 + b) * 4 + h) << 14) + 32 * sl + r32;
#pragma unroll
                for (int mb = 0; mb < 4; ++mb)
#pragma unroll
                    for (int r = 0; r < 16; ++r) S[mb][r] = s0[(32 * mb + crow32(r, hi)) * 128];
            } else {
#pragma unroll
                for (int mb = 0; mb < 4; ++mb)
#pragma unroll
                    for (int r = 0; r < 16; ++r) S[mb][r] = 0.f;
            }
            LBAR();
            for (int s = 0; s < nsteps; ++s) {
                const unsigned char* B0 = shm + (s & 1) * SC_BUF;
                f32x16 u[2], o[2];
#pragma unroll
                for (int mb = 0; mb < 2; ++mb)
#pragma unroll
                    for (int rg = 0; rg < 2; ++rg) { const u32x4 w = *(const u32x4*)(B0 + SC_UP + ((mb * 2 + rg) * 64 + lane) * 16);
#pragma unroll
                        for (int q = 0; q < 4; ++q) { u[mb][8 * rg + 2 * q] = __uint_as_float(w[q] << 16); u[mb][8 * rg + 2 * q + 1] = __uint_as_float(w[q] & 0xffff0000u); } }
                const float gc = *(const float*)(B0 + SC_GC);
                const unsigned char* lrow = B0 + r32 * 272 + hi * 16;
                const unsigned char* srow = B0 + r32 * 144 + hi * 16;
#define RD4(dst, base) do { _Pragma("unroll") for (int kk = 0; kk < 4; ++kk) dst[kk] = *(const bf16x8*)((base) + kk * 32); SBAR(); } while (0)
#define MM4(accv, fr, bop, o_) do { _Pragma("unroll") for (int kk = 0; kk < 4; ++kk) accv = __builtin_amdgcn_mfma_f32_32x32x16_bf16(fr[kk], bop[(o_) + kk], accv, 0, 0, 0); } while (0)
                bf16x8 fa[4], fb[4];
                RD4(fa, lrow + SC_NW); RD4(fb, lrow + SC_NW + 128);
                bf16x8 Sb[8];
#pragma unroll
                for (int kk = 0; kk < 8; ++kk) { const int mb = kk >> 1, hf = kk & 1;
                    u32x4 w = {pk2(S[mb][8 * hf], S[mb][8 * hf + 1]), pk2(S[mb][8 * hf + 2], S[mb][8 * hf + 3]), pk2(S[mb][8 * hf + 4], S[mb][8 * hf + 5]), pk2(S[mb][8 * hf + 6], S[mb][8 * hf + 7])};
                    Sb[kk] = *reinterpret_cast<bf16x8*>(&w); }
#pragma unroll
                for (int mb = 0; mb < 2; ++mb)
#pragma unroll
                    for (int r = 0; r < 16; ++r) o[mb][r] = 0.f;
                MM4(u[0], fa, Sb, 0); RD4(fa, lrow + SC_QG);
                MM4(u[0], fb, Sb, 4); RD4(fb, lrow + SC_QG + 128);
                MM4(o[0], fa, Sb, 0); RD4(fa, lrow + SC_NW + 32 * 272);
                MM4(o[0], fb, Sb, 4); RD4(fb, lrow + SC_NW + 32 * 272 + 128);
                MM4(u[1], fa, Sb, 0); RD4(fa, lrow + SC_QG + 32 * 272);
                MM4(u[1], fb, Sb, 4); RD4(fb, lrow + SC_QG + 32 * 272 + 128);
                MM4(o[1], fa, Sb, 0); RD4(fa, srow + SC_PM);
                MM4(o[1], fb, Sb, 4); RD4(fb, srow + SC_PM + 32 * 144);
                bf16x8 ub[4];
#pragma unroll
                for (int kk = 0; kk < 4; ++kk) { const int mb = kk >> 1, hf = kk & 1;
                    u32x4 w = {pk2(u[mb][8 * hf], u[mb][8 * hf + 1]), pk2(u[mb][8 * hf + 2], u[mb][8 * hf + 3]), pk2(u[mb][8 * hf + 4], u[mb][8 * hf + 5]), pk2(u[mb][8 * hf + 6], u[mb][8 * hf + 7])};
                    ub[kk] = *reinterpret_cast<bf16x8*>(&w); }
#pragma unroll
                for (int mb = 0; mb < 4; ++mb)
#pragma unroll
                    for (int r = 0; r < 16; ++r) S[mb][r] *= gc;
                MM4(o[0], fa, ub, 0); RD4(fa, srow + SC_KD);
                MM4(o[1], fb, ub, 0); RD4(fb, srow + SC_KD + 32 * 144);
                MM4(S[0], fa, ub, 0); RD4(fa, srow + SC_KD + 64 * 144);
                MM4(S[1], fb, ub, 0); RD4(fb, srow + SC_KD + 96 * 144);
                MM4(S[2], fa, ub, 0);
                MM4(S[3], fb, ub, 0);
#undef RD4
#undef MM4
                { unsigned char* ob = shm + SC_OB + (s & 1) * SC_OBSZ + r32 * 2;
#pragma unroll
                  for (int mb = 0; mb < 2; ++mb)
#pragma unroll
                      for (int r = 0; r < 16; ++r) *(bf16_t*)(ob + (32 * mb + crow32(r, hi)) * 80) = f2bf(o[mb][r]); }
                LBAR();
            }
            float* so = (sample ? p.out + OFF_SS + ((((size_t)i * 32 + b) * 4 + h) << 14) : p.out + OFF_PS + ((((size_t)i * 4 + b) * 4 + h) << 14)) + 32 * sl + r32;
#pragma unroll
            for (int mb = 0; mb < 4; ++mb)
#pragma unroll
                for (int r = 0; r < 16; ++r) so[(32 * mb + crow32(r, hi)) * 128] = S[mb][r];
        } else if (wid == 1) {
            LBAR();
            for (int s = 0; s <= nsteps; ++s) {
                if (s >= 1) { const unsigned char* ob = shm + SC_OB + ((s - 1) & 1) * SC_OBSZ;
#pragma unroll
                    for (int k = 0; k < 4; ++k) { const int q = lane + 64 * k, row = q >> 2, cc = q & 3;
                        *(u32x4*)(OG + (size_t)(T0 + 64 * (s - 1) + row) * 512 + h * 128 + 32 * sl + 8 * cc) = *(const u32x4*)(ob + row * 80 + cc * 16); } }
                if (s < nsteps) LBAR();
            }
        } else {
            LBAR();
            for (int s = 0; s < nsteps; ++s) LBAR();
        }
        LBAR();
    }
}

template <int PARTS>
__device__ __forceinline__ void phase_gdn_post(CParams& p, int i, int bid, int nb) {
    const int tid = otid(), lane = tid & 63, wid = tid >> 6;
    const bf16_t* P = (const bf16_t*)(p.ws + WS_BIG); const bf16_t* OG = (const bf16_t*)(p.ws + WS_OG); bf16_t* CAT = (bf16_t*)(p.ws + WS_CAT);
    float ng[8], w0[8], w1[8], w2[8];
    { const float* g = p.in[14] + i * 128 + ((8 * lane) & 127); const float* w = p.in[15] + (size_t)i * 3 * 512 + 8 * lane;
#pragma unroll
      for (int e = 0; e < 8; ++e) { ng[e] = g[e]; w0[e] = w[e]; w1[e] = w[512 + e]; w2[e] = w[1024 + e]; } }
    const int stride = nb * 8;
    for (int row0 = bid * 8 + wid; row0 < MT; row0 += 2 * stride) {
        u32x4 L[2][9]; int rows[2]; rows[0] = row0; rows[1] = row0 + stride < MT ? row0 + stride : row0;
#pragma unroll
        for (int q = 0; q < 2; ++q) { const int row = rows[q]; const bf16_t* pr = P + (size_t)row * NE + 8 * lane;
            const int t = row < MP ? (row & 4095) : ((row - MP) & 63);
            if (PARTS & 1) { L[q][0] = *(const u32x4*)(OG + (size_t)row * 512 + 8 * lane); L[q][1] = *(const u32x4*)(pr + 1536); }
            if (PARTS & 2) {
                L[q][2] = *(const u32x4*)(pr + 2048); L[q][3] = *(const u32x4*)(pr + 2560); L[q][4] = *(const u32x4*)(pr + 3072);
                const bf16_t* p1 = t >= 1 ? pr - NE : pr; const bf16_t* p2 = t >= 2 ? pr - 2 * NE : pr;
                L[q][5] = *(const u32x4*)(p1 + 2560); L[q][6] = *(const u32x4*)(p1 + 3072); L[q][7] = *(const u32x4*)(p2 + 2560); L[q][8] = *(const u32x4*)(p2 + 3072); } }
#pragma unroll
        for (int q = 0; q < 2; ++q) {
            const int row = rows[q];
            if (q == 1 && row0 + stride >= MT) break;
            if (PARTS & 1) { float ov[8], zv[8], r[8]; unpack8(L[q][0], ov); unpack8(L[q][1], zv);
              float ss = 0.f;
#pragma unroll
              for (int e = 0; e < 8; ++e) ss = fmaf(ov[e], ov[e], ss);
              ss = grp16_sum(ss);
              const float rms = 1.f / sqrtf(ss * (1.f / 128.f) + EPS);
#pragma unroll
              for (int e = 0; e < 8; ++e) r[e] = ov[e] * rms * ng[e] * silu_f(zv[e]);
              *(u32x4*)(CAT + (size_t)row * DM + 8 * lane) = pack8f(r); }
            if (PARTS & 2) {
            int b, t, T; bool sample;
            if (row < MP) { b = row >> 12; t = row & 4095; T = 4096; sample = false; } else { const int r2 = row - MP; b = r2 >> 6; t = r2 & 63; T = 64; sample = true; }
            float gb[8], gc[8], hn[8], u0[8], u1[8], u2[8], r[8];
            unpack8(L[q][2], gb); unpack8(L[q][3], gc); unpack8(L[q][4], hn);
#pragma unroll
            for (int e = 0; e < 8; ++e) u0[e] = gc[e] * hn[e];
            const float* st = p.in[7] + ((size_t)i * 32 + b) * 2 * 512 + 8 * lane;
            if (t >= 1) { unpack8(L[q][5], gc); unpack8(L[q][6], hn);
#pragma unroll
                for (int e = 0; e < 8; ++e) u1[e] = gc[e] * hn[e]; }
            else {
#pragma unroll
                for (int e = 0; e < 8; ++e) u1[e] = sample ? st[512 + e] : 0.f; }
            if (t >= 2) { unpack8(L[q][7], gc); unpack8(L[q][8], hn);
#pragma unroll
                for (int e = 0; e < 8; ++e) u2[e] = gc[e] * hn[e]; }
            else {
#pragma unroll
                for (int e = 0; e < 8; ++e) u2[e] = sample ? st[t * 512 + e] : 0.f; }
#pragma unroll
            for (int e = 0; e < 8; ++e) r[e] = gb[e] * (w0[e] * u2[e] + w1[e] * u1[e] + w2[e] * u0[e]);
            *(u32x4*)(CAT + (size_t)row * DM + 512 + 8 * lane) = pack8f(r);
            if (t >= T - 2) { float* d = (sample ? p.out + OFF_SSC + (((size_t)i * 32 + b) * 2 + (t - (T - 2))) * 512 : p.out + OFF_PSC + (((size_t)i * 4 + b) * 2 + (t - (T - 2))) * 512) + 8 * lane;
                *(f32x4*)d = (f32x4){u0[0], u0[1], u0[2], u0[3]}; *(f32x4*)(d + 4) = (f32x4){u0[4], u0[5], u0[6], u0[7]}; }
            }
        }
    }
}

__device__ __forceinline__ void phase_fox_prep(CParams& p, int i) {
    const int tid = otid(), lane = tid & 63, wid = tid >> 6;
    const bf16_t* R = (const bf16_t*)(p.ws + WS_BIG);
    bf16_t* QP = (bf16_t*)(p.ws + WS_QP); bf16_t* KP = (bf16_t*)(p.ws + WS_KP); bf16_t* VP = (bf16_t*)(p.ws + WS_VP);
    bf16_t* QS = (bf16_t*)(p.ws + WS_QS); bf16_t* KS = (bf16_t*)(p.ws + WS_KS); bf16_t* VS = (bf16_t*)(p.ws + WS_VS);
    for (int task = blockIdx.x + gridDim.x * wid; task < 288; task += gridDim.x * 8) {
        const float* src0; const float* src1; int len, n0; float* dst;
        if (task < 32) { const int bb = task >> 3, hh = task & 7; src0 = p.out + OFF_PLF + ((size_t)i * MP + (size_t)bb * 4096) * 8 + hh; src1 = src0; len = 4096; n0 = 4096; dst = (float*)(p.ws + WS_NCP) + task * 4096; }
        else { const int j = task - 32, bb = j >> 3, hh = j & 7; src0 = p.in[4] + ((size_t)i * 32 + bb) * 1024 * 8 + hh; src1 = p.out + OFF_SLF + ((size_t)i * MS + (size_t)bb * 64) * 8 + hh - (size_t)1024 * 8; len = 1088; n0 = 1024; dst = (float*)(p.ws + WS_NCS) + j * 1088; }
        float carry = 0.f;
        for (int s0 = 0; s0 < len; s0 += 512) {
            float v[8];
#pragma unroll
            for (int q = 0; q < 8; ++q) { const int s = s0 + 64 * q + lane; v[q] = s < len ? (s < n0 ? src0[(size_t)s * 8] : src1[(size_t)s * 8]) : 0.f; }
#pragma unroll
            for (int q = 0; q < 8; ++q) { const int s = s0 + 64 * q + lane; float x = wave_incl_scan(v[q], lane) + carry;
                if (s < len) dst[s] = -x * 11.313708498984761f;
                carry = __shfl(x, 63); }
        }
    }
    float qg[8], kg[8];
    { const float* a = p.in[19] + i * 128 + ((8 * lane) & 127); const float* c = p.in[20] + i * 128 + ((8 * lane) & 127);
#pragma unroll
      for (int e = 0; e < 8; ++e) { qg[e] = a[e]; kg[e] = c[e]; } }
    const int stride = gridDim.x * 8;
    for (int row0 = blockIdx.x * 8 + wid; row0 < MT; row0 += 2 * stride) {
        u32x4 L[2][6]; int rows[2]; rows[0] = row0; rows[1] = row0 + stride < MT ? row0 + stride : row0;
#pragma unroll
        for (int q = 0; q < 2; ++q) { const bf16_t* rr = R + (size_t)rows[q] * NO + 8 * lane;
#pragma unroll
            for (int hf = 0; hf < 2; ++hf) { L[q][hf * 3] = *(const u32x4*)(rr + hf * 512); L[q][hf * 3 + 1] = *(const u32x4*)(rr + 1024 + hf * 512); L[q][hf * 3 + 2] = *(const u32x4*)(rr + 2048 + hf * 512); } }
#pragma unroll
        for (int q = 0; q < 2; ++q) {
            const int row = rows[q];
            if (q == 1 && row0 + stride >= MT) break;
            float* fK; float* fV; size_t qbase, kbase; int qstr, kstr; bf16_t* Qd; bf16_t* Kd; bf16_t* Vd;
            if (row < MP) { const int bb = row >> 12, s_ = row & 4095; fK = p.out + OFF_PK + ((size_t)i * MP + row) * 1024; fV = p.out + OFF_PV + ((size_t)i * MP + row) * 1024;
                Qd = QP; Kd = KP; Vd = VP; qstr = 4096; kstr = 4096; qbase = (size_t)bb * 8 * 4096 + s_; kbase = qbase; }
            else { const int r2 = row - MP, bb = r2 >> 6, s_ = r2 & 63; fK = p.out + OFF_SK + ((size_t)i * MS + r2) * 1024; fV = p.out + OFF_SV + ((size_t)i * MS + r2) * 1024;
                Qd = nullptr; Kd = nullptr; Vd = nullptr; qstr = 64; kstr = 0; qbase = (size_t)bb * 8 * 64 + s_; kbase = 0; }
            const bool smp = row >= MP;
#pragma unroll
            for (int hf = 0; hf < 2; ++hf) {
                const int col = hf * 512 + 8 * lane, hh = col >> 7, d = col & 127;
                float x[8], r[8]; float ss;
                unpack8(L[q][hf * 3], x); ss = 0.f;
#pragma unroll
                for (int e = 0; e < 8; ++e) ss = fmaf(x[e], x[e], ss);
                ss = grp16_sum(ss); { const float rms = 1.f / sqrtf(ss * (1.f / 128.f) + EPS);
#pragma unroll
                  for (int e = 0; e < 8; ++e) r[e] = x[e] * rms * qg[e]; }
                if (smp) { float* qd = (float*)(p.ws + WS_KS) + (qbase + (size_t)hh * qstr) * 128 + d;
                    *(f32x4*)qd = (f32x4){r[0], r[1], r[2], r[3]}; *(f32x4*)(qd + 4) = (f32x4){r[4], r[5], r[6], r[7]}; }
                else *(u32x4*)(Qd + (qbase + (size_t)hh * qstr) * 128 + d) = pack8f(r);
                unpack8(L[q][hf * 3 + 1], x); ss = 0.f;
#pragma unroll
                for (int e = 0; e < 8; ++e) ss = fmaf(x[e], x[e], ss);
                ss = grp16_sum(ss); { const float rms = 1.f / sqrtf(ss * (1.f / 128.f) + EPS);
#pragma unroll
                  for (int e = 0; e < 8; ++e) r[e] = x[e] * rms * kg[e]; }
                *(f32x4*)(fK + col) = (f32x4){r[0], r[1], r[2], r[3]}; *(f32x4*)(fK + col + 4) = (f32x4){r[4], r[5], r[6], r[7]};
                if (!smp) *(u32x4*)(Kd + (kbase + (size_t)hh * kstr) * 128 + d) = pack8f(r);
                const u32x4 vw = L[q][hf * 3 + 2]; unpack8(vw, x);
                *(f32x4*)(fV + col) = (f32x4){x[0], x[1], x[2], x[3]}; *(f32x4*)(fV + col + 4) = (f32x4){x[4], x[5], x[6], x[7]};
                if (!smp) *(u32x4*)(Vd + (kbase + (size_t)hh * kstr) * 128 + d) = vw;
            }
        }
    }
}

typedef fa::BlockRef<bf16_t, bf16_t> FaRef;
typedef fa::BlockRef<float, bf16_t> FaRefS;
__device__ __forceinline__ FaRef fox_ref(CParams& p, int g, int k) {
    FaRef r;
    const int xcd = g & 7, j = g >> 3, bh = 4 * xcd + (j >> 3), x = j & 7, bb = bh >> 3, hh = bh & 7, blk = k ? 15 - x : x;
    r.Q = (const bf16_t*)(p.ws + WS_QP) + ((size_t)bh * 4096 + 256 * blk) * 128; r.K = (const bf16_t*)(p.ws + WS_KP) + (size_t)bh * 4096 * 128; r.V = (const bf16_t*)(p.ws + WS_VP) + (size_t)bh * 4096 * 128;
    r.K2 = r.K; r.V2 = r.V;
    r.O = (bf16_t*)(p.ws + WS_CAT) + ((size_t)bb * 4096 + 256 * blk) * 1024 + hh * 128; r.NC = (const float*)(p.ws + WS_NCP) + (size_t)bh * 4096; r.P0 = 256 * blk; r.nrows = 256;
    return r;
}
__device__ __forceinline__ FaRefS fox_ref_s(CParams& p, int i, int g) {
    FaRefS r; const int bh = g, bb = g >> 3, hh = g & 7;
    r.Q = (const float*)(p.ws + WS_KS) + (size_t)bh * 64 * 128;
    r.K = p.in[2] + ((size_t)i * 32 + bb) * 1024 * 1024 + hh * 128; r.V = p.in[3] + ((size_t)i * 32 + bb) * 1024 * 1024 + hh * 128;
    r.K2 = p.out + OFF_SK + ((size_t)i * MS + bb * 64) * 1024 + hh * 128 - (size_t)1024 * 1024; r.V2 = p.out + OFF_SV + ((size_t)i * MS + bb * 64) * 1024 + hh * 128 - (size_t)1024 * 1024;
    r.O = (bf16_t*)(p.ws + WS_CAT) + ((size_t)MP + bb * 64) * 1024 + hh * 128; r.NC = (const float*)(p.ws + WS_NCS) + (size_t)bh * 1088; r.P0 = 1024; r.nrows = 64;
    return r;
}
__device__ __forceinline__ void phase_fox_attn(CParams& p, int i, unsigned char* shm) {
    constexpr int W = 1 << 20;
    for (int g = blockIdx.x; g < 256; g += gridDim.x) {
#pragma unroll 1
        for (int k = 0; k < 2; ++k) {
            int kk = k; asm volatile("" : "+s"(kk));
            fa::Seam<bf16_t> S;
            const FaRef cur = fox_ref(p, g, kk);
            fa::causal_swa_prime<bf16_t, bf16_t>(cur, W, (char*)shm, S);
            fa::causal_swa_block<bf16_t, bf16_t>(cur, cur, 4096, W, (char*)shm, S);
        }
        { fa::Seam<float> S;
          const FaRefS cur = fox_ref_s(p, i, g);
          fa::causal_swa_prime<float, bf16_t>(cur, W, (char*)shm, S);
          fa::causal_swa_block<float, bf16_t>(cur, cur, 1088, W, (char*)shm, S); }
    }
}

__device__ __forceinline__ CParams* kparams() {
    CParams* k = (CParams*)__builtin_amdgcn_kernarg_segment_ptr(); asm volatile("" : "+s"(k)); return k;
}
__global__ __launch_bounds__(512, 2) void mega_fwd(Params p_unused) {
    extern __shared__ __attribute__((aligned(16))) unsigned char shm[];
    cg::grid_group grid = cg::this_grid();
    PG8_LAS unsigned char* lds = (PG8_LAS unsigned char*)shm;
    int ph = 0;
#ifndef PROBE_REP
#define PROBE_REP 0
#endif
#define GSYNC() do { XcdBarrier xb_; xb_.bar = (unsigned*)(kparams()->ws + WS_BAR); xb_.x = xb_xcc_id(); xb_.st = (volatile XB_LAS unsigned*)(lds + LDS_XB); xcd_barrier(xb_); } while (0)
#if PROBE_REP
#define PHASE(kind, ...) do { CParams& p = *kparams(); if (ph >= p.ph_lo && ph < p.ph_hi) { int nrep = 1 + ((PROBE_REP >> (kind)) & 1); asm volatile("" : "+s"(nrep)); \
        for (int rep = 0; rep < nrep; ++rep) { __VA_ARGS__; if (rep + 1 < nrep || ph + 1 < p.ph_hi) GSYNC(); } } ++ph; } while (0)
#else
#define PHASE(kind, ...) do { CParams& p = *kparams(); if (ph >= p.ph_lo && ph < p.ph_hi) { __VA_ARGS__; if (ph + 1 < p.ph_hi) GSYNC(); } ++ph; } while (0)
#endif
    if (otid() == 0) { *(volatile XB_LAS unsigned*)(lds + LDS_XB) = 0u; *(volatile XB_LAS unsigned*)(lds + LDS_XB + 4) = 0u; }
    __syncthreads();
    (void)xcd_barrier_post((unsigned*)(kparams()->ws + WS_BAR), (volatile XB_LAS unsigned*)(lds + LDS_XB));
    if (kparams()->ph_hi - kparams()->ph_lo > 1) grid.sync();
    PHASE(0, phase_init(p, shm));
#pragma unroll 1
    for (int layer = 0; layer < 4; ++layer) {
        const int i = layer >> 1; const bool even = (layer & 1) == 0;
        if (even) PHASE(1, phase_norm<0>(p, layer, shm, layer ? tail_parts(DFF, (int)gridDim.x) : 0)); else PHASE(1, phase_norm<1>(p, layer, shm, tail_parts(DFF, (int)gridDim.x)));
        PHASE(2, const bf16_t* Bt = even ? (const bf16_t*)(p.ws + WS_WINE) + (size_t)i * NE * DM : (const bf16_t*)(p.ws + WS_WINO) + (size_t)i * NO * DM;
              EpiBf16Plain E; E.O = (bf16_t*)(p.ws + WS_BIG); E.ldc = even ? NE : NO;
              run_gemm(lds, (const bf16_t*)(p.ws + WS_H), Bt, even ? NE : NO, DM, E));
        if (even) { PHASE(3, phase_gdn_prep(p, i, shm));
                    PHASE(4, phase_gdn_scan(p, i, shm); __syncthreads();
                             if (gridDim.x > 64) { if (blockIdx.x >= 64) { if (layer == 0) convert_weights(p, shm, 1, 4, (int)blockIdx.x - 64, (int)gridDim.x - 64);
                                                                           phase_gdn_post<2>(p, i, (int)blockIdx.x - 64, (int)gridDim.x - 64); } }
                             else { if (layer == 0) convert_weights(p, shm, 1, 4, (int)blockIdx.x, (int)gridDim.x); phase_gdn_post<2>(p, i, (int)blockIdx.x, (int)gridDim.x); });
                    PHASE(5, phase_gdn_post<1>(p, i, (int)blockIdx.x, (int)gridDim.x)); }
        else { PHASE(6, phase_fox_prep(p, i)); PHASE(7, phase_fox_attn(p, i, shm)); }
        PHASE(31, const bf16_t* Bt = even ? (const bf16_t*)(p.ws + WS_WOUTE) + (size_t)i * DM * DM : (const bf16_t*)(p.ws + WS_WOUTO) + (size_t)i * DM * DM;
              EpiResid E; E.X = p.out; E.ldc = DM; E.slab = (float*)(p.ws + WS_SLAB);
              run_gemm_n1024(lds, (const bf16_t*)(p.ws + WS_CAT), Bt, DM, E));
        PHASE(1, phase_norm<2>(p, layer, shm, tail_parts(DM, (int)gridDim.x)));
        PHASE(9, EpiSwiglu E; E.O = (bf16_t*)(p.ws + WS_BIG); E.ldc = DFF;
              run_gemm(lds, (const bf16_t*)(p.ws + WS_H), (const bf16_t*)(p.ws + WS_WF1) + (size_t)layer * NF1 * DM, NF1, DM, E));
        PHASE(31, EpiResid E; E.X = p.out; E.ldc = DM; E.slab = (float*)(p.ws + WS_SLAB);
              run_gemm_n1024(lds, (const bf16_t*)(p.ws + WS_BIG), (const bf16_t*)(p.ws + WS_WF2) + (size_t)layer * DM * DFF, DFF, E));
    }
    PHASE(1, phase_fixup(p, tail_parts(DFF, (int)gridDim.x)));
#undef PHASE
}
constexpr int N_PHASES = 1 + 2 * 9 + 2 * 8 + 1;

#ifndef MK_PER_PHASE
#define MK_PER_PHASE 0
#endif
extern "C" void kernel_launch(void* const* d_in, const int* in_sizes, int n_in, void* d_out, int out_size, void* d_ws, size_t ws_size, hipStream_t stream) {
    static int grid = 0;
    if (grid == 0) {
        if (n_in != 25 || (size_t)out_size != OUT_TOTAL || ws_size < WS_END) { fprintf(stderr, "kernel_launch: unexpected shapes (n_in %d, out %d, ws %zu < %zu)\n", n_in, out_size, ws_size, (size_t)WS_END); grid = -1; return; }
        int dev = 0, cus = 0, per_cu = 0;
        (void)hipGetDevice(&dev); (void)hipDeviceGetAttribute(&cus, hipDeviceAttributeMultiprocessorCount, dev);
        if (hipFuncSetAttribute((const void*)mega_fwd, hipFuncAttributeMaxDynamicSharedMemorySize, LDS_BYTES) != hipSuccess) { fprintf(stderr, "kernel_launch: hipFuncSetAttribute failed\n"); grid = -1; return; }
        if (hipOccupancyMaxActiveBlocksPerMultiprocessor(&per_cu, (const void*)mega_fwd, 512, LDS_BYTES) != hipSuccess || per_cu < 1) { fprintf(stderr, "kernel_launch: occupancy query says %d\n", per_cu); per_cu = 1; }
        (void)hipGetLastError();
        if (cus <= 0) cus = 256;
        grid = cus * 1;
    }
    if (grid < 0) return;
    (void)hipMemsetAsync((unsigned char*)d_ws + WS_BAR, 0, 16384, stream);
    Params p{};
    for (int k = 0; k < 25; ++k) p.in[k] = (const float*)d_in[k];
    p.out = (float*)d_out; p.ws = (unsigned char*)d_ws;
#if MK_PER_PHASE
    for (int ph = 0; ph < N_PHASES; ++ph) { p.ph_lo = ph; p.ph_hi = ph + 1; hipLaunchKernelGGL(mega_fwd, dim3(grid), dim3(512), LDS_BYTES, stream, p); }
#else
    p.ph_lo = 0; p.ph_hi = N_PHASES;
    void* args[] = {&p};
    hipError_t e = hipLaunchCooperativeKernel((const void*)mega_fwd, dim3(grid), dim3(512), args, LDS_BYTES, stream);
    if (e != hipSuccess) fprintf(stderr, "kernel_launch: cooperative launch failed: %s (grid %d)\n", hipGetErrorString(e), grid);
#endif
}
```

```cpp
#include <hip/hip_runtime.h>
#include <hip/hip_cooperative_groups.h>
#include <cstdio>
#include <cstdint>
namespace cg = cooperative_groups;

typedef unsigned short bf16_t;
typedef short bf16x8 __attribute__((ext_vector_type(8)));
typedef short s16x4 __attribute__((ext_vector_type(4)));
typedef float f32x16 __attribute__((ext_vector_type(16)));
typedef float f32x4 __attribute__((ext_vector_type(4)));
typedef unsigned u32x4 __attribute__((ext_vector_type(4)));
typedef unsigned u32x2 __attribute__((ext_vector_type(2)));

constexpr int DM = 1024, MP = 16384, MS = 2048, MT = MP + MS;
constexpr int EVEN_IN = 3592, ODD_IN = 3080, NE = 3584, NO = 3072, DFF = 2816, NF1 = 2 * DFF;
constexpr float EPS = 1e-6f;
constexpr size_t OFF_Y = 0;
constexpr size_t OFF_PK = (size_t)MT * DM;
constexpr size_t OFF_PV = OFF_PK + (size_t)2 * MP * 1024;
constexpr size_t OFF_PLF = OFF_PV + (size_t)2 * MP * 1024;
constexpr size_t OFF_PS = OFF_PLF + (size_t)2 * MP * 8;
constexpr size_t OFF_PCONV = OFF_PS + (size_t)2 * 4 * 4 * 128 * 128;
constexpr size_t OFF_PSC = OFF_PCONV + (size_t)2 * 4 * 3 * 1536;
constexpr size_t OFF_SK = OFF_PSC + (size_t)2 * 4 * 2 * 512;
constexpr size_t OFF_SV = OFF_SK + (size_t)2 * MS * 1024;
constexpr size_t OFF_SLF = OFF_SV + (size_t)2 * MS * 1024;
constexpr size_t OFF_SS = OFF_SLF + (size_t)2 * MS * 8;
constexpr size_t OFF_SCONV = OFF_SS + (size_t)2 * 32 * 4 * 128 * 128;
constexpr size_t OFF_SSC = OFF_SCONV + (size_t)2 * 32 * 3 * 1536;
constexpr size_t OUT_TOTAL = OFF_SSC + (size_t)2 * 32 * 2 * 512;
static_assert(OUT_TOTAL == 99790848, "output size");
constexpr size_t WS_WINE = 0;
constexpr size_t WS_WOUTE = WS_WINE + (size_t)2 * NE * DM * 2;
constexpr size_t WS_WINO = WS_WOUTE + (size_t)2 * DM * DM * 2;
constexpr size_t WS_WOUTO = WS_WINO + (size_t)2 * NO * DM * 2;
constexpr size_t WS_WF1 = WS_WOUTO + (size_t)2 * DM * DM * 2;
constexpr size_t WS_WF2 = WS_WF1 + (size_t)4 * NF1 * DM * 2;
constexpr size_t WS_H = WS_WF2 + (size_t)4 * DM * DFF * 2;
constexpr size_t WS_BIG = WS_H + (size_t)MT * DM * 2;
constexpr size_t WS_CAT = WS_BIG + (size_t)MT * NE * 2;
constexpr size_t WS_AB = WS_CAT + (size_t)MT * DM * 2;
constexpr size_t WS_OG = WS_AB + (size_t)MT * 8 * 4;
constexpr size_t WS_GC = WS_OG + (size_t)MT * 512 * 2;
constexpr size_t WS_NEGW = WS_GC + 8192;
constexpr size_t WS_QG = WS_NEGW + (size_t)1152 * 16384;
constexpr size_t WS_KDT = WS_QG + (size_t)1152 * 16384;
constexpr size_t WS_PM = WS_KDT + (size_t)1152 * 16384;
constexpr size_t WS_UPRE = WS_PM + (size_t)1152 * 8192;
constexpr size_t WS_QP = WS_UPRE + (size_t)1152 * 16384;
constexpr size_t WS_KP = WS_QP + (size_t)32 * 4096 * 128 * 2;
constexpr size_t WS_VP = WS_KP + (size_t)32 * 4096 * 128 * 2;
constexpr size_t WS_QS = WS_VP + (size_t)32 * 4096 * 128 * 2;
constexpr size_t WS_KS = WS_QS + (size_t)256 * 64 * 128 * 2 + 65536;
constexpr size_t WS_VS = WS_KS + (size_t)256 * 1088 * 128 * 2;
constexpr size_t WS_NCP = WS_VS + (size_t)256 * 1088 * 128 * 2;
constexpr size_t WS_NCS = WS_NCP + (size_t)32 * 4096 * 4;
constexpr size_t WS_BAR = WS_NCS + (size_t)256 * 1088 * 4;
constexpr size_t WS_SLAB = WS_BAR + 16384;
constexpr size_t WS_END = WS_SLAB + (size_t)8 * MS * DM * 4;
constexpr int LDS_BYTES = 163840;
constexpr int LDS_XB = LDS_BYTES - 16;

struct Params { const float* in[25]; float* out; unsigned char* ws; int ph_lo, ph_hi; };
typedef const __attribute__((address_space(4))) Params CParams;

#define KSWZ(row, colB) ((row) * 256 + ((colB) ^ (((row) & 7) << 4)))
#define SBAR() __builtin_amdgcn_sched_barrier(0)
template <class A, class Bt> struct same_t { static constexpr bool v = false; };
template <class A> struct same_t<A, A> { static constexpr bool v = true; };
__device__ __forceinline__ int otid() { int t = threadIdx.x; asm volatile("" : "+v"(t)); return t; }
#define LBAR() asm volatile("s_waitcnt lgkmcnt(0)\n\ts_barrier" ::: "memory")
namespace pg8 {
#define PG8_LAS __attribute__((address_space(3)))
typedef unsigned short bf16_t;
typedef short bf16x8 __attribute__((ext_vector_type(8)));
typedef float f32x4 __attribute__((ext_vector_type(4)));
typedef unsigned u32x4 __attribute__((ext_vector_type(4)));
constexpr int BM = 256, BK = 64, HALF = 128, HTB = HALF * BK * 2  , STAGE_BYTES = 8 * HTB, NXCD = 8, WGM = 8;

__host__ __device__ __forceinline__ int lds_byte(int r, int c) { const int st = (r >> 4) * 2 + (c >> 5), rr = r & 15, cc = c & 31, ob = rr * 64 + cc * 2; return st * 1024 + (ob ^ (((ob >> 9) & 1) << 5)); }
__host__ __device__ __forceinline__ void stage_rc(int b, int& R, int& C) { const int st = b / 1024, sb = b % 1024, swz = sb ^ (((sb >> 9) & 1) << 5); R = (st >> 1) * 16 + swz / 64; C = (st & 1) * 32 + (swz % 64) / 2; }
__host__ __device__ __forceinline__ int perm32(int rho) { const int n = rho >> 4, i = rho & 15; return 8 * (i >> 2) + 4 * n + (i & 3); }

struct Unit { int pm, pn, kt0, nkt, split; };
struct Gemm { const bf16_t* A; const bf16_t* Bt; int M, N, K; };

struct StaticOrder {
    int nM, nN, nwg, G, c, nktf;
    __host__ __device__ void init(int M, int N, int G_, int c_) { nM = M / BM; nN = N / BM; nwg = nM * nN; G = G_; c = c_; }
    __host__ __device__ bool next(int i, Unit& u) const {
        const long L = (long)i * G + c; if (L >= nwg) return false;
        int wgid = (int)L; { const int q = nwg / NXCD, r = nwg % NXCD, xcd = wgid % NXCD, off = wgid / NXCD; wgid = (xcd < r ? xcd * (q + 1) : r * (q + 1) + (xcd - r) * q) + off; }
        const int nig = WGM * nN, gid = wgid / nig, fm = gid * WGM, gsz = (nM - fm) < WGM ? (nM - fm) : WGM;
        u.pm = fm + ((wgid % nig) % gsz); u.pn = (wgid % nig) / gsz; u.kt0 = 0; u.nkt = nktf; u.split = 0; return true;
    }
    __device__ __forceinline__ void a_ready(const Unit&) const {}
    __device__ __forceinline__ void done(const Unit&) const {}
};
__device__ __forceinline__ unsigned cvt_pk_bf16(float lo, float hi) { unsigned r; asm volatile("v_cvt_pk_bf16_f32 %0, %1, %2" : "=v"(r) : "v"(lo), "v"(hi)); return r; }
template <class Epi, class Sched, bool STAMP = false>
__device__ __forceinline__ void gemm_phase(PG8_LAS unsigned char* lds, const Gemm g, const Sched& S, const Epi& E, unsigned long long* stamps) {
    const int tid = otid(), wid = __builtin_amdgcn_readfirstlane(tid >> 6), lane = tid & 63, wr = wid >> 2, wc = wid & 3, fr = lane & 15, fq = lane >> 4;
    const int K = g.K;
    int ts_lo = 0, ts_hi = 0, nts = 0; const unsigned long long rt_entry = STAMP ? (unsigned long long)wall_clock64() : 0ull;
#define PG8_STAMP() do { if (STAMP && wid == 0 && nts < 64) { const unsigned long long _c = (unsigned long long)clock64(); \
        ts_lo = (lane == nts) ? (int)(unsigned)_c : ts_lo; ts_hi = (lane == nts) ? (int)(unsigned)(_c >> 32) : ts_hi; ++nts; } } while (0)
    PG8_STAMP();
    unsigned voffA[2], voffB[2];
#pragma unroll
    for (int i = 0; i < 2; ++i) { int R, C; stage_rc(tid * 16 + i * 8192, R, C); const int Rb = Epi::PERM ? ((R & ~31) + perm32(R & 31)) : R;
        voffA[i] = (unsigned)(R * K + C) * 2u; voffB[i] = (unsigned)(Rb * K + C) * 2u; }
    const size_t kstep = (size_t)(BK * 2);
    const size_t hstep = (size_t)HALF * K * 2;
    const size_t tstep = 2 * hstep;
    const unsigned ldsw = (unsigned)wid * 1024u;
    const int aoff = lds_byte(wr * 64 + fr, fq * 8), boff = lds_byte(wc * 32 + fr, fq * 8);
#define PG8_SA(b, h) (((b) * 2 + (h)) * HTB)
#define PG8_SB(b, h) ((4 + (b) * 2 + (h)) * HTB)
#define PG8_STAGE(bufoff, gbase, voff) do { _Pragma("unroll") for (int _i = 0; _i < 2; ++_i) \
        __builtin_amdgcn_global_load_lds((const unsigned*)((const char*)(gbase) + (voff)[_i]), (PG8_LAS unsigned*)(lds + (bufoff) + ldsw + _i * 8192), 16, 0, 0); } while (0)
#define PG8_LDA(dst, b, h) do { _Pragma("unroll") for (int m = 0; m < 4; ++m) _Pragma("unroll") for (int k = 0; k < 2; ++k) dst[m][k] = *(const PG8_LAS bf16x8*)(lds + PG8_SA(b, h) + aoff + m * 2048 + k * 1024); } while (0)
#define PG8_LDB(dst, b, h) do { _Pragma("unroll") for (int n = 0; n < 2; ++n) _Pragma("unroll") for (int k = 0; k < 2; ++k) dst[n][k] = *(const PG8_LAS bf16x8*)(lds + PG8_SB(b, h) + boff + n * 2048 + k * 1024); } while (0)
#define PG8_MMA(ai, bj, At, Bt) do { __builtin_amdgcn_s_setprio(1); _Pragma("unroll") for (int m = 0; m < 4; ++m) _Pragma("unroll") for (int n = 0; n < 2; ++n) _Pragma("unroll") for (int k = 0; k < 2; ++k) \
        acc[ai][bj][m][n] = __builtin_amdgcn_mfma_f32_16x16x32_bf16(Bt[n][k], At[m][k], acc[ai][bj][m][n], 0, 0, 0); __builtin_amdgcn_s_setprio(0); } while (0)
#define PG8_WAIT_V(n) asm volatile("s_waitcnt vmcnt(" #n ")" ::: "memory")
#define PG8_WAIT_L(n) asm volatile("s_waitcnt lgkmcnt(" #n ")" ::: "memory")
#define PG8_BAR __builtin_amdgcn_s_barrier()
#define PG8_SCHED __builtin_amdgcn_sched_barrier(0)
    Unit cur, nxt; int ui = 0;
    if (!S.next(0, cur)) return;
    f32x4 acc[2][2][4][2];
#pragma unroll
    for (int a = 0; a < 2; ++a)
#pragma unroll
        for (int b = 0; b < 2; ++b)
#pragma unroll
            for (int m = 0; m < 4; ++m)
#pragma unroll
                for (int n = 0; n < 2; ++n) acc[a][b][m][n] = (f32x4){0.f, 0.f, 0.f, 0.f};
    bf16x8 At[4][2], B0[2][2], B1[2][2];
    const char* cA = (const char*)g.A + (size_t)cur.pm * tstep + (size_t)cur.kt0 * kstep; const char* cB = (const char*)g.Bt + (size_t)cur.pn * tstep + (size_t)cur.kt0 * kstep;
    S.a_ready(cur);
    PG8_STAGE(PG8_SB(0, 0), cB, voffB); PG8_STAGE(PG8_SA(0, 0), cA, voffA); PG8_STAGE(PG8_SB(0, 1), cB + hstep, voffB); PG8_STAGE(PG8_SA(0, 1), cA + hstep, voffA);
    if (wr == 1) PG8_BAR;
    PG8_WAIT_V(4); PG8_BAR;
    PG8_STAGE(PG8_SB(1, 0), cB + kstep, voffB); PG8_STAGE(PG8_SA(1, 0), cA + kstep, voffA); PG8_STAGE(PG8_SB(1, 1), cB + hstep + kstep, voffB);
    PG8_WAIT_V(6); PG8_BAR;
    PG8_STAMP();
    for (;;) {
        const bool has_next = S.next(ui + 1, nxt);
        const char* nA = has_next ? (const char*)g.A + (size_t)nxt.pm * tstep + (size_t)nxt.kt0 * kstep : cA; const char* nB = has_next ? (const char*)g.Bt + (size_t)nxt.pn * tstep + (size_t)nxt.kt0 * kstep : cB;
        const int nt = cur.nkt;
        for (int t = 0; t < nt; t += 2) {
            const bool last = (t == nt - 2);
            const char* a1 = cA + (size_t)(t + 1) * kstep;
            const char* a2 = last ? nA : cA + (size_t)(t + 2) * kstep; const char* b2 = last ? nB : cB + (size_t)(t + 2) * kstep;
            const char* a3 = a2 + kstep; const char* b3 = b2 + kstep;
            if (last && has_next) S.a_ready(nxt);
            PG8_LDB(B0, 0, 0); PG8_SCHED; PG8_LDA(At, 0, 0); PG8_STAGE(PG8_SA(1, 1), a1 + hstep, voffA);
            PG8_WAIT_L(8); PG8_BAR; PG8_WAIT_L(0); PG8_MMA(0, 0, At, B0); PG8_BAR; PG8_SCHED;
            PG8_LDB(B1, 0, 1); PG8_STAGE(PG8_SB(0, 0), b2, voffB);
            PG8_BAR; PG8_WAIT_L(0); PG8_MMA(0, 1, At, B1); PG8_BAR;
            PG8_LDA(At, 0, 1); PG8_STAGE(PG8_SA(0, 0), a2, voffA);
            PG8_BAR; PG8_WAIT_L(0); PG8_MMA(1, 0, At, B0); PG8_BAR; PG8_SCHED;
            PG8_STAGE(PG8_SB(0, 1), b2 + hstep, voffB);
            PG8_WAIT_V(6); PG8_BAR; PG8_MMA(1, 1, At, B1); PG8_BAR;
            PG8_LDB(B0, 1, 0); PG8_SCHED; PG8_LDA(At, 1, 0); PG8_STAGE(PG8_SA(0, 1), a2 + hstep, voffA);
            PG8_WAIT_L(8); PG8_BAR; PG8_WAIT_L(0); PG8_MMA(0, 0, At, B0); PG8_BAR; PG8_SCHED;
            PG8_LDB(B1, 1, 1); PG8_STAGE(PG8_SB(1, 0), b3, voffB);
            PG8_BAR; PG8_WAIT_L(0); PG8_MMA(0, 1, At, B1); PG8_BAR;
            PG8_LDA(At, 1, 1); PG8_STAGE(PG8_SA(1, 0), a3, voffA);
            PG8_BAR; PG8_WAIT_L(0); PG8_MMA(1, 0, At, B0); PG8_BAR; PG8_SCHED;
            PG8_STAGE(PG8_SB(1, 1), b3 + hstep, voffB);
            PG8_WAIT_V(6); PG8_BAR; PG8_MMA(1, 1, At, B1); PG8_BAR;
        }
        PG8_STAMP();
        if constexpr (!Epi::AFTER_DRAIN) { E(acc, cur, wr, wc, fr, fq); S.done(cur); }
        PG8_STAMP();
        if (!has_next) break;
#pragma unroll
        for (int a = 0; a < 2; ++a)
#pragma unroll
            for (int b = 0; b < 2; ++b)
#pragma unroll
                for (int m = 0; m < 4; ++m)
#pragma unroll
                    for (int n = 0; n < 2; ++n) acc[a][b][m][n] = (f32x4){0.f, 0.f, 0.f, 0.f};
        cur = nxt; cA = nA; cB = nB; ++ui;
    }
    PG8_WAIT_V(0);
    if (wr == 0) PG8_BAR;
    PG8_BAR;
    if constexpr (Epi::AFTER_DRAIN) { E.fused(acc, cur, wr, wc, fr, fq, lds, wid, lane); S.done(cur); }
    PG8_STAMP();
    if (STAMP && wid == 0) { stamps[lane] = lane < nts ? (((unsigned long long)(unsigned)ts_hi << 32) | (unsigned)ts_lo) : 0ull;
        if (lane == 62) stamps[62] = rt_entry; if (lane == 63) stamps[63] = (unsigned long long)wall_clock64(); }
#undef PG8_STAMP
#undef PG8_SA
#undef PG8_SB
#undef PG8_STAGE
#undef PG8_LDA
#undef PG8_LDB
#undef PG8_MMA
#undef PG8_WAIT_V
#undef PG8_WAIT_L
#undef PG8_BAR
#undef PG8_SCHED
}
}
namespace fa {
constexpr int D = 128, OSTR = 1024;
constexpr float SCALE = 0.08838834764831845f;
constexpr float THR = 8.f;
constexpr bool WSKIP = false;
constexpr int NW = 8, QBLK = 32, KVBLK = 64, QB = NW * QBLK;
constexpr int SHM_V = KVBLK * D * 2, SHM_K = KVBLK * D * 2;
__device__ __forceinline__ int v_st(int k, int c) { const int kk = (k & ~0xC) | ((k & 4) << 1) | ((k & 8) >> 1); return ((kk >> 3) * 4 + (c >> 5)) * 512 + ((kk & 7) * 32 + (c & 31)) * 2; }
__device__ __forceinline__ int v_rd_base(int lane) { return ((lane & 3) << 3) | (((lane >> 2) & 3) << 6) | (((lane >> 4) & 1) << 5) | (((lane >> 5) & 1) << 8); }
constexpr int v_rd_off(int d0, int ks, int half) { return d0 * 512 + ks * 4096 + half * 2048; }
__device__ __forceinline__ int crow(int r, int hi) { return (r & 3) + 8 * (r >> 2) + 4 * hi; }
__device__ __forceinline__ unsigned cvtpk(float lo, float hi) {
    unsigned r; asm volatile("v_cvt_pk_bf16_f32 %0, %1, %2" : "=v"(r) : "v"(lo), "v"(hi)); return r;
}
__device__ __forceinline__ bf16x8 pack8(f32x4 a, f32x4 b) {
    u32x4 w = {cvtpk(a[0], a[1]), cvtpk(a[2], a[3]), cvtpk(b[0], b[1]), cvtpk(b[2], b[3])};
    return *reinterpret_cast<bf16x8*>(&w);
}
template <class T> __device__ __forceinline__ bf16x8 load8(const T* p) {
    if constexpr (same_t<T, float>::v) { return pack8(*(const f32x4*)p, *(const f32x4*)(p + 4)); }
    else { return *reinterpret_cast<const bf16x8*>(p); }
}
__device__ __forceinline__ void mask_tile(f32x16& p0, f32x16& p1, int dq, unsigned W) {
    const float NEG = -__builtin_inff();
#pragma unroll
    for (int r = 0; r < 16; ++r) {
        const int c = (r & 3) + 8 * (r >> 2);
        if ((unsigned)(dq - c) >= W) p0[r] = NEG;
        if ((unsigned)(dq - c - 32) >= W) p1[r] = NEG;
    }
}
__device__ __forceinline__ void partialSM(f32x16& p0, f32x16& p1, float& m_reg, float& mn, float& alpha) {
    float pmax = p0[0]; for (int r = 1; r < 16; ++r) pmax = fmaxf(pmax, p0[r]); for (int r = 0; r < 16; ++r) pmax = fmaxf(pmax, p1[r]);
    { auto rr = __builtin_amdgcn_permlane32_swap(__float_as_uint(pmax), __float_as_uint(pmax), false, false);
      pmax = fmaxf(__uint_as_float(rr[0]), __uint_as_float(rr[1])); }
    constexpr float C2 = 1.4426950408889634f * SCALE;
    if (__builtin_expect(__all((pmax - m_reg) * SCALE <= THR), 1)) { mn = m_reg; alpha = 1.f; }
    else { mn = fmaxf(m_reg, pmax); alpha = __builtin_amdgcn_exp2f((m_reg - mn) * C2); m_reg = mn; }
    const float mnL = -mn * C2;
    for (int r = 0; r < 16; ++r) p0[r] = fmaf(p0[r], C2, mnL); for (int r = 0; r < 16; ++r) p1[r] = fmaf(p1[r], C2, mnL);
    for (int r = 0; r < 16; ++r) p0[r] = __builtin_amdgcn_exp2f(p0[r]);
}
__device__ __forceinline__ void finishSM(f32x16& p0, f32x16& p1, float alpha, float& l_reg, bf16x8& pa0, bf16x8& pa1, bf16x8& pa2, bf16x8& pa3) {
    for (int r = 0; r < 16; ++r) p1[r] = __builtin_amdgcn_exp2f(p1[r]);
    float ps = 0; for (int r = 0; r < 16; ++r) ps += p0[r]; for (int r = 0; r < 16; ++r) ps += p1[r];
    { auto rr = __builtin_amdgcn_permlane32_swap(__float_as_uint(ps), __float_as_uint(ps), false, false);
      ps = __uint_as_float(rr[0]) + __uint_as_float(rr[1]); }
    l_reg = l_reg * alpha + ps;
#define PK4(P, B_, OUT) do { unsigned a0 = cvtpk(P[B_+0], P[B_+1]), a1 = cvtpk(P[B_+2], P[B_+3]);                          \
        unsigned b0 = cvtpk(P[B_+4], P[B_+5]), b1 = cvtpk(P[B_+6], P[B_+7]);                                             \
        auto r0 = __builtin_amdgcn_permlane32_swap(a0, b0, false, false); auto r1 = __builtin_amdgcn_permlane32_swap(a1, b1, false, false); \
        u32x4 w = {r0[0], r1[0], r0[1], r1[1]}; OUT = *reinterpret_cast<bf16x8*>(&w); } while (0)
    PK4(p0, 0, pa0); PK4(p0, 8, pa1); PK4(p1, 0, pa2); PK4(p1, 8, pa3);
#undef PK4
}
template <int KB, bool SK>
__device__ __forceinline__ void qkt(f32x16& p0, f32x16& p1, const char* K_lds, const char* B_lds, int r32, int hi, const bf16x8* qr, bool act) {
    if (SK && !act) { const float NEG = -__builtin_inff();
#pragma unroll
        for (int r = 0; r < 16; ++r) { p0[r] = NEG; p1[r] = NEG; } return; }
    { const float* bl = (const float*)B_lds + 4 * hi;
#pragma unroll
      for (int g = 0; g < 4; ++g) { const f32x4 ba = *(const f32x4*)(bl + 8 * g); const f32x4 bb = *(const f32x4*)(bl + 32 + 8 * g);
#pragma unroll
        for (int e = 0; e < 4; ++e) { p0[4 * g + e] = ba[e]; p1[4 * g + e] = bb[e]; } } }
    const char* kb[4];
#pragma unroll
    for (int dd = 0; dd < 4; ++dd) kb[dd] = K_lds + KB * SHM_K + KSWZ(r32, (dd * 16 + hi * 8) * 2);
#pragma unroll
    for (int d0 = 0; d0 < 8; ++d0) { const char* a = kb[d0 & 3] + (d0 >> 2) * 128;
        bf16x8 b0 = *reinterpret_cast<const bf16x8*>(a);
        bf16x8 b1 = *reinterpret_cast<const bf16x8*>(a + 32 * 256);
        p0 = __builtin_amdgcn_mfma_f32_32x32x16_bf16(b0, qr[d0], p0, 0, 0, 0);
        p1 = __builtin_amdgcn_mfma_f32_32x32x16_bf16(b1, qr[d0], p1, 0, 0, 0); }
}
template <int VB, bool SK>
__device__ __forceinline__ void pv_tile(f32x16* o, int vb0, bf16x8 pa0, bf16x8 pa1, bf16x8 pa2, bf16x8 pa3, bool act) {
    if (SK && !act) return;
#define TRRD(dst, off) asm volatile("ds_read_b64_tr_b16 %0, %1 offset:%2" : "=&v"(dst) : "v"(vb0), "i"(off) : "memory")
#define PV_D0(d0) do { s16x4 l0, l1, l2, l3, h0, h1, h2, h3; constexpr int b_ = VB * SHM_V + v_rd_off(d0, 0, 0);     \
        TRRD(l0, b_); TRRD(h0, b_ + 2048); TRRD(l1, b_ + 4096); TRRD(h1, b_ + 6144); TRRD(l2, b_ + 8192); TRRD(h2, b_ + 10240); TRRD(l3, b_ + 12288); TRRD(h3, b_ + 14336); \
        asm volatile("s_waitcnt lgkmcnt(0)" ::: "memory"); SBAR();                 \
        o[d0] = __builtin_amdgcn_mfma_f32_32x32x16_bf16(pa0, (bf16x8){l0[0], l0[1], l0[2], l0[3], h0[0], h0[1], h0[2], h0[3]}, o[d0], 0, 0, 0);   \
        o[d0] = __builtin_amdgcn_mfma_f32_32x32x16_bf16(pa1, (bf16x8){l1[0], l1[1], l1[2], l1[3], h1[0], h1[1], h1[2], h1[3]}, o[d0], 0, 0, 0);   \
        o[d0] = __builtin_amdgcn_mfma_f32_32x32x16_bf16(pa2, (bf16x8){l2[0], l2[1], l2[2], l2[3], h2[0], h2[1], h2[2], h2[3]}, o[d0], 0, 0, 0);   \
        o[d0] = __builtin_amdgcn_mfma_f32_32x32x16_bf16(pa3, (bf16x8){l3[0], l3[1], l3[2], l3[3], h3[0], h3[1], h3[2], h3[3]}, o[d0], 0, 0, 0); } while (0)
    PV_D0(0); PV_D0(1); PV_D0(2); PV_D0(3);
#undef PV_D0
#undef TRRD
}

template <class TIn, class TOut> struct BlockRef { const TIn* Q; const TIn* K; const TIn* V; const TIn* K2; const TIn* V2; TOut* O; const float* NC; int P0; int nrows; };
template <class TIn> struct Seam {
    bf16x8 qr[8];
    bf16x8 st_v0, st_v1, st_k0, st_k1; f32x4 sf0, sf1, sf2, sf3;
    f32x4 tq[16];
};
__device__ __forceinline__ int swa_jlo(int P0, int W) { const int lowk = P0 - W + 1; return lowk > 0 ? lowk / KVBLK : 0; }
#define ROW(p, k0, rr) ((p) + (size_t)((k0) + (rr)) * D + sc)
#define VMW() asm volatile("s_waitcnt vmcnt(0)" ::: "memory")
#define VMWN(n) asm volatile("s_waitcnt vmcnt(%0)" :: "i"(n) : "memory")
#define SLOAD_H(Kp, Vp, NCp, k0) do { S.st_v0 = load8<TIn>(ROW(Vp, k0, sr)); S.st_v1 = load8<TIn>(ROW(Vp, k0, 32 + sr));              \
                         S.st_k0 = load8<TIn>(ROW(Kp, k0, sr)); S.st_k1 = load8<TIn>(ROW(Kp, k0, 32 + sr)); } while (0)
#define SWRITE_HK(bf) do { *(bf16x8*)(K_lds + (bf) * SHM_K + kws) = S.st_k0; *(bf16x8*)(K_lds + (bf) * SHM_K + kws + 32 * 256) = S.st_k1; } while (0)
#define SWRITE_HV(bf) do { *(bf16x8*)(V_lds + (bf) * SHM_V + vst0) = S.st_v0; *(bf16x8*)(V_lds + (bf) * SHM_V + vst1) = S.st_v1; } while (0)
#define SWRITE_H(bf) do { SWRITE_HV(bf); SWRITE_HK(bf); } while (0)
#define ROWF(p, k0, rr) ((p) + (size_t)((k0) + (rr)) * 1024 + sc)
#define FSEL(a, b, k0) ((const float*)((k0) < 1024 ? (a) : (b)))
#define SLOAD_F(p, k0) do { S.sf0 = *(const f32x4*)ROWF(p, k0, sr); S.sf1 = *(const f32x4*)(ROWF(p, k0, sr) + 4);                \
                            S.sf2 = *(const f32x4*)ROWF(p, k0, 32 + sr); S.sf3 = *(const f32x4*)(ROWF(p, k0, 32 + sr) + 4); } while (0)
#define SWRITE_KF(bf) do { *(bf16x8*)(K_lds + (bf) * SHM_K + kws) = pack8(S.sf0, S.sf1); *(bf16x8*)(K_lds + (bf) * SHM_K + kws + 32 * 256) = pack8(S.sf2, S.sf3); } while (0)
#define SWRITE_VF(bf) do { *(bf16x8*)(V_lds + (bf) * SHM_V + vst0) = pack8(S.sf0, S.sf1); *(bf16x8*)(V_lds + (bf) * SHM_V + vst1) = pack8(S.sf2, S.sf3); } while (0)
template <class TIn, class TOut>
__device__ __forceinline__ void causal_swa_prime(const BlockRef<TIn, TOut>& cur, int W, char* lds, Seam<TIn>& S) {
    constexpr bool F32 = same_t<TIn, float>::v;
    const int tid = otid(), wid = __builtin_amdgcn_readfirstlane(tid >> 6), lane = tid & 63, r32 = lane & 31, hi = lane >> 5;
    const int sr = tid >> 4, sc = (tid & 15) * 8, kws = KSWZ(sr, sc * 2); char* K_lds = lds + 2 * SHM_V; char* B_lds = lds + 2 * SHM_V + 2 * SHM_K + NW * 64 * 4;
    const int kb0 = swa_jlo(cur.P0, W) * KVBLK;
    for (int d0 = 0; d0 < 8; ++d0) S.qr[d0] = load8<TIn>(cur.Q + (size_t)(wid * QBLK + r32) * D + d0 * 16 + hi * 8);
    if constexpr (F32) { SLOAD_F(FSEL(cur.K, cur.K2, kb0), kb0); VMW(); SWRITE_KF(0); SBAR(); SLOAD_F(FSEL(cur.V, cur.V2, kb0), kb0); }
    else { SLOAD_H(cur.K, cur.V, cur.NC, kb0); VMW(); SWRITE_HK(0); }
    __syncthreads();
}
template <class TIn, class TOut>
__device__ __forceinline__ void causal_swa_block(const BlockRef<TIn, TOut>& cur, const BlockRef<TIn, TOut>& nxt, int skv, int W, char* lds, Seam<TIn>& S) {
    constexpr bool F32 = same_t<TIn, float>::v;
    const int tid = otid(), wid = __builtin_amdgcn_readfirstlane(tid >> 6), lane = tid & 63, r32 = lane & 31, hi = lane >> 5;
    const int j_lo = swa_jlo(cur.P0, W);
    int j_hi = (cur.P0 + QB - 1) / KVBLK + 1; if (j_hi > skv / KVBLK) j_hi = skv / KVBLK;
    const int NT = j_hi - j_lo;
    const int kbn = swa_jlo(nxt.P0, W) * KVBLK;
    const int qlo = cur.P0 + wid * QBLK, qm = qlo + r32 - 4 * hi;
    char* V_lds = lds; char* K_lds = lds + 2 * SHM_V; char* B_lds = lds + 2 * SHM_V + 2 * SHM_K + NW * 64 * 4;
    float* ws = (float*)(lds + 2 * SHM_V + 2 * SHM_K) + wid * 64; float* li_l = ws, * al_l = ws + 32;
    float m_reg = -1e30f, l_reg = 0; f32x16 o[4] = {};
    const int sr = tid >> 4, sc = (tid & 15) * 8, vst0 = v_st(sr, sc), vst1 = v_st(32 + sr, sc), kws = KSWZ(sr, sc * 2);
    const int vb0 = (int)(uintptr_t)V_lds + v_rd_base(lane);
    const TIn* Kh = cur.K; const TIn* Vh = cur.V;
#define RESC(a) do { if (__any((a) < 1.f)) { if (hi == 0) al_l[r32] = (a); asm volatile("s_waitcnt lgkmcnt(0)" ::: "memory");              \
                     for (int d_ = 0; d_ < 4; ++d_) for (int r = 0; r < 16; ++r) o[d_][r] *= al_l[crow(r, hi)]; } } while (0)
#define KBASE(t) ((j_lo + (t)) * KVBLK)
#define ACT(t) (KBASE(t) <= qlo + QBLK - 1 && KBASE(t) + KVBLK - 1 >= qlo - W + 1)
#define MASKT(P0_, P1_, t) do { const int kb_ = KBASE(t); if ((!SK || ACT(t)) && (kb_ + KVBLK - 1 > qlo || kb_ <= qlo + QBLK - 1 - W)) mask_tile(P0_, P1_, qm - kb_, (unsigned)W); } while (0)
    constexpr int NQL = F32 ? 16 : 8;
    constexpr bool SK = WSKIP && !F32;
#define SEAM_K0() do { VMWN(NQL); if constexpr (F32) { SWRITE_KF(0); SBAR(); SLOAD_F(FSEL(nxt.V, nxt.V2, kbn), kbn); } else { SWRITE_HK(0); } SBAR(); } while (0)
    f32x16 pA0, pA1, pB0, pB1; float mnA, mnB, alA, alB; bf16x8 pa0, pa1, pa2, pa3;
    { const int nbk = j_hi * KVBLK;
      for (int q = tid * 4; q < nbk; q += 2048) *(f32x4*)(B_lds + q * 4) = *(const f32x4*)(cur.NC + q);
      __syncthreads(); }
    if constexpr (F32) { VMW(); SWRITE_VF(0); SBAR(); } else { SWRITE_HV(0); SBAR(); }
    if (NT > 1) { if constexpr (F32) SLOAD_F(FSEL(cur.K, cur.K2, KBASE(1)), KBASE(1)); else SLOAD_H(Kh, Vh, cur.NC, KBASE(1)); }
    SBAR(); qkt<0, SK>(pA0, pA1, K_lds, B_lds + KBASE(0) * 4, r32, hi, S.qr, ACT(0));
    if constexpr (F32) { if (NT > 1) { VMW(); SWRITE_KF(1); SBAR(); SLOAD_F(FSEL(cur.V, cur.V2, KBASE(1)), KBASE(1)); } }
    MASKT(pA0, pA1, 0); partialSM(pA0, pA1, m_reg, mnA, alA);
    if (NT > 1) { VMW(); if constexpr (F32) { SWRITE_VF(1); SBAR(); if (NT > 2) SLOAD_F(FSEL(cur.K, cur.K2, KBASE(2)), KBASE(2)); } else SWRITE_H(1); }
    __syncthreads();
#define HALF_STEP(PX0, PX1, mnX, alX, PY0, PY1, alY, t, KB, VB, SB) do {                                                      \
        SBAR(); qkt<KB, SK>(PX0, PX1, K_lds, B_lds + KBASE(t) * 4, r32, hi, S.qr, ACT(t));                                             \
        finishSM(PY0, PY1, alY, l_reg, pa0, pa1, pa2, pa3); SBAR();                                                           \
        if ((t) + 1 < NT) { if constexpr (F32) { VMW(); SWRITE_KF(SB); SBAR(); SLOAD_F(FSEL(cur.V, cur.V2, KBASE((t) + 1)), KBASE((t) + 1)); }  \
                            else { SLOAD_H(Kh, Vh, cur.NC, KBASE((t) + 1)); } SBAR(); }                                               \
        pv_tile<VB, SK>(o, vb0, pa0, pa1, pa2, pa3, ACT((t) - 1)); MASKT(PX0, PX1, (t)); partialSM(PX0, PX1, m_reg, mnX, alX);                                        \
        __syncthreads();                                                                                                      \
        if ((t) + 1 < NT) { VMW(); if constexpr (F32) { SWRITE_VF(SB); SBAR(); if ((t) + 2 < NT) SLOAD_F(FSEL(cur.K, cur.K2, KBASE((t) + 2)), KBASE((t) + 2)); } \
                            else { SWRITE_H(SB); } }                                                                          \
        RESC(alX); __syncthreads(); } while (0)
    for (int t = 1; t + 1 < NT; t += 2) {
        HALF_STEP(pB0, pB1, mnB, alB, pA0, pA1, alA, t, 1, 0, 0);
        HALF_STEP(pA0, pA1, mnA, alA, pB0, pB1, alB, t + 1, 0, 1, 1);
    }
    const bool even = (NT & 1) == 0;
    if (even) { SBAR(); qkt<1, SK>(pB0, pB1, K_lds, B_lds + KBASE(NT - 1) * 4, r32, hi, S.qr, ACT(NT - 1)); SBAR(); }
#define QROW(e) (nxt.Q + (size_t)(wid * QBLK + r32) * D + ((e) >> 1) * 16 + hi * 8 + ((e) & 1) * 4)
    if constexpr (F32) { SLOAD_F(FSEL(nxt.K, nxt.K2, kbn), kbn); SBAR();
#pragma unroll
        for (int e = 0; e < 8; ++e) S.tq[e] = *(const f32x4*)QROW(e); }
    else { SLOAD_H(nxt.K, nxt.V, nxt.NC, kbn); SBAR();
#pragma unroll
        for (int d0 = 0; d0 < 8; ++d0) S.qr[d0] = load8<TIn>(nxt.Q + (size_t)(wid * QBLK + r32) * D + d0 * 16 + hi * 8); }
    SBAR();
    finishSM(pA0, pA1, alA, l_reg, pa0, pa1, pa2, pa3); SBAR();
    if constexpr (F32) {
#pragma unroll
        for (int e = 8; e < 16; ++e) S.tq[e] = *(const f32x4*)QROW(e); SBAR(); }
#undef QROW
    pv_tile<0, SK>(o, vb0, pa0, pa1, pa2, pa3, ACT(even ? NT - 2 : NT - 1));
    if (even) { MASKT(pB0, pB1, NT - 1); partialSM(pB0, pB1, m_reg, mnB, alB); __syncthreads(); RESC(alB);
        finishSM(pB0, pB1, alB, l_reg, pa0, pa1, pa2, pa3); SBAR(); pv_tile<1, SK>(o, vb0, pa0, pa1, pa2, pa3, ACT(NT - 1)); }
    SBAR(); SEAM_K0();
    if (hi == 0) li_l[r32] = l_reg; asm volatile("s_waitcnt lgkmcnt(0)" ::: "memory");
    float rli[16];
#pragma unroll
    for (int r = 0; r < 16; ++r) rli[r] = __builtin_amdgcn_rcpf(li_l[crow(r, hi)]);
    TOut* Ow = cur.O + (size_t)(wid * QBLK) * OSTR;
    if (wid * QBLK < cur.nrows)
#pragma unroll
    for (int r = 0; r < 16; ++r) { const int orow = crow(r, hi);
#pragma unroll
        for (int d0 = 0; d0 < 4; ++d0) { const float v = o[d0][r] * rli[r];
            if constexpr (same_t<TOut, float>::v) { Ow[(size_t)orow * OSTR + d0 * 32 + r32] = v; }
            else { const float vn = __shfl_xor(v, 1);
                   if ((r32 & 1) == 0) *(unsigned*)(Ow + (size_t)orow * OSTR + d0 * 32 + r32) = cvtpk(v, vn); } } }
    if constexpr (F32) {
#pragma unroll
        for (int d0 = 0; d0 < 8; ++d0) S.qr[d0] = pack8(S.tq[2 * d0], S.tq[2 * d0 + 1]); }
    __syncthreads();
#undef RESC
#undef KBASE
#undef ACT
#undef MASKT
#undef SEAM_K0
#undef HALF_STEP
}
#undef ROW
#undef VMW
#undef VMWN
#undef SLOAD_H
#undef SWRITE_HK
#undef SWRITE_HV
#undef SWRITE_H
#undef SLOAD_F
#undef SWRITE_KF
#undef SWRITE_VF

}
#define XB_TMO      128
#define XB_XCNT(j)  (256  + 64 * (j))
#define XB_XSUB(j)  (1280 + 64 * (j))
#define XB_XGEN(j)  (2304 + 64 * (j))
#define XB_TOP      3328
#define XB_TOPGEN   3392
#define XCD_BAR_WORDS 3456
#define XB_SPIN_CAP (1u << 18)
#define XB_LAS __attribute__((address_space(3)))

__device__ __forceinline__ unsigned xb_ld(unsigned* p)              { return __hip_atomic_load(p, __ATOMIC_RELAXED, __HIP_MEMORY_SCOPE_AGENT); }
__device__ __forceinline__ unsigned xb_add(unsigned* p, unsigned v) { return __hip_atomic_fetch_add(p, v, __ATOMIC_RELAXED, __HIP_MEMORY_SCOPE_AGENT); }
__device__ __forceinline__ unsigned xb_xcc_id() { return (unsigned)__builtin_amdgcn_s_getreg((3 << 11) | 20) & 0xFu; }
#define XB_SPIN(cond, bar) do { unsigned _sp = 0; while (cond) { __builtin_amdgcn_s_sleep(1); \
    if ((++_sp & 255u) == 0u) { if (xb_ld(&(bar)[XB_TMO])) break; if (_sp > XB_SPIN_CAP) { atomicAdd(&(bar)[XB_TMO], 1u); break; } } } } while (0)

struct XcdBarrier {
    unsigned* bar; unsigned x;
    volatile XB_LAS unsigned* st;
};

__device__ __forceinline__ XcdBarrier xcd_barrier_post(unsigned* bar, volatile XB_LAS unsigned* st) {
    XcdBarrier b; b.bar = bar; b.x = xb_xcc_id(); b.st = st;
    if (threadIdx.x == 0) (void)xb_add(&bar[XB_XCNT(b.x)], 1u);
    return b;
}
__device__ __forceinline__ void xcd_barrier_complete(unsigned* bar, unsigned x, unsigned& nloc, unsigned& nx) {
    const unsigned G = gridDim.x * gridDim.y * gridDim.z;
    unsigned sum, cnt, mine, sp = 0u;
    for (;;) {
        sum = 0u; cnt = 0u; mine = 0u;
#pragma unroll
        for (unsigned j = 0; j < 16; ++j) { const unsigned c = xb_ld(&bar[XB_XCNT(j)]); sum += c; cnt += (c > 0u) ? 1u : 0u; mine = (j == x) ? c : mine; }
        if (sum == G) break;
        __builtin_amdgcn_s_sleep(1);
        if ((++sp & 255u) == 0u) { if (xb_ld(&bar[XB_TMO])) break; if (sp > XB_SPIN_CAP) { atomicAdd(&bar[XB_TMO], 1u); break; } }
    }
    nloc = mine > 0u ? mine : 1u; nx = cnt > 0u ? cnt : 1u;
}

__device__ __forceinline__ void xcd_barrier(const XcdBarrier& b) {
    asm volatile("s_waitcnt vmcnt(0)" ::: "memory");
    __syncthreads();
    if (threadIdx.x == 0) {
        unsigned* bar = b.bar;
        __builtin_amdgcn_s_waitcnt(0);
        unsigned nloc = b.st[0], nx = b.st[1];
        if (nloc == 0u) { xcd_barrier_complete(bar, b.x, nloc, nx); b.st[0] = nloc; b.st[1] = nx; }
        const unsigned old = xb_add(&bar[XB_XSUB(b.x)], 1u);
        const unsigned gen = old / nloc;
        if (old + 1u == (gen + 1u) * nloc) {
            __builtin_amdgcn_fence(__ATOMIC_RELEASE, "agent");
            asm volatile("s_waitcnt vmcnt(0)" ::: "memory");
            const unsigned og = xb_add(&bar[XB_TOP], 1u);
            const unsigned tg = og / nx;
            if (og + 1u == (tg + 1u) * nx) xb_add(&bar[XB_TOPGEN], 1u);
            else XB_SPIN(xb_ld(&bar[XB_TOPGEN]) == tg, bar);
            __builtin_amdgcn_fence(__ATOMIC_ACQUIRE, "agent");
            xb_add(&bar[XB_XGEN(b.x)], 1u);
            asm volatile("s_waitcnt vmcnt(0)" ::: "memory");
        } else {
            XB_SPIN(xb_ld(&bar[XB_XGEN(b.x)]) == gen, bar);
            __builtin_amdgcn_fence(__ATOMIC_ACQUIRE, "agent");
            asm volatile("s_waitcnt vmcnt(0)" ::: "memory");
        }
    }
    __syncthreads();
}


__device__ __forceinline__ float bf2f(unsigned short b) { return __uint_as_float(((unsigned)b) << 16); }
__device__ __forceinline__ unsigned pk2(float lo, float hi) { unsigned r; asm volatile("v_cvt_pk_bf16_f32 %0, %1, %2" : "=v"(r) : "v"(lo), "v"(hi)); return r; }
__device__ __forceinline__ unsigned short f2bf(float x) { return (unsigned short)(pk2(x, 0.f) & 0xffffu); }
__device__ __forceinline__ float wave_sum(float v) {
#pragma unroll
    for (int o = 1; o < 64; o <<= 1) v += __shfl_xor(v, o);
    return v;
}
__device__ __forceinline__ float grp16_sum(float v) {
#pragma unroll
    for (int o = 1; o < 16; o <<= 1) v += __shfl_xor(v, o);
    return v;
}
__device__ __forceinline__ float wave_incl_scan(float v, int lane) {
#pragma unroll
    for (int o = 1; o < 64; o <<= 1) { const float t = __shfl_up(v, o); if (lane >= o) v += t; }
    return v;
}
__device__ __forceinline__ float silu_f(float x) { return x * __builtin_amdgcn_rcpf(1.f + __expf(-x)); }
__device__ __forceinline__ void unpack8(u32x4 w, float (&o)[8]) {
#pragma unroll
    for (int q = 0; q < 4; ++q) { o[2 * q] = __uint_as_float(w[q] << 16); o[2 * q + 1] = __uint_as_float(w[q] & 0xffff0000u); }
}
__device__ __forceinline__ u32x4 pack8f(const float (&v)[8]) { u32x4 w = {pk2(v[0], v[1]), pk2(v[2], v[3]), pk2(v[4], v[5]), pk2(v[6], v[7])}; return w; }
__device__ __forceinline__ int pos16(int x) { return (x & ~12) | (((x >> 2) & 1) << 3) | (((x >> 3) & 1) << 2); }
__device__ __forceinline__ int crow32(int r, int hi) { return (r & 3) + 8 * (r >> 2) + 4 * hi; }

struct EpiBf16Plain {
    static constexpr bool PERM = true, AFTER_DRAIN = false;
    bf16_t* O; int ldc;
    __device__ __forceinline__ void operator()(const pg8::f32x4 (&acc)[2][2][4][2], const pg8::Unit& u, int wr, int wc, int fr, int fq) const {
        const int row0 = u.pm * 256 + wr * 64 + fr, col0 = u.pn * 256 + wc * 32 + 8 * fq;
#pragma unroll
        for (int ai = 0; ai < 2; ++ai)
#pragma unroll
            for (int m = 0; m < 4; ++m) { bf16_t* rowp = O + (size_t)(row0 + ai * 128 + m * 16) * ldc + col0;
#pragma unroll
                for (int bj = 0; bj < 2; ++bj) { const pg8::f32x4 v0 = acc[ai][bj][m][0], v1 = acc[ai][bj][m][1];
                    u32x4 w; w.x = pk2(v0[0], v0[1]); w.y = pk2(v0[2], v0[3]); w.z = pk2(v1[0], v1[1]); w.w = pk2(v1[2], v1[3]);
                    *(u32x4*)(rowp + bj * 128) = w; } }
    }
};
struct EpiSwiglu {
    static constexpr bool PERM = true, AFTER_DRAIN = false;
    bf16_t* O; int ldc;
    __device__ __forceinline__ void operator()(const pg8::f32x4 (&acc)[2][2][4][2], const pg8::Unit& u, int wr, int wc, int fr, int fq) const {
        const int row0 = u.pm * 256 + wr * 64 + fr, col0 = u.pn * 128 + wc * 32 + 8 * fq;
#pragma unroll
        for (int ai = 0; ai < 2; ++ai)
#pragma unroll
            for (int m = 0; m < 4; ++m) { bf16_t* rowp = O + (size_t)(row0 + ai * 128 + m * 16) * ldc + col0;
                float r[8];
#pragma unroll
                for (int n = 0; n < 2; ++n)
#pragma unroll
                    for (int e = 0; e < 4; ++e) { const float g = acc[ai][0][m][n][e], up = acc[ai][1][m][n][e]; r[4 * n + e] = silu_f(g) * up; }
                *(u32x4*)rowp = pack8f(r); }
    }
};
struct EpiResid {
    static constexpr bool PERM = false, AFTER_DRAIN = false;
    float* X; int ldc; float* slab;
    __device__ __forceinline__ void operator()(const pg8::f32x4 (&acc)[2][2][4][2], const pg8::Unit& u, int wr, int wc, int fr, int fq) const {
        const int row0 = u.pm * 256 + wr * 64 + fr, col0 = u.pn * 256 + wc * 32 + 4 * fq;
        if (u.split) {
            float* Sl = slab + (size_t)(u.split - 1) * MS * DM;
#pragma unroll
            for (int ai = 0; ai < 2; ++ai)
#pragma unroll
                for (int m = 0; m < 4; ++m) { float* rowp = Sl + (size_t)(row0 - MP + ai * 128 + m * 16) * DM + col0;
#pragma unroll
                    for (int bj = 0; bj < 2; ++bj)
#pragma unroll
                        for (int n = 0; n < 2; ++n) *(pg8::f32x4*)(rowp + bj * 128 + n * 16) = acc[ai][bj][m][n]; }
        } else {
#pragma unroll
            for (int ai = 0; ai < 2; ++ai)
                {
                    pg8::f32x4 xv[4][2][2];
#pragma unroll
                    for (int mm = 0; mm < 4; ++mm) { const float* rowp = X + (size_t)(row0 + ai * 128 + mm * 16) * ldc + col0;
#pragma unroll
                        for (int bj = 0; bj < 2; ++bj)
#pragma unroll
                            for (int n = 0; n < 2; ++n) xv[mm][bj][n] = *(const pg8::f32x4*)(rowp + bj * 128 + n * 16); }
#pragma unroll
                    for (int mm = 0; mm < 4; ++mm) { float* rowp = X + (size_t)(row0 + ai * 128 + mm * 16) * ldc + col0;
#pragma unroll
                        for (int bj = 0; bj < 2; ++bj)
#pragma unroll
                            for (int n = 0; n < 2; ++n) *(pg8::f32x4*)(rowp + bj * 128 + n * 16) = xv[mm][bj][n] + acc[ai][bj][mm][n]; }
                }
        }
    }
};
template <class Epi>
__device__ __forceinline__ void run_gemm(PG8_LAS unsigned char* lds, const bf16_t* A, const bf16_t* Bt, int N, int K, const Epi& E) {
    pg8::Gemm g; g.A = A; g.Bt = Bt; g.M = MT; g.N = N; g.K = K;
    pg8::StaticOrder S; S.init(MT, N, (int)gridDim.x, (int)blockIdx.x); S.nktf = K / 64;
    pg8::gemm_phase<Epi, pg8::StaticOrder, false>(lds, g, S, E, nullptr);
}

__device__ __forceinline__ int tail_parts(int K, int G) { return G != 256 ? 0 : ((K / 128) >= 16 ? 8 : 4); }
struct TailSplitOrder {
    int c, G, nktf; pg8::StaticOrder so;
    __device__ void init(int K, int G_, int c_) { c = c_; G = G_; nktf = K / 64; so.init(MT, 1024, G_, c_); so.nktf = nktf; }
    __device__ bool next(int i, pg8::Unit& u) const {
        if (G != 256) return so.next(i, u);
        if (i == 0) { u.pm = (c & 7) + 8 * (c >> 5); u.pn = (c >> 3) & 3; u.kt0 = 0; u.nkt = nktf; u.split = 0; return true; }
        if (i > 1) return false;
        const int npairs = nktf >> 1, parts = npairs >= 16 ? 8 : 4, part = c >> 5, tix = c & 31;
        if (part >= parts) return false;
        const int q = npairs / parts, r = npairs - q * parts;
        const int p0 = part * q + (part < r ? part : r), np = q + (part < r ? 1 : 0);
        u.pm = 64 + (tix >> 2); u.pn = tix & 3; u.kt0 = 2 * p0; u.nkt = 2 * np; u.split = part + 1; return true;
    }
    __device__ __forceinline__ void a_ready(const pg8::Unit&) const {}
    __device__ __forceinline__ void done(const pg8::Unit&) const {}
};
__device__ __forceinline__ void run_gemm_n1024(PG8_LAS unsigned char* lds, const bf16_t* A, const bf16_t* Bt, int K, const EpiResid& E) {
    pg8::Gemm g; g.A = A; g.Bt = Bt; g.M = MT; g.N = 1024; g.K = K;
    TailSplitOrder S; S.init(K, (int)gridDim.x, (int)blockIdx.x);
    pg8::gemm_phase<EpiResid, TailSplitOrder, false>(lds, g, S, E, nullptr);
}

__device__ __forceinline__ void transpose_weight(const float* __restrict__ W, int K, int N, bf16_t* WT, int mode, float* tile, int bid, int nb) {
    const int tid = otid();
    const int nct = (N + 63) >> 6, nkt = K >> 6, nt = nct * nkt;
    constexpr int TB = 4;
    for (int t0 = bid; t0 < nt; t0 += TB * nb) {
        float v[TB][8];
#pragma unroll
        for (int q = 0; q < TB; ++q) { const int t = min(t0 + q * nb, nt - 1), kt = t / nct, ct = t - kt * nct, k0 = kt * 64, n0 = ct * 64;
#pragma unroll
            for (int i = 0; i < 8; ++i) { const int r = (tid >> 6) + 8 * i, c = tid & 63, n = n0 + c; v[q][i] = (n < N) ? W[(size_t)(k0 + r) * N + n] : 0.f; } }
#pragma unroll
        for (int q = 0; q < TB; ++q)
#pragma unroll
            for (int i = 0; i < 8; ++i) { const int r = (tid >> 6) + 8 * i, c = tid & 63; tile[q * 4160 + r * 65 + c] = v[q][i]; }
        __syncthreads();
#pragma unroll
        for (int q = 0; q < TB; ++q) { const int t = t0 + q * nb; if (t < nt) { const int kt = t / nct, ct = t - kt * nct, k0 = kt * 64, n0 = ct * 64;
            const int nl = tid >> 3, kc = tid & 7, n = n0 + nl; int dest = -1;
            if (n < N) {
                if (mode == 0) dest = n;
                else if (mode == 1) dest = n < 2048 ? n : (n < 2056 ? -1 : n - 8);
                else if (mode == 2) dest = n < 3072 ? n : -1;
                else if (mode == 3) dest = 256 * (n >> 7) + (n & 127);
                else dest = 256 * (n >> 7) + 128 + (n & 127);
            }
            if (dest >= 0) { float o[8];
#pragma unroll
                for (int e = 0; e < 8; ++e) o[e] = tile[q * 4160 + (8 * kc + e) * 65 + nl];
                *(u32x4*)(WT + (size_t)dest * K + k0 + 8 * kc) = pack8f(o); } } }
        __syncthreads();
    }
}
__device__ __forceinline__ void convert_weights(CParams& p, unsigned char* shm, int l0, int l1, int bid, int nb) {
    float* tile = (float*)shm;
    for (int l = l0; l < l1; ++l) {
        const int i = l >> 1;
        if ((l & 1) == 0) {
            transpose_weight(p.in[10] + (size_t)i * DM * EVEN_IN, DM, EVEN_IN, (bf16_t*)(p.ws + WS_WINE) + (size_t)i * NE * DM, 1, tile, bid, nb);
            transpose_weight(p.in[16] + (size_t)i * DM * DM, DM, DM, (bf16_t*)(p.ws + WS_WOUTE) + (size_t)i * DM * DM, 0, tile, bid, nb);
        } else {
            transpose_weight(p.in[17] + (size_t)i * DM * ODD_IN, DM, ODD_IN, (bf16_t*)(p.ws + WS_WINO) + (size_t)i * NO * DM, 2, tile, bid, nb);
            transpose_weight(p.in[21] + (size_t)i * DM * DM, DM, DM, (bf16_t*)(p.ws + WS_WOUTO) + (size_t)i * DM * DM, 0, tile, bid, nb);
        }
        transpose_weight(p.in[22] + (size_t)l * DM * DFF, DM, DFF, (bf16_t*)(p.ws + WS_WF1) + (size_t)l * NF1 * DM, 3, tile, bid, nb);
        transpose_weight(p.in[23] + (size_t)l * DM * DFF, DM, DFF, (bf16_t*)(p.ws + WS_WF1) + (size_t)l * NF1 * DM, 4, tile, bid, nb);
        transpose_weight(p.in[24] + (size_t)l * DFF * DM, DFF, DM, (bf16_t*)(p.ws + WS_WF2) + (size_t)l * DM * DFF, 0, tile, bid, nb);
    }
}
__device__ __forceinline__ void phase_init(CParams& p, unsigned char* shm) {
    convert_weights(p, shm, 0, 1, (int)blockIdx.x, (int)gridDim.x);
}

template <int MODE>
__device__ __forceinline__ void phase_norm(CParams& p, int layer, unsigned char* shm, int nparts) {
    const int tid = otid(), lane = tid & 63, wid = tid >> 6, i = layer >> 1;
    float* Wsm = (float*)shm;
    const float* X = p.out;
    const bool from_in = (MODE == 0) && layer == 0;
    const float* Xp = from_in ? p.in[0] : X; const float* Xs = from_in ? p.in[1] - (size_t)MP * DM : X;
    bf16_t* H = (bf16_t*)(p.ws + WS_H);
    const float* gain = (MODE == 2 ? p.in[9] : p.in[8]) + layer * DM;
    if (MODE != 2) {
        const float* W = MODE == 0 ? p.in[10] + (size_t)i * DM * EVEN_IN + 2048 : p.in[17] + (size_t)i * DM * ODD_IN + 3072;
        const int ldw = MODE == 0 ? EVEN_IN : ODD_IN;
#pragma unroll
        for (int r = 0; r < 4; ++r) { const int q = tid + 512 * r, k = q >> 1, hf = q & 1;
            const f32x4 w = *(const f32x4*)(W + (size_t)k * ldw + 4 * hf);
            const int j = k >> 8, l = (k & 255) >> 2, e = k & 3;
            *(f32x4*)(Wsm + (((j * 4 + e) * 64 + l) * 8 + 4 * hf)) = w; }
        __syncthreads();
    }
    f32x4 g4[4];
#pragma unroll
    for (int j = 0; j < 4; ++j) g4[j] = *(const f32x4*)(gain + 256 * j + 4 * lane);
    constexpr int R = 3;
    const int stride = gridDim.x * 8;
    f32x4 nv[R][4];
    int row = blockIdx.x * 8 + wid;
#pragma unroll
    for (int r = 0; r < R; ++r) { const int rr = min(row + r * stride, MT - 1); const f32x4* xr = (const f32x4*)((rr < MP ? Xp : Xs) + (size_t)rr * DM) + lane;
#pragma unroll
        for (int j = 0; j < 4; ++j) nv[r][j] = xr[64 * j]; }
    for (; row < MT; row += R * stride) {
        f32x4 cv[R][4];
#pragma unroll
        for (int r = 0; r < R; ++r)
#pragma unroll
            for (int j = 0; j < 4; ++j) cv[r][j] = nv[r][j];
        if (row + R * stride < MT) {
#pragma unroll
            for (int r = 0; r < R; ++r) { const int rr = min(row + (R + r) * stride, MT - 1); const f32x4* xr = (const f32x4*)((rr < MP ? Xp : Xs) + (size_t)rr * DM) + lane;
#pragma unroll
                for (int j = 0; j < 4; ++j) nv[r][j] = xr[64 * j]; }
        }
#pragma unroll
        for (int r = 0; r < R; ++r) {
            const int crow_ = row + r * stride;
            if (crow_ < MT) {
                f32x4 v[4]; float ss = 0.f;
#pragma unroll
                for (int j = 0; j < 4; ++j) v[j] = cv[r][j];
                if (from_in) { f32x4* xw = (f32x4*)(p.out + (size_t)crow_ * DM) + lane;
#pragma unroll
                    for (int j = 0; j < 4; ++j) xw[64 * j] = v[j]; }
                if (crow_ >= MP && nparts > 0) {
                    const f32x4* sl = (const f32x4*)((const float*)(p.ws + WS_SLAB) + (size_t)(crow_ - MP) * DM) + lane;
                    for (int q0 = 0; q0 < nparts; q0 += 4) {
                        f32x4 tsl[4][4];
#pragma unroll
                        for (int q = 0; q < 4; ++q)
#pragma unroll
                            for (int j = 0; j < 4; ++j) tsl[q][j] = sl[(size_t)(q0 + q) * (MS * DM / 4) + 64 * j];
#pragma unroll
                        for (int q = 0; q < 4; ++q)
#pragma unroll
                            for (int j = 0; j < 4; ++j) v[j] += tsl[q][j]; }
                    f32x4* xw = (f32x4*)(p.out + (size_t)crow_ * DM) + lane;
#pragma unroll
                    for (int j = 0; j < 4; ++j) xw[64 * j] = v[j];
                }
#pragma unroll
                for (int j = 0; j < 4; ++j) ss += (v[j].x * v[j].x + v[j].y * v[j].y) + (v[j].z * v[j].z + v[j].w * v[j].w);
                ss = wave_sum(ss);
                const float rstd = 1.f / sqrtf(ss * (1.f / DM) + EPS);
                u32x2* ho = (u32x2*)(H + (size_t)crow_ * DM) + lane;
#pragma unroll
                for (int j = 0; j < 4; ++j) { v[j] = v[j] * rstd * g4[j]; u32x2 w; w.x = pk2(v[j].x, v[j].y); w.y = pk2(v[j].z, v[j].w); ho[64 * j] = w; }
                if (MODE != 2) {
                    float acc[8];
#pragma unroll
                    for (int c = 0; c < 8; ++c) acc[c] = 0.f;
#pragma unroll
                    for (int j = 0; j < 4; ++j)
#pragma unroll
                        for (int e = 0; e < 4; ++e) { const float hv = v[j][e]; const float* wp = Wsm + ((j * 4 + e) * 64 + lane) * 8;
                            const f32x4 w0 = *(const f32x4*)wp, w1 = *(const f32x4*)(wp + 4);
#pragma unroll
                            for (int c = 0; c < 4; ++c) { acc[c] = fmaf(hv, w0[c], acc[c]); acc[4 + c] = fmaf(hv, w1[c], acc[4 + c]); } }
#pragma unroll
                    for (int c = 0; c < 8; ++c) acc[c] = wave_sum(acc[c]);
                    if (MODE == 0) { if (lane == 0) { float* d = (float*)(p.ws + WS_AB) + (size_t)crow_ * 8;
                            *(f32x4*)d = (f32x4){acc[0], acc[1], acc[2], acc[3]}; *(f32x4*)(d + 4) = (f32x4){acc[4], acc[5], acc[6], acc[7]}; } }
                    else {
                        const int c8 = lane & 7;
                        float xs = acc[0];
#pragma unroll
                        for (int c = 1; c < 8; ++c) xs = (c8 == c) ? acc[c] : xs;
                        const float x = xs + p.in[18][i * 8 + c8];
                        const float lf = fminf(x, 0.f) - log1pf(expf(-fabsf(x)));
                        float* d = crow_ < MP ? p.out + OFF_PLF + ((size_t)i * MP + crow_) * 8 : p.out + OFF_SLF + ((size_t)i * MS + (crow_ - MP)) * 8;
                        if (lane < 8) d[lane] = lf; }
                }
            }
        }
    }
}

__device__ __forceinline__ void phase_fixup(CParams& p, int nparts) {
    const int tid = otid(), lane = tid & 63, wid = tid >> 6;
    if (nparts <= 0) return;
    for (int row = MP + blockIdx.x * 8 + wid; row < MT; row += gridDim.x * 8) {
        f32x4* xw = (f32x4*)(p.out + (size_t)row * DM) + lane;
        const f32x4* sl = (const f32x4*)((const float*)(p.ws + WS_SLAB) + (size_t)(row - MP) * DM) + lane;
        f32x4 v[4];
#pragma unroll
        for (int j = 0; j < 4; ++j) v[j] = xw[64 * j];
        for (int q0 = 0; q0 < nparts; q0 += 4) {
            f32x4 tsl[4][4];
#pragma unroll
            for (int q = 0; q < 4; ++q)
#pragma unroll
                for (int j = 0; j < 4; ++j) tsl[q][j] = sl[(size_t)(q0 + q) * (MS * DM / 4) + 64 * j];
#pragma unroll
            for (int q = 0; q < 4; ++q)
#pragma unroll
                for (int j = 0; j < 4; ++j) v[j] += tsl[q][j]; }
#pragma unroll
        for (int j = 0; j < 4; ++j) xw[64 * j] = v[j];
    }
}

__device__ __forceinline__ void phase_gdn_prep(CParams& p, int i, unsigned char* shm) {
    const int tid = otid(), lane = tid & 63, wid = tid >> 6;
    const int half = wid >> 2, w4 = wid & 3;
    const bf16_t* P = (const bf16_t*)(p.ws + WS_BIG);
    const float* AB = (const float*)(p.ws + WS_AB);
    const float* convw = p.in[11] + (size_t)i * 4 * 1536;
    unsigned char* hb = shm + half * 78336;
    bf16_t* qs = (bf16_t*)hb; bf16_t* ks = (bf16_t*)(hb + 17408); bf16_t* vs = (bf16_t*)(hb + 34816);
    float* As = (float*)(hb + 52224); float* Gs = (float*)(hb + 68608); float* Bs = Gs + 64;
    bf16_t* Ps = (bf16_t*)(hb + 69120);
    bf16_t* Wb = vs;
    bf16_t* NEGW = (bf16_t*)(p.ws + WS_NEGW); bf16_t* QG = (bf16_t*)(p.ws + WS_QG); bf16_t* KDT = (bf16_t*)(p.ws + WS_KDT);
    bf16_t* PM = (bf16_t*)(p.ws + WS_PM); bf16_t* UPRE = (bf16_t*)(p.ws + WS_UPRE); float* GC = (float*)(p.ws + WS_GC);
    for (int pr = blockIdx.x; pr < 576; pr += gridDim.x) {
        const int it = 2 * pr + half;
        int b, n, h, T0; bool sample;
        if (it < 1024) { b = it >> 8; n = (it >> 2) & 63; h = it & 3; T0 = b * 4096 + n * 64; sample = false; }
        else { const int j = it - 1024; b = j >> 2; h = j & 3; n = 0; T0 = MP + b * 64; sample = true; }
        const bool first = (n == 0), last = sample || (n == 63);
#ifndef PROBE_PREP_A
#define PROBE_PREP_A 1
#endif
#ifndef PROBE_PREP_D
#define PROBE_PREP_D 1
#endif
#pragma unroll 1
        for (int rr = 0; rr < 2 * PROBE_PREP_A; ++rr) {
            const int task = (otid() & 255) + 256 * (rr & 1);
            if (task < 384) {
                const int tseg = task / 48, cgi = task - tseg * 48, part = cgi >> 4, c8 = (cgi & 15) * 8, t0 = tseg * 8;
                const int col = part * 512 + h * 128 + c8;
                const bool edge = first && t0 == 0;
                u32x4 L[11];
#pragma unroll
                for (int k = 0; k < 11; ++k) { const int tt = t0 - 3 + k; const int rowc = (k < 3 && edge) ? T0 : T0 + tt; L[k] = *(const u32x4*)(P + (size_t)rowc * NE + col); }
                float w[4][8];
#pragma unroll
                for (int tap = 0; tap < 4; ++tap) { const float* wp = convw + tap * 1536 + col; const f32x4 w0 = *(const f32x4*)wp, w1 = *(const f32x4*)(wp + 4);
#pragma unroll
                    for (int e = 0; e < 4; ++e) { w[tap][e] = w0[e]; w[tap][4 + e] = w1[e]; } }
                bf16_t* dst0 = (part == 0 ? qs : (part == 1 ? ks : vs)) + t0 * 136 + c8;
                float xw[4][8];
#pragma unroll
                for (int k = 0; k < 11; ++k) {
                    float (&xv)[8] = xw[k & 3];
                    if (k < 3 && edge) {
                        if (sample) { const float* sp = p.in[6] + (((size_t)i * 32 + b) * 3 + k) * 1536 + col; const f32x4 a = *(const f32x4*)sp, c = *(const f32x4*)(sp + 4);
#pragma unroll
                            for (int e = 0; e < 4; ++e) { xv[e] = a[e]; xv[4 + e] = c[e]; } }
                        else {
#pragma unroll
                            for (int e = 0; e < 8; ++e) xv[e] = 0.f; }
                    } else unpack8(L[k], xv);
                    if (last && t0 == 56 && k >= 8) {
                        float* d = (sample ? p.out + OFF_SCONV + (((size_t)i * 32 + b) * 3 + (k - 8)) * 1536 : p.out + OFF_PCONV + (((size_t)i * 4 + b) * 3 + (k - 8)) * 1536) + col;
                        *(f32x4*)d = (f32x4){xv[0], xv[1], xv[2], xv[3]}; *(f32x4*)(d + 4) = (f32x4){xv[4], xv[5], xv[6], xv[7]}; }
                    if (k >= 3) {
                        const int j = k - 3; float y[8];
#pragma unroll
                        for (int e = 0; e < 8; ++e) y[e] = w[0][e] * xw[j & 3][e];
#pragma unroll
                        for (int tap = 1; tap < 4; ++tap)
#pragma unroll
                            for (int e = 0; e < 8; ++e) y[e] = fmaf(w[tap][e], xw[(j + tap) & 3][e], y[e]);
                        float ss = 0.f;
#pragma unroll
                        for (int e = 0; e < 8; ++e) { y[e] = silu_f(y[e]); ss = fmaf(y[e], y[e], ss); }
                        ss = grp16_sum(ss);
                        const float sc = part == 2 ? 1.f : __builtin_amdgcn_rsqf(ss + EPS) * (part == 0 ? 0.08838834764831845f : 1.f);
#pragma unroll
                        for (int e = 0; e < 8; ++e) y[e] *= sc;
                        *(u32x4*)(dst0 + j * 136) = pack8f(y); }
                }
            }
        }
        if (w4 == 0) {
            const float a = AB[(size_t)(T0 + lane) * 8 + h], bb = AB[(size_t)(T0 + lane) * 8 + 4 + h];
            const float x = a + p.in[13][i * 4 + h];
            const float sp = fmaxf(x, 0.f) + log1pf(expf(-fabsf(x)));
            float g = -expf(p.in[12][i * 4 + h]) * sp;
            g = wave_incl_scan(g, lane);
            Gs[lane] = g; Bs[lane] = 1.f / (1.f + expf(-bb));
        }
        LBAR();
        {
            const int type = w4 >> 1, bi = w4 & 1; const int ln_ = otid() & 63, r32 = ln_ & 31, hi = ln_ >> 5;
            const bf16_t* Xs = type ? qs : ks;
#pragma unroll 1
            for (int bj = 0; bj < 2; ++bj) {
                f32x16 acc = {};
#pragma unroll
                for (int kk = 0; kk < 8; ++kk) {
                    const bf16x8 a = *(const bf16x8*)(Xs + (32 * bi + r32) * 136 + kk * 16 + hi * 8);
                    const bf16x8 bq = *(const bf16x8*)(ks + (32 * bj + r32) * 136 + kk * 16 + hi * 8);
                    acc = __builtin_amdgcn_mfma_f32_32x32x16_bf16(a, bq, acc, 0, 0, 0);
                }
                const int j = 32 * bj + r32; const float Gj = Gs[j];
#pragma unroll
                for (int r = 0; r < 16; ++r) { const int ii = 32 * bi + crow32(r, hi); const float d = __expf(fminf(Gs[ii] - Gj, 0.f));
                    if (type == 0) As[ii * 64 + j] = (ii > j) ? acc[r] * Bs[ii] * d : 0.f;
                    else Ps[ii * 72 + pos16(j)] = f2bf((ii >= j) ? acc[r] * d : 0.f); }
            }
        }
        LBAR();
        if (w4 < 2) {
            typedef float f32x2_t __attribute__((ext_vector_type(2)));
            const int c = otid() & 127; f32x2_t sol[64];
#pragma unroll 1
            for (int rep_ = 0; rep_ < PROBE_PREP_D; ++rep_) {
#pragma unroll
            for (int r = 0; r < 64; ++r) { const float br = Bs[r]; sol[r] = (f32x2_t){bf2f(vs[r * 136 + c]) * br, bf2f(ks[r * 136 + c]) * br * __expf(Gs[r])}; }
#pragma unroll
            for (int r = 1; r < 64; ++r) { f32x2_t a = sol[r];
#pragma unroll
                for (int j = 0; j < r; ++j) { const float m = -As[r * 64 + j]; a = __builtin_elementwise_fma((f32x2_t){m, m}, sol[j], a); }
                sol[r] = a; }
            }
            { const int sl = c >> 5, cc = c & 31;
#pragma unroll
              for (int mb = 0; mb < 2; ++mb)
#pragma unroll
                  for (int rg = 0; rg < 2; ++rg)
#pragma unroll
                      for (int hh = 0; hh < 2; ++hh) { const int tb = 32 * mb + 16 * rg + 4 * hh;
                          u32x4 w = {pk2(sol[tb].x, sol[tb + 1].x), pk2(sol[tb + 2].x, sol[tb + 3].x), pk2(sol[tb + 8].x, sol[tb + 9].x), pk2(sol[tb + 10].x, sol[tb + 11].x)};
                          *(u32x4*)(UPRE + ((((size_t)it * 4 + sl) * 2 + mb) * 2 + rg) * 512 + (cc + 32 * hh) * 8) = w; } }
            LBAR();
            { const int pp = pos16(c);
#pragma unroll
              for (int r = 0; r < 64; ++r) Wb[r * 136 + pp] = f2bf(-sol[r].y); }
        } else {
            const int t2 = otid() & 127; const float GL = Gs[63];
#pragma unroll 2
            for (int r = 0; r < 8; ++r) { const int ch = t2 + 128 * r, row = ch >> 4, pc = ch & 15, dk0 = 16 * (pc >> 1) + 4 * (pc & 1);
                const float eg = __expf(Gs[row]); const bf16_t* s_ = qs + row * 136 + dk0; float v[8];
#pragma unroll
                for (int e = 0; e < 4; ++e) { v[e] = bf2f(s_[e]) * eg; v[4 + e] = bf2f(s_[8 + e]) * eg; }
                *(u32x4*)(QG + (size_t)it * 8192 + row * 128 + pc * 8) = pack8f(v); }
#pragma unroll 2
            for (int r = 0; r < 8; ++r) { const int ch = t2 + 128 * r, dk = ch & 127, pc = ch >> 7, t0 = 16 * (pc >> 1) + 4 * (pc & 1); float v[8];
#pragma unroll
                for (int e = 0; e < 8; ++e) { const int te = t0 + (e & 3) + 8 * (e >> 2); v[e] = bf2f(ks[te * 136 + dk]) * __expf(GL - Gs[te]); }
                *(u32x4*)(KDT + (size_t)it * 8192 + dk * 64 + pc * 8) = pack8f(v); }
            if (t2 == 0) GC[it] = __expf(GL);
#pragma unroll
            for (int r = 0; r < 4; ++r) { const int ch = t2 + 128 * r, row = ch >> 3, cc = ch & 7;
                *(u32x4*)(PM + (size_t)it * 4096 + row * 64 + cc * 8) = *(const u32x4*)(Ps + row * 72 + cc * 8); }
            LBAR();
        }
        LBAR();
        { const int t4 = otid() & 255;
#pragma unroll
          for (int r = 0; r < 4; ++r) { const int ch = t4 + 256 * r, row = ch >> 4, cc = ch & 15;
              *(u32x4*)(NEGW + (size_t)it * 8192 + row * 128 + cc * 8) = *(const u32x4*)(Wb + row * 136 + cc * 8); } }
        LBAR();
    }
}

constexpr int SC_NW = 0, SC_QG = 17408, SC_KD = 34816, SC_PM = 53248, SC_UP = 62464, SC_GC = 66560, SC_BUF = 66816, SC_OB = 2 * SC_BUF, SC_OBSZ = 64 * 80;
static_assert(SC_OB + 2 * SC_OBSZ <= LDS_BYTES - 16, "scan LDS");
__device__ __forceinline__ void phase_gdn_scan(CParams& p, int i, unsigned char* shm) {
    const int tid = otid(), lane = tid & 63, wid = tid >> 6, r32 = lane & 31, hi = lane >> 5;
    const u32x4* NEGW = (const u32x4*)(p.ws + WS_NEGW); const u32x4* QG = (const u32x4*)(p.ws + WS_QG); const u32x4* KDT = (const u32x4*)(p.ws + WS_KDT);
    const u32x4* PM = (const u32x4*)(p.ws + WS_PM); const u32x4* UPRE = (const u32x4*)(p.ws + WS_UPRE); const float* GC = (const float*)(p.ws + WS_GC);
    bf16_t* OG = (bf16_t*)(p.ws + WS_OG);
    const int nb = gridDim.x, bid = blockIdx.x;
    for (int it = bid; it < 576; it = (nb > 64 ? (it < 64 ? 576 : it + (nb - 64)) : it + nb)) {
        int b, h, sl, nsteps, ch0, chs, T0; bool sample;
        if (it < 64) { b = it >> 4; h = (it >> 2) & 3; sl = it & 3; nsteps = 64; ch0 = b * 256 + h; chs = 4; T0 = b * 4096; sample = false; }
        else { const int j = it - 64; b = j >> 4; h = (j >> 2) & 3; sl = j & 3; nsteps = 1; ch0 = 1024 + (j >> 2); chs = 0; T0 = MP + b * 64; sample = true; }
        if (wid >= 4) {
            const int t2 = tid - 256; u32x4 st[15]; float stg = 0.f;
#define SC_LOAD(chv) do { const size_t ch_ = (size_t)(chv); \
                _Pragma("unroll") for (int r = 0; r < 4; ++r) st[r] = NEGW[ch_ * 1024 + t2 + 256 * r]; \
                _Pragma("unroll") for (int r = 0; r < 4; ++r) st[4 + r] = QG[ch_ * 1024 + t2 + 256 * r]; \
                _Pragma("unroll") for (int r = 0; r < 4; ++r) st[8 + r] = KDT[ch_ * 1024 + t2 + 256 * r]; \
                _Pragma("unroll") for (int r = 0; r < 2; ++r) st[12 + r] = PM[ch_ * 512 + t2 + 256 * r]; \
                st[14] = UPRE[(ch_ * 4 + sl) * 256 + t2]; if (t2 == 0) stg = GC[ch_]; } while (0)
#define SC_WRITE(bufi) do { unsigned char* base = shm + (bufi) * SC_BUF; \
                _Pragma("unroll") for (int r = 0; r < 4; ++r) { const int q = t2 + 256 * r; *(u32x4*)(base + SC_NW + (q >> 4) * 272 + (q & 15) * 16) = st[r]; } \
                _Pragma("unroll") for (int r = 0; r < 4; ++r) { const int q = t2 + 256 * r; *(u32x4*)(base + SC_QG + (q >> 4) * 272 + (q & 15) * 16) = st[4 + r]; } \
                _Pragma("unroll") for (int r = 0; r < 4; ++r) { const int q = t2 + 256 * r; *(u32x4*)(base + SC_KD + (q >> 3) * 144 + (q & 7) * 16) = st[8 + r]; } \
                _Pragma("unroll") for (int r = 0; r < 2; ++r) { const int q = t2 + 256 * r; *(u32x4*)(base + SC_PM + (q >> 3) * 144 + (q & 7) * 16) = st[12 + r]; } \
                *(u32x4*)(base + SC_UP + t2 * 16) = st[14]; if (t2 == 0) *(float*)(base + SC_GC) = stg; } while (0)
            SC_LOAD(ch0); SC_WRITE(0);
            if (nsteps > 1) SC_LOAD(ch0 + chs);
            LBAR();
            for (int s = 0; s < nsteps; ++s) {
                if (s + 1 < nsteps) { SC_WRITE((s + 1) & 1); if (s + 2 < nsteps) SC_LOAD(ch0 + (s + 2) * chs); }
                LBAR();
            }
#undef SC_LOAD
#undef SC_WRITE
        } else if (wid == 0) {
            f32x16 S[4];
            if (sample) { const float* s0 = p.in[5] + ((((size_t)i * 32 + b) * 4 + h) << 14) + 32 * sl + r32;
#pragma unroll
                for (int mb = 0; mb < 4; ++mb)
#pragma unroll
                    for (int r = 0; r < 16; ++r) S[mb][r] = s0[(32 * mb + crow32(r, hi)) * 128];
            } else {
#pragma unroll
                for (int mb = 0; mb < 4; ++mb)
#pragma unroll
                    for (int r = 0; r < 16; ++r) S[mb][r] = 0.f;
            }
            LBAR();
            for (int s = 0; s < nsteps; ++s) {
                const unsigned char* B0 = shm + (s & 1) * SC_BUF;
                f32x16 u[2], o[2];
#pragma unroll
                for (int mb = 0; mb < 2; ++mb)
#pragma unroll
                    for (int rg = 0; rg < 2; ++rg) { const u32x4 w = *(const u32x4*)(B0 + SC_UP + ((mb * 2 + rg) * 64 + lane) * 16);
#pragma unroll
                        for (int q = 0; q < 4; ++q) { u[mb][8 * rg + 2 * q] = __uint_as_float(w[q] << 16); u[mb][8 * rg + 2 * q + 1] = __uint_as_float(w[q] & 0xffff0000u); } }
                const float gc = *(const float*)(B0 + SC_GC);
                const unsigned char* lrow = B0 + r32 * 272 + hi * 16;
                const unsigned char* srow = B0 + r32 * 144 + hi * 16;
#define RD4(dst, base) do { _Pragma("unroll") for (int kk = 0; kk < 4; ++kk) dst[kk] = *(const bf16x8*)((base) + kk * 32); SBAR(); } while (0)
#define MM4(accv, fr, bop, o_) do { _Pragma("unroll") for (int kk = 0; kk < 4; ++kk) accv = __builtin_amdgcn_mfma_f32_32x32x16_bf16(fr[kk], bop[(o_) + kk], accv, 0, 0, 0); } while (0)
                bf16x8 fa[4], fb[4];
                RD4(fa, lrow + SC_NW); RD4(fb, lrow + SC_NW + 128);
                bf16x8 Sb[8];
#pragma unroll
                for (int kk = 0; kk < 8; ++kk) { const int mb = kk >> 1, hf = kk & 1;
                    u32x4 w = {pk2(S[mb][8 * hf], S[mb][8 * hf + 1]), pk2(S[mb][8 * hf + 2], S[mb][8 * hf + 3]), pk2(S[mb][8 * hf + 4], S[mb][8 * hf + 5]), pk2(S[mb][8 * hf + 6], S[mb][8 * hf + 7])};
                    Sb[kk] = *reinterpret_cast<bf16x8*>(&w); }
#pragma unroll
                for (int mb = 0; mb < 2; ++mb)
#pragma unroll
                    for (int r = 0; r < 16; ++r) o[mb][r] = 0.f;
                MM4(u[0], fa, Sb, 0); RD4(fa, lrow + SC_QG);
                MM4(u[0], fb, Sb, 4); RD4(fb, lrow + SC_QG + 128);
                MM4(o[0], fa, Sb, 0); RD4(fa, lrow + SC_NW + 32 * 272);
                MM4(o[0], fb, Sb, 4); RD4(fb, lrow + SC_NW + 32 * 272 + 128);
                MM4(u[1], fa, Sb, 0); RD4(fa, lrow + SC_QG + 32 * 272);
                MM4(u[1], fb, Sb, 4); RD4(fb, lrow + SC_QG + 32 * 272 + 128);
                MM4(o[1], fa, Sb, 0); RD4(fa, srow + SC_PM);
                MM4(o[1], fb, Sb, 4); RD4(fb, srow + SC_PM + 32 * 144);
                bf16x8 ub[4];
#pragma unroll
                for (int kk = 0; kk < 4; ++kk) { const int mb = kk >> 1, hf = kk & 1;
                    u32x4 w = {pk2(u[mb][8 * hf], u[mb][8 * hf + 1]), pk2(u[mb][8 * hf + 2], u[mb][8 * hf + 3]), pk2(u[mb][8 * hf + 4], u[mb][8 * hf + 5]), pk2(u[mb][8 * hf + 6], u[mb][8 * hf + 7])};
                    ub[kk] = *reinterpret_cast<bf16x8*>(&w); }
#pragma unroll
                for (int mb = 0; mb < 4; ++mb)
#pragma unroll
                    for (int r = 0; r < 16; ++r) S[mb][r] *= gc;
                MM4(o[0], fa, ub, 0); RD4(fa, srow + SC_KD);
                MM4(o[1], fb, ub, 0); RD4(fb, srow + SC_KD + 32 * 144);
                MM4(S[0], fa, ub, 0); RD4(fa, srow + SC_KD + 64 * 144);
                MM4(S[1], fb, ub, 0); RD4(fb, srow + SC_KD + 96 * 144);
                MM4(S[2], fa, ub, 0);
                MM4(S[3], fb, ub, 0);
#undef RD4
#undef MM4
                { unsigned char* ob = shm + SC_OB + (s & 1) * SC_OBSZ + r32 * 2;
#pragma unroll
                  for (int mb = 0; mb < 2; ++mb)
#pragma unroll
                      for (int r = 0; r < 16; ++r) *(bf16_t*)(ob + (32 * mb + crow32(r, hi)) * 80) = f2bf(o[mb][r]); }
                LBAR();
            }
            float* so = (sample ? p.out + OFF_SS + ((((size_t)i * 32 + b) * 4 + h) << 14) : p.out + OFF_PS + ((((size_t)i * 4 + b) * 4 + h) << 14)) + 32 * sl + r32;
#pragma unroll
            for (int mb = 0; mb < 4; ++mb)
#pragma unroll
                for (int r = 0; r < 16; ++r) so[(32 * mb + crow32(r, hi)) * 128] = S[mb][r];
        } else if (wid == 1) {
            LBAR();
            for (int s = 0; s <= nsteps; ++s) {
                if (s >= 1) { const unsigned char* ob = shm + SC_OB + ((s - 1) & 1) * SC_OBSZ;
#pragma unroll
                    for (int k = 0; k < 4; ++k) { const int q = lane + 64 * k, row = q >> 2, cc = q & 3;
                        *(u32x4*)(OG + (size_t)(T0 + 64 * (s - 1) + row) * 512 + h * 128 + 32 * sl + 8 * cc) = *(const u32x4*)(ob + row * 80 + cc * 16); } }
                if (s < nsteps) LBAR();
            }
        } else {
            LBAR();
            for (int s = 0; s < nsteps; ++s) LBAR();
        }
        LBAR();
    }
}

template <int PARTS>
__device__ __forceinline__ void phase_gdn_post(CParams& p, int i, int bid, int nb) {
    const int tid = otid(), lane = tid & 63, wid = tid >> 6;
    const bf16_t* P = (const bf16_t*)(p.ws + WS_BIG); const bf16_t* OG = (const bf16_t*)(p.ws + WS_OG); bf16_t* CAT = (bf16_t*)(p.ws + WS_CAT);
    float ng[8], w0[8], w1[8], w2[8];
    { const float* g = p.in[14] + i * 128 + ((8 * lane) & 127); const float* w = p.in[15] + (size_t)i * 3 * 512 + 8 * lane;
#pragma unroll
      for (int e = 0; e < 8; ++e) { ng[e] = g[e]; w0[e] = w[e]; w1[e] = w[512 + e]; w2[e] = w[1024 + e]; } }
    const int stride = nb * 8;
    for (int row0 = bid * 8 + wid; row0 < MT; row0 += 2 * stride) {
        u32x4 L[2][9]; int rows[2]; rows[0] = row0; rows[1] = row0 + stride < MT ? row0 + stride : row0;
#pragma unroll
        for (int q = 0; q < 2; ++q) { const int row = rows[q]; const bf16_t* pr = P + (size_t)row * NE + 8 * lane;
            const int t = row < MP ? (row & 4095) : ((row - MP) & 63);
            if (PARTS & 1) { L[q][0] = *(const u32x4*)(OG + (size_t)row * 512 + 8 * lane); L[q][1] = *(const u32x4*)(pr + 1536); }
            if (PARTS & 2) {
                L[q][2] = *(const u32x4*)(pr + 2048); L[q][3] = *(const u32x4*)(pr + 2560); L[q][4] = *(const u32x4*)(pr + 3072);
                const bf16_t* p1 = t >= 1 ? pr - NE : pr; const bf16_t* p2 = t >= 2 ? pr - 2 * NE : pr;
                L[q][5] = *(const u32x4*)(p1 + 2560); L[q][6] = *(const u32x4*)(p1 + 3072); L[q][7] = *(const u32x4*)(p2 + 2560); L[q][8] = *(const u32x4*)(p2 + 3072); } }
#pragma unroll
        for (int q = 0; q < 2; ++q) {
            const int row = rows[q];
            if (q == 1 && row0 + stride >= MT) break;
            if (PARTS & 1) { float ov[8], zv[8], r[8]; unpack8(L[q][0], ov); unpack8(L[q][1], zv);
              float ss = 0.f;
#pragma unroll
              for (int e = 0; e < 8; ++e) ss = fmaf(ov[e], ov[e], ss);
              ss = grp16_sum(ss);
              const float rms = 1.f / sqrtf(ss * (1.f / 128.f) + EPS);
#pragma unroll
              for (int e = 0; e < 8; ++e) r[e] = ov[e] * rms * ng[e] * silu_f(zv[e]);
              *(u32x4*)(CAT + (size_t)row * DM + 8 * lane) = pack8f(r); }
            if (PARTS & 2) {
            int b, t, T; bool sample;
            if (row < MP) { b = row >> 12; t = row & 4095; T = 4096; sample = false; } else { const int r2 = row - MP; b = r2 >> 6; t = r2 & 63; T = 64; sample = true; }
            float gb[8], gc[8], hn[8], u0[8], u1[8], u2[8], r[8];
            unpack8(L[q][2], gb); unpack8(L[q][3], gc); unpack8(L[q][4], hn);
#pragma unroll
            for (int e = 0; e < 8; ++e) u0[e] = gc[e] * hn[e];
            const float* st = p.in[7] + ((size_t)i * 32 + b) * 2 * 512 + 8 * lane;
            if (t >= 1) { unpack8(L[q][5], gc); unpack8(L[q][6], hn);
#pragma unroll
                for (int e = 0; e < 8; ++e) u1[e] = gc[e] * hn[e]; }
            else {
#pragma unroll
                for (int e = 0; e < 8; ++e) u1[e] = sample ? st[512 + e] : 0.f; }
            if (t >= 2) { unpack8(L[q][7], gc); unpack8(L[q][8], hn);
#pragma unroll
                for (int e = 0; e < 8; ++e) u2[e] = gc[e] * hn[e]; }
            else {
#pragma unroll
                for (int e = 0; e < 8; ++e) u2[e] = sample ? st[t * 512 + e] : 0.f; }
#pragma unroll
            for (int e = 0; e < 8; ++e) r[e] = gb[e] * (w0[e] * u2[e] + w1[e] * u1[e] + w2[e] * u0[e]);
            *(u32x4*)(CAT + (size_t)row * DM + 512 + 8 * lane) = pack8f(r);
            if (t >= T - 2) { float* d = (sample ? p.out + OFF_SSC + (((size_t)i * 32 + b) * 2 + (t - (T - 2))) * 512 : p.out + OFF_PSC + (((size_t)i * 4 + b) * 2 + (t - (T - 2))) * 512) + 8 * lane;
                *(f32x4*)d = (f32x4){u0[0], u0[1], u0[2], u0[3]}; *(f32x4*)(d + 4) = (f32x4){u0[4], u0[5], u0[6], u0[7]}; }
            }
        }
    }
}

__device__ __forceinline__ void phase_fox_prep(CParams& p, int i) {
    const int tid = otid(), lane = tid & 63, wid = tid >> 6;
    const bf16_t* R = (const bf16_t*)(p.ws + WS_BIG);
    bf16_t* QP = (bf16_t*)(p.ws + WS_QP); bf16_t* KP = (bf16_t*)(p.ws + WS_KP); bf16_t* VP = (bf16_t*)(p.ws + WS_VP);
    bf16_t* QS = (bf16_t*)(p.ws + WS_QS); bf16_t* KS = (bf16_t*)(p.ws + WS_KS); bf16_t* VS = (bf16_t*)(p.ws + WS_VS);
    for (int task = blockIdx.x + gridDim.x * wid; task < 288; task += gridDim.x * 8) {
        const float* src0; const float* src1; int len, n0; float* dst;
        if (task < 32) { const int bb = task >> 3, hh = task & 7; src0 = p.out + OFF_PLF + ((size_t)i * MP + (size_t)bb * 4096) * 8 + hh; src1 = src0; len = 4096; n0 = 4096; dst = (float*)(p.ws + WS_NCP) + task * 4096; }
        else { const int j = task - 32, bb = j >> 3, hh = j & 7; src0 = p.in[4] + ((size_t)i * 32 + bb) * 1024 * 8 + hh; src1 = p.out + OFF_SLF + ((size_t)i * MS + (size_t)bb * 64) * 8 + hh - (size_t)1024 * 8; len = 1088; n0 = 1024; dst = (float*)(p.ws + WS_NCS) + j * 1088; }
        float carry = 0.f;
        for (int s0 = 0; s0 < len; s0 += 512) {
            float v[8];
#pragma unroll
            for (int q = 0; q < 8; ++q) { const int s = s0 + 64 * q + lane; v[q] = s < len ? (s < n0 ? src0[(size_t)s * 8] : src1[(size_t)s * 8]) : 0.f; }
#pragma unroll
            for (int q = 0; q < 8; ++q) { const int s = s0 + 64 * q + lane; float x = wave_incl_scan(v[q], lane) + carry;
                if (s < len) dst[s] = -x * 11.313708498984761f;
                carry = __shfl(x, 63); }
        }
    }
    float qg[8], kg[8];
    { const float* a = p.in[19] + i * 128 + ((8 * lane) & 127); const float* c = p.in[20] + i * 128 + ((8 * lane) & 127);
#pragma unroll
      for (int e = 0; e < 8; ++e) { qg[e] = a[e]; kg[e] = c[e]; } }
    const int stride = gridDim.x * 8;
    for (int row0 = blockIdx.x * 8 + wid; row0 < MT; row0 += 2 * stride) {
        u32x4 L[2][6]; int rows[2]; rows[0] = row0; rows[1] = row0 + stride < MT ? row0 + stride : row0;
#pragma unroll
        for (int q = 0; q < 2; ++q) { const bf16_t* rr = R + (size_t)rows[q] * NO + 8 * lane;
#pragma unroll
            for (int hf = 0; hf < 2; ++hf) { L[q][hf * 3] = *(const u32x4*)(rr + hf * 512); L[q][hf * 3 + 1] = *(const u32x4*)(rr + 1024 + hf * 512); L[q][hf * 3 + 2] = *(const u32x4*)(rr + 2048 + hf * 512); } }
#pragma unroll
        for (int q = 0; q < 2; ++q) {
            const int row = rows[q];
            if (q == 1 && row0 + stride >= MT) break;
            float* fK; float* fV; size_t qbase, kbase; int qstr, kstr; bf16_t* Qd; bf16_t* Kd; bf16_t* Vd;
            if (row < MP) { const int bb = row >> 12, s_ = row & 4095; fK = p.out + OFF_PK + ((size_t)i * MP + row) * 1024; fV = p.out + OFF_PV + ((size_t)i * MP + row) * 1024;
                Qd = QP; Kd = KP; Vd = VP; qstr = 4096; kstr = 4096; qbase = (size_t)bb * 8 * 4096 + s_; kbase = qbase; }
            else { const int r2 = row - MP, bb = r2 >> 6, s_ = r2 & 63; fK = p.out + OFF_SK + ((size_t)i * MS + r2) * 1024; fV = p.out + OFF_SV + ((size_t)i * MS + r2) * 1024;
                Qd = nullptr; Kd = nullptr; Vd = nullptr; qstr = 64; kstr = 0; qbase = (size_t)bb * 8 * 64 + s_; kbase = 0; }
            const bool smp = row >= MP;
#pragma unroll
            for (int hf = 0; hf < 2; ++hf) {
                const int col = hf * 512 + 8 * lane, hh = col >> 7, d = col & 127;
                float x[8], r[8]; float ss;
                unpack8(L[q][hf * 3], x); ss = 0.f;
#pragma unroll
                for (int e = 0; e < 8; ++e) ss = fmaf(x[e], x[e], ss);
                ss = grp16_sum(ss); { const float rms = 1.f / sqrtf(ss * (1.f / 128.f) + EPS);
#pragma unroll
                  for (int e = 0; e < 8; ++e) r[e] = x[e] * rms * qg[e]; }
                if (smp) { float* qd = (float*)(p.ws + WS_KS) + (qbase + (size_t)hh * qstr) * 128 + d;
                    *(f32x4*)qd = (f32x4){r[0], r[1], r[2], r[3]}; *(f32x4*)(qd + 4) = (f32x4){r[4], r[5], r[6], r[7]}; }
                else *(u32x4*)(Qd + (qbase + (size_t)hh * qstr) * 128 + d) = pack8f(r);
                unpack8(L[q][hf * 3 + 1], x); ss = 0.f;
#pragma unroll
                for (int e = 0; e < 8; ++e) ss = fmaf(x[e], x[e], ss);
                ss = grp16_sum(ss); { const float rms = 1.f / sqrtf(ss * (1.f / 128.f) + EPS);
#pragma unroll
                  for (int e = 0; e < 8; ++e) r[e] = x[e] * rms * kg[e]; }
                *(f32x4*)(fK + col) = (f32x4){r[0], r[1], r[2], r[3]}; *(f32x4*)(fK + col + 4) = (f32x4){r[4], r[5], r[6], r[7]};
                if (!smp) *(u32x4*)(Kd + (kbase + (size_t)hh * kstr) * 128 + d) = pack8f(r);
                const u32x4 vw = L[q][hf * 3 + 2]; unpack8(vw, x);
                *(f32x4*)(fV + col) = (f32x4){x[0], x[1], x[2], x[3]}; *(f32x4*)(fV + col + 4) = (f32x4){x[4], x[5], x[6], x[7]};
                if (!smp) *(u32x4*)(Vd + (kbase + (size_t)hh * kstr) * 128 + d) = vw;
            }
        }
    }
}

typedef fa::BlockRef<bf16_t, bf16_t> FaRef;
typedef fa::BlockRef<float, bf16_t> FaRefS;
__device__ __forceinline__ FaRef fox_ref(CParams& p, int g, int k) {
    FaRef r;
    const int xcd = g & 7, j = g >> 3, bh = 4 * xcd + (j >> 3), x = j & 7, bb = bh >> 3, hh = bh & 7, blk = k ? 15 - x : x;
    r.Q = (const bf16_t*)(p.ws + WS_QP) + ((size_t)bh * 4096 + 256 * blk) * 128; r.K = (const bf16_t*)(p.ws + WS_KP) + (size_t)bh * 4096 * 128; r.V = (const bf16_t*)(p.ws + WS_VP) + (size_t)bh * 4096 * 128;
    r.K2 = r.K; r.V2 = r.V;
    r.O = (bf16_t*)(p.ws + WS_CAT) + ((size_t)bb * 4096 + 256 * blk) * 1024 + hh * 128; r.NC = (const float*)(p.ws + WS_NCP) + (size_t)bh * 4096; r.P0 = 256 * blk; r.nrows = 256;
    return r;
}
__device__ __forceinline__ FaRefS fox_ref_s(CParams& p, int i, int g) {
    FaRefS r; const int bh = g, bb = g >> 3, hh = g & 7;
    r.Q = (const float*)(p.ws + WS_KS) + (size_t)bh * 64 * 128;
    r.K = p.in[2] + ((size_t)i * 32 + bb) * 1024 * 1024 + hh * 128; r.V = p.in[3] + ((size_t)i * 32 + bb) * 1024 * 1024 + hh * 128;
    r.K2 = p.out + OFF_SK + ((size_t)i * MS + bb * 64) * 1024 + hh * 128 - (size_t)1024 * 1024; r.V2 = p.out + OFF_SV + ((size_t)i * MS + bb * 64) * 1024 + hh * 128 - (size_t)1024 * 1024;
    r.O = (bf16_t*)(p.ws + WS_CAT) + ((size_t)MP + bb * 64) * 1024 + hh * 128; r.NC = (const float*)(p.ws + WS_NCS) + (size_t)bh * 1088; r.P0 = 1024; r.nrows = 64;
    return r;
}
__device__ __forceinline__ void phase_fox_attn(CParams& p, int i, unsigned char* shm) {
    constexpr int W = 1 << 20;
    for (int g = blockIdx.x; g < 256; g += gridDim.x) {
#pragma unroll 1
        for (int k = 0; k < 2; ++k) {
            int kk = k; asm volatile("" : "+s"(kk));
            fa::Seam<bf16_t> S;
            const FaRef cur = fox_ref(p, g, kk);
            fa::causal_swa_prime<bf16_t, bf16_t>(cur, W, (char*)shm, S);
            fa::causal_swa_block<bf16_t, bf16_t>(cur, cur, 4096, W, (char*)shm, S);
        }
        { fa::Seam<float> S;
          const FaRefS cur = fox_ref_s(p, i, g);
          fa::causal_swa_prime<float, bf16_t>(cur, W, (char*)shm, S);
          fa::causal_swa_block<float, bf16_t>(cur, cur, 1088, W, (char*)shm, S); }
    }
}

__device__ __forceinline__ CParams* kparams() {
    CParams* k = (CParams*)__builtin_amdgcn_kernarg_segment_ptr(); asm volatile("" : "+s"(k)); return k;
}
__global__ __launch_bounds__(512, 2) void mega_fwd(Params p_unused) {
    extern __shared__ __attribute__((aligned(16))) unsigned char shm[];
    cg::grid_group grid = cg::this_grid();
    PG8_LAS unsigned char* lds = (PG8_LAS unsigned char*)shm;
    int ph = 0;
#ifndef PROBE_REP
#define PROBE_REP 0
#endif
#define GSYNC() do { XcdBarrier xb_; xb_.bar = (unsigned*)(kparams()->ws + WS_BAR); xb_.x = xb_xcc_id(); xb_.st = (volatile XB_LAS unsigned*)(lds + LDS_XB); xcd_barrier(xb_); } while (0)
#if PROBE_REP
#define PHASE(kind, ...) do { CParams& p = *kparams(); if (ph >= p.ph_lo && ph < p.ph_hi) { int nrep = 1 + ((PROBE_REP >> (kind)) & 1); asm volatile("" : "+s"(nrep)); \
        for (int rep = 0; rep < nrep; ++rep) { __VA_ARGS__; if (rep + 1 < nrep || ph + 1 < p.ph_hi) GSYNC(); } } ++ph; } while (0)
#else
#define PHASE(kind, ...) do { CParams& p = *kparams(); if (ph >= p.ph_lo && ph < p.ph_hi) { __VA_ARGS__; if (ph + 1 < p.ph_hi) GSYNC(); } ++ph; } while (0)
#endif
    if (otid() == 0) { *(volatile XB_LAS unsigned*)(lds + LDS_XB) = 0u; *(volatile XB_LAS unsigned*)(lds + LDS_XB + 4) = 0u; }
    __syncthreads();
    (void)xcd_barrier_post((unsigned*)(kparams()->ws + WS_BAR), (volatile XB_LAS unsigned*)(lds + LDS_XB));
    if (kparams()->ph_hi - kparams()->ph_lo > 1) grid.sync();
    PHASE(0, phase_init(p, shm));
#pragma unroll 1
    for (int layer = 0; layer < 4; ++layer) {
        const int i = layer >> 1; const bool even = (layer & 1) == 0;
        if (even) PHASE(1, phase_norm<0>(p, layer, shm, layer ? tail_parts(DFF, (int)gridDim.x) : 0)); else PHASE(1, phase_norm<1>(p, layer, shm, tail_parts(DFF, (int)gridDim.x)));
        PHASE(2, const bf16_t* Bt = even ? (const bf16_t*)(p.ws + WS_WINE) + (size_t)i * NE * DM : (const bf16_t*)(p.ws + WS_WINO) + (size_t)i * NO * DM;
              EpiBf16Plain E; E.O = (bf16_t*)(p.ws + WS_BIG); E.ldc = even ? NE : NO;
              run_gemm(lds, (const bf16_t*)(p.ws + WS_H), Bt, even ? NE : NO, DM, E));
        if (even) { PHASE(3, phase_gdn_prep(p, i, shm));
                    PHASE(4, phase_gdn_scan(p, i, shm); __syncthreads();
                             if (gridDim.x > 64) { if (blockIdx.x >= 64) { if (layer == 0) convert_weights(p, shm, 1, 4, (int)blockIdx.x - 64, (int)gridDim.x - 64);
                                                                           phase_gdn_post<2>(p, i, (int)blockIdx.x - 64, (int)gridDim.x - 64); } }
                             else { if (layer == 0) convert_weights(p, shm, 1, 4, (int)blockIdx.x, (int)gridDim.x); phase_gdn_post<2>(p, i, (int)blockIdx.x, (int)gridDim.x); });
                    PHASE(5, phase_gdn_post<1>(p, i, (int)blockIdx.x, (int)gridDim.x)); }
        else { PHASE(6, phase_fox_prep(p, i)); PHASE(7, phase_fox_attn(p, i, shm)); }
        PHASE(31, const bf16_t* Bt = even ? (const bf16_t*)(p.ws + WS_WOUTE) + (size_t)i * DM * DM : (const bf16_t*)(p.ws + WS_WOUTO) + (size_t)i * DM * DM;
              EpiResid E; E.X = p.out; E.ldc = DM; E.slab = (float*)(p.ws + WS_SLAB);
              run_gemm_n1024(lds, (const bf16_t*)(p.ws + WS_CAT), Bt, DM, E));
        PHASE(1, phase_norm<2>(p, layer, shm, tail_parts(DM, (int)gridDim.x)));
        PHASE(9, EpiSwiglu E; E.O = (bf16_t*)(p.ws + WS_BIG); E.ldc = DFF;
              run_gemm(lds, (const bf16_t*)(p.ws + WS_H), (const bf16_t*)(p.ws + WS_WF1) + (size_t)layer * NF1 * DM, NF1, DM, E));
        PHASE(31, EpiResid E; E.X = p.out; E.ldc = DM; E.slab = (float*)(p.ws + WS_SLAB);
              run_gemm_n1024(lds, (const bf16_t*)(p.ws + WS_BIG), (const bf16_t*)(p.ws + WS_WF2) + (size_t)layer * DM * DFF, DFF, E));
    }
    PHASE(1, phase_fixup(p, tail_parts(DFF, (int)gridDim.x)));
#undef PHASE
}
constexpr int N_PHASES = 1 + 2 * 9 + 2 * 8 + 1;

#ifndef MK_PER_PHASE
#define MK_PER_PHASE 0
#endif
extern "C" void kernel_launch(void* const* d_in, const int* in_sizes, int n_in, void* d_out, int out_size, void* d_ws, size_t ws_size, hipStream_t stream) {
    static int grid = 0;
    if (grid == 0) {
        if (n_in != 25 || (size_t)out_size != OUT_TOTAL || ws_size < WS_END) { fprintf(stderr, "kernel_launch: unexpected shapes (n_in %d, out %d, ws %zu < %zu)\n", n_in, out_size, ws_size, (size_t)WS_END); grid = -1; return; }
        int dev = 0, cus = 0, per_cu = 0;
        (void)hipGetDevice(&dev); (void)hipDeviceGetAttribute(&cus, hipDeviceAttributeMultiprocessorCount, dev);
        if (hipFuncSetAttribute((const void*)mega_fwd, hipFuncAttributeMaxDynamicSharedMemorySize, LDS_BYTES) != hipSuccess) { fprintf(stderr, "kernel_launch: hipFuncSetAttribute failed\n"); grid = -1; return; }
        if (hipOccupancyMaxActiveBlocksPerMultiprocessor(&per_cu, (const void*)mega_fwd, 512, LDS_BYTES) != hipSuccess || per_cu < 1) { fprintf(stderr, "kernel_launch: occupancy query says %d\n", per_cu); per_cu = 1; }
        (void)hipGetLastError();
        if (cus <= 0) cus = 256;
        grid = cus * 1;
    }
    if (grid < 0) return;
    (void)hipMemsetAsync((unsigned char*)d_ws + WS_BAR, 0, 16384, stream);
    Params p{};
    for (int k = 0; k < 25; ++k) p.in[k] = (const float*)d_in[k];
    p.out = (float*)d_out; p.ws = (unsigned char*)d_ws;
#if MK_PER_PHASE
    for (int ph = 0; ph < N_PHASES; ++ph) { p.ph_lo = ph; p.ph_hi = ph + 1; hipLaunchKernelGGL(mega_fwd, dim3(grid), dim3(512), LDS_BYTES, stream, p); }
#else
    p.ph_lo = 0; p.ph_hi = N_PHASES;
    void* args[] = {&p};
    hipError_t e = hipLaunchCooperativeKernel((const void*)mega_fwd, dim3(grid), dim3(512), args, LDS_BYTES, stream);
    if (e != hipSuccess) fprintf(stderr, "kernel_launch: cooperative launch failed: %s (grid %d)\n", hipGetErrorString(e), grid);
#endif
}
```

```cpp
#include <hip/hip_runtime.h>
#include <hip/hip_cooperative_groups.h>
#include <cstdio>
#include <cstdint>
namespace cg = cooperative_groups;

typedef unsigned short bf16_t;
typedef short bf16x8 __attribute__((ext_vector_type(8)));
typedef short s16x4 __attribute__((ext_vector_type(4)));
typedef float f32x16 __attribute__((ext_vector_type(16)));
typedef float f32x4 __attribute__((ext_vector_type(4)));
typedef unsigned u32x4 __attribute__((ext_vector_type(4)));
typedef unsigned u32x2 __attribute__((ext_vector_type(2)));

constexpr int DM = 1024, MP = 16384, MS = 2048, MT = MP + MS;
constexpr int EVEN_IN = 3592, ODD_IN = 3080, NE = 3584, NO = 3072, DFF = 2816, NF1 = 2 * DFF;
constexpr float EPS = 1e-6f;
constexpr size_t OFF_Y = 0;
constexpr size_t OFF_PK = (size_t)MT * DM;
constexpr size_t OFF_PV = OFF_PK + (size_t)2 * MP * 1024;
constexpr size_t OFF_PLF = OFF_PV + (size_t)2 * MP * 1024;
constexpr size_t OFF_PS = OFF_PLF + (size_t)2 * MP * 8;
constexpr size_t OFF_PCONV = OFF_PS + (size_t)2 * 4 * 4 * 128 * 128;
constexpr size_t OFF_PSC = OFF_PCONV + (size_t)2 * 4 * 3 * 1536;
constexpr size_t OFF_SK = OFF_PSC + (size_t)2 * 4 * 2 * 512;
constexpr size_t OFF_SV = OFF_SK + (size_t)2 * MS * 1024;
constexpr size_t OFF_SLF = OFF_SV + (size_t)2 * MS * 1024;
constexpr size_t OFF_SS = OFF_SLF + (size_t)2 * MS * 8;
constexpr size_t OFF_SCONV = OFF_SS + (size_t)2 * 32 * 4 * 128 * 128;
constexpr size_t OFF_SSC = OFF_SCONV + (size_t)2 * 32 * 3 * 1536;
constexpr size_t OUT_TOTAL = OFF_SSC + (size_t)2 * 32 * 2 * 512;
static_assert(OUT_TOTAL == 99790848, "output size");
constexpr size_t WS_WINE = 0;
constexpr size_t WS_WOUTE = WS_WINE + (size_t)2 * NE * DM * 2;
constexpr size_t WS_WINO = WS_WOUTE + (size_t)2 * DM * DM * 2;
constexpr size_t WS_WOUTO = WS_WINO + (size_t)2 * NO * DM * 2;
constexpr size_t WS_WF1 = WS_WOUTO + (size_t)2 * DM * DM * 2;
constexpr size_t WS_WF2 = WS_WF1 + (size_t)4 * NF1 * DM * 2;
constexpr size_t WS_H = WS_WF2 + (size_t)4 * DM * DFF * 2;
constexpr size_t WS_BIG = WS_H + (size_t)MT * DM * 2;
constexpr size_t WS_CAT = WS_BIG + (size_t)MT * NE * 2;
constexpr size_t WS_AB = WS_CAT + (size_t)MT * DM * 2;
constexpr size_t WS_OG = WS_AB + (size_t)MT * 8 * 4;
constexpr size_t WS_GC = WS_OG + (size_t)MT * 512 * 2;
constexpr size_t WS_NEGW = WS_GC + 8192;
constexpr size_t WS_QG = WS_NEGW + (size_t)1152 * 16384;
constexpr size_t WS_KDT = WS_QG + (size_t)1152 * 16384;
constexpr size_t WS_PM = WS_KDT + (size_t)1152 * 16384;
constexpr size_t WS_UPRE = WS_PM + (size_t)1152 * 8192;
constexpr size_t WS_QP = WS_UPRE + (size_t)1152 * 16384;
constexpr size_t WS_KP = WS_QP + (size_t)32 * 4096 * 128 * 2;
constexpr size_t WS_VP = WS_KP + (size_t)32 * 4096 * 128 * 2;
constexpr size_t WS_QS = WS_VP + (size_t)32 * 4096 * 128 * 2;
constexpr size_t WS_KS = WS_QS + (size_t)256 * 64 * 128 * 2 + 65536;
constexpr size_t WS_VS = WS_KS + (size_t)256 * 1088 * 128 * 2;
constexpr size_t WS_NCP = WS_VS + (size_t)256 * 1088 * 128 * 2;
constexpr size_t WS_NCS = WS_NCP + (size_t)32 * 4096 * 4;
constexpr size_t WS_BAR = WS_NCS + (size_t)256 * 1088 * 4;
constexpr size_t WS_SLAB = WS_BAR + 16384;
constexpr size_t WS_END = WS_SLAB + (size_t)8 * MS * DM * 4;
constexpr int LDS_BYTES = 163840;
constexpr int LDS_XB = LDS_BYTES - 16;

struct Params { const float* in[25]; float* out; unsigned char* ws; int ph_lo, ph_hi; };
typedef const __attribute__((address_space(4))) Params CParams;

#define KSWZ(row, colB) ((row) * 256 + ((colB) ^ (((row) & 7) << 4)))
#define SBAR() __builtin_amdgcn_sched_barrier(0)
template <class A, class Bt> struct same_t { static constexpr bool v = false; };
template <class A> struct same_t<A, A> { static constexpr bool v = true; };
__device__ __forceinline__ int otid() { int t = threadIdx.x; asm volatile("" : "+v"(t)); return t; }
#define LBAR() asm volatile("s_waitcnt lgkmcnt(0)\n\ts_barrier" ::: "memory")
namespace pg8 {
#define PG8_LAS __attribute__((address_space(3)))
typedef unsigned short bf16_t;
typedef short bf16x8 __attribute__((ext_vector_type(8)));
typedef float f32x4 __attribute__((ext_vector_type(4)));
typedef unsigned u32x4 __attribute__((ext_vector_type(4)));
constexpr int BM = 256, BK = 64, HALF = 128, HTB = HALF * BK * 2  , STAGE_BYTES = 8 * HTB, NXCD = 8, WGM = 8;

__host__ __device__ __forceinline__ int lds_byte(int r, int c) { const int st = (r >> 4) * 2 + (c >> 5), rr = r & 15, cc = c & 31, ob = rr * 64 + cc * 2; return st * 1024 + (ob ^ (((ob >> 9) & 1) << 5)); }
__host__ __device__ __forceinline__ void stage_rc(int b, int& R, int& C) { const int st = b / 1024, sb = b % 1024, swz = sb ^ (((sb >> 9) & 1) << 5); R = (st >> 1) * 16 + swz / 64; C = (st & 1) * 32 + (swz % 64) / 2; }
__host__ __device__ __forceinline__ int perm32(int rho) { const int n = rho >> 4, i = rho & 15; return 8 * (i >> 2) + 4 * n + (i & 3); }

struct Unit { int pm, pn, kt0, nkt, split; };
struct Gemm { const bf16_t* A; const bf16_t* Bt; int M, N, K; };

struct StaticOrder {
    int nM, nN, nwg, G, c, nktf;
    __host__ __device__ void init(int M, int N, int G_, int c_) { nM = M / BM; nN = N / BM; nwg = nM * nN; G = G_; c = c_; }
    __host__ __device__ bool next(int i, Unit& u) const {
        const long L = (long)i * G + c; if (L >= nwg) return false;
        int wgid = (int)L; { const int q = nwg / NXCD, r = nwg % NXCD, xcd = wgid % NXCD, off = wgid / NXCD; wgid = (xcd < r ? xcd * (q + 1) : r * (q + 1) + (xcd - r) * q) + off; }
        const int nig = WGM * nN, gid = wgid / nig, fm = gid * WGM, gsz = (nM - fm) < WGM ? (nM - fm) : WGM;
        u.pm = fm + ((wgid % nig) % gsz); u.pn = (wgid % nig) / gsz; u.kt0 = 0; u.nkt = nktf; u.split = 0; return true;
    }
    __device__ __forceinline__ void a_ready(const Unit&) const {}
    __device__ __forceinline__ void done(const Unit&) const {}
};
__device__ __forceinline__ unsigned cvt_pk_bf16(float lo, float hi) { unsigned r; asm volatile("v_cvt_pk_bf16_f32 %0, %1, %2" : "=v"(r) : "v"(lo), "v"(hi)); return r; }
template <class Epi, class Sched, bool STAMP = false>
__device__ __forceinline__ void gemm_phase(PG8_LAS unsigned char* lds, const Gemm g, const Sched& S, const Epi& E, unsigned long long* stamps) {
    const int tid = otid(), wid = __builtin_amdgcn_readfirstlane(tid >> 6), lane = tid & 63, wr = wid >> 2, wc = wid & 3, fr = lane & 15, fq = lane >> 4;
    const int K = g.K;
    int ts_lo = 0, ts_hi = 0, nts = 0; const unsigned long long rt_entry = STAMP ? (unsigned long long)wall_clock64() : 0ull;
#define PG8_STAMP() do { if (STAMP && wid == 0 && nts < 64) { const unsigned long long _c = (unsigned long long)clock64(); \
        ts_lo = (lane == nts) ? (int)(unsigned)_c : ts_lo; ts_hi = (lane == nts) ? (int)(unsigned)(_c >> 32) : ts_hi; ++nts; } } while (0)
    PG8_STAMP();
    unsigned voffA[2], voffB[2];
#pragma unroll
    for (int i = 0; i < 2; ++i) { int R, C; stage_rc(tid * 16 + i * 8192, R, C); const int Rb = Epi::PERM ? ((R & ~31) + perm32(R & 31)) : R;
        voffA[i] = (unsigned)(R * K + C) * 2u; voffB[i] = (unsigned)(Rb * K + C) * 2u; }
    const size_t kstep = (size_t)(BK * 2);
    const size_t hstep = (size_t)HALF * K * 2;
    const size_t tstep = 2 * hstep;
    const unsigned ldsw = (unsigned)wid * 1024u;
    const int aoff = lds_byte(wr * 64 + fr, fq * 8), boff = lds_byte(wc * 32 + fr, fq * 8);
#define PG8_SA(b, h) (((b) * 2 + (h)) * HTB)
#define PG8_SB(b, h) ((4 + (b) * 2 + (h)) * HTB)
#define PG8_STAGE(bufoff, gbase, voff) do { _Pragma("unroll") for (int _i = 0; _i < 2; ++_i) \
        __builtin_amdgcn_global_load_lds((const unsigned*)((const char*)(gbase) + (voff)[_i]), (PG8_LAS unsigned*)(lds + (bufoff) + ldsw + _i * 8192), 16, 0, 0); } while (0)
#define PG8_LDA(dst, b, h) do { _Pragma("unroll") for (int m = 0; m < 4; ++m) _Pragma("unroll") for (int k = 0; k < 2; ++k) dst[m][k] = *(const PG8_LAS bf16x8*)(lds + PG8_SA(b, h) + aoff + m * 2048 + k * 1024); } while (0)
#define PG8_LDB(dst, b, h) do { _Pragma("unroll") for (int n = 0; n < 2; ++n) _Pragma("unroll") for (int k = 0; k < 2; ++k) dst[n][k] = *(const PG8_LAS bf16x8*)(lds + PG8_SB(b, h) + boff + n * 2048 + k * 1024); } while (0)
#define PG8_MMA(ai, bj, At, Bt) do { __builtin_amdgcn_s_setprio(1); _Pragma("unroll") for (int m = 0; m < 4; ++m) _Pragma("unroll") for (int n = 0; n < 2; ++n) _Pragma("unroll") for (int k = 0; k < 2; ++k) \
        acc[ai][bj][m][n] = __builtin_amdgcn_mfma_f32_16x16x32_bf16(Bt[n][k], At[m][k], acc[ai][bj][m][n], 0, 0, 0); __builtin_amdgcn_s_setprio(0); } while (0)
#define PG8_WAIT_V(n) asm volatile("s_waitcnt vmcnt(" #n ")" ::: "memory")
#define PG8_WAIT_L(n) asm volatile("s_waitcnt lgkmcnt(" #n ")" ::: "memory")
#define PG8_BAR __builtin_amdgcn_s_barrier()
#define PG8_SCHED __builtin_amdgcn_sched_barrier(0)
    Unit cur, nxt; int ui = 0;
    if (!S.next(0, cur)) return;
    f32x4 acc[2][2][4][2];
#pragma unroll
    for (int a = 0; a < 2; ++a)
#pragma unroll
        for (int b = 0; b < 2; ++b)
#pragma unroll
            for (int m = 0; m < 4; ++m)
#pragma unroll
                for (int n = 0; n < 2; ++n) acc[a][b][m][n] = (f32x4){0.f, 0.f, 0.f, 0.f};
    bf16x8 At[4][2], B0[2][2], B1[2][2];
    const char* cA = (const char*)g.A + (size_t)cur.pm * tstep + (size_t)cur.kt0 * kstep; const char* cB = (const char*)g.Bt + (size_t)cur.pn * tstep + (size_t)cur.kt0 * kstep;
    S.a_ready(cur);
    PG8_STAGE(PG8_SB(0, 0), cB, voffB); PG8_STAGE(PG8_SA(0, 0), cA, voffA); PG8_STAGE(PG8_SB(0, 1), cB + hstep, voffB); PG8_STAGE(PG8_SA(0, 1), cA + hstep, voffA);
    if (wr == 1) PG8_BAR;
    PG8_WAIT_V(4); PG8_BAR;
    PG8_STAGE(PG8_SB(1, 0), cB + kstep, voffB); PG8_STAGE(PG8_SA(1, 0), cA + kstep, voffA); PG8_STAGE(PG8_SB(1, 1), cB + hstep + kstep, voffB);
    PG8_WAIT_V(6); PG8_BAR;
    PG8_STAMP();
    for (;;) {
        const bool has_next = S.next(ui + 1, nxt);
        const char* nA = has_next ? (const char*)g.A + (size_t)nxt.pm * tstep + (size_t)nxt.kt0 * kstep : cA; const char* nB = has_next ? (const char*)g.Bt + (size_t)nxt.pn * tstep + (size_t)nxt.kt0 * kstep : cB;
        const int nt = cur.nkt;
        for (int t = 0; t < nt; t += 2) {
            const bool last = (t == nt - 2);
            const char* a1 = cA + (size_t)(t + 1) * kstep;
            const char* a2 = last ? nA : cA + (size_t)(t + 2) * kstep; const char* b2 = last ? nB : cB + (size_t)(t + 2) * kstep;
            const char* a3 = a2 + kstep; const char* b3 = b2 + kstep;
            if (last && has_next) S.a_ready(nxt);
            PG8_LDB(B0, 0, 0); PG8_SCHED; PG8_LDA(At, 0, 0); PG8_STAGE(PG8_SA(1, 1), a1 + hstep, voffA);
            PG8_WAIT_L(8); PG8_BAR; PG8_WAIT_L(0); PG8_MMA(0, 0, At, B0); PG8_BAR; PG8_SCHED;
            PG8_LDB(B1, 0, 1); PG8_STAGE(PG8_SB(0, 0), b2, voffB);
            PG8_BAR; PG8_WAIT_L(0); PG8_MMA(0, 1, At, B1); PG8_BAR;
            PG8_LDA(At, 0, 1); PG8_STAGE(PG8_SA(0, 0), a2, voffA);
            PG8_BAR; PG8_WAIT_L(0); PG8_MMA(1, 0, At, B0); PG8_BAR; PG8_SCHED;
            PG8_STAGE(PG8_SB(0, 1), b2 + hstep, voffB);
            PG8_WAIT_V(6); PG8_BAR; PG8_MMA(1, 1, At, B1); PG8_BAR;
            PG8_LDB(B0, 1, 0); PG8_SCHED; PG8_LDA(At, 1, 0); PG8_STAGE(PG8_SA(0, 1), a2 + hstep, voffA);
            PG8_WAIT_L(8); PG8_BAR; PG8_WAIT_L(0); PG8_MMA(0, 0, At, B0); PG8_BAR; PG8_SCHED;
            PG8_LDB(B1, 1, 1); PG8_STAGE(PG8_SB(1, 0), b3, voffB);
            PG8_BAR; PG8_WAIT_L(0); PG8_MMA(0, 1, At, B1); PG8_BAR;
            PG8_LDA(At, 1, 1); PG8_STAGE(PG8_SA(1, 0), a3, voffA);
            PG8_BAR; PG8_WAIT_L(0); PG8_MMA(1, 0, At, B0); PG8_BAR; PG8_SCHED;
            PG8_STAGE(PG8_SB(1, 1), b3 + hstep, voffB);
            PG8_WAIT_V(6); PG8_BAR; PG8_MMA(1, 1, At, B1); PG8_BAR;
        }
        PG8_STAMP();
        if constexpr (!Epi::AFTER_DRAIN) { E(acc, cur, wr, wc, fr, fq); S.done(cur); }
        PG8_STAMP();
        if (!has_next) break;
#pragma unroll
        for (int a = 0; a < 2; ++a)
#pragma unroll
            for (int b = 0; b < 2; ++b)
#pragma unroll
                for (int m = 0; m < 4; ++m)
#pragma unroll
                    for (int n = 0; n < 2; ++n) acc[a][b][m][n] = (f32x4){0.f, 0.f, 0.f, 0.f};
        cur = nxt; cA = nA; cB = nB; ++ui;
    }
    PG8_WAIT_V(0);
    if (wr == 0) PG8_BAR;
    PG8_BAR;
    if constexpr (Epi::AFTER_DRAIN) { E.fused(acc, cur, wr, wc, fr, fq, lds, wid, lane); S.done(cur); }
    PG8_STAMP();
    if (STAMP && wid == 0) { stamps[lane] = lane < nts ? (((unsigned long long)(unsigned)ts_hi << 32) | (unsigned)ts_lo) : 0ull;
        if (lane == 62) stamps[62] = rt_entry; if (lane == 63) stamps[63] = (unsigned long long)wall_clock64(); }
#undef PG8_STAMP
#undef PG8_SA
#undef PG8_SB
#undef PG8_STAGE
#undef PG8_LDA
#undef PG8_LDB
#undef PG8_MMA
#undef PG8_WAIT_V
#undef PG8_WAIT_L
#undef PG8_BAR
#undef PG8_SCHED
}
}
namespace fa {
constexpr int D = 128, OSTR = 1024;
constexpr float SCALE = 0.08838834764831845f;
constexpr float THR = 8.f;
constexpr bool WSKIP = false;
constexpr int NW = 8, QBLK = 32, KVBLK = 64, QB = NW * QBLK;
constexpr int SHM_V = KVBLK * D * 2, SHM_K = KVBLK * D * 2;
__device__ __forceinline__ int v_st(int k, int c) { const int kk = (k & ~0xC) | ((k & 4) << 1) | ((k & 8) >> 1); return ((kk >> 3) * 4 + (c >> 5)) * 512 + ((kk & 7) * 32 + (c & 31)) * 2; }
__device__ __forceinline__ int v_rd_base(int lane) { return ((lane & 3) << 3) | (((lane >> 2) & 3) << 6) | (((lane >> 4) & 1) << 5) | (((lane >> 5) & 1) << 8); }
constexpr int v_rd_off(int d0, int ks, int half) { return d0 * 512 + ks * 4096 + half * 2048; }
__device__ __forceinline__ int crow(int r, int hi) { return (r & 3) + 8 * (r >> 2) + 4 * hi; }
__device__ __forceinline__ unsigned cvtpk(float lo, float hi) {
    unsigned r; asm volatile("v_cvt_pk_bf16_f32 %0, %1, %2" : "=v"(r) : "v"(lo), "v"(hi)); return r;
}
__device__ __forceinline__ bf16x8 pack8(f32x4 a, f32x4 b) {
    u32x4 w = {cvtpk(a[0], a[1]), cvtpk(a[2], a[3]), cvtpk(b[0], b[1]), cvtpk(b[2], b[3])};
    return *reinterpret_cast<bf16x8*>(&w);
}
template <class T> __device__ __forceinline__ bf16x8 load8(const T* p) {
    if constexpr (same_t<T, float>::v) { return pack8(*(const f32x4*)p, *(const f32x4*)(p + 4)); }
    else { return *reinterpret_cast<const bf16x8*>(p); }
}
__device__ __forceinline__ void mask_tile(f32x16& p0, f32x16& p1, int dq, unsigned W) {
    const float NEG = -__builtin_inff();
#pragma unroll
    for (int r = 0; r < 16; ++r) {
        const int c = (r & 3) + 8 * (r >> 2);
        if ((unsigned)(dq - c) >= W) p0[r] = NEG;
        if ((unsigned)(dq - c - 32) >= W) p1[r] = NEG;
    }
}
__device__ __forceinline__ void partialSM(f32x16& p0, f32x16& p1, float& m_reg, float& mn, float& alpha) {
    float pmax = p0[0]; for (int r = 1; r < 16; ++r) pmax = fmaxf(pmax, p0[r]); for (int r = 0; r < 16; ++r) pmax = fmaxf(pmax, p1[r]);
    { auto rr = __builtin_amdgcn_permlane32_swap(__float_as_uint(pmax), __float_as_uint(pmax), false, false);
      pmax = fmaxf(__uint_as_float(rr[0]), __uint_as_float(rr[1])); }
    constexpr float C2 = 1.4426950408889634f * SCALE;
    if (__builtin_expect(__all((pmax - m_reg) * SCALE <= THR), 1)) { mn = m_reg; alpha = 1.f; }
    else { mn = fmaxf(m_reg, pmax); alpha = __builtin_amdgcn_exp2f((m_reg - mn) * C2); m_reg = mn; }
    const float mnL = -mn * C2;
    for (int r = 0; r < 16; ++r) p0[r] = fmaf(p0[r], C2, mnL); for (int r = 0; r < 16; ++r) p1[r] = fmaf(p1[r], C2, mnL);
    for (int r = 0; r < 16; ++r) p0[r] = __builtin_amdgcn_exp2f(p0[r]);
}
__device__ __forceinline__ void finishSM(f32x16& p0, f32x16& p1, float alpha, float& l_reg, bf16x8& pa0, bf16x8& pa1, bf16x8& pa2, bf16x8& pa3) {
    for (int r = 0; r < 16; ++r) p1[r] = __builtin_amdgcn_exp2f(p1[r]);
    float ps = 0; for (int r = 0; r < 16; ++r) ps += p0[r]; for (int r = 0; r < 16; ++r) ps += p1[r];
    { auto rr = __builtin_amdgcn_permlane32_swap(__float_as_uint(ps), __float_as_uint(ps), false, false);
      ps = __uint_as_float(rr[0]) + __uint_as_float(rr[1]); }
    l_reg = l_reg * alpha + ps;
#define PK4(P, B_, OUT) do { unsigned a0 = cvtpk(P[B_+0], P[B_+1]), a1 = cvtpk(P[B_+2], P[B_+3]);                          \
        unsigned b0 = cvtpk(P[B_+4], P[B_+5]), b1 = cvtpk(P[B_+6], P[B_+7]);                                             \
        auto r0 = __builtin_amdgcn_permlane32_swap(a0, b0, false, false); auto r1 = __builtin_amdgcn_permlane32_swap(a1, b1, false, false); \
        u32x4 w = {r0[0], r1[0], r0[1], r1[1]}; OUT = *reinterpret_cast<bf16x8*>(&w); } while (0)
    PK4(p0, 0, pa0); PK4(p0, 8, pa1); PK4(p1, 0, pa2); PK4(p1, 8, pa3);
#undef PK4
}
template <int KB, bool SK>
__device__ __forceinline__ void qkt(f32x16& p0, f32x16& p1, const char* K_lds, const char* B_lds, int r32, int hi, const bf16x8* qr, bool act) {
    if (SK && !act) { const float NEG = -__builtin_inff();
#pragma unroll
        for (int r = 0; r < 16; ++r) { p0[r] = NEG; p1[r] = NEG; } return; }
    { const float* bl = (const float*)B_lds + 4 * hi;
#pragma unroll
      for (int g = 0; g < 4; ++g) { const f32x4 ba = *(const f32x4*)(bl + 8 * g); const f32x4 bb = *(const f32x4*)(bl + 32 + 8 * g);
#pragma unroll
        for (int e = 0; e < 4; ++e) { p0[4 * g + e] = ba[e]; p1[4 * g + e] = bb[e]; } } }
    const char* kb[4];
#pragma unroll
    for (int dd = 0; dd < 4; ++dd) kb[dd] = K_lds + KB * SHM_K + KSWZ(r32, (dd * 16 + hi * 8) * 2);
#pragma unroll
    for (int d0 = 0; d0 < 8; ++d0) { const char* a = kb[d0 & 3] + (d0 >> 2) * 128;
        bf16x8 b0 = *reinterpret_cast<const bf16x8*>(a);
        bf16x8 b1 = *reinterpret_cast<const bf16x8*>(a + 32 * 256);
        p0 = __builtin_amdgcn_mfma_f32_32x32x16_bf16(b0, qr[d0], p0, 0, 0, 0);
        p1 = __builtin_amdgcn_mfma_f32_32x32x16_bf16(b1, qr[d0], p1, 0, 0, 0); }
}
template <int VB, bool SK>
__device__ __forceinline__ void pv_tile(f32x16* o, int vb0, bf16x8 pa0, bf16x8 pa1, bf16x8 pa2, bf16x8 pa3, bool act) {
    if (SK && !act) return;
#define TRRD(dst, off) asm volatile("ds_read_b64_tr_b16 %0, %1 offset:%2" : "=&v"(dst) : "v"(vb0), "i"(off) : "memory")
#define PV_D0(d0) do { s16x4 l0, l1, l2, l3, h0, h1, h2, h3; constexpr int b_ = VB * SHM_V + v_rd_off(d0, 0, 0);     \
        TRRD(l0, b_); TRRD(h0, b_ + 2048); TRRD(l1, b_ + 4096); TRRD(h1, b_ + 6144); TRRD(l2, b_ + 8192); TRRD(h2, b_ + 10240); TRRD(l3, b_ + 12288); TRRD(h3, b_ + 14336); \
        asm volatile("s_waitcnt lgkmcnt(0)" ::: "memory"); SBAR();                 \
        o[d0] = __builtin_amdgcn_mfma_f32_32x32x16_bf16(pa0, (bf16x8){l0[0], l0[1], l0[2], l0[3], h0[0], h0[1], h0[2], h0[3]}, o[d0], 0, 0, 0);   \
        o[d0] = __builtin_amdgcn_mfma_f32_32x32x16_bf16(pa1, (bf16x8){l1[0], l1[1], l1[2], l1[3], h1[0], h1[1], h1[2], h1[3]}, o[d0], 0, 0, 0);   \
        o[d0] = __builtin_amdgcn_mfma_f32_32x32x16_bf16(pa2, (bf16x8){l2[0], l2[1], l2[2], l2[3], h2[0], h2[1], h2[2], h2[3]}, o[d0], 0, 0, 0);   \
        o[d0] = __builtin_amdgcn_mfma_f32_32x32x16_bf16(pa3, (bf16x8){l3[0], l3[1], l3[2], l3[3], h3[0], h3[1], h3[2], h3[3]}, o[d0], 0, 0, 0); } while (0)
    PV_D0(0); PV_D0(1); PV_D0(2); PV_D0(3);
#undef PV_D0
#undef TRRD
}

template <class TIn, class TOut> struct BlockRef { const TIn* Q; const TIn* K; const TIn* V; const TIn* K2; const TIn* V2; TOut* O; const float* NC; int P0; int nrows; };
template <class TIn> struct Seam {
    bf16x8 qr[8];
    bf16x8 st_v0, st_v1, st_k0, st_k1; f32x4 sf0, sf1, sf2, sf3;
    f32x4 tq[16];
};
__device__ __forceinline__ int swa_jlo(int P0, int W) { const int lowk = P0 - W + 1; return lowk > 0 ? lowk / KVBLK : 0; }
#define ROW(p, k0, rr) ((p) + (size_t)((k0) + (rr)) * D + sc)
#define VMW() asm volatile("s_waitcnt vmcnt(0)" ::: "memory")
#define VMWN(n) asm volatile("s_waitcnt vmcnt(%0)" :: "i"(n) : "memory")
#define SLOAD_H(Kp, Vp, NCp, k0) do { S.st_v0 = load8<TIn>(ROW(Vp, k0, sr)); S.st_v1 = load8<TIn>(ROW(Vp, k0, 32 + sr));              \
                         S.st_k0 = load8<TIn>(ROW(Kp, k0, sr)); S.st_k1 = load8<TIn>(ROW(Kp, k0, 32 + sr)); } while (0)
#define SWRITE_HK(bf) do { *(bf16x8*)(K_lds + (bf) * SHM_K + kws) = S.st_k0; *(bf16x8*)(K_lds + (bf) * SHM_K + kws + 32 * 256) = S.st_k1; } while (0)
#define SWRITE_HV(bf) do { *(bf16x8*)(V_lds + (bf) * SHM_V + vst0) = S.st_v0; *(bf16x8*)(V_lds + (bf) * SHM_V + vst1) = S.st_v1; } while (0)
#define SWRITE_H(bf) do { SWRITE_HV(bf); SWRITE_HK(bf); } while (0)
#define ROWF(p, k0, rr) ((p) + (size_t)((k0) + (rr)) * 1024 + sc)
#define FSEL(a, b, k0) ((const float*)((k0) < 1024 ? (a) : (b)))
#define SLOAD_F(p, k0) do { S.sf0 = __builtin_nontemporal_load((const f32x4*)ROWF(p, k0, sr)); S.sf1 = __builtin_nontemporal_load((const f32x4*)(ROWF(p, k0, sr) + 4));                \
                            S.sf2 = __builtin_nontemporal_load((const f32x4*)ROWF(p, k0, 32 + sr)); S.sf3 = __builtin_nontemporal_load((const f32x4*)(ROWF(p, k0, 32 + sr) + 4)); } while (0)
#define SWRITE_KF(bf) do { *(bf16x8*)(K_lds + (bf) * SHM_K + kws) = pack8(S.sf0, S.sf1); *(bf16x8*)(K_lds + (bf) * SHM_K + kws + 32 * 256) = pack8(S.sf2, S.sf3); } while (0)
#define SWRITE_VF(bf) do { *(bf16x8*)(V_lds + (bf) * SHM_V + vst0) = pack8(S.sf0, S.sf1); *(bf16x8*)(V_lds + (bf) * SHM_V + vst1) = pack8(S.sf2, S.sf3); } while (0)
template <class TIn, class TOut>
__device__ __forceinline__ void causal_swa_prime(const BlockRef<TIn, TOut>& cur, int W, char* lds, Seam<TIn>& S) {
    constexpr bool F32 = same_t<TIn, float>::v;
    const int tid = otid(), wid = __builtin_amdgcn_readfirstlane(tid >> 6), lane = tid & 63, r32 = lane & 31, hi = lane >> 5;
    const int sr = tid >> 4, sc = (tid & 15) * 8, kws = KSWZ(sr, sc * 2); char* K_lds = lds + 2 * SHM_V; char* B_lds = lds + 2 * SHM_V + 2 * SHM_K + NW * 64 * 4;
    const int kb0 = swa_jlo(cur.P0, W) * KVBLK;
    for (int d0 = 0; d0 < 8; ++d0) S.qr[d0] = load8<TIn>(cur.Q + (size_t)(wid * QBLK + r32) * D + d0 * 16 + hi * 8);
    if constexpr (F32) { SLOAD_F(FSEL(cur.K, cur.K2, kb0), kb0); VMW(); SWRITE_KF(0); SBAR(); SLOAD_F(FSEL(cur.V, cur.V2, kb0), kb0); }
    else { SLOAD_H(cur.K, cur.V, cur.NC, kb0); VMW(); SWRITE_HK(0); }
    __syncthreads();
}
template <class TIn, class TOut>
__device__ __forceinline__ void causal_swa_block(const BlockRef<TIn, TOut>& cur, const BlockRef<TIn, TOut>& nxt, int skv, int W, char* lds, Seam<TIn>& S) {
    constexpr bool F32 = same_t<TIn, float>::v;
    const int tid = otid(), wid = __builtin_amdgcn_readfirstlane(tid >> 6), lane = tid & 63, r32 = lane & 31, hi = lane >> 5;
    const int j_lo = swa_jlo(cur.P0, W);
    int j_hi = (cur.P0 + QB - 1) / KVBLK + 1; if (j_hi > skv / KVBLK) j_hi = skv / KVBLK;
    const int NT = j_hi - j_lo;
    const int kbn = swa_jlo(nxt.P0, W) * KVBLK;
    const int qlo = cur.P0 + wid * QBLK, qm = qlo + r32 - 4 * hi;
    char* V_lds = lds; char* K_lds = lds + 2 * SHM_V; char* B_lds = lds + 2 * SHM_V + 2 * SHM_K + NW * 64 * 4;
    float* ws = (float*)(lds + 2 * SHM_V + 2 * SHM_K) + wid * 64; float* li_l = ws, * al_l = ws + 32;
    float m_reg = -1e30f, l_reg = 0; f32x16 o[4] = {};
    const int sr = tid >> 4, sc = (tid & 15) * 8, vst0 = v_st(sr, sc), vst1 = v_st(32 + sr, sc), kws = KSWZ(sr, sc * 2);
    const int vb0 = (int)(uintptr_t)V_lds + v_rd_base(lane);
    const TIn* Kh = cur.K; const TIn* Vh = cur.V;
#define RESC(a) do { if (__any((a) < 1.f)) { if (hi == 0) al_l[r32] = (a); asm volatile("s_waitcnt lgkmcnt(0)" ::: "memory");              \
                     for (int d_ = 0; d_ < 4; ++d_) for (int r = 0; r < 16; ++r) o[d_][r] *= al_l[crow(r, hi)]; } } while (0)
#define KBASE(t) ((j_lo + (t)) * KVBLK)
#define ACT(t) (KBASE(t) <= qlo + QBLK - 1 && KBASE(t) + KVBLK - 1 >= qlo - W + 1)
#define MASKT(P0_, P1_, t) do { const int kb_ = KBASE(t); if ((!SK || ACT(t)) && (kb_ + KVBLK - 1 > qlo || kb_ <= qlo + QBLK - 1 - W)) mask_tile(P0_, P1_, qm - kb_, (unsigned)W); } while (0)
    constexpr int NQL = F32 ? 16 : 8;
    constexpr bool SK = WSKIP && !F32;
#define SEAM_K0() do { VMWN(NQL); if constexpr (F32) { SWRITE_KF(0); SBAR(); SLOAD_F(FSEL(nxt.V, nxt.V2, kbn), kbn); } else { SWRITE_HK(0); } SBAR(); } while (0)
    f32x16 pA0, pA1, pB0, pB1; float mnA, mnB, alA, alB; bf16x8 pa0, pa1, pa2, pa3;
    { const int nbk = j_hi * KVBLK;
      for (int q = tid * 4; q < nbk; q += 2048) *(f32x4*)(B_lds + q * 4) = *(const f32x4*)(cur.NC + q);
      __syncthreads(); }
    if constexpr (F32) { VMW(); SWRITE_VF(0); SBAR(); } else { SWRITE_HV(0); SBAR(); }
    if (NT > 1) { if constexpr (F32) SLOAD_F(FSEL(cur.K, cur.K2, KBASE(1)), KBASE(1)); else SLOAD_H(Kh, Vh, cur.NC, KBASE(1)); }
    SBAR(); qkt<0, SK>(pA0, pA1, K_lds, B_lds + KBASE(0) * 4, r32, hi, S.qr, ACT(0));
    if constexpr (F32) { if (NT > 1) { VMW(); SWRITE_KF(1); SBAR(); SLOAD_F(FSEL(cur.V, cur.V2, KBASE(1)), KBASE(1)); } }
    MASKT(pA0, pA1, 0); partialSM(pA0, pA1, m_reg, mnA, alA);
    if (NT > 1) { VMW(); if constexpr (F32) { SWRITE_VF(1); SBAR(); if (NT > 2) SLOAD_F(FSEL(cur.K, cur.K2, KBASE(2)), KBASE(2)); } else SWRITE_H(1); }
    __syncthreads();
#define HALF_STEP(PX0, PX1, mnX, alX, PY0, PY1, alY, t, KB, VB, SB) do {                                                      \
        SBAR(); qkt<KB, SK>(PX0, PX1, K_lds, B_lds + KBASE(t) * 4, r32, hi, S.qr, ACT(t));                                             \
        finishSM(PY0, PY1, alY, l_reg, pa0, pa1, pa2, pa3); SBAR();                                                           \
        if ((t) + 1 < NT) { if constexpr (F32) { VMW(); SWRITE_KF(SB); SBAR(); SLOAD_F(FSEL(cur.V, cur.V2, KBASE((t) + 1)), KBASE((t) + 1)); }  \
                            else { SLOAD_H(Kh, Vh, cur.NC, KBASE((t) + 1)); } SBAR(); }                                               \
        pv_tile<VB, SK>(o, vb0, pa0, pa1, pa2, pa3, ACT((t) - 1)); MASKT(PX0, PX1, (t)); partialSM(PX0, PX1, m_reg, mnX, alX);                                        \
        __syncthreads();                                                                                                      \
        if ((t) + 1 < NT) { VMW(); if constexpr (F32) { SWRITE_VF(SB); SBAR(); if ((t) + 2 < NT) SLOAD_F(FSEL(cur.K, cur.K2, KBASE((t) + 2)), KBASE((t) + 2)); } \
                            else { SWRITE_H(SB); } }                                                                          \
        RESC(alX); __syncthreads(); } while (0)
    for (int t = 1; t + 1 < NT; t += 2) {
        HALF_STEP(pB0, pB1, mnB, alB, pA0, pA1, alA, t, 1, 0, 0);
        HALF_STEP(pA0, pA1, mnA, alA, pB0, pB1, alB, t + 1, 0, 1, 1);
    }
    const bool even = (NT & 1) == 0;
    if (even) { SBAR(); qkt<1, SK>(pB0, pB1, K_lds, B_lds + KBASE(NT - 1) * 4, r32, hi, S.qr, ACT(NT - 1)); SBAR(); }
#define QROW(e) (nxt.Q + (size_t)(wid * QBLK + r32) * D + ((e) >> 1) * 16 + hi * 8 + ((e) & 1) * 4)
    if constexpr (F32) { SLOAD_F(FSEL(nxt.K, nxt.K2, kbn), kbn); SBAR();
#pragma unroll
        for (int e = 0; e < 8; ++e) S.tq[e] = *(const f32x4*)QROW(e); }
    else { SLOAD_H(nxt.K, nxt.V, nxt.NC, kbn); SBAR();
#pragma unroll
        for (int d0 = 0; d0 < 8; ++d0) S.qr[d0] = load8<TIn>(nxt.Q + (size_t)(wid * QBLK + r32) * D + d0 * 16 + hi * 8); }
    SBAR();
    finishSM(pA0, pA1, alA, l_reg, pa0, pa1, pa2, pa3); SBAR();
    if constexpr (F32) {
#pragma unroll
        for (int e = 8; e < 16; ++e) S.tq[e] = *(const f32x4*)QROW(e); SBAR(); }
#undef QROW
    pv_tile<0, SK>(o, vb0, pa0, pa1, pa2, pa3, ACT(even ? NT - 2 : NT - 1));
    if (even) { MASKT(pB0, pB1, NT - 1); partialSM(pB0, pB1, m_reg, mnB, alB); __syncthreads(); RESC(alB);
        finishSM(pB0, pB1, alB, l_reg, pa0, pa1, pa2, pa3); SBAR(); pv_tile<1, SK>(o, vb0, pa0, pa1, pa2, pa3, ACT(NT - 1)); }
    SBAR(); SEAM_K0();
    if (hi == 0) li_l[r32] = l_reg; asm volatile("s_waitcnt lgkmcnt(0)" ::: "memory");
    float rli[16];
#pragma unroll
    for (int r = 0; r < 16; ++r) rli[r] = __builtin_amdgcn_rcpf(li_l[crow(r, hi)]);
    TOut* Ow = cur.O + (size_t)(wid * QBLK) * OSTR;
    if (wid * QBLK < cur.nrows)
#pragma unroll
    for (int r = 0; r < 16; ++r) { const int orow = crow(r, hi);
#pragma unroll
        for (int d0 = 0; d0 < 4; ++d0) { const float v = o[d0][r] * rli[r];
            if constexpr (same_t<TOut, float>::v) { Ow[(size_t)orow * OSTR + d0 * 32 + r32] = v; }
            else { const float vn = __shfl_xor(v, 1);
                   if ((r32 & 1) == 0) *(unsigned*)(Ow + (size_t)orow * OSTR + d0 * 32 + r32) = cvtpk(v, vn); } } }
    if constexpr (F32) {
#pragma unroll
        for (int d0 = 0; d0 < 8; ++d0) S.qr[d0] = pack8(S.tq[2 * d0], S.tq[2 * d0 + 1]); }
    __syncthreads();
#undef RESC
#undef KBASE
#undef ACT
#undef MASKT
#undef SEAM_K0
#undef HALF_STEP
}
#undef ROW
#undef VMW
#undef VMWN
#undef SLOAD_H
#undef SWRITE_HK
#undef SWRITE_HV
#undef SWRITE_H
#undef SLOAD_F
#undef SWRITE_KF
#undef SWRITE_VF

}
#define XB_TMO      128
#define XB_XCNT(j)  (256  + 64 * (j))
#define XB_XSUB(j)  (1280 + 64 * (j))
#define XB_XGEN(j)  (2304 + 64 * (j))
#define XB_TOP      3328
#define XB_TOPGEN   3392
#define XCD_BAR_WORDS 3456
#define XB_SPIN_CAP (1u << 18)
#define XB_LAS __attribute__((address_space(3)))

__device__ __forceinline__ unsigned xb_ld(unsigned* p)              { return __hip_atomic_load(p, __ATOMIC_RELAXED, __HIP_MEMORY_SCOPE_AGENT); }
__device__ __forceinline__ unsigned xb_add(unsigned* p, unsigned v) { return __hip_atomic_fetch_add(p, v, __ATOMIC_RELAXED, __HIP_MEMORY_SCOPE_AGENT); }
__device__ __forceinline__ unsigned xb_xcc_id() { return (unsigned)__builtin_amdgcn_s_getreg((3 << 11) | 20) & 0xFu; }
#define XB_SPIN(cond, bar) do { unsigned _sp = 0; while (cond) { __builtin_amdgcn_s_sleep(1); \
    if ((++_sp & 255u) == 0u) { if (xb_ld(&(bar)[XB_TMO])) break; if (_sp > XB_SPIN_CAP) { atomicAdd(&(bar)[XB_TMO], 1u); break; } } } } while (0)

struct XcdBarrier {
    unsigned* bar; unsigned x;
    volatile XB_LAS unsigned* st;
};

__device__ __forceinline__ XcdBarrier xcd_barrier_post(unsigned* bar, volatile XB_LAS unsigned* st) {
    XcdBarrier b; b.bar = bar; b.x = xb_xcc_id(); b.st = st;
    if (threadIdx.x == 0) (void)xb_add(&bar[XB_XCNT(b.x)], 1u);
    return b;
}
__device__ __forceinline__ void xcd_barrier_complete(unsigned* bar, unsigned x, unsigned& nloc, unsigned& nx) {
    const unsigned G = gridDim.x * gridDim.y * gridDim.z;
    unsigned sum, cnt, mine, sp = 0u;
    for (;;) {
        sum = 0u; cnt = 0u; mine = 0u;
#pragma unroll
        for (unsigned j = 0; j < 16; ++j) { const unsigned c = xb_ld(&bar[XB_XCNT(j)]); sum += c; cnt += (c > 0u) ? 1u : 0u; mine = (j == x) ? c : mine; }
        if (sum == G) break;
        __builtin_amdgcn_s_sleep(1);
        if ((++sp & 255u) == 0u) { if (xb_ld(&bar[XB_TMO])) break; if (sp > XB_SPIN_CAP) { atomicAdd(&bar[XB_TMO], 1u); break; } }
    }
    nloc = mine > 0u ? mine : 1u; nx = cnt > 0u ? cnt : 1u;
}

__device__ __forceinline__ void xcd_barrier(const XcdBarrier& b) {
    asm volatile("s_waitcnt vmcnt(0)" ::: "memory");
    __syncthreads();
    if (threadIdx.x == 0) {
        unsigned* bar = b.bar;
        __builtin_amdgcn_s_waitcnt(0);
        unsigned nloc = b.st[0], nx = b.st[1];
        if (nloc == 0u) { xcd_barrier_complete(bar, b.x, nloc, nx); b.st[0] = nloc; b.st[1] = nx; }
        const unsigned old = xb_add(&bar[XB_XSUB(b.x)], 1u);
        const unsigned gen = old / nloc;
        if (old + 1u == (gen + 1u) * nloc) {
            __builtin_amdgcn_fence(__ATOMIC_RELEASE, "agent");
            asm volatile("s_waitcnt vmcnt(0)" ::: "memory");
            const unsigned og = xb_add(&bar[XB_TOP], 1u);
            const unsigned tg = og / nx;
            if (og + 1u == (tg + 1u) * nx) xb_add(&bar[XB_TOPGEN], 1u);
            else XB_SPIN(xb_ld(&bar[XB_TOPGEN]) == tg, bar);
            __builtin_amdgcn_fence(__ATOMIC_ACQUIRE, "agent");
            xb_add(&bar[XB_XGEN(b.x)], 1u);
            asm volatile("s_waitcnt vmcnt(0)" ::: "memory");
        } else {
            XB_SPIN(xb_ld(&bar[XB_XGEN(b.x)]) == gen, bar);
            __builtin_amdgcn_fence(__ATOMIC_ACQUIRE, "agent");
            asm volatile("s_waitcnt vmcnt(0)" ::: "memory");
        }
    }
    __syncthreads();
}


__device__ __forceinline__ float bf2f(unsigned short b) { return __uint_as_float(((unsigned)b) << 16); }
__device__ __forceinline__ unsigned pk2(float lo, float hi) { unsigned r; asm volatile("v_cvt_pk_bf16_f32 %0, %1, %2" : "=v"(r) : "v"(lo), "v"(hi)); return r; }
__device__ __forceinline__ unsigned short f2bf(float x) { return (unsigned short)(pk2(x, 0.f) & 0xffffu); }
__device__ __forceinline__ float wave_sum(float v) {
#pragma unroll
    for (int o = 1; o < 64; o <<= 1) v += __shfl_xor(v, o);
    return v;
}
__device__ __forceinline__ float grp16_sum(float v) {
#pragma unroll
    for (int o = 1; o < 16; o <<= 1) v += __shfl_xor(v, o);
    return v;
}
__device__ __forceinline__ float wave_incl_scan(float v, int lane) {
#pragma unroll
    for (int o = 1; o < 64; o <<= 1) { const float t = __shfl_up(v, o); if (lane >= o) v += t; }
    return v;
}
__device__ __forceinline__ float silu_f(float x) { return x * __builtin_amdgcn_rcpf(1.f + __expf(-x)); }
__device__ __forceinline__ void unpack8(u32x4 w, float (&o)[8]) {
#pragma unroll
    for (int q = 0; q < 4; ++q) { o[2 * q] = __uint_as_float(w[q] << 16); o[2 * q + 1] = __uint_as_float(w[q] & 0xffff0000u); }
}
__device__ __forceinline__ u32x4 pack8f(const float (&v)[8]) { u32x4 w = {pk2(v[0], v[1]), pk2(v[2], v[3]), pk2(v[4], v[5]), pk2(v[6], v[7])}; return w; }
__device__ __forceinline__ int pos16(int x) { return (x & ~12) | (((x >> 2) & 1) << 3) | (((x >> 3) & 1) << 2); }
__device__ __forceinline__ int crow32(int r, int hi) { return (r & 3) + 8 * (r >> 2) + 4 * hi; }

struct EpiBf16Plain {
    static constexpr bool PERM = true, AFTER_DRAIN = false;
    bf16_t* O; int ldc;
    __device__ __forceinline__ void operator()(const pg8::f32x4 (&acc)[2][2][4][2], const pg8::Unit& u, int wr, int wc, int fr, int fq) const {
        const int row0 = u.pm * 256 + wr * 64 + fr, col0 = u.pn * 256 + wc * 32 + 8 * fq;
#pragma unroll
        for (int ai = 0; ai < 2; ++ai)
#pragma unroll
            for (int m = 0; m < 4; ++m) { bf16_t* rowp = O + (size_t)(row0 + ai * 128 + m * 16) * ldc + col0;
#pragma unroll
                for (int bj = 0; bj < 2; ++bj) { const pg8::f32x4 v0 = acc[ai][bj][m][0], v1 = acc[ai][bj][m][1];
                    u32x4 w; w.x = pk2(v0[0], v0[1]); w.y = pk2(v0[2], v0[3]); w.z = pk2(v1[0], v1[1]); w.w = pk2(v1[2], v1[3]);
                    *(u32x4*)(rowp + bj * 128) = w; } }
    }
};
struct EpiSwiglu {
    static constexpr bool PERM = true, AFTER_DRAIN = false;
    bf16_t* O; int ldc;
    __device__ __forceinline__ void operator()(const pg8::f32x4 (&acc)[2][2][4][2], const pg8::Unit& u, int wr, int wc, int fr, int fq) const {
        const int row0 = u.pm * 256 + wr * 64 + fr, col0 = u.pn * 128 + wc * 32 + 8 * fq;
#pragma unroll
        for (int ai = 0; ai < 2; ++ai)
#pragma unroll
            for (int m = 0; m < 4; ++m) { bf16_t* rowp = O + (size_t)(row0 + ai * 128 + m * 16) * ldc + col0;
                float r[8];
#pragma unroll
                for (int n = 0; n < 2; ++n)
#pragma unroll
                    for (int e = 0; e < 4; ++e) { const float g = acc[ai][0][m][n][e], up = acc[ai][1][m][n][e]; r[4 * n + e] = silu_f(g) * up; }
                *(u32x4*)rowp = pack8f(r); }
    }
};
struct EpiResid {
    static constexpr bool PERM = false, AFTER_DRAIN = false;
    float* X; int ldc; float* slab;
    __device__ __forceinline__ void operator()(const pg8::f32x4 (&acc)[2][2][4][2], const pg8::Unit& u, int wr, int wc, int fr, int fq) const {
        const int row0 = u.pm * 256 + wr * 64 + fr, col0 = u.pn * 256 + wc * 32 + 4 * fq;
        if (u.split) {
            float* Sl = slab + (size_t)(u.split - 1) * MS * DM;
#pragma unroll
            for (int ai = 0; ai < 2; ++ai)
#pragma unroll
                for (int m = 0; m < 4; ++m) { float* rowp = Sl + (size_t)(row0 - MP + ai * 128 + m * 16) * DM + col0;
#pragma unroll
                    for (int bj = 0; bj < 2; ++bj)
#pragma unroll
                        for (int n = 0; n < 2; ++n) *(pg8::f32x4*)(rowp + bj * 128 + n * 16) = acc[ai][bj][m][n]; }
        } else {
#pragma unroll
            for (int ai = 0; ai < 2; ++ai)
                {
                    pg8::f32x4 xv[4][2][2];
#pragma unroll
                    for (int mm = 0; mm < 4; ++mm) { const float* rowp = X + (size_t)(row0 + ai * 128 + mm * 16) * ldc + col0;
#pragma unroll
                        for (int bj = 0; bj < 2; ++bj)
#pragma unroll
                            for (int n = 0; n < 2; ++n) xv[mm][bj][n] = *(const pg8::f32x4*)(rowp + bj * 128 + n * 16); }
#pragma unroll
                    for (int mm = 0; mm < 4; ++mm) { float* rowp = X + (size_t)(row0 + ai * 128 + mm * 16) * ldc + col0;
#pragma unroll
                        for (int bj = 0; bj < 2; ++bj)
#pragma unroll
                            for (int n = 0; n < 2; ++n) *(pg8::f32x4*)(rowp + bj * 128 + n * 16) = xv[mm][bj][n] + acc[ai][bj][mm][n]; }
                }
        }
    }
};
template <class Epi>
__device__ __forceinline__ void run_gemm(PG8_LAS unsigned char* lds, const bf16_t* A, const bf16_t* Bt, int N, int K, const Epi& E) {
    pg8::Gemm g; g.A = A; g.Bt = Bt; g.M = MT; g.N = N; g.K = K;
    pg8::StaticOrder S; S.init(MT, N, (int)gridDim.x, (int)blockIdx.x); S.nktf = K / 64;
    pg8::gemm_phase<Epi, pg8::StaticOrder, false>(lds, g, S, E, nullptr);
}

__device__ __forceinline__ int tail_parts(int K, int G) { return G != 256 ? 0 : ((K / 128) >= 16 ? 8 : 4); }
struct TailSplitOrder {
    int c, G, nktf; pg8::StaticOrder so;
    __device__ void init(int K, int G_, int c_) { c = c_; G = G_; nktf = K / 64; so.init(MT, 1024, G_, c_); so.nktf = nktf; }
    __device__ bool next(int i, pg8::Unit& u) const {
        if (G != 256) return so.next(i, u);
        if (i == 0) { u.pm = (c & 7) + 8 * (c >> 5); u.pn = (c >> 3) & 3; u.kt0 = 0; u.nkt = nktf; u.split = 0; return true; }
        if (i > 1) return false;
        const int npairs = nktf >> 1, parts = npairs >= 16 ? 8 : 4, part = c >> 5, tix = c & 31;
        if (part >= parts) return false;
        const int q = npairs / parts, r = npairs - q * parts;
        const int p0 = part * q + (part < r ? part : r), np = q + (part < r ? 1 : 0);
        u.pm = 64 + (tix >> 2); u.pn = tix & 3; u.kt0 = 2 * p0; u.nkt = 2 * np; u.split = part + 1; return true;
    }
    __device__ __forceinline__ void a_ready(const pg8::Unit&) const {}
    __device__ __forceinline__ void done(const pg8::Unit&) const {}
};
__device__ __forceinline__ void run_gemm_n1024(PG8_LAS unsigned char* lds, const bf16_t* A, const bf16_t* Bt, int K, const EpiResid& E) {
    pg8::Gemm g; g.A = A; g.Bt = Bt; g.M = MT; g.N = 1024; g.K = K;
    TailSplitOrder S; S.init(K, (int)gridDim.x, (int)blockIdx.x);
    pg8::gemm_phase<EpiResid, TailSplitOrder, false>(lds, g, S, E, nullptr);
}

__device__ __forceinline__ void transpose_weight(const float* __restrict__ W, int K, int N, bf16_t* WT, int mode, float* tile, int bid, int nb) {
    const int tid = otid();
    const int nct = (N + 63) >> 6, nkt = K >> 6, nt = nct * nkt;
    constexpr int TB = 4;
    for (int t0 = bid; t0 < nt; t0 += TB * nb) {
        float v[TB][8];
#pragma unroll
        for (int q = 0; q < TB; ++q) { const int t = min(t0 + q * nb, nt - 1), kt = t / nct, ct = t - kt * nct, k0 = kt * 64, n0 = ct * 64;
#pragma unroll
            for (int i = 0; i < 8; ++i) { const int r = (tid >> 6) + 8 * i, c = tid & 63, n = n0 + c; v[q][i] = (n < N) ? W[(size_t)(k0 + r) * N + n] : 0.f; } }
#pragma unroll
        for (int q = 0; q < TB; ++q)
#pragma unroll
            for (int i = 0; i < 8; ++i) { const int r = (tid >> 6) + 8 * i, c = tid & 63; tile[q * 4160 + r * 65 + c] = v[q][i]; }
        __syncthreads();
#pragma unroll
        for (int q = 0; q < TB; ++q) { const int t = t0 + q * nb; if (t < nt) { const int kt = t / nct, ct = t - kt * nct, k0 = kt * 64, n0 = ct * 64;
            const int nl = tid >> 3, kc = tid & 7, n = n0 + nl; int dest = -1;
            if (n < N) {
                if (mode == 0) dest = n;
                else if (mode == 1) dest = n < 2048 ? n : (n < 2056 ? -1 : n - 8);
                else if (mode == 2) dest = n < 3072 ? n : -1;
                else if (mode == 3) dest = 256 * (n >> 7) + (n & 127);
                else dest = 256 * (n >> 7) + 128 + (n & 127);
            }
            if (dest >= 0) { float o[8];
#pragma unroll
                for (int e = 0; e < 8; ++e) o[e] = tile[q * 4160 + (8 * kc + e) * 65 + nl];
                *(u32x4*)(WT + (size_t)dest * K + k0 + 8 * kc) = pack8f(o); } } }
        __syncthreads();
    }
}
__device__ __forceinline__ void convert_weights(CParams& p, unsigned char* shm, int l0, int l1, int bid, int nb) {
    float* tile = (float*)shm;
    for (int l = l0; l < l1; ++l) {
        const int i = l >> 1;
        if ((l & 1) == 0) {
            transpose_weight(p.in[10] + (size_t)i * DM * EVEN_IN, DM, EVEN_IN, (bf16_t*)(p.ws + WS_WINE) + (size_t)i * NE * DM, 1, tile, bid, nb);
            transpose_weight(p.in[16] + (size_t)i * DM * DM, DM, DM, (bf16_t*)(p.ws + WS_WOUTE) + (size_t)i * DM * DM, 0, tile, bid, nb);
        } else {
            transpose_weight(p.in[17] + (size_t)i * DM * ODD_IN, DM, ODD_IN, (bf16_t*)(p.ws + WS_WINO) + (size_t)i * NO * DM, 2, tile, bid, nb);
            transpose_weight(p.in[21] + (size_t)i * DM * DM, DM, DM, (bf16_t*)(p.ws + WS_WOUTO) + (size_t)i * DM * DM, 0, tile, bid, nb);
        }
        transpose_weight(p.in[22] + (size_t)l * DM * DFF, DM, DFF, (bf16_t*)(p.ws + WS_WF1) + (size_t)l * NF1 * DM, 3, tile, bid, nb);
        transpose_weight(p.in[23] + (size_t)l * DM * DFF, DM, DFF, (bf16_t*)(p.ws + WS_WF1) + (size_t)l * NF1 * DM, 4, tile, bid, nb);
        transpose_weight(p.in[24] + (size_t)l * DFF * DM, DFF, DM, (bf16_t*)(p.ws + WS_WF2) + (size_t)l * DM * DFF, 0, tile, bid, nb);
    }
}
__device__ __forceinline__ void phase_init(CParams& p, unsigned char* shm) {
    convert_weights(p, shm, 0, 1, (int)blockIdx.x, (int)gridDim.x);
}

template <int MODE>
__device__ __forceinline__ void phase_norm(CParams& p, int layer, unsigned char* shm, int nparts) {
    const int tid = otid(), lane = tid & 63, wid = tid >> 6, i = layer >> 1;
    float* Wsm = (float*)shm;
    const float* X = p.out;
    const bool from_in = (MODE == 0) && layer == 0;
    const float* Xp = from_in ? p.in[0] : X; const float* Xs = from_in ? p.in[1] - (size_t)MP * DM : X;
    bf16_t* H = (bf16_t*)(p.ws + WS_H);
    const float* gain = (MODE == 2 ? p.in[9] : p.in[8]) + layer * DM;
    if (MODE != 2) {
        const float* W = MODE == 0 ? p.in[10] + (size_t)i * DM * EVEN_IN + 2048 : p.in[17] + (size_t)i * DM * ODD_IN + 3072;
        const int ldw = MODE == 0 ? EVEN_IN : ODD_IN;
#pragma unroll
        for (int r = 0; r < 4; ++r) { const int q = tid + 512 * r, k = q >> 1, hf = q & 1;
            const f32x4 w = *(const f32x4*)(W + (size_t)k * ldw + 4 * hf);
            const int j = k >> 8, l = (k & 255) >> 2, e = k & 3;
            *(f32x4*)(Wsm + (((j * 4 + e) * 64 + l) * 8 + 4 * hf)) = w; }
        __syncthreads();
    }
    f32x4 g4[4];
#pragma unroll
    for (int j = 0; j < 4; ++j) g4[j] = *(const f32x4*)(gain + 256 * j + 4 * lane);
    constexpr int R = 3;
    const int stride = gridDim.x * 8;
    f32x4 nv[R][4];
    int row = blockIdx.x * 8 + wid;
#pragma unroll
    for (int r = 0; r < R; ++r) { const int rr = min(row + r * stride, MT - 1); const f32x4* xr = (const f32x4*)((rr < MP ? Xp : Xs) + (size_t)rr * DM) + lane;
#pragma unroll
        for (int j = 0; j < 4; ++j) nv[r][j] = xr[64 * j]; }
    for (; row < MT; row += R * stride) {
        f32x4 cv[R][4];
#pragma unroll
        for (int r = 0; r < R; ++r)
#pragma unroll
            for (int j = 0; j < 4; ++j) cv[r][j] = nv[r][j];
        if (row + R * stride < MT) {
#pragma unroll
            for (int r = 0; r < R; ++r) { const int rr = min(row + (R + r) * stride, MT - 1); const f32x4* xr = (const f32x4*)((rr < MP ? Xp : Xs) + (size_t)rr * DM) + lane;
#pragma unroll
                for (int j = 0; j < 4; ++j) nv[r][j] = xr[64 * j]; }
        }
#pragma unroll
        for (int r = 0; r < R; ++r) {
            const int crow_ = row + r * stride;
            if (crow_ < MT) {
                f32x4 v[4]; float ss = 0.f;
#pragma unroll
                for (int j = 0; j < 4; ++j) v[j] = cv[r][j];
                if (from_in) { f32x4* xw = (f32x4*)(p.out + (size_t)crow_ * DM) + lane;
#pragma unroll
                    for (int j = 0; j < 4; ++j) xw[64 * j] = v[j]; }
                if (crow_ >= MP && nparts > 0) {
                    const f32x4* sl = (const f32x4*)((const float*)(p.ws + WS_SLAB) + (size_t)(crow_ - MP) * DM) + lane;
                    for (int q0 = 0; q0 < nparts; q0 += 4) {
                        f32x4 tsl[4][4];
#pragma unroll
                        for (int q = 0; q < 4; ++q)
#pragma unroll
                            for (int j = 0; j < 4; ++j) tsl[q][j] = sl[(size_t)(q0 + q) * (MS * DM / 4) + 64 * j];
#pragma unroll
                        for (int q = 0; q < 4; ++q)
#pragma unroll
                            for (int j = 0; j < 4; ++j) v[j] += tsl[q][j]; }
                    f32x4* xw = (f32x4*)(p.out + (size_t)crow_ * DM) + lane;
#pragma unroll
                    for (int j = 0; j < 4; ++j) xw[64 * j] = v[j];
                }
#pragma unroll
                for (int j = 0; j < 4; ++j) ss += (v[j].x * v[j].x + v[j].y * v[j].y) + (v[j].z * v[j].z + v[j].w * v[j].w);
                ss = wave_sum(ss);
                const float rstd = 1.f / sqrtf(ss * (1.f / DM) + EPS);
                u32x2* ho = (u32x2*)(H + (size_t)crow_ * DM) + lane;
#pragma unroll
                for (int j = 0; j < 4; ++j) { v[j] = v[j] * rstd * g4[j]; u32x2 w; w.x = pk2(v[j].x, v[j].y); w.y = pk2(v[j].z, v[j].w); ho[64 * j] = w; }
                if (MODE != 2) {
                    float acc[8];
#pragma unroll
                    for (int c = 0; c < 8; ++c) acc[c] = 0.f;
#pragma unroll
                    for (int j = 0; j < 4; ++j)
#pragma unroll
                        for (int e = 0; e < 4; ++e) { const float hv = v[j][e]; const float* wp = Wsm + ((j * 4 + e) * 64 + lane) * 8;
                            const f32x4 w0 = *(const f32x4*)wp, w1 = *(const f32x4*)(wp + 4);
#pragma unroll
                            for (int c = 0; c < 4; ++c) { acc[c] = fmaf(hv, w0[c], acc[c]); acc[4 + c] = fmaf(hv, w1[c], acc[4 + c]); } }
#pragma unroll
                    for (int c = 0; c < 8; ++c) acc[c] = wave_sum(acc[c]);
                    if (MODE == 0) { if (lane == 0) { float* d = (float*)(p.ws + WS_AB) + (size_t)crow_ * 8;
                            *(f32x4*)d = (f32x4){acc[0], acc[1], acc[2], acc[3]}; *(f32x4*)(d + 4) = (f32x4){acc[4], acc[5], acc[6], acc[7]}; } }
                    else {
                        const int c8 = lane & 7;
                        float xs = acc[0];
#pragma unroll
                        for (int c = 1; c < 8; ++c) xs = (c8 == c) ? acc[c] : xs;
                        const float x = xs + p.in[18][i * 8 + c8];
                        const float lf = fminf(x, 0.f) - log1pf(expf(-fabsf(x)));
                        float* d = crow_ < MP ? p.out + OFF_PLF + ((size_t)i * MP + crow_) * 8 : p.out + OFF_SLF + ((size_t)i * MS + (crow_ - MP)) * 8;
                        if (lane < 8) d[lane] = lf; }
                }
            }
        }
    }
}

__device__ __forceinline__ void phase_fixup(CParams& p, int nparts) {
    const int tid = otid(), lane = tid & 63, wid = tid >> 6;
    if (nparts <= 0) return;
    for (int row = MP + blockIdx.x * 8 + wid; row < MT; row += gridDim.x * 8) {
        f32x4* xw = (f32x4*)(p.out + (size_t)row * DM) + lane;
        const f32x4* sl = (const f32x4*)((const float*)(p.ws + WS_SLAB) + (size_t)(row - MP) * DM) + lane;
        f32x4 v[4];
#pragma unroll
        for (int j = 0; j < 4; ++j) v[j] = xw[64 * j];
        for (int q0 = 0; q0 < nparts; q0 += 4) {
            f32x4 tsl[4][4];
#pragma unroll
            for (int q = 0; q < 4; ++q)
#pragma unroll
                for (int j = 0; j < 4; ++j) tsl[q][j] = sl[(size_t)(q0 + q) * (MS * DM / 4) + 64 * j];
#pragma unroll
            for (int q = 0; q < 4; ++q)
#pragma unroll
                for (int j = 0; j < 4; ++j) v[j] += tsl[q][j]; }
#pragma unroll
        for (int j = 0; j < 4; ++j) xw[64 * j] = v[j];
    }
}

__device__ __forceinline__ void phase_gdn_prep(CParams& p, int i, unsigned char* shm) {
    const int tid = otid(), lane = tid & 63, wid = tid >> 6;
    const int half = wid >> 2, w4 = wid & 3;
    const bf16_t* P = (const bf16_t*)(p.ws + WS_BIG);
    const float* AB = (const float*)(p.ws + WS_AB);
    const float* convw = p.in[11] + (size_t)i * 4 * 1536;
    unsigned char* hb = shm + half * 78336;
    bf16_t* qs = (bf16_t*)hb; bf16_t* ks = (bf16_t*)(hb + 17408); bf16_t* vs = (bf16_t*)(hb + 34816);
    float* As = (float*)(hb + 52224); float* Gs = (float*)(hb + 68608); float* Bs = Gs + 64;
    bf16_t* Ps = (bf16_t*)(hb + 69120);
    bf16_t* Wb = vs;
    bf16_t* NEGW = (bf16_t*)(p.ws + WS_NEGW); bf16_t* QG = (bf16_t*)(p.ws + WS_QG); bf16_t* KDT = (bf16_t*)(p.ws + WS_KDT);
    bf16_t* PM = (bf16_t*)(p.ws + WS_PM); bf16_t* UPRE = (bf16_t*)(p.ws + WS_UPRE); float* GC = (float*)(p.ws + WS_GC);
    for (int pr = blockIdx.x; pr < 576; pr += gridDim.x) {
        const int it = 2 * pr + half;
        int b, n, h, T0; bool sample;
        if (it < 1024) { b = it >> 8; n = (it >> 2) & 63; h = it & 3; T0 = b * 4096 + n * 64; sample = false; }
        else { const int j = it - 1024; b = j >> 2; h = j & 3; n = 0; T0 = MP + b * 64; sample = true; }
        const bool first = (n == 0), last = sample || (n == 63);
#ifndef PROBE_PREP_A
#define PROBE_PREP_A 1
#endif
#ifndef PROBE_PREP_D
#define PROBE_PREP_D 1
#endif
#pragma unroll 1
        for (int rr = 0; rr < 2 * PROBE_PREP_A; ++rr) {
            const int task = (otid() & 255) + 256 * (rr & 1);
            if (task < 384) {
                const int tseg = task / 48, cgi = task - tseg * 48, part = cgi >> 4, c8 = (cgi & 15) * 8, t0 = tseg * 8;
                const int col = part * 512 + h * 128 + c8;
                const bool edge = first && t0 == 0;
                u32x4 L[11];
#pragma unroll
                for (int k = 0; k < 11; ++k) { const int tt = t0 - 3 + k; const int rowc = (k < 3 && edge) ? T0 : T0 + tt; L[k] = *(const u32x4*)(P + (size_t)rowc * NE + col); }
                float w[4][8];
#pragma unroll
                for (int tap = 0; tap < 4; ++tap) { const float* wp = convw + tap * 1536 + col; const f32x4 w0 = *(const f32x4*)wp, w1 = *(const f32x4*)(wp + 4);
#pragma unroll
                    for (int e = 0; e < 4; ++e) { w[tap][e] = w0[e]; w[tap][4 + e] = w1[e]; } }
                bf16_t* dst0 = (part == 0 ? qs : (part == 1 ? ks : vs)) + t0 * 136 + c8;
                float xw[4][8];
#pragma unroll
                for (int k = 0; k < 11; ++k) {
                    float (&xv)[8] = xw[k & 3];
                    if (k < 3 && edge) {
                        if (sample) { const float* sp = p.in[6] + (((size_t)i * 32 + b) * 3 + k) * 1536 + col; const f32x4 a = *(const f32x4*)sp, c = *(const f32x4*)(sp + 4);
#pragma unroll
                            for (int e = 0; e < 4; ++e) { xv[e] = a[e]; xv[4 + e] = c[e]; } }
                        else {
#pragma unroll
                            for (int e = 0; e < 8; ++e) xv[e] = 0.f; }
                    } else unpack8(L[k], xv);
                    if (last && t0 == 56 && k >= 8) {
                        float* d = (sample ? p.out + OFF_SCONV + (((size_t)i * 32 + b) * 3 + (k - 8)) * 1536 : p.out + OFF_PCONV + (((size_t)i * 4 + b) * 3 + (k - 8)) * 1536) + col;
                        *(f32x4*)d = (f32x4){xv[0], xv[1], xv[2], xv[3]}; *(f32x4*)(d + 4) = (f32x4){xv[4], xv[5], xv[6], xv[7]}; }
                    if (k >= 3) {
                        const int j = k - 3; float y[8];
#pragma unroll
                        for (int e = 0; e < 8; ++e) y[e] = w[0][e] * xw[j & 3][e];
#pragma unroll
                        for (int tap = 1; tap < 4; ++tap)
#pragma unroll
                            for (int e = 0; e < 8; ++e) y[e] = fmaf(w[tap][e], xw[(j + tap) & 3][e], y[e]);
                        float ss = 0.f;
#pragma unroll
                        for (int e = 0; e < 8; ++e) { y[e] = silu_f(y[e]); ss = fmaf(y[e], y[e], ss); }
                        ss = grp16_sum(ss);
                        const float sc = part == 2 ? 1.f : __builtin_amdgcn_rsqf(ss + EPS) * (part == 0 ? 0.08838834764831845f : 1.f);
#pragma unroll
                        for (int e = 0; e < 8; ++e) y[e] *= sc;
                        *(u32x4*)(dst0 + j * 136) = pack8f(y); }
                }
            }
        }
        if (w4 == 0) {
            const float a = AB[(size_t)(T0 + lane) * 8 + h], bb = AB[(size_t)(T0 + lane) * 8 + 4 + h];
            const float x = a + p.in[13][i * 4 + h];
            const float sp = fmaxf(x, 0.f) + log1pf(expf(-fabsf(x)));
            float g = -expf(p.in[12][i * 4 + h]) * sp;
            g = wave_incl_scan(g, lane);
            Gs[lane] = g; Bs[lane] = 1.f / (1.f + expf(-bb));
        }
        LBAR();
        {
            const int type = w4 >> 1, bi = w4 & 1; const int ln_ = otid() & 63, r32 = ln_ & 31, hi = ln_ >> 5;
            const bf16_t* Xs = type ? qs : ks;
#pragma unroll 1
            for (int bj = 0; bj < 2; ++bj) {
                f32x16 acc = {};
#pragma unroll
                for (int kk = 0; kk < 8; ++kk) {
                    const bf16x8 a = *(const bf16x8*)(Xs + (32 * bi + r32) * 136 + kk * 16 + hi * 8);
                    const bf16x8 bq = *(const bf16x8*)(ks + (32 * bj + r32) * 136 + kk * 16 + hi * 8);
                    acc = __builtin_amdgcn_mfma_f32_32x32x16_bf16(a, bq, acc, 0, 0, 0);
                }
                const int j = 32 * bj + r32; const float Gj = Gs[j];
#pragma unroll
                for (int r = 0; r < 16; ++r) { const int ii = 32 * bi + crow32(r, hi); const float d = __expf(fminf(Gs[ii] - Gj, 0.f));
                    if (type == 0) As[ii * 64 + j] = (ii > j) ? acc[r] * Bs[ii] * d : 0.f;
                    else Ps[ii * 72 + pos16(j)] = f2bf((ii >= j) ? acc[r] * d : 0.f); }
            }
        }
        LBAR();
        if (w4 < 2) {
            typedef float f32x2_t __attribute__((ext_vector_type(2)));
            const int c = otid() & 127; f32x2_t sol[64];
#pragma unroll 1
            for (int rep_ = 0; rep_ < PROBE_PREP_D; ++rep_) {
#pragma unroll
            for (int r = 0; r < 64; ++r) { const float br = Bs[r]; sol[r] = (f32x2_t){bf2f(vs[r * 136 + c]) * br, bf2f(ks[r * 136 + c]) * br * __expf(Gs[r])}; }
#pragma unroll
            for (int r = 1; r < 64; ++r) { f32x2_t a = sol[r];
#pragma unroll
                for (int j = 0; j < r; ++j) { const float m = -As[r * 64 + j]; a = __builtin_elementwise_fma((f32x2_t){m, m}, sol[j], a); }
                sol[r] = a; }
            }
            { const int sl = c >> 5, cc = c & 31;
#pragma unroll
              for (int mb = 0; mb < 2; ++mb)
#pragma unroll
                  for (int rg = 0; rg < 2; ++rg)
#pragma unroll
                      for (int hh = 0; hh < 2; ++hh) { const int tb = 32 * mb + 16 * rg + 4 * hh;
                          u32x4 w = {pk2(sol[tb].x, sol[tb + 1].x), pk2(sol[tb + 2].x, sol[tb + 3].x), pk2(sol[tb + 8].x, sol[tb + 9].x), pk2(sol[tb + 10].x, sol[tb + 11].x)};
                          *(u32x4*)(UPRE + ((((size_t)it * 4 + sl) * 2 + mb) * 2 + rg) * 512 + (cc + 32 * hh) * 8) = w; } }
            LBAR();
            { const int pp = pos16(c);
#pragma unroll
              for (int r = 0; r < 64; ++r) Wb[r * 136 + pp] = f2bf(-sol[r].y); }
        } else {
            const int t2 = otid() & 127; const float GL = Gs[63];
#pragma unroll 2
            for (int r = 0; r < 8; ++r) { const int ch = t2 + 128 * r, row = ch >> 4, pc = ch & 15, dk0 = 16 * (pc >> 1) + 4 * (pc & 1);
                const float eg = __expf(Gs[row]); const bf16_t* s_ = qs + row * 136 + dk0; float v[8];
#pragma unroll
                for (int e = 0; e < 4; ++e) { v[e] = bf2f(s_[e]) * eg; v[4 + e] = bf2f(s_[8 + e]) * eg; }
                *(u32x4*)(QG + (size_t)it * 8192 + row * 128 + pc * 8) = pack8f(v); }
#pragma unroll 2
            for (int r = 0; r < 8; ++r) { const int ch = t2 + 128 * r, dk = ch & 127, pc = ch >> 7, t0 = 16 * (pc >> 1) + 4 * (pc & 1); float v[8];
#pragma unroll
                for (int e = 0; e < 8; ++e) { const int te = t0 + (e & 3) + 8 * (e >> 2); v[e] = bf2f(ks[te * 136 + dk]) * __expf(GL - Gs[te]); }
                *(u32x4*)(KDT + (size_t)it * 8192 + dk * 64 + pc * 8) = pack8f(v); }
            if (t2 == 0) GC[it] = __expf(GL);
#pragma unroll
            for (int r = 0; r < 4; ++r) { const int ch = t2 + 128 * r, row = ch >> 3, cc = ch & 7;
                *(u32x4*)(PM + (size_t)it * 4096 + row * 64 + cc * 8) = *(const u32x4*)(Ps + row * 72 + cc * 8); }
            LBAR();
        }
        LBAR();
        { const int t4 = otid() & 255;
#pragma unroll
          for (int r = 0; r < 4; ++r) { const int ch = t4 + 256 * r, row = ch >> 4, cc = ch & 15;
              *(u32x4*)(NEGW + (size_t)it * 8192 + row * 128 + cc * 8) = *(const u32x4*)(Wb + row * 136 + cc * 8); } }
        LBAR();
    }
}

constexpr int SC_NW = 0, SC_QG = 17408, SC_KD = 34816, SC_PM = 53248, SC_UP = 62464, SC_GC = 66560, SC_BUF = 66816, SC_OB = 2 * SC_BUF, SC_OBSZ = 64 * 80;
static_assert(SC_OB + 2 * SC_OBSZ <= LDS_BYTES - 16, "scan LDS");
__device__ __forceinline__ void phase_gdn_scan(CParams& p, int i, unsigned char* shm) {
    const int tid = otid(), lane = tid & 63, wid = tid >> 6, r32 = lane & 31, hi = lane >> 5;
    const u32x4* NEGW = (const u32x4*)(p.ws + WS_NEGW); const u32x4* QG = (const u32x4*)(p.ws + WS_QG); const u32x4* KDT = (const u32x4*)(p.ws + WS_KDT);
    const u32x4* PM = (const u32x4*)(p.ws + WS_PM); const u32x4* UPRE = (const u32x4*)(p.ws + WS_UPRE); const float* GC = (const float*)(p.ws + WS_GC);
    bf16_t* OG = (bf16_t*)(p.ws + WS_OG);
    const int nb = gridDim.x, bid = blockIdx.x;
    for (int it = bid; it < 576; it = (nb > 64 ? (it < 64 ? 576 : it + (nb - 64)) : it + nb)) {
        int b, h, sl, nsteps, ch0, chs, T0; bool sample;
        if (it < 64) { b = it >> 4; h = (it >> 2) & 3; sl = it & 3; nsteps = 64; ch0 = b * 256 + h; chs = 4; T0 = b * 4096; sample = false; }
        else { const int j = it - 64; b = j >> 4; h = (j >> 2) & 3; sl = j & 3; nsteps = 1; ch0 = 1024 + (j >> 2); chs = 0; T0 = MP + b * 64; sample = true; }
        if (wid >= 4) {
            const int t2 = tid - 256; u32x4 st[15]; float stg = 0.f;
#define SC_LOAD(chv) do { const size_t ch_ = (size_t)(chv); \
                _Pragma("unroll") for (int r = 0; r < 4; ++r) st[r] = NEGW[ch_ * 1024 + t2 + 256 * r]; \
                _Pragma("unroll") for (int r = 0; r < 4; ++r) st[4 + r] = QG[ch_ * 1024 + t2 + 256 * r]; \
                _Pragma("unroll") for (int r = 0; r < 4; ++r) st[8 + r] = KDT[ch_ * 1024 + t2 + 256 * r]; \
                _Pragma("unroll") for (int r = 0; r < 2; ++r) st[12 + r] = PM[ch_ * 512 + t2 + 256 * r]; \
                st[14] = UPRE[(ch_ * 4 + sl) * 256 + t2]; if (t2 == 0) stg = GC[ch_]; } while (0)
#define SC_WRITE(bufi) do { unsigned char* base = shm + (bufi) * SC_BUF; \
                _Pragma("unroll") for (int r = 0; r < 4; ++r) { const int q = t2 + 256 * r; *(u32x4*)(base + SC_NW + (q >> 4) * 272 + (q & 15) * 16) = st[r]; } \
                _Pragma("unroll") for (int r = 0; r < 4; ++r) { const int q = t2 + 256 * r; *(u32x4*)(base + SC_QG + (q >> 4) * 272 + (q & 15) * 16) = st[4 + r]; } \
                _Pragma("unroll") for (int r = 0; r < 4; ++r) { const int q = t2 + 256 * r; *(u32x4*)(base + SC_KD + (q >> 3) * 144 + (q & 7) * 16) = st[8 + r]; } \
                _Pragma("unroll") for (int r = 0; r < 2; ++r) { const int q = t2 + 256 * r; *(u32x4*)(base + SC_PM + (q >> 3) * 144 + (q & 7) * 16) = st[12 + r]; } \
                *(u32x4*)(base + SC_UP + t2 * 16) = st[14]; if (t2 == 0) *(float*)(base + SC_GC) = stg; } while (0)
            SC_LOAD(ch0); SC_WRITE(0);
            if (nsteps > 1) SC_LOAD(ch0 + chs);
            LBAR();
            for (int s = 0; s < nsteps; ++s) {
                if (s + 1 < nsteps) { SC_WRITE((s + 1) & 1); if (s + 2 < nsteps) SC_LOAD(ch0 + (s + 2) * chs); }
                LBAR();
            }
#undef SC_LOAD
#undef SC_WRITE
        } else if (wid == 0) {
            f32x16 S[4];
            if (sample) { const float* s0 = p.in[5] + ((((size_t)i * 32 + b) * 4 + h) << 14) + 32 * sl + r32;
#pragma unroll
                for (int mb = 0; mb < 4; ++mb)
#pragma unroll
                    for (int r = 0; r < 16; ++r) S[mb][r] = s0[(32 * mb + crow32(r, hi)) * 128];
            } else {
#pragma unroll
                for (int mb = 0; mb < 4; ++mb)
#pragma unroll
                    for (int r = 0; r < 16; ++r) S[mb][r] = 0.f;
            }
            LBAR();
            for (int s = 0; s < nsteps; ++s) {
                const unsigned char* B0 = shm + (s & 1) * SC_BUF;
                f32x16 u[2], o[2];
#pragma unroll
                for (int mb = 0; mb < 2; ++mb)
#pragma unroll
                    for (int rg = 0; rg < 2; ++rg) { const u32x4 w = *(const u32x4*)(B0 + SC_UP + ((mb * 2 + rg) * 64 + lane) * 16);
#pragma unroll
                        for (int q = 0; q < 4; ++q) { u[mb][8 * rg + 2 * q] = __uint_as_float(w[q] << 16); u[mb][8 * rg + 2 * q + 1] = __uint_as_float(w[q] & 0xffff0000u); } }
                const float gc = *(const float*)(B0 + SC_GC);
                const unsigned char* lrow = B0 + r32 * 272 + hi * 16;
                const unsigned char* srow = B0 + r32 * 144 + hi * 16;
#define RD4(dst, base) do { _Pragma("unroll") for (int kk = 0; kk < 4; ++kk) dst[kk] = *(const bf16x8*)((base) + kk * 32); SBAR(); } while (0)
#define MM4(accv, fr, bop, o_) do { _Pragma("unroll") for (int kk = 0; kk < 4; ++kk) accv = __builtin_amdgcn_mfma_f32_32x32x16_bf16(fr[kk], bop[(o_) + kk], accv, 0, 0, 0); } while (0)
                bf16x8 fa[4], fb[4];
                RD4(fa, lrow + SC_NW); RD4(fb, lrow + SC_NW + 128);
                bf16x8 Sb[8];
#pragma unroll
                for (int kk = 0; kk < 8; ++kk) { const int mb = kk >> 1, hf = kk & 1;
                    u32x4 w = {pk2(S[mb][8 * hf], S[mb][8 * hf + 1]), pk2(S[mb][8 * hf + 2], S[mb][8 * hf + 3]), pk2(S[mb][8 * hf + 4], S[mb][8 * hf + 5]), pk2(S[mb][8 * hf + 6], S[mb][8 * hf + 7])};
                    Sb[kk] = *reinterpret_cast<bf16x8*>(&w); }
#pragma unroll
                for (int mb = 0; mb < 2; ++mb)
#pragma unroll
                    for (int r = 0; r < 16; ++r) o[mb][r] = 0.f;
                MM4(u[0], fa, Sb, 0); RD4(fa, lrow + SC_QG);
                MM4(u[0], fb, Sb, 4); RD4(fb, lrow + SC_QG + 128);
                MM4(o[0], fa, Sb, 0); RD4(fa, lrow + SC_NW + 32 * 272);
                MM4(o[0], fb, Sb, 4); RD4(fb, lrow + SC_NW + 32 * 272 + 128);
                MM4(u[1], fa, Sb, 0); RD4(fa, lrow + SC_QG + 32 * 272);
                MM4(u[1], fb, Sb, 4); RD4(fb, lrow + SC_QG + 32 * 272 + 128);
                MM4(o[1], fa, Sb, 0); RD4(fa, srow + SC_PM);
                MM4(o[1], fb, Sb, 4); RD4(fb, srow + SC_PM + 32 * 144);
                bf16x8 ub[4];
#pragma unroll
                for (int kk = 0; kk < 4; ++kk) { const int mb = kk >> 1, hf = kk & 1;
                    u32x4 w = {pk2(u[mb][8 * hf], u[mb][8 * hf + 1]), pk2(u[mb][8 * hf + 2], u[mb][8 * hf + 3]), pk2(u[mb][8 * hf + 4], u[mb][8 * hf + 5]), pk2(u[mb][8 * hf + 6], u[mb][8 * hf + 7])};
                    ub[kk] = *reinterpret_cast<bf16x8*>(&w); }
#pragma unroll
                for (int mb = 0; mb < 4; ++mb)
#pragma unroll
                    for (int r = 0; r < 16; ++r) S[mb][r] *= gc;
                MM4(o[0], fa, ub, 0); RD4(fa, srow + SC_KD);
                MM4(o[1], fb, ub, 0); RD4(fb, srow + SC_KD + 32 * 144);
                MM4(S[0], fa, ub, 0); RD4(fa, srow + SC_KD + 64 * 144);
                MM4(S[1], fb, ub, 0); RD4(fb, srow + SC_KD + 96 * 144);
                MM4(S[2], fa, ub, 0);
                MM4(S[3], fb, ub, 0);
#undef RD4
#undef MM4
                { unsigned char* ob = shm + SC_OB + (s & 1) * SC_OBSZ + r32 * 2;
#pragma unroll
                  for (int mb = 0; mb < 2; ++mb)
#pragma unroll
                      for (int r = 0; r < 16; ++r) *(bf16_t*)(ob + (32 * mb + crow32(r, hi)) * 80) = f2bf(o[mb][r]); }
                LBAR();
            }
            float* so = (sample ? p.out + OFF_SS + ((((size_t)i * 32 + b) * 4 + h) << 14) : p.out + OFF_PS + ((((size_t)i * 4 + b) * 4 + h) << 14)) + 32 * sl + r32;
#pragma unroll
            for (int mb = 0; mb < 4; ++mb)
#pragma unroll
                for (int r = 0; r < 16; ++r) so[(32 * mb + crow32(r, hi)) * 128] = S[mb][r];
        } else if (wid == 1) {
            LBAR();
            for (int s = 0; s <= nsteps; ++s) {
                if (s >= 1) { const unsigned char* ob = shm + SC_OB + ((s - 1) & 1) * SC_OBSZ;
#pragma unroll
                    for (int k = 0; k < 4; ++k) { const int q = lane + 64 * k, row = q >> 2, cc = q & 3;
                        *(u32x4*)(OG + (size_t)(T0 + 64 * (s - 1) + row) * 512 + h * 128 + 32 * sl + 8 * cc) = *(const u32x4*)(ob + row * 80 + cc * 16); } }
                if (s < nsteps) LBAR();
            }
        } else {
            LBAR();
            for (int s = 0; s < nsteps; ++s) LBAR();
        }
        LBAR();
    }
}

template <int PARTS>
__device__ __forceinline__ void phase_gdn_post(CParams& p, int i, int bid, int nb) {
    const int tid = otid(), lane = tid & 63, wid = tid >> 6;
    const bf16_t* P = (const bf16_t*)(p.ws + WS_BIG); const bf16_t* OG = (const bf16_t*)(p.ws + WS_OG); bf16_t* CAT = (bf16_t*)(p.ws + WS_CAT);
    float ng[8], w0[8], w1[8], w2[8];
    { const float* g = p.in[14] + i * 128 + ((8 * lane) & 127); const float* w = p.in[15] + (size_t)i * 3 * 512 + 8 * lane;
#pragma unroll
      for (int e = 0; e < 8; ++e) { ng[e] = g[e]; w0[e] = w[e]; w1[e] = w[512 + e]; w2[e] = w[1024 + e]; } }
    const int stride = nb * 8;
    for (int row0 = bid * 8 + wid; row0 < MT; row0 += 2 * stride) {
        u32x4 L[2][9]; int rows[2]; rows[0] = row0; rows[1] = row0 + stride < MT ? row0 + stride : row0;
#pragma unroll
        for (int q = 0; q < 2; ++q) { const int row = rows[q]; const bf16_t* pr = P + (size_t)row * NE + 8 * lane;
            const int t = row < MP ? (row & 4095) : ((row - MP) & 63);
            if (PARTS & 1) { L[q][0] = *(const u32x4*)(OG + (size_t)row * 512 + 8 * lane); L[q][1] = *(const u32x4*)(pr + 1536); }
            if (PARTS & 2) {
                L[q][2] = *(const u32x4*)(pr + 2048); L[q][3] = *(const u32x4*)(pr + 2560); L[q][4] = *(const u32x4*)(pr + 3072);
                const bf16_t* p1 = t >= 1 ? pr - NE : pr; const bf16_t* p2 = t >= 2 ? pr - 2 * NE : pr;
                L[q][5] = *(const u32x4*)(p1 + 2560); L[q][6] = *(const u32x4*)(p1 + 3072); L[q][7] = *(const u32x4*)(p2 + 2560); L[q][8] = *(const u32x4*)(p2 + 3072); } }
#pragma unroll
        for (int q = 0; q < 2; ++q) {
            const int row = rows[q];
            if (q == 1 && row0 + stride >= MT) break;
            if (PARTS & 1) { float ov[8], zv[8], r[8]; unpack8(L[q][0], ov); unpack8(L[q][1], zv);
              float ss = 0.f;
#pragma unroll
              for (int e = 0; e < 8; ++e) ss = fmaf(ov[e], ov[e], ss);
              ss = grp16_sum(ss);
              const float rms = 1.f / sqrtf(ss * (1.f / 128.f) + EPS);
#pragma unroll
              for (int e = 0; e < 8; ++e) r[e] = ov[e] * rms * ng[e] * silu_f(zv[e]);
              *(u32x4*)(CAT + (size_t)row * DM + 8 * lane) = pack8f(r); }
            if (PARTS & 2) {
            int b, t, T; bool sample;
            if (row < MP) { b = row >> 12; t = row & 4095; T = 4096; sample = false; } else { const int r2 = row - MP; b = r2 >> 6; t = r2 & 63; T = 64; sample = true; }
            float gb[8], gc[8], hn[8], u0[8], u1[8], u2[8], r[8];
            unpack8(L[q][2], gb); unpack8(L[q][3], gc); unpack8(L[q][4], hn);
#pragma unroll
            for (int e = 0; e < 8; ++e) u0[e] = gc[e] * hn[e];
            const float* st = p.in[7] + ((size_t)i * 32 + b) * 2 * 512 + 8 * lane;
            if (t >= 1) { unpack8(L[q][5], gc); unpack8(L[q][6], hn);
#pragma unroll
                for (int e = 0; e < 8; ++e) u1[e] = gc[e] * hn[e]; }
            else {
#pragma unroll
                for (int e = 0; e < 8; ++e) u1[e] = sample ? st[512 + e] : 0.f; }
            if (t >= 2) { unpack8(L[q][7], gc); unpack8(L[q][8], hn);
#pragma unroll
                for (int e = 0; e < 8; ++e) u2[e] = gc[e] * hn[e]; }
            else {
#pragma unroll
                for (int e = 0; e < 8; ++e) u2[e] = sample ? st[t * 512 + e] : 0.f; }
#pragma unroll
            for (int e = 0; e < 8; ++e) r[e] = gb[e] * (w0[e] * u2[e] + w1[e] * u1[e] + w2[e] * u0[e]);
            *(u32x4*)(CAT + (size_t)row * DM + 512 + 8 * lane) = pack8f(r);
            if (t >= T - 2) { float* d = (sample ? p.out + OFF_SSC + (((size_t)i * 32 + b) * 2 + (t - (T - 2))) * 512 : p.out + OFF_PSC + (((size_t)i * 4 + b) * 2 + (t - (T - 2))) * 512) + 8 * lane;
                *(f32x4*)d = (f32x4){u0[0], u0[1], u0[2], u0[3]}; *(f32x4*)(d + 4) = (f32x4){u0[4], u0[5], u0[6], u0[7]}; }
            }
        }
    }
}

__device__ __forceinline__ void phase_fox_prep(CParams& p, int i) {
    const int tid = otid(), lane = tid & 63, wid = tid >> 6;
    const bf16_t* R = (const bf16_t*)(p.ws + WS_BIG);
    bf16_t* QP = (bf16_t*)(p.ws + WS_QP); bf16_t* KP = (bf16_t*)(p.ws + WS_KP); bf16_t* VP = (bf16_t*)(p.ws + WS_VP);
    bf16_t* QS = (bf16_t*)(p.ws + WS_QS); bf16_t* KS = (bf16_t*)(p.ws + WS_KS); bf16_t* VS = (bf16_t*)(p.ws + WS_VS);
    for (int task = blockIdx.x + gridDim.x * wid; task < 288; task += gridDim.x * 8) {
        const float* src0; const float* src1; int len, n0; float* dst;
        if (task < 32) { const int bb = task >> 3, hh = task & 7; src0 = p.out + OFF_PLF + ((size_t)i * MP + (size_t)bb * 4096) * 8 + hh; src1 = src0; len = 4096; n0 = 4096; dst = (float*)(p.ws + WS_NCP) + task * 4096; }
        else { const int j = task - 32, bb = j >> 3, hh = j & 7; src0 = p.in[4] + ((size_t)i * 32 + bb) * 1024 * 8 + hh; src1 = p.out + OFF_SLF + ((size_t)i * MS + (size_t)bb * 64) * 8 + hh - (size_t)1024 * 8; len = 1088; n0 = 1024; dst = (float*)(p.ws + WS_NCS) + j * 1088; }
        float carry = 0.f;
        for (int s0 = 0; s0 < len; s0 += 512) {
            float v[8];
#pragma unroll
            for (int q = 0; q < 8; ++q) { const int s = s0 + 64 * q + lane; v[q] = s < len ? (s < n0 ? src0[(size_t)s * 8] : src1[(size_t)s * 8]) : 0.f; }
#pragma unroll
            for (int q = 0; q < 8; ++q) { const int s = s0 + 64 * q + lane; float x = wave_incl_scan(v[q], lane) + carry;
                if (s < len) dst[s] = -x * 11.313708498984761f;
                carry = __shfl(x, 63); }
        }
    }
    float qg[8], kg[8];
    { const float* a = p.in[19] + i * 128 + ((8 * lane) & 127); const float* c = p.in[20] + i * 128 + ((8 * lane) & 127);
#pragma unroll
      for (int e = 0; e < 8; ++e) { qg[e] = a[e]; kg[e] = c[e]; } }
    const int stride = gridDim.x * 8;
    for (int row0 = blockIdx.x * 8 + wid; row0 < MT; row0 += 2 * stride) {
        u32x4 L[2][6]; int rows[2]; rows[0] = row0; rows[1] = row0 + stride < MT ? row0 + stride : row0;
#pragma unroll
        for (int q = 0; q < 2; ++q) { const bf16_t* rr = R + (size_t)rows[q] * NO + 8 * lane;
#pragma unroll
            for (int hf = 0; hf < 2; ++hf) { L[q][hf * 3] = *(const u32x4*)(rr + hf * 512); L[q][hf * 3 + 1] = *(const u32x4*)(rr + 1024 + hf * 512); L[q][hf * 3 + 2] = *(const u32x4*)(rr + 2048 + hf * 512); } }
#pragma unroll
        for (int q = 0; q < 2; ++q) {
            const int row = rows[q];
            if (q == 1 && row0 + stride >= MT) break;
            float* fK; float* fV; size_t qbase, kbase; int qstr, kstr; bf16_t* Qd; bf16_t* Kd; bf16_t* Vd;
            if (row < MP) { const int bb = row >> 12, s_ = row & 4095; fK = p.out + OFF_PK + ((size_t)i * MP + row) * 1024; fV = p.out + OFF_PV + ((size_t)i * MP + row) * 1024;
                Qd = QP; Kd = KP; Vd = VP; qstr = 4096; kstr = 4096; qbase = (size_t)bb * 8 * 4096 + s_; kbase = qbase; }
            else { const int r2 = row - MP, bb = r2 >> 6, s_ = r2 & 63; fK = p.out + OFF_SK + ((size_t)i * MS + r2) * 1024; fV = p.out + OFF_SV + ((size_t)i * MS + r2) * 1024;
                Qd = nullptr; Kd = nullptr; Vd = nullptr; qstr = 64; kstr = 0; qbase = (size_t)bb * 8 * 64 + s_; kbase = 0; }
            const bool smp = row >= MP;
#pragma unroll
            for (int hf = 0; hf < 2; ++hf) {
                const int col = hf * 512 + 8 * lane, hh = col >> 7, d = col & 127;
                float x[8], r[8]; float ss;
                unpack8(L[q][hf * 3], x); ss = 0.f;
#pragma unroll
                for (int e = 0; e < 8; ++e) ss = fmaf(x[e], x[e], ss);
                ss = grp16_sum(ss); { const float rms = 1.f / sqrtf(ss * (1.f / 128.f) + EPS);
#pragma unroll
                  for (int e = 0; e < 8; ++e) r[e] = x[e] * rms * qg[e]; }
                if (smp) { float* qd = (float*)(p.ws + WS_KS) + (qbase + (size_t)hh * qstr) * 128 + d;
                    *(f32x4*)qd = (f32x4){r[0], r[1], r[2], r[3]}; *(f32x4*)(qd + 4) = (f32x4){r[4], r[5], r[6], r[7]}; }
                else *(u32x4*)(Qd + (qbase + (size_t)hh * qstr) * 128 + d) = pack8f(r);
                unpack8(L[q][hf * 3 + 1], x); ss = 0.f;
#pragma unroll
                for (int e = 0; e < 8; ++e) ss = fmaf(x[e], x[e], ss);
                ss = grp16_sum(ss); { const float rms = 1.f / sqrtf(ss * (1.f / 128.f) + EPS);
#pragma unroll
                  for (int e = 0; e < 8; ++e) r[e] = x[e] * rms * kg[e]; }
                __builtin_nontemporal_store((f32x4){r[0], r[1], r[2], r[3]}, (f32x4*)(fK + col)); __builtin_nontemporal_store((f32x4){r[4], r[5], r[6], r[7]}, (f32x4*)(fK + col + 4));
                if (!smp) *(u32x4*)(Kd + (kbase + (size_t)hh * kstr) * 128 + d) = pack8f(r);
                const u32x4 vw = L[q][hf * 3 + 2]; unpack8(vw, x);
                __builtin_nontemporal_store((f32x4){x[0], x[1], x[2], x[3]}, (f32x4*)(fV + col)); __builtin_nontemporal_store((f32x4){x[4], x[5], x[6], x[7]}, (f32x4*)(fV + col + 4));
                if (!smp) *(u32x4*)(Vd + (kbase + (size_t)hh * kstr) * 128 + d) = vw;
            }
        }
    }
}

typedef fa::BlockRef<bf16_t, bf16_t> FaRef;
typedef fa::BlockRef<float, bf16_t> FaRefS;
__device__ __forceinline__ FaRef fox_ref(CParams& p, int g, int k) {
    FaRef r;
    const int xcd = g & 7, j = g >> 3, bh = 4 * xcd + (j >> 3), x = j & 7, bb = bh >> 3, hh = bh & 7, blk = k ? 15 - x : x;
    r.Q = (const bf16_t*)(p.ws + WS_QP) + ((size_t)bh * 4096 + 256 * blk) * 128; r.K = (const bf16_t*)(p.ws + WS_KP) + (size_t)bh * 4096 * 128; r.V = (const bf16_t*)(p.ws + WS_VP) + (size_t)bh * 4096 * 128;
    r.K2 = r.K; r.V2 = r.V;
    r.O = (bf16_t*)(p.ws + WS_CAT) + ((size_t)bb * 4096 + 256 * blk) * 1024 + hh * 128; r.NC = (const float*)(p.ws + WS_NCP) + (size_t)bh * 4096; r.P0 = 256 * blk; r.nrows = 256;
    return r;
}
__device__ __forceinline__ FaRefS fox_ref_s(CParams& p, int i, int g) {
    FaRefS r; const int bh = g, bb = g >> 3, hh = g & 7;
    r.Q = (const float*)(p.ws + WS_KS) + (size_t)bh * 64 * 128;
    r.K = p.in[2] + ((size_t)i * 32 + bb) * 1024 * 1024 + hh * 128; r.V = p.in[3] + ((size_t)i * 32 + bb) * 1024 * 1024 + hh * 128;
    r.K2 = p.out + OFF_SK + ((size_t)i * MS + bb * 64) * 1024 + hh * 128 - (size_t)1024 * 1024; r.V2 = p.out + OFF_SV + ((size_t)i * MS + bb * 64) * 1024 + hh * 128 - (size_t)1024 * 1024;
    r.O = (bf16_t*)(p.ws + WS_CAT) + ((size_t)MP + bb * 64) * 1024 + hh * 128; r.NC = (const float*)(p.ws + WS_NCS) + (size_t)bh * 1088; r.P0 = 1024; r.nrows = 64;
    return r;
}
__device__ __forceinline__ void phase_fox_attn(CParams& p, int i, unsigned char* shm) {
    constexpr int W = 1 << 20;
    for (int g = blockIdx.x; g < 256; g += gridDim.x) {
#pragma unroll 1
        for (int k = 0; k < 2; ++k) {
            int kk = k; asm volatile("" : "+s"(kk));
            fa::Seam<bf16_t> S;
            const FaRef cur = fox_ref(p, g, kk);
            fa::causal_swa_prime<bf16_t, bf16_t>(cur, W, (char*)shm, S);
            fa::causal_swa_block<bf16_t, bf16_t>(cur, cur, 4096, W, (char*)shm, S);
        }
        { fa::Seam<float> S;
          const FaRefS cur = fox_ref_s(p, i, g);
          fa::causal_swa_prime<float, bf16_t>(cur, W, (char*)shm, S);
          fa::causal_swa_block<float, bf16_t>(cur, cur, 1088, W, (char*)shm, S); }
    }
}

__device__ __forceinline__ CParams* kparams() {
    CParams* k = (CParams*)__builtin_amdgcn_kernarg_segment_ptr(); asm volatile("" : "+s"(k)); return k;
}
__global__ __launch_bounds__(512, 2) void mega_fwd(Params p_unused) {
    extern __shared__ __attribute__((aligned(16))) unsigned char shm[];
    cg::grid_group grid = cg::this_grid();
    PG8_LAS unsigned char* lds = (PG8_LAS unsigned char*)shm;
    int ph = 0;
#ifndef PROBE_REP
#define PROBE_REP 0
#endif
#define GSYNC() do { XcdBarrier xb_; xb_.bar = (unsigned*)(kparams()->ws + WS_BAR); xb_.x = xb_xcc_id(); xb_.st = (volatile XB_LAS unsigned*)(lds + LDS_XB); xcd_barrier(xb_); } while (0)
#if PROBE_REP
#define PHASE(kind, ...) do { CParams& p = *kparams(); if (ph >= p.ph_lo && ph < p.ph_hi) { int nrep = 1 + ((PROBE_REP >> (kind)) & 1); asm volatile("" : "+s"(nrep)); \
        for (int rep = 0; rep < nrep; ++rep) { __VA_ARGS__; if (rep + 1 < nrep || ph + 1 < p.ph_hi) GSYNC(); } } ++ph; } while (0)
#else
#define PHASE(kind, ...) do { CParams& p = *kparams(); if (ph >= p.ph_lo && ph < p.ph_hi) { __VA_ARGS__; if (ph + 1 < p.ph_hi) GSYNC(); } ++ph; } while (0)
#endif
    if (otid() == 0) { *(volatile XB_LAS unsigned*)(lds + LDS_XB) = 0u; *(volatile XB_LAS unsigned*)(lds + LDS_XB + 4) = 0u; }
    __syncthreads();
    (void)xcd_barrier_post((unsigned*)(kparams()->ws + WS_BAR), (volatile XB_LAS unsigned*)(lds + LDS_XB));
    if (kparams()->ph_hi - kparams()->ph_lo > 1) grid.sync();
    PHASE(0, phase_init(p, shm));
#pragma unroll 1
    for (int layer = 0; layer < 4; ++layer) {
        const int i = layer >> 1; const bool even = (layer & 1) == 0;
        if (even) PHASE(1, phase_norm<0>(p, layer, shm, layer ? tail_parts(DFF, (int)gridDim.x) : 0)); else PHASE(1, phase_norm<1>(p, layer, shm, tail_parts(DFF, (int)gridDim.x)));
        PHASE(2, const bf16_t* Bt = even ? (const bf16_t*)(p.ws + WS_WINE) + (size_t)i * NE * DM : (const bf16_t*)(p.ws + WS_WINO) + (size_t)i * NO * DM;
              EpiBf16Plain E; E.O = (bf16_t*)(p.ws + WS_BIG); E.ldc = even ? NE : NO;
              run_gemm(lds, (const bf16_t*)(p.ws + WS_H), Bt, even ? NE : NO, DM, E));
        if (even) { PHASE(3, phase_gdn_prep(p, i, shm));
                    PHASE(4, phase_gdn_scan(p, i, shm); __syncthreads();
                             if (gridDim.x > 64) { if (blockIdx.x >= 64) { if (layer == 0) convert_weights(p, shm, 1, 4, (int)blockIdx.x - 64, (int)gridDim.x - 64);
                                                                           phase_gdn_post<2>(p, i, (int)blockIdx.x - 64, (int)gridDim.x - 64); } }
                             else { if (layer == 0) convert_weights(p, shm, 1, 4, (int)blockIdx.x, (int)gridDim.x); phase_gdn_post<2>(p, i, (int)blockIdx.x, (int)gridDim.x); });
                    PHASE(5, phase_gdn_post<1>(p, i, (int)blockIdx.x, (int)gridDim.x)); }
        else { PHASE(6, phase_fox_prep(p, i)); PHASE(7, phase_fox_attn(p, i, shm)); }
        PHASE(31, const bf16_t* Bt = even ? (const bf16_t*)(p.ws + WS_WOUTE) + (size_t)i * DM * DM : (const bf16_t*)(p.ws + WS_WOUTO) + (size_t)i * DM * DM;
              EpiResid E; E.X = p.out; E.ldc = DM; E.slab = (float*)(p.ws + WS_SLAB);
              run_gemm_n1024(lds, (const bf16_t*)(p.ws + WS_CAT), Bt, DM, E));
        PHASE(1, phase_norm<2>(p, layer, shm, tail_parts(DM, (int)gridDim.x)));
        PHASE(9, EpiSwiglu E; E.O = (bf16_t*)(p.ws + WS_BIG); E.ldc = DFF;
              run_gemm(lds, (const bf16_t*)(p.ws + WS_H), (const bf16_t*)(p.ws + WS_WF1) + (size_t)layer * NF1 * DM, NF1, DM, E));
        PHASE(31, EpiResid E; E.X = p.out; E.ldc = DM; E.slab = (float*)(p.ws + WS_SLAB);
              run_gemm_n1024(lds, (const bf16_t*)(p.ws + WS_BIG), (const bf16_t*)(p.ws + WS_WF2) + (size_t)layer * DM * DFF, DFF, E));
    }
    PHASE(1, phase_fixup(p, tail_parts(DFF, (int)gridDim.x)));
#undef PHASE
}
constexpr int N_PHASES = 1 + 2 * 9 + 2 * 8 + 1;

#ifndef MK_PER_PHASE
#define MK_PER_PHASE 0
#endif
extern "C" void kernel_launch(void* const* d_in, const int* in_sizes, int n_in, void* d_out, int out_size, void* d_ws, size_t ws_size, hipStream_t stream) {
    static int grid = 0;
    if (grid == 0) {
        if (n_in != 25 || (size_t)out_size != OUT_TOTAL || ws_size < WS_END) { fprintf(stderr, "kernel_launch: unexpected shapes (n_in %d, out %d, ws %zu < %zu)\n", n_in, out_size, ws_size, (size_t)WS_END); grid = -1; return; }
        int dev = 0, cus = 0, per_cu = 0;
        (void)hipGetDevice(&dev); (void)hipDeviceGetAttribute(&cus, hipDeviceAttributeMultiprocessorCount, dev);
        if (hipFuncSetAttribute((const void*)mega_fwd, hipFuncAttributeMaxDynamicSharedMemorySize, LDS_BYTES) != hipSuccess) { fprintf(stderr, "kernel_launch: hipFuncSetAttribute failed\n"); grid = -1; return; }
        if (hipOccupancyMaxActiveBlocksPerMultiprocessor(&per_cu, (const void*)mega_fwd, 512, LDS_BYTES) != hipSuccess || per_cu < 1) { fprintf(stderr, "kernel_launch: occupancy query says %d\n", per_cu); per_cu = 1; }
        (void)hipGetLastError();
        if (cus <= 0) cus = 256;
        grid = cus * 1;
    }
    if (grid < 0) return;
    (void)hipMemsetAsync((unsigned char*)d_ws + WS_BAR, 0, 16384, stream);
    Params p{};
    for (int k = 0; k < 25; ++k) p.in[k] = (const float*)d_in[k];
    p.out = (float*)d_out; p.ws = (unsigned char*)d_ws;
#if MK_PER_PHASE
    for (int ph = 0; ph < N_PHASES; ++ph) { p.ph_lo = ph; p.ph_hi = ph + 1; hipLaunchKernelGGL(mega_fwd, dim3(grid), dim3(512), LDS_BYTES, stream, p); }
#else
    p.ph_lo = 0; p.ph_hi = N_PHASES;
    void* args[] = {&p};
    hipError_t e = hipLaunchCooperativeKernel((const void*)mega_fwd, dim3(grid), dim3(512), args, LDS_BYTES, stream);
    if (e != hipSuccess) fprintf(stderr, "kernel_launch: cooperative launch failed: %s (grid %d)\n", hipGetErrorString(e), grid);
#endif
}
```

```cpp
#include <hip/hip_runtime.h>
#include <hip/hip_cooperative_groups.h>
#include <cstdio>
#include <cstdint>
namespace cg = cooperative_groups;

typedef unsigned short bf16_t;
typedef short bf16x8 __attribute__((ext_vector_type(8)));
typedef short s16x4 __attribute__((ext_vector_type(4)));
typedef float f32x16 __attribute__((ext_vector_type(16)));
typedef float f32x4 __attribute__((ext_vector_type(4)));
typedef unsigned u32x4 __attribute__((ext_vector_type(4)));
typedef unsigned u32x2 __attribute__((ext_vector_type(2)));

constexpr int DM = 1024, MP = 16384, MS = 2048, MT = MP + MS;
constexpr int EVEN_IN = 3592, ODD_IN = 3080, NE = 3584, NO = 3072, DFF = 2816, NF1 = 2 * DFF;
constexpr float EPS = 1e-6f;
constexpr size_t OFF_Y = 0;
constexpr size_t OFF_PK = (size_t)MT * DM;
constexpr size_t OFF_PV = OFF_PK + (size_t)2 * MP * 1024;
constexpr size_t OFF_PLF = OFF_PV + (size_t)2 * MP * 1024;
constexpr size_t OFF_PS = OFF_PLF + (size_t)2 * MP * 8;
constexpr size_t OFF_PCONV = OFF_PS + (size_t)2 * 4 * 4 * 128 * 128;
constexpr size_t OFF_PSC = OFF_PCONV + (size_t)2 * 4 * 3 * 1536;
constexpr size_t OFF_SK = OFF_PSC + (size_t)2 * 4 * 2 * 512;
constexpr size_t OFF_SV = OFF_SK + (size_t)2 * MS * 1024;
constexpr size_t OFF_SLF = OFF_SV + (size_t)2 * MS * 1024;
constexpr size_t OFF_SS = OFF_SLF + (size_t)2 * MS * 8;
constexpr size_t OFF_SCONV = OFF_SS + (size_t)2 * 32 * 4 * 128 * 128;
constexpr size_t OFF_SSC = OFF_SCONV + (size_t)2 * 32 * 3 * 1536;
constexpr size_t OUT_TOTAL = OFF_SSC + (size_t)2 * 32 * 2 * 512;
static_assert(OUT_TOTAL == 99790848, "output size");
constexpr size_t WS_WINE = 0;
constexpr size_t WS_WOUTE = WS_WINE + (size_t)2 * NE * DM * 2;
constexpr size_t WS_WINO = WS_WOUTE + (size_t)2 * DM * DM * 2;
constexpr size_t WS_WOUTO = WS_WINO + (size_t)2 * NO * DM * 2;
constexpr size_t WS_WF1 = WS_WOUTO + (size_t)2 * DM * DM * 2;
constexpr size_t WS_WF2 = WS_WF1 + (size_t)4 * NF1 * DM * 2;
constexpr size_t WS_H = WS_WF2 + (size_t)4 * DM * DFF * 2;
constexpr size_t WS_BIG = WS_H + (size_t)MT * DM * 2;
constexpr size_t WS_CAT = WS_BIG + (size_t)MT * NE * 2;
constexpr size_t WS_AB = WS_CAT + (size_t)MT * DM * 2;
constexpr size_t WS_OG = WS_AB + (size_t)MT * 8 * 4;
constexpr size_t WS_GC = WS_OG + (size_t)MT * 512 * 2;
constexpr size_t WS_NEGW = WS_GC + 8192;
constexpr size_t WS_QG = WS_NEGW + (size_t)1152 * 16384;
constexpr size_t WS_KDT = WS_QG + (size_t)1152 * 16384;
constexpr size_t WS_PM = WS_KDT + (size_t)1152 * 16384;
constexpr size_t WS_UPRE = WS_PM + (size_t)1152 * 8192;
constexpr size_t WS_QP = WS_UPRE + (size_t)1152 * 16384;
constexpr size_t WS_KP = WS_QP + (size_t)32 * 4096 * 128 * 2;
constexpr size_t WS_VP = WS_KP + (size_t)32 * 4096 * 128 * 2;
constexpr size_t WS_QS = WS_VP + (size_t)32 * 4096 * 128 * 2;
constexpr size_t WS_KS = WS_QS + (size_t)256 * 64 * 128 * 2 + 65536;
constexpr size_t WS_VS = WS_KS + (size_t)256 * 1088 * 128 * 2;
constexpr size_t WS_NCP = WS_VS + (size_t)256 * 1088 * 128 * 2;
constexpr size_t WS_NCS = WS_NCP + (size_t)32 * 4096 * 4;
constexpr size_t WS_BAR = WS_NCS + (size_t)256 * 1088 * 4;
constexpr size_t WS_SLAB = WS_BAR + 16384;
constexpr size_t WS_END = WS_SLAB + (size_t)8 * MS * DM * 4;
constexpr int LDS_BYTES = 163840;
constexpr int LDS_XB = LDS_BYTES - 16;

struct Params { const float* in[25]; float* out; unsigned char* ws; int ph_lo, ph_hi; };
typedef const __attribute__((address_space(4))) Params CParams;

#define KSWZ(row, colB) ((row) * 256 + ((colB) ^ (((row) & 7) << 4)))
#define SBAR() __builtin_amdgcn_sched_barrier(0)
template <class A, class Bt> struct same_t { static constexpr bool v = false; };
template <class A> struct same_t<A, A> { static constexpr bool v = true; };
__device__ __forceinline__ int otid() { int t = threadIdx.x; asm volatile("" : "+v"(t)); return t; }
#define LBAR() asm volatile("s_waitcnt lgkmcnt(0)\n\ts_barrier" ::: "memory")
namespace pg8 {
#define PG8_LAS __attribute__((address_space(3)))
typedef unsigned short bf16_t;
typedef short bf16x8 __attribute__((ext_vector_type(8)));
typedef float f32x4 __attribute__((ext_vector_type(4)));
typedef unsigned u32x4 __attribute__((ext_vector_type(4)));
constexpr int BM = 256, BK = 64, HALF = 128, HTB = HALF * BK * 2  , STAGE_BYTES = 8 * HTB, NXCD = 8, WGM = 8;

__host__ __device__ __forceinline__ int lds_byte(int r, int c) { const int st = (r >> 4) * 2 + (c >> 5), rr = r & 15, cc = c & 31, ob = rr * 64 + cc * 2; return st * 1024 + (ob ^ (((ob >> 9) & 1) << 5)); }
__host__ __device__ __forceinline__ void stage_rc(int b, int& R, int& C) { const int st = b / 1024, sb = b % 1024, swz = sb ^ (((sb >> 9) & 1) << 5); R = (st >> 1) * 16 + swz / 64; C = (st & 1) * 32 + (swz % 64) / 2; }
__host__ __device__ __forceinline__ int perm32(int rho) { const int n = rho >> 4, i = rho & 15; return 8 * (i >> 2) + 4 * n + (i & 3); }

struct Unit { int pm, pn, kt0, nkt, split; };
struct Gemm { const bf16_t* A; const bf16_t* Bt; int M, N, K; };

struct StaticOrder {
    int nM, nN, nwg, G, c, nktf;
    __host__ __device__ void init(int M, int N, int G_, int c_) { nM = M / BM; nN = N / BM; nwg = nM * nN; G = G_; c = c_; }
    __host__ __device__ bool next(int i, Unit& u) const {
        const long L = (long)i * G + c; if (L >= nwg) return false;
        int wgid = (int)L; { const int q = nwg / NXCD, r = nwg % NXCD, xcd = wgid % NXCD, off = wgid / NXCD; wgid = (xcd < r ? xcd * (q + 1) : r * (q + 1) + (xcd - r) * q) + off; }
        const int nig = WGM * nN, gid = wgid / nig, fm = gid * WGM, gsz = (nM - fm) < WGM ? (nM - fm) : WGM;
        u.pm = fm + ((wgid % nig) % gsz); u.pn = (wgid % nig) / gsz; u.kt0 = 0; u.nkt = nktf; u.split = 0; return true;
    }
    __device__ __forceinline__ void a_ready(const Unit&) const {}
    __device__ __forceinline__ void done(const Unit&) const {}
};
__device__ __forceinline__ unsigned cvt_pk_bf16(float lo, float hi) { unsigned r; asm volatile("v_cvt_pk_bf16_f32 %0, %1, %2" : "=v"(r) : "v"(lo), "v"(hi)); return r; }
template <class Epi, class Sched, bool STAMP = false>
__device__ __forceinline__ void gemm_phase(PG8_LAS unsigned char* lds, const Gemm g, const Sched& S, const Epi& E, unsigned long long* stamps) {
    const int tid = otid(), wid = __builtin_amdgcn_readfirstlane(tid >> 6), lane = tid & 63, wr = wid >> 2, wc = wid & 3, fr = lane & 15, fq = lane >> 4;
    const int K = g.K;
    int ts_lo = 0, ts_hi = 0, nts = 0; const unsigned long long rt_entry = STAMP ? (unsigned long long)wall_clock64() : 0ull;
#define PG8_STAMP() do { if (STAMP && wid == 0 && nts < 64) { const unsigned long long _c = (unsigned long long)clock64(); \
        ts_lo = (lane == nts) ? (int)(unsigned)_c : ts_lo; ts_hi = (lane == nts) ? (int)(unsigned)(_c >> 32) : ts_hi; ++nts; } } while (0)
    PG8_STAMP();
    unsigned voffA[2], voffB[2];
#pragma unroll
    for (int i = 0; i < 2; ++i) { int R, C; stage_rc(tid * 16 + i * 8192, R, C); const int Rb = Epi::PERM ? ((R & ~31) + perm32(R & 31)) : R;
        voffA[i] = (unsigned)(R * K + C) * 2u; voffB[i] = (unsigned)(Rb * K + C) * 2u; }
    const size_t kstep = (size_t)(BK * 2);
    const size_t hstep = (size_t)HALF * K * 2;
    const size_t tstep = 2 * hstep;
    const unsigned ldsw = (unsigned)wid * 1024u;
    const int aoff = lds_byte(wr * 64 + fr, fq * 8), boff = lds_byte(wc * 32 + fr, fq * 8);
#define PG8_SA(b, h) (((b) * 2 + (h)) * HTB)
#define PG8_SB(b, h) ((4 + (b) * 2 + (h)) * HTB)
#define PG8_STAGE(bufoff, gbase, voff) do { _Pragma("unroll") for (int _i = 0; _i < 2; ++_i) \
        __builtin_amdgcn_global_load_lds((const unsigned*)((const char*)(gbase) + (voff)[_i]), (PG8_LAS unsigned*)(lds + (bufoff) + ldsw + _i * 8192), 16, 0, 0); } while (0)
#define PG8_LDA(dst, b, h) do { _Pragma("unroll") for (int m = 0; m < 4; ++m) _Pragma("unroll") for (int k = 0; k < 2; ++k) dst[m][k] = *(const PG8_LAS bf16x8*)(lds + PG8_SA(b, h) + aoff + m * 2048 + k * 1024); } while (0)
#define PG8_LDB(dst, b, h) do { _Pragma("unroll") for (int n = 0; n < 2; ++n) _Pragma("unroll") for (int k = 0; k < 2; ++k) dst[n][k] = *(const PG8_LAS bf16x8*)(lds + PG8_SB(b, h) + boff + n * 2048 + k * 1024); } while (0)
#define PG8_MMA(ai, bj, At, Bt) do { __builtin_amdgcn_s_setprio(1); _Pragma("unroll") for (int m = 0; m < 4; ++m) _Pragma("unroll") for (int n = 0; n < 2; ++n) _Pragma("unroll") for (int k = 0; k < 2; ++k) \
        acc[ai][bj][m][n] = __builtin_amdgcn_mfma_f32_16x16x32_bf16(Bt[n][k], At[m][k], acc[ai][bj][m][n], 0, 0, 0); __builtin_amdgcn_s_setprio(0); } while (0)
#define PG8_WAIT_V(n) asm volatile("s_waitcnt vmcnt(" #n ")" ::: "memory")
#define PG8_WAIT_L(n) asm volatile("s_waitcnt lgkmcnt(" #n ")" ::: "memory")
#define PG8_BAR __builtin_amdgcn_s_barrier()
#define PG8_SCHED __builtin_amdgcn_sched_barrier(0)
    Unit cur, nxt; int ui = 0;
    if (!S.next(0, cur)) return;
    f32x4 acc[2][2][4][2];
#pragma unroll
    for (int a = 0; a < 2; ++a)
#pragma unroll
        for (int b = 0; b < 2; ++b)
#pragma unroll
            for (int m = 0; m < 4; ++m)
#pragma unroll
                for (int n = 0; n < 2; ++n) acc[a][b][m][n] = (f32x4){0.f, 0.f, 0.f, 0.f};
    bf16x8 At[4][2], B0[2][2], B1[2][2];
    const char* cA = (const char*)g.A + (size_t)cur.pm * tstep + (size_t)cur.kt0 * kstep; const char* cB = (const char*)g.Bt + (size_t)cur.pn * tstep + (size_t)cur.kt0 * kstep;
    S.a_ready(cur);
    PG8_STAGE(PG8_SB(0, 0), cB, voffB); PG8_STAGE(PG8_SA(0, 0), cA, voffA); PG8_STAGE(PG8_SB(0, 1), cB + hstep, voffB); PG8_STAGE(PG8_SA(0, 1), cA + hstep, voffA);
    if (wr == 1) PG8_BAR;
    PG8_WAIT_V(4); PG8_BAR;
    PG8_STAGE(PG8_SB(1, 0), cB + kstep, voffB); PG8_STAGE(PG8_SA(1, 0), cA + kstep, voffA); PG8_STAGE(PG8_SB(1, 1), cB + hstep + kstep, voffB);
    PG8_WAIT_V(6); PG8_BAR;
    PG8_STAMP();
    for (;;) {
        const bool has_next = S.next(ui + 1, nxt);
        const char* nA = has_next ? (const char*)g.A + (size_t)nxt.pm * tstep + (size_t)nxt.kt0 * kstep : cA; const char* nB = has_next ? (const char*)g.Bt + (size_t)nxt.pn * tstep + (size_t)nxt.kt0 * kstep : cB;
        const int nt = cur.nkt;
        for (int t = 0; t < nt; t += 2) {
            const bool last = (t == nt - 2);
            const char* a1 = cA + (size_t)(t + 1) * kstep;
            const char* a2 = last ? nA : cA + (size_t)(t + 2) * kstep; const char* b2 = last ? nB : cB + (size_t)(t + 2) * kstep;
            const char* a3 = a2 + kstep; const char* b3 = b2 + kstep;
            if (last && has_next) S.a_ready(nxt);
            PG8_LDB(B0, 0, 0); PG8_SCHED; PG8_LDA(At, 0, 0); PG8_STAGE(PG8_SA(1, 1), a1 + hstep, voffA);
            PG8_WAIT_L(8); PG8_BAR; PG8_WAIT_L(0); PG8_MMA(0, 0, At, B0); PG8_BAR; PG8_SCHED;
            PG8_LDB(B1, 0, 1); PG8_STAGE(PG8_SB(0, 0), b2, voffB);
            PG8_BAR; PG8_WAIT_L(0); PG8_MMA(0, 1, At, B1); PG8_BAR;
            PG8_LDA(At, 0, 1); PG8_STAGE(PG8_SA(0, 0), a2, voffA);
            PG8_BAR; PG8_WAIT_L(0); PG8_MMA(1, 0, At, B0); PG8_BAR; PG8_SCHED;
            PG8_STAGE(PG8_SB(0, 1), b2 + hstep, voffB);
            PG8_WAIT_V(6); PG8_BAR; PG8_MMA(1, 1, At, B1); PG8_BAR;
            PG8_LDB(B0, 1, 0); PG8_SCHED; PG8_LDA(At, 1, 0); PG8_STAGE(PG8_SA(0, 1), a2 + hstep, voffA);
            PG8_WAIT_L(8); PG8_BAR; PG8_WAIT_L(0); PG8_MMA(0, 0, At, B0); PG8_BAR; PG8_SCHED;
            PG8_LDB(B1, 1, 1); PG8_STAGE(PG8_SB(1, 0), b3, voffB);
            PG8_BAR; PG8_WAIT_L(0); PG8_MMA(0, 1, At, B1); PG8_BAR;
            PG8_LDA(At, 1, 1); PG8_STAGE(PG8_SA(1, 0), a3, voffA);
            PG8_BAR; PG8_WAIT_L(0); PG8_MMA(1, 0, At, B0); PG8_BAR; PG8_SCHED;
            PG8_STAGE(PG8_SB(1, 1), b3 + hstep, voffB);
            PG8_WAIT_V(6); PG8_BAR; PG8_MMA(1, 1, At, B1); PG8_BAR;
        }
        PG8_STAMP();
        if constexpr (!Epi::AFTER_DRAIN) { E(acc, cur, wr, wc, fr, fq); S.done(cur); }
        PG8_STAMP();
        if (!has_next) break;
#pragma unroll
        for (int a = 0; a < 2; ++a)
#pragma unroll
            for (int b = 0; b < 2; ++b)
#pragma unroll
                for (int m = 0; m < 4; ++m)
#pragma unroll
                    for (int n = 0; n < 2; ++n) acc[a][b][m][n] = (f32x4){0.f, 0.f, 0.f, 0.f};
        cur = nxt; cA = nA; cB = nB; ++ui;
    }
    PG8_WAIT_V(0);
    if (wr == 0) PG8_BAR;
    PG8_BAR;
    if constexpr (Epi::AFTER_DRAIN) { E.fused(acc, cur, wr, wc, fr, fq, lds, wid, lane); S.done(cur); }
    PG8_STAMP();
    if (STAMP && wid == 0) { stamps[lane] = lane < nts ? (((unsigned long long)(unsigned)ts_hi << 32) | (unsigned)ts_lo) : 0ull;
        if (lane == 62) stamps[62] = rt_entry; if (lane == 63) stamps[63] = (unsigned long long)wall_clock64(); }
#undef PG8_STAMP
#undef PG8_SA
#undef PG8_SB
#undef PG8_STAGE
#undef PG8_LDA
#undef PG8_LDB
#undef PG8_MMA
#undef PG8_WAIT_V
#undef PG8_WAIT_L
#undef PG8_BAR
#undef PG8_SCHED
}
}
namespace fa {
constexpr int D = 128, OSTR = 1024;
constexpr float SCALE = 0.08838834764831845f;
constexpr float THR = 8.f;
constexpr bool WSKIP = false;
constexpr int NW = 8, QBLK = 32, KVBLK = 64, QB = NW * QBLK;
constexpr int SHM_V = KVBLK * D * 2, SHM_K = KVBLK * D * 2;
__device__ __forceinline__ int v_st(int k, int c) { const int kk = (k & ~0xC) | ((k & 4) << 1) | ((k & 8) >> 1); return ((kk >> 3) * 4 + (c >> 5)) * 512 + ((kk & 7) * 32 + (c & 31)) * 2; }
__device__ __forceinline__ int v_rd_base(int lane) { return ((lane & 3) << 3) | (((lane >> 2) & 3) << 6) | (((lane >> 4) & 1) << 5) | (((lane >> 5) & 1) << 8); }
constexpr int v_rd_off(int d0, int ks, int half) { return d0 * 512 + ks * 4096 + half * 2048; }
__device__ __forceinline__ int crow(int r, int hi) { return (r & 3) + 8 * (r >> 2) + 4 * hi; }
__device__ __forceinline__ unsigned cvtpk(float lo, float hi) {
    unsigned r; asm volatile("v_cvt_pk_bf16_f32 %0, %1, %2" : "=v"(r) : "v"(lo), "v"(hi)); return r;
}
__device__ __forceinline__ bf16x8 pack8(f32x4 a, f32x4 b) {
    u32x4 w = {cvtpk(a[0], a[1]), cvtpk(a[2], a[3]), cvtpk(b[0], b[1]), cvtpk(b[2], b[3])};
    return *reinterpret_cast<bf16x8*>(&w);
}
template <class T> __device__ __forceinline__ bf16x8 load8(const T* p) {
    if constexpr (same_t<T, float>::v) { return pack8(*(const f32x4*)p, *(const f32x4*)(p + 4)); }
    else { return *reinterpret_cast<const bf16x8*>(p); }
}
__device__ __forceinline__ void mask_tile(f32x16& p0, f32x16& p1, int dq, unsigned W) {
    const float NEG = -__builtin_inff();
#pragma unroll
    for (int r = 0; r < 16; ++r) {
        const int c = (r & 3) + 8 * (r >> 2);
        if ((unsigned)(dq - c) >= W) p0[r] = NEG;
        if ((unsigned)(dq - c - 32) >= W) p1[r] = NEG;
    }
}
__device__ __forceinline__ void partialSM(f32x16& p0, f32x16& p1, float& m_reg, float& mn, float& alpha) {
    float pmax = p0[0]; for (int r = 1; r < 16; ++r) pmax = fmaxf(pmax, p0[r]); for (int r = 0; r < 16; ++r) pmax = fmaxf(pmax, p1[r]);
    { auto rr = __builtin_amdgcn_permlane32_swap(__float_as_uint(pmax), __float_as_uint(pmax), false, false);
      pmax = fmaxf(__uint_as_float(rr[0]), __uint_as_float(rr[1])); }
    constexpr float C2 = 1.4426950408889634f * SCALE;
    if (__builtin_expect(__all((pmax - m_reg) * SCALE <= THR), 1)) { mn = m_reg; alpha = 1.f; }
    else { mn = fmaxf(m_reg, pmax); alpha = __builtin_amdgcn_exp2f((m_reg - mn) * C2); m_reg = mn; }
    const float mnL = -mn * C2;
    for (int r = 0; r < 16; ++r) p0[r] = fmaf(p0[r], C2, mnL); for (int r = 0; r < 16; ++r) p1[r] = fmaf(p1[r], C2, mnL);
    for (int r = 0; r < 16; ++r) p0[r] = __builtin_amdgcn_exp2f(p0[r]);
}
__device__ __forceinline__ void finishSM(f32x16& p0, f32x16& p1, float alpha, float& l_reg, bf16x8& pa0, bf16x8& pa1, bf16x8& pa2, bf16x8& pa3) {
    for (int r = 0; r < 16; ++r) p1[r] = __builtin_amdgcn_exp2f(p1[r]);
    float ps = 0; for (int r = 0; r < 16; ++r) ps += p0[r]; for (int r = 0; r < 16; ++r) ps += p1[r];
    { auto rr = __builtin_amdgcn_permlane32_swap(__float_as_uint(ps), __float_as_uint(ps), false, false);
      ps = __uint_as_float(rr[0]) + __uint_as_float(rr[1]); }
    l_reg = l_reg * alpha + ps;
#define PK4(P, B_, OUT) do { unsigned a0 = cvtpk(P[B_+0], P[B_+1]), a1 = cvtpk(P[B_+2], P[B_+3]);                          \
        unsigned b0 = cvtpk(P[B_+4], P[B_+5]), b1 = cvtpk(P[B_+6], P[B_+7]);                                             \
        auto r0 = __builtin_amdgcn_permlane32_swap(a0, b0, false, false); auto r1 = __builtin_amdgcn_permlane32_swap(a1, b1, false, false); \
        u32x4 w = {r0[0], r1[0], r0[1], r1[1]}; OUT = *reinterpret_cast<bf16x8*>(&w); } while (0)
    PK4(p0, 0, pa0); PK4(p0, 8, pa1); PK4(p1, 0, pa2); PK4(p1, 8, pa3);
#undef PK4
}
template <int KB, bool SK>
__device__ __forceinline__ void qkt(f32x16& p0, f32x16& p1, const char* K_lds, const char* B_lds, int r32, int hi, const bf16x8* qr, bool act) {
    if (SK && !act) { const float NEG = -__builtin_inff();
#pragma unroll
        for (int r = 0; r < 16; ++r) { p0[r] = NEG; p1[r] = NEG; } return; }
    { const float* bl = (const float*)B_lds + 4 * hi;
#pragma unroll
      for (int g = 0; g < 4; ++g) { const f32x4 ba = *(const f32x4*)(bl + 8 * g); const f32x4 bb = *(const f32x4*)(bl + 32 + 8 * g);
#pragma unroll
        for (int e = 0; e < 4; ++e) { p0[4 * g + e] = ba[e]; p1[4 * g + e] = bb[e]; } } }
    const char* kb[4];
#pragma unroll
    for (int dd = 0; dd < 4; ++dd) kb[dd] = K_lds + KB * SHM_K + KSWZ(r32, (dd * 16 + hi * 8) * 2);
#pragma unroll
    for (int d0 = 0; d0 < 8; ++d0) { const char* a = kb[d0 & 3] + (d0 >> 2) * 128;
        bf16x8 b0 = *reinterpret_cast<const bf16x8*>(a);
        bf16x8 b1 = *reinterpret_cast<const bf16x8*>(a + 32 * 256);
        p0 = __builtin_amdgcn_mfma_f32_32x32x16_bf16(b0, qr[d0], p0, 0, 0, 0);
        p1 = __builtin_amdgcn_mfma_f32_32x32x16_bf16(b1, qr[d0], p1, 0, 0, 0); }
}
template <int VB, bool SK>
__device__ __forceinline__ void pv_tile(f32x16* o, int vb0, bf16x8 pa0, bf16x8 pa1, bf16x8 pa2, bf16x8 pa3, bool act) {
    if (SK && !act) return;
#define TRRD(dst, off) asm volatile("ds_read_b64_tr_b16 %0, %1 offset:%2" : "=&v"(dst) : "v"(vb0), "i"(off) : "memory")
#define PV_D0(d0) do { s16x4 l0, l1, l2, l3, h0, h1, h2, h3; constexpr int b_ = VB * SHM_V + v_rd_off(d0, 0, 0);     \
        TRRD(l0, b_); TRRD(h0, b_ + 2048); TRRD(l1, b_ + 4096); TRRD(h1, b_ + 6144); TRRD(l2, b_ + 8192); TRRD(h2, b_ + 10240); TRRD(l3, b_ + 12288); TRRD(h3, b_ + 14336); \
        asm volatile("s_waitcnt lgkmcnt(0)" ::: "memory"); SBAR();                 \
        o[d0] = __builtin_amdgcn_mfma_f32_32x32x16_bf16(pa0, (bf16x8){l0[0], l0[1], l0[2], l0[3], h0[0], h0[1], h0[2], h0[3]}, o[d0], 0, 0, 0);   \
        o[d0] = __builtin_amdgcn_mfma_f32_32x32x16_bf16(pa1, (bf16x8){l1[0], l1[1], l1[2], l1[3], h1[0], h1[1], h1[2], h1[3]}, o[d0], 0, 0, 0);   \
        o[d0] = __builtin_amdgcn_mfma_f32_32x32x16_bf16(pa2, (bf16x8){l2[0], l2[1], l2[2], l2[3], h2[0], h2[1], h2[2], h2[3]}, o[d0], 0, 0, 0);   \
        o[d0] = __builtin_amdgcn_mfma_f32_32x32x16_bf16(pa3, (bf16x8){l3[0], l3[1], l3[2], l3[3], h3[0], h3[1], h3[2], h3[3]}, o[d0], 0, 0, 0); } while (0)
    PV_D0(0); PV_D0(1); PV_D0(2); PV_D0(3);
#undef PV_D0
#undef TRRD
}

template <class TIn, class TOut> struct BlockRef { const TIn* Q; const TIn* K; const TIn* V; const TIn* K2; const TIn* V2; TOut* O; const float* NC; int P0; int nrows; };
template <class TIn> struct Seam {
    bf16x8 qr[8];
    bf16x8 st_v0, st_v1, st_k0, st_k1; f32x4 sf0, sf1, sf2, sf3;
    f32x4 tq[16];
};
__device__ __forceinline__ int swa_jlo(int P0, int W) { const int lowk = P0 - W + 1; return lowk > 0 ? lowk / KVBLK : 0; }
#define ROW(p, k0, rr) ((p) + (size_t)((k0) + (rr)) * D + sc)
#define VMW() asm volatile("s_waitcnt vmcnt(0)" ::: "memory")
#define VMWN(n) asm volatile("s_waitcnt vmcnt(%0)" :: "i"(n) : "memory")
#define SLOAD_H(Kp, Vp, NCp, k0) do { S.st_v0 = load8<TIn>(ROW(Vp, k0, sr)); S.st_v1 = load8<TIn>(ROW(Vp, k0, 32 + sr));              \
                         S.st_k0 = load8<TIn>(ROW(Kp, k0, sr)); S.st_k1 = load8<TIn>(ROW(Kp, k0, 32 + sr)); } while (0)
#define SWRITE_HK(bf) do { *(bf16x8*)(K_lds + (bf) * SHM_K + kws) = S.st_k0; *(bf16x8*)(K_lds + (bf) * SHM_K + kws + 32 * 256) = S.st_k1; } while (0)
#define SWRITE_HV(bf) do { *(bf16x8*)(V_lds + (bf) * SHM_V + vst0) = S.st_v0; *(bf16x8*)(V_lds + (bf) * SHM_V + vst1) = S.st_v1; } while (0)
#define SWRITE_H(bf) do { SWRITE_HV(bf); SWRITE_HK(bf); } while (0)
#define ROWF(p, k0, rr) ((p) + (size_t)((k0) + (rr)) * 1024 + sc)
#define FSEL(a, b, k0) ((const float*)((k0) < 1024 ? (a) : (b)))
#define SLOAD_F(p, k0) do { S.sf0 = __builtin_nontemporal_load((const f32x4*)ROWF(p, k0, sr)); S.sf1 = __builtin_nontemporal_load((const f32x4*)(ROWF(p, k0, sr) + 4));                \
                            S.sf2 = __builtin_nontemporal_load((const f32x4*)ROWF(p, k0, 32 + sr)); S.sf3 = __builtin_nontemporal_load((const f32x4*)(ROWF(p, k0, 32 + sr) + 4)); } while (0)
#define SWRITE_KF(bf) do { *(bf16x8*)(K_lds + (bf) * SHM_K + kws) = pack8(S.sf0, S.sf1); *(bf16x8*)(K_lds + (bf) * SHM_K + kws + 32 * 256) = pack8(S.sf2, S.sf3); } while (0)
#define SWRITE_VF(bf) do { *(bf16x8*)(V_lds + (bf) * SHM_V + vst0) = pack8(S.sf0, S.sf1); *(bf16x8*)(V_lds + (bf) * SHM_V + vst1) = pack8(S.sf2, S.sf3); } while (0)
template <class TIn, class TOut>
__device__ __forceinline__ void causal_swa_prime(const BlockRef<TIn, TOut>& cur, int W, char* lds, Seam<TIn>& S) {
    constexpr bool F32 = same_t<TIn, float>::v;
    const int tid = otid(), wid = __builtin_amdgcn_readfirstlane(tid >> 6), lane = tid & 63, r32 = lane & 31, hi = lane >> 5;
    const int sr = tid >> 4, sc = (tid & 15) * 8, kws = KSWZ(sr, sc * 2); char* K_lds = lds + 2 * SHM_V; char* B_lds = lds + 2 * SHM_V + 2 * SHM_K + NW * 64 * 4;
    const int kb0 = swa_jlo(cur.P0, W) * KVBLK;
    for (int d0 = 0; d0 < 8; ++d0) S.qr[d0] = load8<TIn>(cur.Q + (size_t)(wid * QBLK + r32) * D + d0 * 16 + hi * 8);
    if constexpr (F32) { SLOAD_F(FSEL(cur.K, cur.K2, kb0), kb0); VMW(); SWRITE_KF(0); SBAR(); SLOAD_F(FSEL(cur.V, cur.V2, kb0), kb0); }
    else { SLOAD_H(cur.K, cur.V, cur.NC, kb0); VMW(); SWRITE_HK(0); }
    __syncthreads();
}
template <class TIn, class TOut>
__device__ __forceinline__ void causal_swa_block(const BlockRef<TIn, TOut>& cur, const BlockRef<TIn, TOut>& nxt, int skv, int W, char* lds, Seam<TIn>& S) {
    constexpr bool F32 = same_t<TIn, float>::v;
    const int tid = otid(), wid = __builtin_amdgcn_readfirstlane(tid >> 6), lane = tid & 63, r32 = lane & 31, hi = lane >> 5;
    const int j_lo = swa_jlo(cur.P0, W);
    int j_hi = (cur.P0 + QB - 1) / KVBLK + 1; if (j_hi > skv / KVBLK) j_hi = skv / KVBLK;
    const int NT = j_hi - j_lo;
    const int kbn = swa_jlo(nxt.P0, W) * KVBLK;
    const int qlo = cur.P0 + wid * QBLK, qm = qlo + r32 - 4 * hi;
    char* V_lds = lds; char* K_lds = lds + 2 * SHM_V; char* B_lds = lds + 2 * SHM_V + 2 * SHM_K + NW * 64 * 4;
    float* ws = (float*)(lds + 2 * SHM_V + 2 * SHM_K) + wid * 64; float* li_l = ws, * al_l = ws + 32;
    float m_reg = -1e30f, l_reg = 0; f32x16 o[4] = {};
    const int sr = tid >> 4, sc = (tid & 15) * 8, vst0 = v_st(sr, sc), vst1 = v_st(32 + sr, sc), kws = KSWZ(sr, sc * 2);
    const int vb0 = (int)(uintptr_t)V_lds + v_rd_base(lane);
    const TIn* Kh = cur.K; const TIn* Vh = cur.V;
#define RESC(a) do { if (__any((a) < 1.f)) { if (hi == 0) al_l[r32] = (a); asm volatile("s_waitcnt lgkmcnt(0)" ::: "memory");              \
                     for (int d_ = 0; d_ < 4; ++d_) for (int r = 0; r < 16; ++r) o[d_][r] *= al_l[crow(r, hi)]; } } while (0)
#define KBASE(t) ((j_lo + (t)) * KVBLK)
#define ACT(t) (KBASE(t) <= qlo + QBLK - 1 && KBASE(t) + KVBLK - 1 >= qlo - W + 1)
#define MASKT(P0_, P1_, t) do { const int kb_ = KBASE(t); if ((!SK || ACT(t)) && (kb_ + KVBLK - 1 > qlo || kb_ <= qlo + QBLK - 1 - W)) mask_tile(P0_, P1_, qm - kb_, (unsigned)W); } while (0)
    constexpr int NQL = F32 ? 16 : 8;
    constexpr bool SK = WSKIP && !F32;
#define SEAM_K0() do { VMWN(NQL); if constexpr (F32) { SWRITE_KF(0); SBAR(); SLOAD_F(FSEL(nxt.V, nxt.V2, kbn), kbn); } else { SWRITE_HK(0); } SBAR(); } while (0)
    f32x16 pA0, pA1, pB0, pB1; float mnA, mnB, alA, alB; bf16x8 pa0, pa1, pa2, pa3;
    { const int nbk = j_hi * KVBLK;
      for (int q = tid * 4; q < nbk; q += 2048) *(f32x4*)(B_lds + q * 4) = *(const f32x4*)(cur.NC + q);
      __syncthreads(); }
    if constexpr (F32) { VMW(); SWRITE_VF(0); SBAR(); } else { SWRITE_HV(0); SBAR(); }
    if (NT > 1) { if constexpr (F32) SLOAD_F(FSEL(cur.K, cur.K2, KBASE(1)), KBASE(1)); else SLOAD_H(Kh, Vh, cur.NC, KBASE(1)); }
    SBAR(); qkt<0, SK>(pA0, pA1, K_lds, B_lds + KBASE(0) * 4, r32, hi, S.qr, ACT(0));
    if constexpr (F32) { if (NT > 1) { VMW(); SWRITE_KF(1); SBAR(); SLOAD_F(FSEL(cur.V, cur.V2, KBASE(1)), KBASE(1)); } }
    MASKT(pA0, pA1, 0); partialSM(pA0, pA1, m_reg, mnA, alA);
    if (NT > 1) { VMW(); if constexpr (F32) { SWRITE_VF(1); SBAR(); if (NT > 2) SLOAD_F(FSEL(cur.K, cur.K2, KBASE(2)), KBASE(2)); } else SWRITE_H(1); }
    __syncthreads();
#define HALF_STEP(PX0, PX1, mnX, alX, PY0, PY1, alY, t, KB, VB, SB) do {                                                      \
        SBAR(); qkt<KB, SK>(PX0, PX1, K_lds, B_lds + KBASE(t) * 4, r32, hi, S.qr, ACT(t));                                             \
        finishSM(PY0, PY1, alY, l_reg, pa0, pa1, pa2, pa3); SBAR();                                                           \
        if ((t) + 1 < NT) { if constexpr (F32) { VMW(); SWRITE_KF(SB); SBAR(); SLOAD_F(FSEL(cur.V, cur.V2, KBASE((t) + 1)), KBASE((t) + 1)); }  \
                            else { SLOAD_H(Kh, Vh, cur.NC, KBASE((t) + 1)); } SBAR(); }                                               \
        pv_tile<VB, SK>(o, vb0, pa0, pa1, pa2, pa3, ACT((t) - 1)); MASKT(PX0, PX1, (t)); partialSM(PX0, PX1, m_reg, mnX, alX);                                        \
        __syncthreads();                                                                                                      \
        if ((t) + 1 < NT) { VMW(); if constexpr (F32) { SWRITE_VF(SB); SBAR(); if ((t) + 2 < NT) SLOAD_F(FSEL(cur.K, cur.K2, KBASE((t) + 2)), KBASE((t) + 2)); } \
                            else { SWRITE_H(SB); } }                                                                          \
        RESC(alX); __syncthreads(); } while (0)
    for (int t = 1; t + 1 < NT; t += 2) {
        HALF_STEP(pB0, pB1, mnB, alB, pA0, pA1, alA, t, 1, 0, 0);
        HALF_STEP(pA0, pA1, mnA, alA, pB0, pB1, alB, t + 1, 0, 1, 1);
    }
    const bool even = (NT & 1) == 0;
    if (even) { SBAR(); qkt<1, SK>(pB0, pB1, K_lds, B_lds + KBASE(NT - 1) * 4, r32, hi, S.qr, ACT(NT - 1)); SBAR(); }
#define QROW(e) (nxt.Q + (size_t)(wid * QBLK + r32) * D + ((e) >> 1) * 16 + hi * 8 + ((e) & 1) * 4)
    if constexpr (F32) { SLOAD_F(FSEL(nxt.K, nxt.K2, kbn), kbn); SBAR();
#pragma unroll
        for (int e = 0; e < 8; ++e) S.tq[e] = *(const f32x4*)QROW(e); }
    else { SLOAD_H(nxt.K, nxt.V, nxt.NC, kbn); SBAR();
#pragma unroll
        for (int d0 = 0; d0 < 8; ++d0) S.qr[d0] = load8<TIn>(nxt.Q + (size_t)(wid * QBLK + r32) * D + d0 * 16 + hi * 8); }
    SBAR();
    finishSM(pA0, pA1, alA, l_reg, pa0, pa1, pa2, pa3); SBAR();
    if constexpr (F32) {
#pragma unroll
        for (int e = 8; e < 16; ++e) S.tq[e] = *(const f32x4*)QROW(e); SBAR(); }
#undef QROW
    pv_tile<0, SK>(o, vb0, pa0, pa1, pa2, pa3, ACT(even ? NT - 2 : NT - 1));
    if (even) { MASKT(pB0, pB1, NT - 1); partialSM(pB0, pB1, m_reg, mnB, alB); __syncthreads(); RESC(alB);
        finishSM(pB0, pB1, alB, l_reg, pa0, pa1, pa2, pa3); SBAR(); pv_tile<1, SK>(o, vb0, pa0, pa1, pa2, pa3, ACT(NT - 1)); }
    SBAR(); SEAM_K0();
    if (hi == 0) li_l[r32] = l_reg; asm volatile("s_waitcnt lgkmcnt(0)" ::: "memory");
    float rli[16];
#pragma unroll
    for (int r = 0; r < 16; ++r) rli[r] = __builtin_amdgcn_rcpf(li_l[crow(r, hi)]);
    TOut* Ow = cur.O + (size_t)(wid * QBLK) * OSTR;
    if (wid * QBLK < cur.nrows)
#pragma unroll
    for (int r = 0; r < 16; ++r) { const int orow = crow(r, hi);
#pragma unroll
        for (int d0 = 0; d0 < 4; ++d0) { const float v = o[d0][r] * rli[r];
            if constexpr (same_t<TOut, float>::v) { Ow[(size_t)orow * OSTR + d0 * 32 + r32] = v; }
            else { const float vn = __shfl_xor(v, 1);
                   if ((r32 & 1) == 0) *(unsigned*)(Ow + (size_t)orow * OSTR + d0 * 32 + r32) = cvtpk(v, vn); } } }
    if constexpr (F32) {
#pragma unroll
        for (int d0 = 0; d0 < 8; ++d0) S.qr[d0] = pack8(S.tq[2 * d0], S.tq[2 * d0 + 1]); }
    __syncthreads();
#undef RESC
#undef KBASE
#undef ACT
#undef MASKT
#undef SEAM_K0
#undef HALF_STEP
}
#undef ROW
#undef VMW
#undef VMWN
#undef SLOAD_H
#undef SWRITE_HK
#undef SWRITE_HV
#undef SWRITE_H
#undef SLOAD_F
#undef SWRITE_KF
#undef SWRITE_VF

}
#define XB_TMO      128
#define XB_XCNT(j)  (256  + 64 * (j))
#define XB_XSUB(j)  (1280 + 64 * (j))
#define XB_XGEN(j)  (2304 + 64 * (j))
#define XB_TOP      3328
#define XB_TOPGEN   3392
#define XCD_BAR_WORDS 3456
#define XB_SPIN_CAP (1u << 18)
#define XB_LAS __attribute__((address_space(3)))

__device__ __forceinline__ unsigned xb_ld(unsigned* p)              { return __hip_atomic_load(p, __ATOMIC_RELAXED, __HIP_MEMORY_SCOPE_AGENT); }
__device__ __forceinline__ unsigned xb_add(unsigned* p, unsigned v) { return __hip_atomic_fetch_add(p, v, __ATOMIC_RELAXED, __HIP_MEMORY_SCOPE_AGENT); }
__device__ __forceinline__ unsigned xb_xcc_id() { return (unsigned)__builtin_amdgcn_s_getreg((3 << 11) | 20) & 0xFu; }
#define XB_SPIN(cond, bar) do { unsigned _sp = 0; while (cond) { __builtin_amdgcn_s_sleep(1); \
    if ((++_sp & 255u) == 0u) { if (xb_ld(&(bar)[XB_TMO])) break; if (_sp > XB_SPIN_CAP) { atomicAdd(&(bar)[XB_TMO], 1u); break; } } } } while (0)

struct XcdBarrier {
    unsigned* bar; unsigned x;
    volatile XB_LAS unsigned* st;
};

__device__ __forceinline__ XcdBarrier xcd_barrier_post(unsigned* bar, volatile XB_LAS unsigned* st) {
    XcdBarrier b; b.bar = bar; b.x = xb_xcc_id(); b.st = st;
    if (threadIdx.x == 0) (void)xb_add(&bar[XB_XCNT(b.x)], 1u);
    return b;
}
__device__ __forceinline__ void xcd_barrier_complete(unsigned* bar, unsigned x, unsigned& nloc, unsigned& nx) {
    const unsigned G = gridDim.x * gridDim.y * gridDim.z;
    unsigned sum, cnt, mine, sp = 0u;
    for (;;) {
        sum = 0u; cnt = 0u; mine = 0u;
#pragma unroll
        for (unsigned j = 0; j < 16; ++j) { const unsigned c = xb_ld(&bar[XB_XCNT(j)]); sum += c; cnt += (c > 0u) ? 1u : 0u; mine = (j == x) ? c : mine; }
        if (sum == G) break;
        __builtin_amdgcn_s_sleep(1);
        if ((++sp & 255u) == 0u) { if (xb_ld(&bar[XB_TMO])) break; if (sp > XB_SPIN_CAP) { atomicAdd(&bar[XB_TMO], 1u); break; } }
    }
    nloc = mine > 0u ? mine : 1u; nx = cnt > 0u ? cnt : 1u;
}

__device__ __forceinline__ void xcd_barrier(const XcdBarrier& b) {
    asm volatile("s_waitcnt vmcnt(0)" ::: "memory");
    __syncthreads();
    if (threadIdx.x == 0) {
        unsigned* bar = b.bar;
        __builtin_amdgcn_s_waitcnt(0);
        unsigned nloc = b.st[0], nx = b.st[1];
        if (nloc == 0u) { xcd_barrier_complete(bar, b.x, nloc, nx); b.st[0] = nloc; b.st[1] = nx; }
        const unsigned old = xb_add(&bar[XB_XSUB(b.x)], 1u);
        const unsigned gen = old / nloc;
        if (old + 1u == (gen + 1u) * nloc) {
            __builtin_amdgcn_fence(__ATOMIC_RELEASE, "agent");
            asm volatile("s_waitcnt vmcnt(0)" ::: "memory");
            const unsigned og = xb_add(&bar[XB_TOP], 1u);
            const unsigned tg = og / nx;
            if (og + 1u == (tg + 1u) * nx) xb_add(&bar[XB_TOPGEN], 1u);
            else XB_SPIN(xb_ld(&bar[XB_TOPGEN]) == tg, bar);
            __builtin_amdgcn_fence(__ATOMIC_ACQUIRE, "agent");
            xb_add(&bar[XB_XGEN(b.x)], 1u);
            asm volatile("s_waitcnt vmcnt(0)" ::: "memory");
        } else {
            XB_SPIN(xb_ld(&bar[XB_XGEN(b.x)]) == gen, bar);
            __builtin_amdgcn_fence(__ATOMIC_ACQUIRE, "agent");
            asm volatile("s_waitcnt vmcnt(0)" ::: "memory");
        }
    }
    __syncthreads();
}


__device__ __forceinline__ float bf2f(unsigned short b) { return __uint_as_float(((unsigned)b) << 16); }
__device__ __forceinline__ unsigned pk2(float lo, float hi) { unsigned r; asm volatile("v_cvt_pk_bf16_f32 %0, %1, %2" : "=v"(r) : "v"(lo), "v"(hi)); return r; }
__device__ __forceinline__ unsigned short f2bf(float x) { return (unsigned short)(pk2(x, 0.f) & 0xffffu); }
__device__ __forceinline__ float wave_sum(float v) {
#pragma unroll
    for (int o = 1; o < 64; o <<= 1) v += __shfl_xor(v, o);
    return v;
}
__device__ __forceinline__ float grp16_sum(float v) {
#pragma unroll
    for (int o = 1; o < 16; o <<= 1) v += __shfl_xor(v, o);
    return v;
}
__device__ __forceinline__ float wave_incl_scan(float v, int lane) {
#pragma unroll
    for (int o = 1; o < 64; o <<= 1) { const float t = __shfl_up(v, o); if (lane >= o) v += t; }
    return v;
}
__device__ __forceinline__ float silu_f(float x) { return x * __builtin_amdgcn_rcpf(1.f + __expf(-x)); }
__device__ __forceinline__ void unpack8(u32x4 w, float (&o)[8]) {
#pragma unroll
    for (int q = 0; q < 4; ++q) { o[2 * q] = __uint_as_float(w[q] << 16); o[2 * q + 1] = __uint_as_float(w[q] & 0xffff0000u); }
}
__device__ __forceinline__ u32x4 pack8f(const float (&v)[8]) { u32x4 w = {pk2(v[0], v[1]), pk2(v[2], v[3]), pk2(v[4], v[5]), pk2(v[6], v[7])}; return w; }
__device__ __forceinline__ int pos16(int x) { return (x & ~12) | (((x >> 2) & 1) << 3) | (((x >> 3) & 1) << 2); }
__device__ __forceinline__ int crow32(int r, int hi) { return (r & 3) + 8 * (r >> 2) + 4 * hi; }

struct EpiBf16Plain {
    static constexpr bool PERM = true, AFTER_DRAIN = false;
    bf16_t* O; int ldc;
    __device__ __forceinline__ void operator()(const pg8::f32x4 (&acc)[2][2][4][2], const pg8::Unit& u, int wr, int wc, int fr, int fq) const {
        const int row0 = u.pm * 256 + wr * 64 + fr, col0 = u.pn * 256 + wc * 32 + 8 * fq;
#pragma unroll
        for (int ai = 0; ai < 2; ++ai)
#pragma unroll
            for (int m = 0; m < 4; ++m) { bf16_t* rowp = O + (size_t)(row0 + ai * 128 + m * 16) * ldc + col0;
#pragma unroll
                for (int bj = 0; bj < 2; ++bj) { const pg8::f32x4 v0 = acc[ai][bj][m][0], v1 = acc[ai][bj][m][1];
                    u32x4 w; w.x = pk2(v0[0], v0[1]); w.y = pk2(v0[2], v0[3]); w.z = pk2(v1[0], v1[1]); w.w = pk2(v1[2], v1[3]);
                    *(u32x4*)(rowp + bj * 128) = w; } }
    }
};
struct EpiSwiglu {
    static constexpr bool PERM = true, AFTER_DRAIN = false;
    bf16_t* O; int ldc;
    __device__ __forceinline__ void operator()(const pg8::f32x4 (&acc)[2][2][4][2], const pg8::Unit& u, int wr, int wc, int fr, int fq) const {
        const int row0 = u.pm * 256 + wr * 64 + fr, col0 = u.pn * 128 + wc * 32 + 8 * fq;
#pragma unroll
        for (int ai = 0; ai < 2; ++ai)
#pragma unroll
            for (int m = 0; m < 4; ++m) { bf16_t* rowp = O + (size_t)(row0 + ai * 128 + m * 16) * ldc + col0;
                float r[8];
#pragma unroll
                for (int n = 0; n < 2; ++n)
#pragma unroll
                    for (int e = 0; e < 4; ++e) { const float g = acc[ai][0][m][n][e], up = acc[ai][1][m][n][e]; r[4 * n + e] = silu_f(g) * up; }
                *(u32x4*)rowp = pack8f(r); }
    }
};
struct EpiResid {
    static constexpr bool PERM = false, AFTER_DRAIN = false;
    float* X; int ldc; float* slab;
    __device__ __forceinline__ void operator()(const pg8::f32x4 (&acc)[2][2][4][2], const pg8::Unit& u, int wr, int wc, int fr, int fq) const {
        const int row0 = u.pm * 256 + wr * 64 + fr, col0 = u.pn * 256 + wc * 32 + 4 * fq;
        if (u.split) {
            float* Sl = slab + (size_t)(u.split - 1) * MS * DM;
#pragma unroll
            for (int ai = 0; ai < 2; ++ai)
#pragma unroll
                for (int m = 0; m < 4; ++m) { float* rowp = Sl + (size_t)(row0 - MP + ai * 128 + m * 16) * DM + col0;
#pragma unroll
                    for (int bj = 0; bj < 2; ++bj)
#pragma unroll
                        for (int n = 0; n < 2; ++n) *(pg8::f32x4*)(rowp + bj * 128 + n * 16) = acc[ai][bj][m][n]; }
        } else {
#pragma unroll
            for (int ai = 0; ai < 2; ++ai)
                {
                    pg8::f32x4 xv[4][2][2];
#pragma unroll
                    for (int mm = 0; mm < 4; ++mm) { const float* rowp = X + (size_t)(row0 + ai * 128 + mm * 16) * ldc + col0;
#pragma unroll
                        for (int bj = 0; bj < 2; ++bj)
#pragma unroll
                            for (int n = 0; n < 2; ++n) xv[mm][bj][n] = *(const pg8::f32x4*)(rowp + bj * 128 + n * 16); }
#pragma unroll
                    for (int mm = 0; mm < 4; ++mm) { float* rowp = X + (size_t)(row0 + ai * 128 + mm * 16) * ldc + col0;
#pragma unroll
                        for (int bj = 0; bj < 2; ++bj)
#pragma unroll
                            for (int n = 0; n < 2; ++n) *(pg8::f32x4*)(rowp + bj * 128 + n * 16) = xv[mm][bj][n] + acc[ai][bj][mm][n]; }
                }
        }
    }
};
template <class Epi>
__device__ __forceinline__ void run_gemm(PG8_LAS unsigned char* lds, const bf16_t* A, const bf16_t* Bt, int N, int K, const Epi& E) {
    pg8::Gemm g; g.A = A; g.Bt = Bt; g.M = MT; g.N = N; g.K = K;
    pg8::StaticOrder S; S.init(MT, N, (int)gridDim.x, (int)blockIdx.x); S.nktf = K / 64;
    pg8::gemm_phase<Epi, pg8::StaticOrder, false>(lds, g, S, E, nullptr);
}

__device__ __forceinline__ int tail_parts(int K, int G) { return G != 256 ? 0 : ((K / 128) >= 16 ? 8 : 4); }
struct TailSplitOrder {
    int c, G, nktf; pg8::StaticOrder so;
    __device__ void init(int K, int G_, int c_) { c = c_; G = G_; nktf = K / 64; so.init(MT, 1024, G_, c_); so.nktf = nktf; }
    __device__ bool next(int i, pg8::Unit& u) const {
        if (G != 256) return so.next(i, u);
        if (i == 0) { u.pm = (c & 7) + 8 * (c >> 5); u.pn = (c >> 3) & 3; u.kt0 = 0; u.nkt = nktf; u.split = 0; return true; }
        if (i > 1) return false;
        const int npairs = nktf >> 1, parts = npairs >= 16 ? 8 : 4, part = c >> 5, tix = c & 31;
        if (part >= parts) return false;
        const int q = npairs / parts, r = npairs - q * parts;
        const int p0 = part * q + (part < r ? part : r), np = q + (part < r ? 1 : 0);
        u.pm = 64 + (tix >> 2); u.pn = tix & 3; u.kt0 = 2 * p0; u.nkt = 2 * np; u.split = part + 1; return true;
    }
    __device__ __forceinline__ void a_ready(const pg8::Unit&) const {}
    __device__ __forceinline__ void done(const pg8::Unit&) const {}
};
__device__ __forceinline__ void run_gemm_n1024(PG8_LAS unsigned char* lds, const bf16_t* A, const bf16_t* Bt, int K, const EpiResid& E) {
    pg8::Gemm g; g.A = A; g.Bt = Bt; g.M = MT; g.N = 1024; g.K = K;
    TailSplitOrder S; S.init(K, (int)gridDim.x, (int)blockIdx.x);
    pg8::gemm_phase<EpiResid, TailSplitOrder, false>(lds, g, S, E, nullptr);
}

__device__ __forceinline__ void transpose_weight(const float* __restrict__ W, int K, int N, bf16_t* WT, int mode, float* tile, int bid, int nb) {
    const int tid = otid();
    const int nct = (N + 63) >> 6, nkt = K >> 6, nt = nct * nkt;
    constexpr int TB = 4;
    for (int t0 = bid; t0 < nt; t0 += TB * nb) {
        float v[TB][8];
#pragma unroll
        for (int q = 0; q < TB; ++q) { const int t = min(t0 + q * nb, nt - 1), kt = t / nct, ct = t - kt * nct, k0 = kt * 64, n0 = ct * 64;
#pragma unroll
            for (int i = 0; i < 8; ++i) { const int r = (tid >> 6) + 8 * i, c = tid & 63, n = n0 + c; v[q][i] = (n < N) ? __builtin_nontemporal_load(W + (size_t)(k0 + r) * N + n) : 0.f; } }
#pragma unroll
        for (int q = 0; q < TB; ++q)
#pragma unroll
            for (int i = 0; i < 8; ++i) { const int r = (tid >> 6) + 8 * i, c = tid & 63; tile[q * 4160 + r * 65 + c] = v[q][i]; }
        __syncthreads();
#pragma unroll
        for (int q = 0; q < TB; ++q) { const int t = t0 + q * nb; if (t < nt) { const int kt = t / nct, ct = t - kt * nct, k0 = kt * 64, n0 = ct * 64;
            const int nl = tid >> 3, kc = tid & 7, n = n0 + nl; int dest = -1;
            if (n < N) {
                if (mode == 0) dest = n;
                else if (mode == 1) dest = n < 2048 ? n : (n < 2056 ? -1 : n - 8);
                else if (mode == 2) dest = n < 3072 ? n : -1;
                else if (mode == 3) dest = 256 * (n >> 7) + (n & 127);
                else dest = 256 * (n >> 7) + 128 + (n & 127);
            }
            if (dest >= 0) { float o[8];
#pragma unroll
                for (int e = 0; e < 8; ++e) o[e] = tile[q * 4160 + (8 * kc + e) * 65 + nl];
                __builtin_nontemporal_store(pack8f(o), (u32x4*)(WT + (size_t)dest * K + k0 + 8 * kc)); } } }
        __syncthreads();
    }
}
__device__ __forceinline__ void convert_weights(CParams& p, unsigned char* shm, int l0, int l1, int bid, int nb) {
    float* tile = (float*)shm;
    for (int l = l0; l < l1; ++l) {
        const int i = l >> 1;
        if ((l & 1) == 0) {
            transpose_weight(p.in[10] + (size_t)i * DM * EVEN_IN, DM, EVEN_IN, (bf16_t*)(p.ws + WS_WINE) + (size_t)i * NE * DM, 1, tile, bid, nb);
            transpose_weight(p.in[16] + (size_t)i * DM * DM, DM, DM, (bf16_t*)(p.ws + WS_WOUTE) + (size_t)i * DM * DM, 0, tile, bid, nb);
        } else {
            transpose_weight(p.in[17] + (size_t)i * DM * ODD_IN, DM, ODD_IN, (bf16_t*)(p.ws + WS_WINO) + (size_t)i * NO * DM, 2, tile, bid, nb);
            transpose_weight(p.in[21] + (size_t)i * DM * DM, DM, DM, (bf16_t*)(p.ws + WS_WOUTO) + (size_t)i * DM * DM, 0, tile, bid, nb);
        }
        transpose_weight(p.in[22] + (size_t)l * DM * DFF, DM, DFF, (bf16_t*)(p.ws + WS_WF1) + (size_t)l * NF1 * DM, 3, tile, bid, nb);
        transpose_weight(p.in[23] + (size_t)l * DM * DFF, DM, DFF, (bf16_t*)(p.ws + WS_WF1) + (size_t)l * NF1 * DM, 4, tile, bid, nb);
        transpose_weight(p.in[24] + (size_t)l * DFF * DM, DFF, DM, (bf16_t*)(p.ws + WS_WF2) + (size_t)l * DM * DFF, 0, tile, bid, nb);
    }
}
__device__ __forceinline__ void phase_init(CParams& p, unsigned char* shm) {
    convert_weights(p, shm, 0, 1, (int)blockIdx.x, (int)gridDim.x);
}

template <int MODE>
__device__ __forceinline__ void phase_norm(CParams& p, int layer, unsigned char* shm, int nparts) {
    const int tid = otid(), lane = tid & 63, wid = tid >> 6, i = layer >> 1;
    float* Wsm = (float*)shm;
    const float* X = p.out;
    const bool from_in = (MODE == 0) && layer == 0;
    const float* Xp = from_in ? p.in[0] : X; const float* Xs = from_in ? p.in[1] - (size_t)MP * DM : X;
    bf16_t* H = (bf16_t*)(p.ws + WS_H);
    const float* gain = (MODE == 2 ? p.in[9] : p.in[8]) + layer * DM;
    if (MODE != 2) {
        const float* W = MODE == 0 ? p.in[10] + (size_t)i * DM * EVEN_IN + 2048 : p.in[17] + (size_t)i * DM * ODD_IN + 3072;
        const int ldw = MODE == 0 ? EVEN_IN : ODD_IN;
#pragma unroll
        for (int r = 0; r < 4; ++r) { const int q = tid + 512 * r, k = q >> 1, hf = q & 1;
            const f32x4 w = *(const f32x4*)(W + (size_t)k * ldw + 4 * hf);
            const int j = k >> 8, l = (k & 255) >> 2, e = k & 3;
            *(f32x4*)(Wsm + (((j * 4 + e) * 64 + l) * 8 + 4 * hf)) = w; }
        __syncthreads();
    }
    f32x4 g4[4];
#pragma unroll
    for (int j = 0; j < 4; ++j) g4[j] = *(const f32x4*)(gain + 256 * j + 4 * lane);
    constexpr int R = 3;
    const int stride = gridDim.x * 8;
    f32x4 nv[R][4];
    int row = blockIdx.x * 8 + wid;
#pragma unroll
    for (int r = 0; r < R; ++r) { const int rr = min(row + r * stride, MT - 1); const f32x4* xr = (const f32x4*)((rr < MP ? Xp : Xs) + (size_t)rr * DM) + lane;
#pragma unroll
        for (int j = 0; j < 4; ++j) nv[r][j] = xr[64 * j]; }
    for (; row < MT; row += R * stride) {
        f32x4 cv[R][4];
#pragma unroll
        for (int r = 0; r < R; ++r)
#pragma unroll
            for (int j = 0; j < 4; ++j) cv[r][j] = nv[r][j];
        if (row + R * stride < MT) {
#pragma unroll
            for (int r = 0; r < R; ++r) { const int rr = min(row + (R + r) * stride, MT - 1); const f32x4* xr = (const f32x4*)((rr < MP ? Xp : Xs) + (size_t)rr * DM) + lane;
#pragma unroll
                for (int j = 0; j < 4; ++j) nv[r][j] = xr[64 * j]; }
        }
#pragma unroll
        for (int r = 0; r < R; ++r) {
            const int crow_ = row + r * stride;
            if (crow_ < MT) {
                f32x4 v[4]; float ss = 0.f;
#pragma unroll
                for (int j = 0; j < 4; ++j) v[j] = cv[r][j];
                if (from_in) { f32x4* xw = (f32x4*)(p.out + (size_t)crow_ * DM) + lane;
#pragma unroll
                    for (int j = 0; j < 4; ++j) xw[64 * j] = v[j]; }
                if (crow_ >= MP && nparts > 0) {
                    const f32x4* sl = (const f32x4*)((const float*)(p.ws + WS_SLAB) + (size_t)(crow_ - MP) * DM) + lane;
                    for (int q0 = 0; q0 < nparts; q0 += 4) {
                        f32x4 tsl[4][4];
#pragma unroll
                        for (int q = 0; q < 4; ++q)
#pragma unroll
                            for (int j = 0; j < 4; ++j) tsl[q][j] = sl[(size_t)(q0 + q) * (MS * DM / 4) + 64 * j];
#pragma unroll
                        for (int q = 0; q < 4; ++q)
#pragma unroll
                            for (int j = 0; j < 4; ++j) v[j] += tsl[q][j]; }
                    f32x4* xw = (f32x4*)(p.out + (size_t)crow_ * DM) + lane;
#pragma unroll
                    for (int j = 0; j < 4; ++j) xw[64 * j] = v[j];
                }
#pragma unroll
                for (int j = 0; j < 4; ++j) ss += (v[j].x * v[j].x + v[j].y * v[j].y) + (v[j].z * v[j].z + v[j].w * v[j].w);
                ss = wave_sum(ss);
                const float rstd = 1.f / sqrtf(ss * (1.f / DM) + EPS);
                u32x2* ho = (u32x2*)(H + (size_t)crow_ * DM) + lane;
#pragma unroll
                for (int j = 0; j < 4; ++j) { v[j] = v[j] * rstd * g4[j]; u32x2 w; w.x = pk2(v[j].x, v[j].y); w.y = pk2(v[j].z, v[j].w); ho[64 * j] = w; }
                if (MODE != 2) {
                    float acc[8];
#pragma unroll
                    for (int c = 0; c < 8; ++c) acc[c] = 0.f;
#pragma unroll
                    for (int j = 0; j < 4; ++j)
#pragma unroll
                        for (int e = 0; e < 4; ++e) { const float hv = v[j][e]; const float* wp = Wsm + ((j * 4 + e) * 64 + lane) * 8;
                            const f32x4 w0 = *(const f32x4*)wp, w1 = *(const f32x4*)(wp + 4);
#pragma unroll
                            for (int c = 0; c < 4; ++c) { acc[c] = fmaf(hv, w0[c], acc[c]); acc[4 + c] = fmaf(hv, w1[c], acc[4 + c]); } }
#pragma unroll
                    for (int c = 0; c < 8; ++c) acc[c] = wave_sum(acc[c]);
                    if (MODE == 0) { if (lane == 0) { float* d = (float*)(p.ws + WS_AB) + (size_t)crow_ * 8;
                            *(f32x4*)d = (f32x4){acc[0], acc[1], acc[2], acc[3]}; *(f32x4*)(d + 4) = (f32x4){acc[4], acc[5], acc[6], acc[7]}; } }
                    else {
                        const int c8 = lane & 7;
                        float xs = acc[0];
#pragma unroll
                        for (int c = 1; c < 8; ++c) xs = (c8 == c) ? acc[c] : xs;
                        const float x = xs + p.in[18][i * 8 + c8];
                        const float lf = fminf(x, 0.f) - log1pf(expf(-fabsf(x)));
                        float* d = crow_ < MP ? p.out + OFF_PLF + ((size_t)i * MP + crow_) * 8 : p.out + OFF_SLF + ((size_t)i * MS + (crow_ - MP)) * 8;
                        if (lane < 8) d[lane] = lf; }
                }
            }
        }
    }
}

__device__ __forceinline__ void phase_fixup(CParams& p, int nparts) {
    const int tid = otid(), lane = tid & 63, wid = tid >> 6;
    if (nparts <= 0) return;
    for (int row = MP + blockIdx.x * 8 + wid; row < MT; row += gridDim.x * 8) {
        f32x4* xw = (f32x4*)(p.out + (size_t)row * DM) + lane;
        const f32x4* sl = (const f32x4*)((const float*)(p.ws + WS_SLAB) + (size_t)(row - MP) * DM) + lane;
        f32x4 v[4];
#pragma unroll
        for (int j = 0; j < 4; ++j) v[j] = xw[64 * j];
        for (int q0 = 0; q0 < nparts; q0 += 4) {
            f32x4 tsl[4][4];
#pragma unroll
            for (int q = 0; q < 4; ++q)
#pragma unroll
                for (int j = 0; j < 4; ++j) tsl[q][j] = sl[(size_t)(q0 + q) * (MS * DM / 4) + 64 * j];
#pragma unroll
            for (int q = 0; q < 4; ++q)
#pragma unroll
                for (int j = 0; j < 4; ++j) v[j] += tsl[q][j]; }
#pragma unroll
        for (int j = 0; j < 4; ++j) xw[64 * j] = v[j];
    }
}

__device__ __forceinline__ void phase_gdn_prep(CParams& p, int i, unsigned char* shm) {
    const int tid = otid(), lane = tid & 63, wid = tid >> 6;
    const int half = wid >> 2, w4 = wid & 3;
    const bf16_t* P = (const bf16_t*)(p.ws + WS_BIG);
    const float* AB = (const float*)(p.ws + WS_AB);
    const float* convw = p.in[11] + (size_t)i * 4 * 1536;
    unsigned char* hb = shm + half * 78336;
    bf16_t* qs = (bf16_t*)hb; bf16_t* ks = (bf16_t*)(hb + 17408); bf16_t* vs = (bf16_t*)(hb + 34816);
    float* As = (float*)(hb + 52224); float* Gs = (float*)(hb + 68608); float* Bs = Gs + 64;
    bf16_t* Ps = (bf16_t*)(hb + 69120);
    bf16_t* Wb = vs;
    bf16_t* NEGW = (bf16_t*)(p.ws + WS_NEGW); bf16_t* QG = (bf16_t*)(p.ws + WS_QG); bf16_t* KDT = (bf16_t*)(p.ws + WS_KDT);
    bf16_t* PM = (bf16_t*)(p.ws + WS_PM); bf16_t* UPRE = (bf16_t*)(p.ws + WS_UPRE); float* GC = (float*)(p.ws + WS_GC);
    for (int pr = blockIdx.x; pr < 576; pr += gridDim.x) {
        const int it = 2 * pr + half;
        int b, n, h, T0; bool sample;
        if (it < 1024) { b = it >> 8; n = (it >> 2) & 63; h = it & 3; T0 = b * 4096 + n * 64; sample = false; }
        else { const int j = it - 1024; b = j >> 2; h = j & 3; n = 0; T0 = MP + b * 64; sample = true; }
        const bool first = (n == 0), last = sample || (n == 63);
#ifndef PROBE_PREP_A
#define PROBE_PREP_A 1
#endif
#ifndef PROBE_PREP_D
#define PROBE_PREP_D 1
#endif
#pragma unroll 1
        for (int rr = 0; rr < 2 * PROBE_PREP_A; ++rr) {
            const int task = (otid() & 255) + 256 * (rr & 1);
            if (task < 384) {
                const int tseg = task / 48, cgi = task - tseg * 48, part = cgi >> 4, c8 = (cgi & 15) * 8, t0 = tseg * 8;
                const int col = part * 512 + h * 128 + c8;
                const bool edge = first && t0 == 0;
                u32x4 L[11];
#pragma unroll
                for (int k = 0; k < 11; ++k) { const int tt = t0 - 3 + k; const int rowc = (k < 3 && edge) ? T0 : T0 + tt; L[k] = *(const u32x4*)(P + (size_t)rowc * NE + col); }
                float w[4][8];
#pragma unroll
                for (int tap = 0; tap < 4; ++tap) { const float* wp = convw + tap * 1536 + col; const f32x4 w0 = *(const f32x4*)wp, w1 = *(const f32x4*)(wp + 4);
#pragma unroll
                    for (int e = 0; e < 4; ++e) { w[tap][e] = w0[e]; w[tap][4 + e] = w1[e]; } }
                bf16_t* dst0 = (part == 0 ? qs : (part == 1 ? ks : vs)) + t0 * 136 + c8;
                float xw[4][8];
#pragma unroll
                for (int k = 0; k < 11; ++k) {
                    float (&xv)[8] = xw[k & 3];
                    if (k < 3 && edge) {
                        if (sample) { const float* sp = p.in[6] + (((size_t)i * 32 + b) * 3 + k) * 1536 + col; const f32x4 a = *(const f32x4*)sp, c = *(const f32x4*)(sp + 4);
#pragma unroll
                            for (int e = 0; e < 4; ++e) { xv[e] = a[e]; xv[4 + e] = c[e]; } }
                        else {
#pragma unroll
                            for (int e = 0; e < 8; ++e) xv[e] = 0.f; }
                    } else unpack8(L[k], xv);
                    if (last && t0 == 56 && k >= 8) {
                        float* d = (sample ? p.out + OFF_SCONV + (((size_t)i * 32 + b) * 3 + (k - 8)) * 1536 : p.out + OFF_PCONV + (((size_t)i * 4 + b) * 3 + (k - 8)) * 1536) + col;
                        *(f32x4*)d = (f32x4){xv[0], xv[1], xv[2], xv[3]}; *(f32x4*)(d + 4) = (f32x4){xv[4], xv[5], xv[6], xv[7]}; }
                    if (k >= 3) {
                        const int j = k - 3; float y[8];
#pragma unroll
                        for (int e = 0; e < 8; ++e) y[e] = w[0][e] * xw[j & 3][e];
#pragma unroll
                        for (int tap = 1; tap < 4; ++tap)
#pragma unroll
                            for (int e = 0; e < 8; ++e) y[e] = fmaf(w[tap][e], xw[(j + tap) & 3][e], y[e]);
                        float ss = 0.f;
#pragma unroll
                        for (int e = 0; e < 8; ++e) { y[e] = silu_f(y[e]); ss = fmaf(y[e], y[e], ss); }
                        ss = grp16_sum(ss);
                        const float sc = part == 2 ? 1.f : __builtin_amdgcn_rsqf(ss + EPS) * (part == 0 ? 0.08838834764831845f : 1.f);
#pragma unroll
                        for (int e = 0; e < 8; ++e) y[e] *= sc;
                        *(u32x4*)(dst0 + j * 136) = pack8f(y); }
                }
            }
        }
        if (w4 == 0) {
            const float a = AB[(size_t)(T0 + lane) * 8 + h], bb = AB[(size_t)(T0 + lane) * 8 + 4 + h];
            const float x = a + p.in[13][i * 4 + h];
            const float sp = fmaxf(x, 0.f) + log1pf(expf(-fabsf(x)));
            float g = -expf(p.in[12][i * 4 + h]) * sp;
            g = wave_incl_scan(g, lane);
            Gs[lane] = g; Bs[lane] = 1.f / (1.f + expf(-bb));
        }
        LBAR();
        {
            const int type = w4 >> 1, bi = w4 & 1; const int ln_ = otid() & 63, r32 = ln_ & 31, hi = ln_ >> 5;
            const bf16_t* Xs = type ? qs : ks;
#pragma unroll 1
            for (int bj = 0; bj < 2; ++bj) {
                f32x16 acc = {};
#pragma unroll
                for (int kk = 0; kk < 8; ++kk) {
                    const bf16x8 a = *(const bf16x8*)(Xs + (32 * bi + r32) * 136 + kk * 16 + hi * 8);
                    const bf16x8 bq = *(const bf16x8*)(ks + (32 * bj + r32) * 136 + kk * 16 + hi * 8);
                    acc = __builtin_amdgcn_mfma_f32_32x32x16_bf16(a, bq, acc, 0, 0, 0);
                }
                const int j = 32 * bj + r32; const float Gj = Gs[j];
#pragma unroll
                for (int r = 0; r < 16; ++r) { const int ii = 32 * bi + crow32(r, hi); const float d = __expf(fminf(Gs[ii] - Gj, 0.f));
                    if (type == 0) As[ii * 64 + j] = (ii > j) ? acc[r] * Bs[ii] * d : 0.f;
                    else Ps[ii * 72 + pos16(j)] = f2bf((ii >= j) ? acc[r] * d : 0.f); }
            }
        }
        LBAR();
        if (w4 < 2) {
            typedef float f32x2_t __attribute__((ext_vector_type(2)));
            const int c = otid() & 127; f32x2_t sol[64];
#pragma unroll 1
            for (int rep_ = 0; rep_ < PROBE_PREP_D; ++rep_) {
#pragma unroll
            for (int r = 0; r < 64; ++r) { const float br = Bs[r]; sol[r] = (f32x2_t){bf2f(vs[r * 136 + c]) * br, bf2f(ks[r * 136 + c]) * br * __expf(Gs[r])}; }
#pragma unroll
            for (int r = 1; r < 64; ++r) { f32x2_t a = sol[r];
#pragma unroll
                for (int j = 0; j < r; ++j) { const float m = -As[r * 64 + j]; a = __builtin_elementwise_fma((f32x2_t){m, m}, sol[j], a); }
                sol[r] = a; }
            }
            { const int sl = c >> 5, cc = c & 31;
#pragma unroll
              for (int mb = 0; mb < 2; ++mb)
#pragma unroll
                  for (int rg = 0; rg < 2; ++rg)
#pragma unroll
                      for (int hh = 0; hh < 2; ++hh) { const int tb = 32 * mb + 16 * rg + 4 * hh;
                          u32x4 w = {pk2(sol[tb].x, sol[tb + 1].x), pk2(sol[tb + 2].x, sol[tb + 3].x), pk2(sol[tb + 8].x, sol[tb + 9].x), pk2(sol[tb + 10].x, sol[tb + 11].x)};
                          *(u32x4*)(UPRE + ((((size_t)it * 4 + sl) * 2 + mb) * 2 + rg) * 512 + (cc + 32 * hh) * 8) = w; } }
            LBAR();
            { const int pp = pos16(c);
#pragma unroll
              for (int r = 0; r < 64; ++r) Wb[r * 136 + pp] = f2bf(-sol[r].y); }
        } else {
            const int t2 = otid() & 127; const float GL = Gs[63];
#pragma unroll 2
            for (int r = 0; r < 8; ++r) { const int ch = t2 + 128 * r, row = ch >> 4, pc = ch & 15, dk0 = 16 * (pc >> 1) + 4 * (pc & 1);
                const float eg = __expf(Gs[row]); const bf16_t* s_ = qs + row * 136 + dk0; float v[8];
#pragma unroll
                for (int e = 0; e < 4; ++e) { v[e] = bf2f(s_[e]) * eg; v[4 + e] = bf2f(s_[8 + e]) * eg; }
                *(u32x4*)(QG + (size_t)it * 8192 + row * 128 + pc * 8) = pack8f(v); }
#pragma unroll 2
            for (int r = 0; r < 8; ++r) { const int ch = t2 + 128 * r, dk = ch & 127, pc = ch >> 7, t0 = 16 * (pc >> 1) + 4 * (pc & 1); float v[8];
#pragma unroll
                for (int e = 0; e < 8; ++e) { const int te = t0 + (e & 3) + 8 * (e >> 2); v[e] = bf2f(ks[te * 136 + dk]) * __expf(GL - Gs[te]); }
                *(u32x4*)(KDT + (size_t)it * 8192 + dk * 64 + pc * 8) = pack8f(v); }
            if (t2 == 0) GC[it] = __expf(GL);
#pragma unroll
            for (int r = 0; r < 4; ++r) { const int ch = t2 + 128 * r, row = ch >> 3, cc = ch & 7;
                *(u32x4*)(PM + (size_t)it * 4096 + row * 64 + cc * 8) = *(const u32x4*)(Ps + row * 72 + cc * 8); }
            LBAR();
        }
        LBAR();
        { const int t4 = otid() & 255;
#pragma unroll
          for (int r = 0; r < 4; ++r) { const int ch = t4 + 256 * r, row = ch >> 4, cc = ch & 15;
              *(u32x4*)(NEGW + (size_t)it * 8192 + row * 128 + cc * 8) = *(const u32x4*)(Wb + row * 136 + cc * 8); } }
        LBAR();
    }
}

constexpr int SC_NW = 0, SC_QG = 17408, SC_KD = 34816, SC_PM = 53248, SC_UP = 62464, SC_GC = 66560, SC_BUF = 66816, SC_OB = 2 * SC_BUF, SC_OBSZ = 64 * 80;
static_assert(SC_OB + 2 * SC_OBSZ <= LDS_BYTES - 16, "scan LDS");
__device__ __forceinline__ void phase_gdn_scan(CParams& p, int i, unsigned char* shm) {
    const int tid = otid(), lane = tid & 63, wid = tid >> 6, r32 = lane & 31, hi = lane >> 5;
    const u32x4* NEGW = (const u32x4*)(p.ws + WS_NEGW); const u32x4* QG = (const u32x4*)(p.ws + WS_QG); const u32x4* KDT = (const u32x4*)(p.ws + WS_KDT);
    const u32x4* PM = (const u32x4*)(p.ws + WS_PM); const u32x4* UPRE = (const u32x4*)(p.ws + WS_UPRE); const float* GC = (const float*)(p.ws + WS_GC);
    bf16_t* OG = (bf16_t*)(p.ws + WS_OG);
    const int nb = gridDim.x, bid = blockIdx.x;
    for (int it = bid; it < 576; it = (nb > 64 ? (it < 64 ? 576 : it + (nb - 64)) : it + nb)) {
        int b, h, sl, nsteps, ch0, chs, T0; bool sample;
        if (it < 64) { b = it >> 4; h = (it >> 2) & 3; sl = it & 3; nsteps = 64; ch0 = b * 256 + h; chs = 4; T0 = b * 4096; sample = false; }
        else { const int j = it - 64; b = j >> 4; h = (j >> 2) & 3; sl = j & 3; nsteps = 1; ch0 = 1024 + (j >> 2); chs = 0; T0 = MP + b * 64; sample = true; }
        if (wid >= 4) {
            const int t2 = tid - 256; u32x4 st[15]; float stg = 0.f;
#define SC_LOAD(chv) do { const size_t ch_ = (size_t)(chv); \
                _Pragma("unroll") for (int r = 0; r < 4; ++r) st[r] = NEGW[ch_ * 1024 + t2 + 256 * r]; \
                _Pragma("unroll") for (int r = 0; r < 4; ++r) st[4 + r] = QG[ch_ * 1024 + t2 + 256 * r]; \
                _Pragma("unroll") for (int r = 0; r < 4; ++r) st[8 + r] = KDT[ch_ * 1024 + t2 + 256 * r]; \
                _Pragma("unroll") for (int r = 0; r < 2; ++r) st[12 + r] = PM[ch_ * 512 + t2 + 256 * r]; \
                st[14] = UPRE[(ch_ * 4 + sl) * 256 + t2]; if (t2 == 0) stg = GC[ch_]; } while (0)
#define SC_WRITE(bufi) do { unsigned char* base = shm + (bufi) * SC_BUF; \
                _Pragma("unroll") for (int r = 0; r < 4; ++r) { const int q = t2 + 256 * r; *(u32x4*)(base + SC_NW + (q >> 4) * 272 + (q & 15) * 16) = st[r]; } \
                _Pragma("unroll") for (int r = 0; r < 4; ++r) { const int q = t2 + 256 * r; *(u32x4*)(base + SC_QG + (q >> 4) * 272 + (q & 15) * 16) = st[4 + r]; } \
                _Pragma("unroll") for (int r = 0; r < 4; ++r) { const int q = t2 + 256 * r; *(u32x4*)(base + SC_KD + (q >> 3) * 144 + (q & 7) * 16) = st[8 + r]; } \
                _Pragma("unroll") for (int r = 0; r < 2; ++r) { const int q = t2 + 256 * r; *(u32x4*)(base + SC_PM + (q >> 3) * 144 + (q & 7) * 16) = st[12 + r]; } \
                *(u32x4*)(base + SC_UP + t2 * 16) = st[14]; if (t2 == 0) *(float*)(base + SC_GC) = stg; } while (0)
            SC_LOAD(ch0); SC_WRITE(0);
            if (nsteps > 1) SC_LOAD(ch0 + chs);
            LBAR();
            for (int s = 0; s < nsteps; ++s) {
                if (s + 1 < nsteps) { SC_WRITE((s + 1) & 1); if (s + 2 < nsteps) SC_LOAD(ch0 + (s + 2) * chs); }
                LBAR();
            }
#undef SC_LOAD
#undef SC_WRITE
        } else if (wid == 0) {
            f32x16 S[4];
            if (sample) { const float* s0 = p.in[5] + ((((size_t)i * 32 + b) * 4 + h) << 14) + 32 * sl + r32;
#pragma unroll
                for (int mb = 0; mb < 4; ++mb)
#pragma unroll
                    for (int r = 0; r < 16; ++r) S[mb][r] = s0[(32 * mb + crow32(r, hi)) * 128];
            } else {
#pragma unroll
                for (int mb = 0; mb < 4; ++mb)
#pragma unroll
                    for (int r = 0; r < 16; ++r) S[mb][r] = 0.f;
            }
            LBAR();
            for (int s = 0; s < nsteps; ++s) {
                const unsigned char* B0 = shm + (s & 1) * SC_BUF;
                f32x16 u[2], o[2];
#pragma unroll
                for (int mb = 0; mb < 2; ++mb)
#pragma unroll
                    for (int rg = 0; rg < 2; ++rg) { const u32x4 w = *(const u32x4*)(B0 + SC_UP + ((mb * 2 + rg) * 64 + lane) * 16);
#pragma unroll
                        for (int q = 0; q < 4; ++q) { u[mb][8 * rg + 2 * q] = __uint_as_float(w[q] << 16); u[mb][8 * rg + 2 * q + 1] = __uint_as_float(w[q] & 0xffff0000u); } }
                const float gc = *(const float*)(B0 + SC_GC);
                const unsigned char* lrow = B0 + r32 * 272 + hi * 16;
                const unsigned char* srow = B0 + r32 * 144 + hi * 16;
#define RD4(dst, base) do { _Pragma("unroll") for (int kk = 0; kk < 4; ++kk) dst[kk] = *(const bf16x8*)((base) + kk * 32); SBAR(); } while (0)
#define MM4(accv, fr, bop, o_) do { _Pragma("unroll") for (int kk = 0; kk < 4; ++kk) accv = __builtin_amdgcn_mfma_f32_32x32x16_bf16(fr[kk], bop[(o_) + kk], accv, 0, 0, 0); } while (0)
                bf16x8 fa[4], fb[4];
                RD4(fa, lrow + SC_NW); RD4(fb, lrow + SC_NW + 128);
                bf16x8 Sb[8];
#pragma unroll
                for (int kk = 0; kk < 8; ++kk) { const int mb = kk >> 1, hf = kk & 1;
                    u32x4 w = {pk2(S[mb][8 * hf], S[mb][8 * hf + 1]), pk2(S[mb][8 * hf + 2], S[mb][8 * hf + 3]), pk2(S[mb][8 * hf + 4], S[mb][8 * hf + 5]), pk2(S[mb][8 * hf + 6], S[mb][8 * hf + 7])};
                    Sb[kk] = *reinterpret_cast<bf16x8*>(&w); }
#pragma unroll
                for (int mb = 0; mb < 2; ++mb)
#pragma unroll
                    for (int r = 0; r < 16; ++r) o[mb][r] = 0.f;
                MM4(u[0], fa, Sb, 0); RD4(fa, lrow + SC_QG);
                MM4(u[0], fb, Sb, 4); RD4(fb, lrow + SC_QG + 128);
                MM4(o[0], fa, Sb, 0); RD4(fa, lrow + SC_NW + 32 * 272);
                MM4(o[0], fb, Sb, 4); RD4(fb, lrow + SC_NW + 32 * 272 + 128);
                MM4(u[1], fa, Sb, 0); RD4(fa, lrow + SC_QG + 32 * 272);
                MM4(u[1], fb, Sb, 4); RD4(fb, lrow + SC_QG + 32 * 272 + 128);
                MM4(o[1], fa, Sb, 0); RD4(fa, srow + SC_PM);
                MM4(o[1], fb, Sb, 4); RD4(fb, srow + SC_PM + 32 * 144);
                bf16x8 ub[4];
#pragma unroll
                for (int kk = 0; kk < 4; ++kk) { const int mb = kk >> 1, hf = kk & 1;
                    u32x4 w = {pk2(u[mb][8 * hf], u[mb][8 * hf + 1]), pk2(u[mb][8 * hf + 2], u[mb][8 * hf + 3]), pk2(u[mb][8 * hf + 4], u[mb][8 * hf + 5]), pk2(u[mb][8 * hf + 6], u[mb][8 * hf + 7])};
                    ub[kk] = *reinterpret_cast<bf16x8*>(&w); }
#pragma unroll
                for (int mb = 0; mb < 4; ++mb)
#pragma unroll
                    for (int r = 0; r < 16; ++r) S[mb][r] *= gc;
                MM4(o[0], fa, ub, 0); RD4(fa, srow + SC_KD);
                MM4(o[1], fb, ub, 0); RD4(fb, srow + SC_KD + 32 * 144);
                MM4(S[0], fa, ub, 0); RD4(fa, srow + SC_KD + 64 * 144);
                MM4(S[1], fb, ub, 0); RD4(fb, srow + SC_KD + 96 * 144);
                MM4(S[2], fa, ub, 0);
                MM4(S[3], fb, ub, 0);
#undef RD4
#undef MM4
                { unsigned char* ob = shm + SC_OB + (s & 1) * SC_OBSZ + r32 * 2;
#pragma unroll
                  for (int mb = 0; mb < 2; ++mb)
#pragma unroll
                      for (int r = 0; r < 16; ++r) *(bf16_t*)(ob + (32 * mb + crow32(r, hi)) * 80) = f2bf(o[mb][r]); }
                LBAR();
            }
            float* so = (sample ? p.out + OFF_SS + ((((size_t)i * 32 + b) * 4 + h) << 14) : p.out + OFF_PS + ((((size_t)i * 4 + b) * 4 + h) << 14)) + 32 * sl + r32;
#pragma unroll
            for (int mb = 0; mb < 4; ++mb)
#pragma unroll
                for (int r = 0; r < 16; ++r) so[(32 * mb + crow32(r, hi)) * 128] = S[mb][r];
        } else if (wid == 1) {
            LBAR();
            for (int s = 0; s <= nsteps; ++s) {
                if (s >= 1) { const unsigned char* ob = shm + SC_OB + ((s - 1) & 1) * SC_OBSZ;
#pragma unroll
                    for (int k = 0; k < 4; ++k) { const int q = lane + 64 * k, row = q >> 2, cc = q & 3;
                        *(u32x4*)(OG + (size_t)(T0 + 64 * (s - 1) + row) * 512 + h * 128 + 32 * sl + 8 * cc) = *(const u32x4*)(ob + row * 80 + cc * 16); } }
                if (s < nsteps) LBAR();
            }
        } else {
            LBAR();
            for (int s = 0; s < nsteps; ++s) LBAR();
        }
        LBAR();
    }
}

template <int PARTS>
__device__ __forceinline__ void phase_gdn_post(CParams& p, int i, int bid, int nb) {
    const int tid = otid(), lane = tid & 63, wid = tid >> 6;
    const bf16_t* P = (const bf16_t*)(p.ws + WS_BIG); const bf16_t* OG = (const bf16_t*)(p.ws + WS_OG); bf16_t* CAT = (bf16_t*)(p.ws + WS_CAT);
    float ng[8], w0[8], w1[8], w2[8];
    { const float* g = p.in[14] + i * 128 + ((8 * lane) & 127); const float* w = p.in[15] + (size_t)i * 3 * 512 + 8 * lane;
#pragma unroll
      for (int e = 0; e < 8; ++e) { ng[e] = g[e]; w0[e] = w[e]; w1[e] = w[512 + e]; w2[e] = w[1024 + e]; } }
    const int stride = nb * 8;
    for (int row0 = bid * 8 + wid; row0 < MT; row0 += 2 * stride) {
        u32x4 L[2][9]; int rows[2]; rows[0] = row0; rows[1] = row0 + stride < MT ? row0 + stride : row0;
#pragma unroll
        for (int q = 0; q < 2; ++q) { const int row = rows[q]; const bf16_t* pr = P + (size_t)row * NE + 8 * lane;
            const int t = row < MP ? (row & 4095) : ((row - MP) & 63);
            if (PARTS & 1) { L[q][0] = *(const u32x4*)(OG + (size_t)row * 512 + 8 * lane); L[q][1] = *(const u32x4*)(pr + 1536); }
            if (PARTS & 2) {
                L[q][2] = *(const u32x4*)(pr + 2048); L[q][3] = *(const u32x4*)(pr + 2560); L[q][4] = *(const u32x4*)(pr + 3072);
                const bf16_t* p1 = t >= 1 ? pr - NE : pr; const bf16_t* p2 = t >= 2 ? pr - 2 * NE : pr;
                L[q][5] = *(const u32x4*)(p1 + 2560); L[q][6] = *(const u32x4*)(p1 + 3072); L[q][7] = *(const u32x4*)(p2 + 2560); L[q][8] = *(const u32x4*)(p2 + 3072); } }
#pragma unroll
        for (int q = 0; q < 2; ++q) {
            const int row = rows[q];
            if (q == 1 && row0 + stride >= MT) break;
            if (PARTS & 1) { float ov[8], zv[8], r[8]; unpack8(L[q][0], ov); unpack8(L[q][1], zv);
              float ss = 0.f;
#pragma unroll
              for (int e = 0; e < 8; ++e) ss = fmaf(ov[e], ov[e], ss);
              ss = grp16_sum(ss);
              const float rms = 1.f / sqrtf(ss * (1.f / 128.f) + EPS);
#pragma unroll
              for (int e = 0; e < 8; ++e) r[e] = ov[e] * rms * ng[e] * silu_f(zv[e]);
              *(u32x4*)(CAT + (size_t)row * DM + 8 * lane) = pack8f(r); }
            if (PARTS & 2) {
            int b, t, T; bool sample;
            if (row < MP) { b = row >> 12; t = row & 4095; T = 4096; sample = false; } else { const int r2 = row - MP; b = r2 >> 6; t = r2 & 63; T = 64; sample = true; }
            float gb[8], gc[8], hn[8], u0[8], u1[8], u2[8], r[8];
            unpack8(L[q][2], gb); unpack8(L[q][3], gc); unpack8(L[q][4], hn);
#pragma unroll
            for (int e = 0; e < 8; ++e) u0[e] = gc[e] * hn[e];
            const float* st = p.in[7] + ((size_t)i * 32 + b) * 2 * 512 + 8 * lane;
            if (t >= 1) { unpack8(L[q][5], gc); unpack8(L[q][6], hn);
#pragma unroll
                for (int e = 0; e < 8; ++e) u1[e] = gc[e] * hn[e]; }
            else {
#pragma unroll
                for (int e = 0; e < 8; ++e) u1[e] = sample ? st[512 + e] : 0.f; }
            if (t >= 2) { unpack8(L[q][7], gc); unpack8(L[q][8], hn);
#pragma unroll
                for (int e = 0; e < 8; ++e) u2[e] = gc[e] * hn[e]; }
            else {
#pragma unroll
                for (int e = 0; e < 8; ++e) u2[e] = sample ? st[t * 512 + e] : 0.f; }
#pragma unroll
            for (int e = 0; e < 8; ++e) r[e] = gb[e] * (w0[e] * u2[e] + w1[e] * u1[e] + w2[e] * u0[e]);
            *(u32x4*)(CAT + (size_t)row * DM + 512 + 8 * lane) = pack8f(r);
            if (t >= T - 2) { float* d = (sample ? p.out + OFF_SSC + (((size_t)i * 32 + b) * 2 + (t - (T - 2))) * 512 : p.out + OFF_PSC + (((size_t)i * 4 + b) * 2 + (t - (T - 2))) * 512) + 8 * lane;
                *(f32x4*)d = (f32x4){u0[0], u0[1], u0[2], u0[3]}; *(f32x4*)(d + 4) = (f32x4){u0[4], u0[5], u0[6], u0[7]}; }
            }
        }
    }
}

__device__ __forceinline__ void phase_fox_prep(CParams& p, int i) {
    const int tid = otid(), lane = tid & 63, wid = tid >> 6;
    const bf16_t* R = (const bf16_t*)(p.ws + WS_BIG);
    bf16_t* QP = (bf16_t*)(p.ws + WS_QP); bf16_t* KP = (bf16_t*)(p.ws + WS_KP); bf16_t* VP = (bf16_t*)(p.ws + WS_VP);
    bf16_t* QS = (bf16_t*)(p.ws + WS_QS); bf16_t* KS = (bf16_t*)(p.ws + WS_KS); bf16_t* VS = (bf16_t*)(p.ws + WS_VS);
    for (int task = blockIdx.x + gridDim.x * wid; task < 288; task += gridDim.x * 8) {
        const float* src0; const float* src1; int len, n0; float* dst;
        if (task < 32) { const int bb = task >> 3, hh = task & 7; src0 = p.out + OFF_PLF + ((size_t)i * MP + (size_t)bb * 4096) * 8 + hh; src1 = src0; len = 4096; n0 = 4096; dst = (float*)(p.ws + WS_NCP) + task * 4096; }
        else { const int j = task - 32, bb = j >> 3, hh = j & 7; src0 = p.in[4] + ((size_t)i * 32 + bb) * 1024 * 8 + hh; src1 = p.out + OFF_SLF + ((size_t)i * MS + (size_t)bb * 64) * 8 + hh - (size_t)1024 * 8; len = 1088; n0 = 1024; dst = (float*)(p.ws + WS_NCS) + j * 1088; }
        float carry = 0.f;
        for (int s0 = 0; s0 < len; s0 += 512) {
            float v[8];
#pragma unroll
            for (int q = 0; q < 8; ++q) { const int s = s0 + 64 * q + lane; v[q] = s < len ? (s < n0 ? src0[(size_t)s * 8] : src1[(size_t)s * 8]) : 0.f; }
#pragma unroll
            for (int q = 0; q < 8; ++q) { const int s = s0 + 64 * q + lane; float x = wave_incl_scan(v[q], lane) + carry;
                if (s < len) dst[s] = -x * 11.313708498984761f;
                carry = __shfl(x, 63); }
        }
    }
    float qg[8], kg[8];
    { const float* a = p.in[19] + i * 128 + ((8 * lane) & 127); const float* c = p.in[20] + i * 128 + ((8 * lane) & 127);
#pragma unroll
      for (int e = 0; e < 8; ++e) { qg[e] = a[e]; kg[e] = c[e]; } }
    const int stride = gridDim.x * 8;
    for (int row0 = blockIdx.x * 8 + wid; row0 < MT; row0 += 2 * stride) {
        u32x4 L[2][6]; int rows[2]; rows[0] = row0; rows[1] = row0 + stride < MT ? row0 + stride : row0;
#pragma unroll
        for (int q = 0; q < 2; ++q) { const bf16_t* rr = R + (size_t)rows[q] * NO + 8 * lane;
#pragma unroll
            for (int hf = 0; hf < 2; ++hf) { L[q][hf * 3] = *(const u32x4*)(rr + hf * 512); L[q][hf * 3 + 1] = *(const u32x4*)(rr + 1024 + hf * 512); L[q][hf * 3 + 2] = *(const u32x4*)(rr + 2048 + hf * 512); } }
#pragma unroll
        for (int q = 0; q < 2; ++q) {
            const int row = rows[q];
            if (q == 1 && row0 + stride >= MT) break;
            float* fK; float* fV; size_t qbase, kbase; int qstr, kstr; bf16_t* Qd; bf16_t* Kd; bf16_t* Vd;
            if (row < MP) { const int bb = row >> 12, s_ = row & 4095; fK = p.out + OFF_PK + ((size_t)i * MP + row) * 1024; fV = p.out + OFF_PV + ((size_t)i * MP + row) * 1024;
                Qd = QP; Kd = KP; Vd = VP; qstr = 4096; kstr = 4096; qbase = (size_t)bb * 8 * 4096 + s_; kbase = qbase; }
            else { const int r2 = row - MP, bb = r2 >> 6, s_ = r2 & 63; fK = p.out + OFF_SK + ((size_t)i * MS + r2) * 1024; fV = p.out + OFF_SV + ((size_t)i * MS + r2) * 1024;
                Qd = nullptr; Kd = nullptr; Vd = nullptr; qstr = 64; kstr = 0; qbase = (size_t)bb * 8 * 64 + s_; kbase = 0; }
            const bool smp = row >= MP;
#pragma unroll
            for (int hf = 0; hf < 2; ++hf) {
                const int col = hf * 512 + 8 * lane, hh = col >> 7, d = col & 127;
                float x[8], r[8]; float ss;
                unpack8(L[q][hf * 3], x); ss = 0.f;
#pragma unroll
                for (int e = 0; e < 8; ++e) ss = fmaf(x[e], x[e], ss);
                ss = grp16_sum(ss); { const float rms = 1.f / sqrtf(ss * (1.f / 128.f) + EPS);
#pragma unroll
                  for (int e = 0; e < 8; ++e) r[e] = x[e] * rms * qg[e]; }
                if (smp) { float* qd = (float*)(p.ws + WS_KS) + (qbase + (size_t)hh * qstr) * 128 + d;
                    *(f32x4*)qd = (f32x4){r[0], r[1], r[2], r[3]}; *(f32x4*)(qd + 4) = (f32x4){r[4], r[5], r[6], r[7]}; }
                else *(u32x4*)(Qd + (qbase + (size_t)hh * qstr) * 128 + d) = pack8f(r);
                unpack8(L[q][hf * 3 + 1], x); ss = 0.f;
#pragma unroll
                for (int e = 0; e < 8; ++e) ss = fmaf(x[e], x[e], ss);
                ss = grp16_sum(ss); { const float rms = 1.f / sqrtf(ss * (1.f / 128.f) + EPS);
#pragma unroll
                  for (int e = 0; e < 8; ++e) r[e] = x[e] * rms * kg[e]; }
                __builtin_nontemporal_store((f32x4){r[0], r[1], r[2], r[3]}, (f32x4*)(fK + col)); __builtin_nontemporal_store((f32x4){r[4], r[5], r[6], r[7]}, (f32x4*)(fK + col + 4));
                if (!smp) *(u32x4*)(Kd + (kbase + (size_t)hh * kstr) * 128 + d) = pack8f(r);
                const u32x4 vw = L[q][hf * 3 + 2]; unpack8(vw, x);
                __builtin_nontemporal_store((f32x4){x[0], x[1], x[2], x[3]}, (f32x4*)(fV + col)); __builtin_nontemporal_store((f32x4){x[4], x[5], x[6], x[7]}, (f32x4*)(fV + col + 4));
                if (!smp) *(u32x4*)(Vd + (kbase + (size_t)hh * kstr) * 128 + d) = vw;
            }
        }
    }
}

typedef fa::BlockRef<bf16_t, bf16_t> FaRef;
typedef fa::BlockRef<float, bf16_t> FaRefS;
__device__ __forceinline__ FaRef fox_ref(CParams& p, int g, int k) {
    FaRef r;
    const int xcd = g & 7, j = g >> 3, bh = 4 * xcd + (j >> 3), x = j & 7, bb = bh >> 3, hh = bh & 7, blk = k ? 15 - x : x;
    r.Q = (const bf16_t*)(p.ws + WS_QP) + ((size_t)bh * 4096 + 256 * blk) * 128; r.K = (const bf16_t*)(p.ws + WS_KP) + (size_t)bh * 4096 * 128; r.V = (const bf16_t*)(p.ws + WS_VP) + (size_t)bh * 4096 * 128;
    r.K2 = r.K; r.V2 = r.V;
    r.O = (bf16_t*)(p.ws + WS_CAT) + ((size_t)bb * 4096 + 256 * blk) * 1024 + hh * 128; r.NC = (const float*)(p.ws + WS_NCP) + (size_t)bh * 4096; r.P0 = 256 * blk; r.nrows = 256;
    return r;
}
__device__ __forceinline__ FaRefS fox_ref_s(CParams& p, int i, int g) {
    FaRefS r; const int bh = g, bb = g >> 3, hh = g & 7;
    r.Q = (const float*)(p.ws + WS_KS) + (size_t)bh * 64 * 128;
    r.K = p.in[2] + ((size_t)i * 32 + bb) * 1024 * 1024 + hh * 128; r.V = p.in[3] + ((size_t)i * 32 + bb) * 1024 * 1024 + hh * 128;
    r.K2 = p.out + OFF_SK + ((size_t)i * MS + bb * 64) * 1024 + hh * 128 - (size_t)1024 * 1024; r.V2 = p.out + OFF_SV + ((size_t)i * MS + bb * 64) * 1024 + hh * 128 - (size_t)1024 * 1024;
    r.O = (bf16_t*)(p.ws + WS_CAT) + ((size_t)MP + bb * 64) * 1024 + hh * 128; r.NC = (const float*)(p.ws + WS_NCS) + (size_t)bh * 1088; r.P0 = 1024; r.nrows = 64;
    return r;
}
__device__ __forceinline__ void phase_fox_attn(CParams& p, int i, unsigned char* shm) {
    constexpr int W = 1 << 20;
    for (int g = blockIdx.x; g < 256; g += gridDim.x) {
#pragma unroll 1
        for (int k = 0; k < 2; ++k) {
            int kk = k; asm volatile("" : "+s"(kk));
            fa::Seam<bf16_t> S;
            const FaRef cur = fox_ref(p, g, kk);
            fa::causal_swa_prime<bf16_t, bf16_t>(cur, W, (char*)shm, S);
            fa::causal_swa_block<bf16_t, bf16_t>(cur, cur, 4096, W, (char*)shm, S);
        }
        { fa::Seam<float> S;
          const FaRefS cur = fox_ref_s(p, i, g);
          fa::causal_swa_prime<float, bf16_t>(cur, W, (char*)shm, S);
          fa::causal_swa_block<float, bf16_t>(cur, cur, 1088, W, (char*)shm, S); }
    }
}

__device__ __forceinline__ CParams* kparams() {
    CParams* k = (CParams*)__builtin_amdgcn_kernarg_segment_ptr(); asm volatile("" : "+s"(k)); return k;
}
__global__ __launch_bounds__(512, 2) void mega_fwd(Params p_unused) {
    extern __shared__ __attribute__((aligned(16))) unsigned char shm[];
    cg::grid_group grid = cg::this_grid();
    PG8_LAS unsigned char* lds = (PG8_LAS unsigned char*)shm;
    int ph = 0;
#ifndef PROBE_REP
#define PROBE_REP 0
#endif
#define GSYNC() do { XcdBarrier xb_; xb_.bar = (unsigned*)(kparams()->ws + WS_BAR); xb_.x = xb_xcc_id(); xb_.st = (volatile XB_LAS unsigned*)(lds + LDS_XB); xcd_barrier(xb_); } while (0)
#if PROBE_REP
#define PHASE(kind, ...) do { CParams& p = *kparams(); if (ph >= p.ph_lo && ph < p.ph_hi) { int nrep = 1 + ((PROBE_REP >> (kind)) & 1); asm volatile("" : "+s"(nrep)); \
        for (int rep = 0; rep < nrep; ++rep) { __VA_ARGS__; if (rep + 1 < nrep || ph + 1 < p.ph_hi) GSYNC(); } } ++ph; } while (0)
#else
#define PHASE(kind, ...) do { CParams& p = *kparams(); if (ph >= p.ph_lo && ph < p.ph_hi) { __VA_ARGS__; if (ph + 1 < p.ph_hi) GSYNC(); } ++ph; } while (0)
#endif
    if (otid() == 0) { *(volatile XB_LAS unsigned*)(lds + LDS_XB) = 0u; *(volatile XB_LAS unsigned*)(lds + LDS_XB + 4) = 0u; }
    __syncthreads();
    (void)xcd_barrier_post((unsigned*)(kparams()->ws + WS_BAR), (volatile XB_LAS unsigned*)(lds + LDS_XB));
    if (kparams()->ph_hi - kparams()->ph_lo > 1) grid.sync();
    PHASE(0, phase_init(p, shm));
#pragma unroll 1
    for (int layer = 0; layer < 4; ++layer) {
        const int i = layer >> 1; const bool even = (layer & 1) == 0;
        if (even) PHASE(1, phase_norm<0>(p, layer, shm, layer ? tail_parts(DFF, (int)gridDim.x) : 0)); else PHASE(1, phase_norm<1>(p, layer, shm, tail_parts(DFF, (int)gridDim.x)));
        PHASE(2, const bf16_t* Bt = even ? (const bf16_t*)(p.ws + WS_WINE) + (size_t)i * NE * DM : (const bf16_t*)(p.ws + WS_WINO) + (size_t)i * NO * DM;
              EpiBf16Plain E; E.O = (bf16_t*)(p.ws + WS_BIG); E.ldc = even ? NE : NO;
              run_gemm(lds, (const bf16_t*)(p.ws + WS_H), Bt, even ? NE : NO, DM, E));
        if (even) { PHASE(3, phase_gdn_prep(p, i, shm));
                    PHASE(4, phase_gdn_scan(p, i, shm); __syncthreads();
                             if (gridDim.x > 64) { if (blockIdx.x >= 64) { if (layer == 0) convert_weights(p, shm, 1, 4, (int)blockIdx.x - 64, (int)gridDim.x - 64);
                                                                           phase_gdn_post<2>(p, i, (int)blockIdx.x - 64, (int)gridDim.x - 64); } }
                             else { if (layer == 0) convert_weights(p, shm, 1, 4, (int)blockIdx.x, (int)gridDim.x); phase_gdn_post<2>(p, i, (int)blockIdx.x, (int)gridDim.x); });
                    PHASE(5, phase_gdn_post<1>(p, i, (int)blockIdx.x, (int)gridDim.x)); }
        else { PHASE(6, phase_fox_prep(p, i)); PHASE(7, phase_fox_attn(p, i, shm)); }
        PHASE(31, const bf16_t* Bt = even ? (const bf16_t*)(p.ws + WS_WOUTE) + (size_t)i * DM * DM : (const bf16_t*)(p.ws + WS_WOUTO) + (size_t)i * DM * DM;
              EpiResid E; E.X = p.out; E.ldc = DM; E.slab = (float*)(p.ws + WS_SLAB);
              run_gemm_n1024(lds, (const bf16_t*)(p.ws + WS_CAT), Bt, DM, E));
        PHASE(1, phase_norm<2>(p, layer, shm, tail_parts(DM, (int)gridDim.x)));
        PHASE(9, EpiSwiglu E; E.O = (bf16_t*)(p.ws + WS_BIG); E.ldc = DFF;
              run_gemm(lds, (const bf16_t*)(p.ws + WS_H), (const bf16_t*)(p.ws + WS_WF1) + (size_t)layer * NF1 * DM, NF1, DM, E));
        PHASE(31, EpiResid E; E.X = p.out; E.ldc = DM; E.slab = (float*)(p.ws + WS_SLAB);
              run_gemm_n1024(lds, (const bf16_t*)(p.ws + WS_BIG), (const bf16_t*)(p.ws + WS_WF2) + (size_t)layer * DM * DFF, DFF, E));
    }
    PHASE(1, phase_fixup(p, tail_parts(DFF, (int)gridDim.x)));
#undef PHASE
}
constexpr int N_PHASES = 1 + 2 * 9 + 2 * 8 + 1;

#ifndef MK_PER_PHASE
#define MK_PER_PHASE 0
#endif
extern "C" void kernel_launch(void* const* d_in, const int* in_sizes, int n_in, void* d_out, int out_size, void* d_ws, size_t ws_size, hipStream_t stream) {
    static int grid = 0;
    if (grid == 0) {
        if (n_in != 25 || (size_t)out_size != OUT_TOTAL || ws_size < WS_END) { fprintf(stderr, "kernel_launch: unexpected shapes (n_in %d, out %d, ws %zu < %zu)\n", n_in, out_size, ws_size, (size_t)WS_END); grid = -1; return; }
        int dev = 0, cus = 0, per_cu = 0;
        (void)hipGetDevice(&dev); (void)hipDeviceGetAttribute(&cus, hipDeviceAttributeMultiprocessorCount, dev);
        if (hipFuncSetAttribute((const void*)mega_fwd, hipFuncAttributeMaxDynamicSharedMemorySize, LDS_BYTES) != hipSuccess) { fprintf(stderr, "kernel_launch: hipFuncSetAttribute failed\n"); grid = -1; return; }
        if (hipOccupancyMaxActiveBlocksPerMultiprocessor(&per_cu, (const void*)mega_fwd, 512, LDS_BYTES) != hipSuccess || per_cu < 1) { fprintf(stderr, "kernel_launch: occupancy query says %d\n", per_cu); per_cu = 1; }
        (void)hipGetLastError();
        if (cus <= 0) cus = 256;
        grid = cus * 1;
    }
    if (grid < 0) return;
    (void)hipMemsetAsync((unsigned char*)d_ws + WS_BAR, 0, 16384, stream);
    Params p{};
    for (int k = 0; k < 25; ++k) p.in[k] = (const float*)d_in[k];
    p.out = (float*)d_out; p.ws = (unsigned char*)d_ws;
#if MK_PER_PHASE
    for (int ph = 0; ph < N_PHASES; ++ph) { p.ph_lo = ph; p.ph_hi = ph + 1; hipLaunchKernelGGL(mega_fwd, dim3(grid), dim3(512), LDS_BYTES, stream, p); }
#else
    p.ph_lo = 0; p.ph_hi = N_PHASES;
    void* args[] = {&p};
    hipError_t e = hipLaunchCooperativeKernel((const void*)mega_fwd, dim3(grid), dim3(512), args, LDS_BYTES, stream);
    if (e != hipSuccess) fprintf(stderr, "kernel_launch: cooperative launch failed: %s (grid %d)\n", hipGetErrorString(e), grid);
#endif
}
```
